# Optimizing an MI355X kernel written in HIP

```python
import math
import jax, jax.numpy as jnp
from jax import lax
import numpy as np

D_MODEL = 1024
BATCH = 8
SEQ = 4096
DEPTH = 1

MIX_WIDTH = D_MODEL
MLA_WIDTH = MIX_WIDTH // 2
RET_WIDTH = MIX_WIDTH - MLA_WIDTH
MLA_HEADS = 4
MLA_NOPE_DIM = 128
MLA_ROPE_DIM = 64
MLA_QK_DIM = MLA_NOPE_DIM + MLA_ROPE_DIM
MLA_V_DIM = MLA_WIDTH // MLA_HEADS
MLA_Q_RANK = 256
MLA_KV_RANK = 128
Q_BLOCK = 128
RET_HEADS = 4
RET_HEAD_DIM = RET_WIDTH // RET_HEADS
RET_CHUNK = 128
MEM_TOKENS = 256
CROSS_HEADS = 4
CROSS_HEAD_DIM = D_MODEL // CROSS_HEADS
N_GROUPS = 4
EXPERTS_PER_GROUP = 8
N_EXPERTS = N_GROUPS * EXPERTS_PER_GROUP
TOP_K = 2
EXPERT_FF = 256
ROPE_BASE = 10000.0
EPS = 1e-6
NEG_INF = -1e30
IN_SPLITS = (MLA_Q_RANK, MLA_KV_RANK, MLA_ROPE_DIM, RET_WIDTH, RET_WIDTH, RET_WIDTH, RET_WIDTH)
IN_COLS = sum(IN_SPLITS)

kernel_name = 'hybrid_mla_retention_hmoe_block'


def rms_norm(x, g):
    xf = x.astype(jnp.float32)
    y = xf * lax.rsqrt(jnp.mean(xf * xf, axis=-1, keepdims=True) + EPS)
    return (y * g.astype(jnp.float32)).astype(x.dtype)


def rope(x, positions):
    half = x.shape[-1] // 2
    inv_freq = ROPE_BASE ** (-jnp.arange(half, dtype=jnp.float32) / half)
    ang = positions.astype(jnp.float32)[:, :, None] * inv_freq
    cos = jnp.cos(ang)[:, :, None, :]
    sin = jnp.sin(ang)[:, :, None, :]
    xf = x.astype(jnp.float32)
    x1, x2 = xf[..., :half], xf[..., half:]
    return jnp.concatenate([x1 * cos - x2 * sin, x2 * cos + x1 * sin], axis=-1).astype(x.dtype)


def causal_block_attention(q, k, v):
    B, S, H, dq = q.shape
    dv = v.shape[-1]
    nb = S // Q_BLOCK
    scale = dq ** -0.5
    qb = q.reshape(B, nb, Q_BLOCK, H, dq).transpose(1, 0, 2, 3, 4)
    k_idx = jnp.arange(S)

    def one_block(args):
        q_blk, b = args
        s = jnp.einsum('bqhd,bkhd->bhqk', q_blk, k, preferred_element_type=jnp.float32) * scale
        q_idx = b * Q_BLOCK + jnp.arange(Q_BLOCK)
        s = jnp.where(k_idx[None, :] <= q_idx[:, None], s, NEG_INF)
        p = jax.nn.softmax(s, axis=-1).astype(v.dtype)
        return jnp.einsum('bhqk,bkhd->bqhd', p, v)

    out = lax.map(one_block, (qb, jnp.arange(nb)))
    return out.transpose(1, 0, 2, 3, 4).reshape(B, S, H, dv)


def retention_chunkwise(q, k, v):
    B, S, H, dk = q.shape
    dv = v.shape[-1]
    nc = S // RET_CHUNK

    def to_chunks(t):
        return t.astype(jnp.float32).reshape(B, nc, RET_CHUNK, H, t.shape[-1]).transpose(1, 0, 3, 2, 4)

    lg = jnp.log(1.0 - jnp.exp2(-5.0 - jnp.arange(H, dtype=jnp.float32)))
    idx = jnp.arange(RET_CHUNK, dtype=jnp.float32)
    diff = idx[:, None] - idx[None, :]
    intra = jnp.where(diff >= 0, jnp.exp(jnp.maximum(diff, 0.0)[None] * lg[:, None, None]), 0.0)
    q_decay = jnp.exp((idx + 1.0)[None] * lg[:, None])[:, :, None]
    k_decay = jnp.exp((RET_CHUNK - 1.0 - idx)[None] * lg[:, None])[:, :, None]
    chunk_decay = jnp.exp(RET_CHUNK * lg)[:, None, None]

    def step(state, qkv):
        qc, kc, vc = qkv
        scores = jnp.einsum('bhid,bhjd->bhij', qc, kc) * intra
        o = (jnp.einsum('bhij,bhjv->bhiv', scores, vc)
             + jnp.einsum('bhid,bhdv->bhiv', qc * q_decay, state))
        state = state * chunk_decay + jnp.einsum('bhjd,bhjv->bhdv', kc * k_decay, vc)
        return state, o

    state0 = jnp.zeros((B, H, dk, dv), jnp.float32)
    _, o = lax.scan(step, state0, (to_chunks(q), to_chunks(k), to_chunks(v)))
    return o.transpose(1, 0, 3, 2, 4).reshape(B, S, H, dv)


def mla_group(c_q, c_kv, k_pe, positions, q_norm_g, w_uq, kv_norm_g, w_ukv, q_qk_g, k_qk_g):
    B, S, _ = c_q.shape
    q = (rms_norm(c_q, q_norm_g) @ w_uq).reshape(B, S, MLA_HEADS, MLA_QK_DIM)
    kv = (rms_norm(c_kv, kv_norm_g) @ w_ukv).reshape(B, S, MLA_HEADS, MLA_NOPE_DIM + MLA_V_DIM)
    k_nope, v = kv[..., :MLA_NOPE_DIM], kv[..., MLA_NOPE_DIM:]
    k_rope = jnp.broadcast_to(k_pe[:, :, None, :], (B, S, MLA_HEADS, MLA_ROPE_DIM))
    k = jnp.concatenate([k_nope, k_rope], axis=-1)
    q = rms_norm(q, q_qk_g)
    k = rms_norm(k, k_qk_g)
    q = jnp.concatenate([q[..., :MLA_NOPE_DIM], rope(q[..., MLA_NOPE_DIM:], positions)], axis=-1)
    k = jnp.concatenate([k[..., :MLA_NOPE_DIM], rope(k[..., MLA_NOPE_DIM:], positions)], axis=-1)
    o = causal_block_attention(q, k, v)
    return o.reshape(B, S, MLA_WIDTH)


def retention_group(rq, rk, rv, rg, positions, gn_g):
    B, S, _ = rq.shape
    q = rope(rq.reshape(B, S, RET_HEADS, RET_HEAD_DIM), positions)
    k = rope(rk.reshape(B, S, RET_HEADS, RET_HEAD_DIM), positions) * (RET_HEAD_DIM ** -0.5)
    v = rv.reshape(B, S, RET_HEADS, RET_HEAD_DIM)
    o = retention_chunkwise(q, k, v)
    mu = jnp.mean(o, axis=-1, keepdims=True)
    var = jnp.mean(jnp.square(o - mu), axis=-1, keepdims=True)
    o = ((o - mu) * lax.rsqrt(var + EPS)).reshape(B, S, RET_WIDTH) * gn_g.astype(jnp.float32)
    return (o * jax.nn.silu(rg.astype(jnp.float32))).astype(rq.dtype)


def memory_cross_attention(h, m, w_q, w_kv, q_qk_g, k_qk_g, w_o):
    B, S, _ = h.shape
    M = m.shape[1]
    q = rms_norm((h @ w_q).reshape(B, S, CROSS_HEADS, CROSS_HEAD_DIM), q_qk_g)
    kv = m @ w_kv
    k = rms_norm(kv[..., :D_MODEL].reshape(B, M, CROSS_HEADS, CROSS_HEAD_DIM), k_qk_g)
    v = kv[..., D_MODEL:].reshape(B, M, CROSS_HEADS, CROSS_HEAD_DIM)
    s = jnp.einsum('bshd,bmhd->bhsm', q, k, preferred_element_type=jnp.float32) * (CROSS_HEAD_DIM ** -0.5)
    p = jax.nn.softmax(s, axis=-1).astype(v.dtype)
    o = jnp.einsum('bhsm,bmhd->bshd', p, v).reshape(B, S, D_MODEL)
    return o @ w_o


def hierarchical_moe(h, w_group, b_group, w_expert, b_expert, w_gate, w_up, w_down):
    def per_row(hr):
        S = hr.shape[0]
        g_logits = jnp.einsum('sd,dg->sg', hr, w_group, preferred_element_type=jnp.float32)
        g_prob = jax.nn.softmax(g_logits, axis=-1)
        g_sel = jnp.argmax(g_logits + b_group.astype(jnp.float32), axis=-1)
        g_w = jnp.take_along_axis(g_prob, g_sel[:, None], axis=-1)
        e_all = jnp.einsum('sd,de->se', hr, w_expert, preferred_element_type=jnp.float32)
        e_all = e_all.reshape(S, N_GROUPS, EXPERTS_PER_GROUP)
        e_logits = jnp.take_along_axis(e_all, g_sel[:, None, None], axis=1)[:, 0]
        e_bias = b_expert.astype(jnp.float32).reshape(N_GROUPS, EXPERTS_PER_GROUP)[g_sel]
        e_prob = jax.nn.softmax(e_logits, axis=-1)
        _, top_idx = lax.top_k(e_logits + e_bias, TOP_K)
        top_p = jnp.take_along_axis(e_prob, top_idx, axis=-1)
        top_p = top_p / jnp.sum(top_p, axis=-1, keepdims=True)
        local_w = jnp.sum(jax.nn.one_hot(top_idx, EXPERTS_PER_GROUP, dtype=jnp.float32) * top_p[..., None], axis=1)
        gate = (jax.nn.one_hot(g_sel, N_GROUPS, dtype=jnp.float32)[:, :, None]
                * local_w[:, None, :] * g_w[:, :, None]).reshape(S, N_EXPERTS)
        a = jnp.einsum('sd,edf->sef', hr, w_gate)
        u = jnp.einsum('sd,edf->sef', hr, w_up)
        act = jax.nn.silu(a) * u * gate[:, :, None].astype(hr.dtype)
        return jnp.einsum('sef,efd->sd', act, w_down)

    return lax.map(per_row, h)


def setup_inputs(seed: int = 0) -> dict:
    key = jax.random.key(seed)
    ks = jax.random.split(key, 32)

    def w(k, shape, fan_in):
        return jax.random.normal(k, (DEPTH,) + shape, jnp.float32) * (fan_in ** -0.5)

    def gain(k, n):
        return 1.0 + 0.02 * jax.random.normal(k, (DEPTH, n), jnp.float32)

    def bias(k, n):
        return 0.01 * jax.random.normal(k, (DEPTH, n), jnp.float32)

    x = jax.random.normal(ks[0], (BATCH, SEQ, D_MODEL), jnp.float32)
    mem = jax.random.normal(ks[1], (BATCH, MEM_TOKENS, D_MODEL), jnp.float32)
    offsets = jax.random.randint(ks[2], (BATCH, 1), 0, 1024, dtype=jnp.int32)
    positions = offsets + jnp.arange(SEQ, dtype=jnp.int32)[None, :]
    return {
        'x': x,
        'mem': mem,
        'positions': positions,
        'attn_norm_g': gain(ks[3], D_MODEL),
        'w_in': w(ks[4], (D_MODEL, IN_COLS), D_MODEL),
        'mla_q_norm_g': gain(ks[5], MLA_Q_RANK),
        'mla_w_uq': w(ks[6], (MLA_Q_RANK, MLA_HEADS * MLA_QK_DIM), MLA_Q_RANK),
        'mla_kv_norm_g': gain(ks[7], MLA_KV_RANK),
        'mla_w_ukv': w(ks[8], (MLA_KV_RANK, MLA_HEADS * (MLA_NOPE_DIM + MLA_V_DIM)), MLA_KV_RANK),
        'mla_q_qk_g': gain(ks[9], MLA_QK_DIM),
        'mla_k_qk_g': gain(ks[10], MLA_QK_DIM),
        'ret_gn_g': gain(ks[11], RET_WIDTH),
        'w_out': w(ks[12], (MIX_WIDTH, D_MODEL), MIX_WIDTH),
        'cross_norm_g': gain(ks[13], D_MODEL),
        'mem_norm_g': gain(ks[14], D_MODEL),
        'cross_w_q': w(ks[15], (D_MODEL, D_MODEL), D_MODEL),
        'cross_w_kv': w(ks[16], (D_MODEL, 2 * D_MODEL), D_MODEL),
        'cross_q_qk_g': gain(ks[17], CROSS_HEAD_DIM),
        'cross_k_qk_g': gain(ks[18], CROSS_HEAD_DIM),
        'cross_w_o': w(ks[19], (D_MODEL, D_MODEL), D_MODEL),
        'moe_norm_g': gain(ks[20], D_MODEL),
        'router_w_group': w(ks[21], (D_MODEL, N_GROUPS), D_MODEL),
        'router_b_group': bias(ks[22], N_GROUPS),
        'router_w_expert': w(ks[23], (D_MODEL, N_EXPERTS), D_MODEL),
        'router_b_expert': bias(ks[24], N_EXPERTS),
        'expert_w_gate': w(ks[25], (N_EXPERTS, D_MODEL, EXPERT_FF), D_MODEL),
        'expert_w_up': w(ks[26], (N_EXPERTS, D_MODEL, EXPERT_FF), D_MODEL),
        'expert_w_down': w(ks[27], (N_EXPERTS, EXPERT_FF, D_MODEL), EXPERT_FF),
    }


def reference(x, mem, positions, attn_norm_g, w_in, mla_q_norm_g, mla_w_uq, mla_kv_norm_g, mla_w_ukv,
              mla_q_qk_g, mla_k_qk_g, ret_gn_g, w_out, cross_norm_g, mem_norm_g, cross_w_q, cross_w_kv,
              cross_q_qk_g, cross_k_qk_g, cross_w_o, moe_norm_g, router_w_group, router_b_group,
              router_w_expert, router_b_expert, expert_w_gate, expert_w_up, expert_w_down):
    split_points = [int(s) for s in np.cumsum(IN_SPLITS)[:-1]]
    for l in range(DEPTH):
        h = rms_norm(x, attn_norm_g[l])
        proj = h @ w_in[l]
        c_q, c_kv, k_pe, rq, rk, rv, rg = jnp.split(proj, split_points, axis=-1)
        a_out = mla_group(c_q, c_kv, k_pe, positions, mla_q_norm_g[l], mla_w_uq[l],
                          mla_kv_norm_g[l], mla_w_ukv[l], mla_q_qk_g[l], mla_k_qk_g[l])
        r_out = retention_group(rq, rk, rv, rg, positions, ret_gn_g[l])
        x = x + jnp.concatenate([a_out, r_out], axis=-1) @ w_out[l]
        hc = rms_norm(x, cross_norm_g[l])
        m = rms_norm(mem, mem_norm_g[l])
        x = x + memory_cross_attention(hc, m, cross_w_q[l], cross_w_kv[l], cross_q_qk_g[l],
                                       cross_k_qk_g[l], cross_w_o[l])
        hm = rms_norm(x, moe_norm_g[l])
        x = x + hierarchical_moe(hm, router_w_group[l], router_b_group[l], router_w_expert[l],
                                 router_b_expert[l], expert_w_gate[l], expert_w_up[l], expert_w_down[l])
    return x
```

```cpp
#include <hip/hip_runtime.h>
#include <hip/hip_cooperative_groups.h>
#include <cstdint>
#include <cstdio>
#include <cmath>
#include <cstring>

typedef unsigned short bf16_t;
constexpr float EPS = 1e-6f;
constexpr int T_TOK = 32768;
__device__ __forceinline__ float bf2f(bf16_t h) { return __uint_as_float((unsigned)h << 16); }
__device__ __forceinline__ bf16_t f2bf(float f) { const unsigned u = __float_as_uint(f); return (bf16_t)((u + 0x7fffu + ((u >> 16) & 1u)) >> 16); }

constexpr size_t MiB = (size_t)1 << 20;
constexpr size_t WS_CTL = 0;
constexpr size_t WS_SSQ_CQ = 1 * MiB, WS_SSQ_CKV = WS_SSQ_CQ + 128 * 1024, WS_SSQ_KPE = WS_SSQ_CKV + 128 * 1024, WS_SSQ1 = WS_SSQ_KPE + 128 * 1024, WS_SSQ2 = WS_SSQ1 + 128 * 1024;
constexpr size_t WS_SEL = 2 * MiB, WS_WTS = WS_SEL + 256 * 1024;
constexpr size_t WS_RW = 4 * MiB;
constexpr size_t WS_CS = 5 * MiB;
constexpr size_t WS_MB = 21 * MiB, WS_KC = 25 * MiB, WS_VC = 29 * MiB;
constexpr size_t WS_WB = 33 * MiB;
constexpr size_t WS_RQ = 97 * MiB, WS_RK = 129 * MiB, WS_RV = 161 * MiB, WS_RG = 193 * MiB;
constexpr size_t WS_HB = 225 * MiB;
constexpr size_t WS_QM = 225 * MiB, WS_KM = 273 * MiB, WS_VM = 321 * MiB;
constexpr size_t WS_KVS = 353 * MiB;
constexpr size_t WS_AO = 385 * MiB;
constexpr size_t WS_CQ = 449 * MiB, WS_CKV = 465 * MiB;
constexpr size_t WS_PJ = 289 * MiB;
constexpr size_t WS_RAW = 353 * MiB;
constexpr size_t WS_XB = 97 * MiB;
constexpr size_t WS_QCR = 161 * MiB;
constexpr size_t WS_PC = 161 * MiB;
constexpr size_t WS_QC = 225 * MiB;
constexpr size_t WS_OC = 289 * MiB;
constexpr size_t WS_KVR = 353 * MiB;
constexpr size_t WS_CNT = 64 * 1024;
constexpr size_t WS_LISTS = 353 * MiB, WS_ROWW = 361 * MiB;
constexpr size_t WS_H = 161 * MiB;
constexpr size_t WS_NEED = 481 * MiB;
#define LAS __attribute__((address_space(3)))
typedef short bf16x8 __attribute__((ext_vector_type(8)));
typedef float f32x4 __attribute__((ext_vector_type(4)));
typedef float f32x2 __attribute__((ext_vector_type(2)));
typedef unsigned u32x4 __attribute__((ext_vector_type(4)));
typedef unsigned u32x2 __attribute__((ext_vector_type(2)));

namespace pg8 {
constexpr int BM = 256, BK = 64, HALF = 128, HTB = HALF * BK * 2, STAGE_BYTES = 8 * HTB, NXCD = 8, WGM = 8;
__host__ __device__ __forceinline__ int lds_byte(int r, int c) { const int st = (r >> 4) * 2 + (c >> 5), rr = r & 15, cc = c & 31, ob = rr * 64 + cc * 2; return st * 1024 + (ob ^ (((ob >> 9) & 1) << 5)); }
__host__ __device__ __forceinline__ void stage_rc(int b, int& R, int& C) { const int st = b / 1024, sb = b % 1024, swz = sb ^ (((sb >> 9) & 1) << 5); R = (st >> 1) * 16 + swz / 64; C = (st & 1) * 32 + (swz % 64) / 2; }
__host__ __device__ __forceinline__ int perm32(int rho) { const int n = rho >> 4, i = rho & 15; return 8 * (i >> 2) + 4 * n + (i & 3); }
__device__ __forceinline__ unsigned cvt_pk_bf16(float lo, float hi) { unsigned r; asm volatile("v_cvt_pk_bf16_f32 %0, %1, %2" : "=v"(r) : "v"(lo), "v"(hi)); return r; }

struct Unit { int pm, pn; const char* a; const char* b; const int* rows; int nvalid, seg; };

struct GridOrder {
    int nM, nN, nwg, G, c; const char* A; const char* B; size_t strideA, strideB;
    __device__ void init(const bf16_t* A_, int lda, const bf16_t* B_, int ldb, int M, int N, int G_, int c_) {
        nM = M / BM; nN = N / BM; nwg = nM * nN; G = G_; c = c_; A = (const char*)A_; B = (const char*)B_; strideA = (size_t)BM * lda * 2; strideB = (size_t)BM * ldb * 2; }
    __device__ bool next(int i, Unit& u) const {
        const long L = (long)i * G + c; if (L >= nwg) return false;
        int wgid = (int)L; { const int q = nwg / NXCD, r = nwg % NXCD, xcd = wgid % NXCD, off = wgid / NXCD; wgid = (xcd < r ? xcd * (q + 1) : r * (q + 1) + (xcd - r) * q) + off; }
        const int nig = WGM * nN, gid = wgid / nig, fm = gid * WGM, gsz = (nM - fm) < WGM ? (nM - fm) : WGM;
        u.pm = fm + ((wgid % nig) % gsz); u.pn = (wgid % nig) / gsz; u.a = A + (size_t)u.pm * strideA; u.b = B + (size_t)u.pn * strideB; u.rows = nullptr; u.nvalid = 256; u.seg = 0; return true;
    }
};

#define XBAR() do { asm volatile("s_waitcnt lgkmcnt(0)" ::: "memory"); __builtin_amdgcn_s_barrier(); asm volatile("" ::: "memory"); } while (0)

__device__ __forceinline__ void row_allreduce_sum(float (&s)[2][4], int wr, int wc, int fr, int fq, LAS unsigned char* xl) {
    LAS float* P = (LAS float*)xl;
#pragma unroll
    for (int ai = 0; ai < 2; ++ai)
#pragma unroll
        for (int m = 0; m < 4; ++m) { float v = s[ai][m]; v += __shfl_xor(v, 16); v += __shfl_xor(v, 32); if (fq == 0) P[(ai * HALF + wr * 64 + m * 16 + fr) * 4 + wc] = v; }
    XBAR();
#pragma unroll
    for (int ai = 0; ai < 2; ++ai)
#pragma unroll
        for (int m = 0; m < 4; ++m) { const f32x4 p = *(const LAS f32x4*)(P + (ai * HALF + wr * 64 + m * 16 + fr) * 4); s[ai][m] = (p[0] + p[1]) + (p[2] + p[3]); }
    XBAR();
}
__device__ __forceinline__ void row_allreduce_max(float (&s)[2][4], int wr, int wc, int fr, int fq, LAS unsigned char* xl) {
    LAS float* P = (LAS float*)xl;
#pragma unroll
    for (int ai = 0; ai < 2; ++ai)
#pragma unroll
        for (int m = 0; m < 4; ++m) { float v = s[ai][m]; v = fmaxf(v, __shfl_xor(v, 16)); v = fmaxf(v, __shfl_xor(v, 32)); if (fq == 0) P[(ai * HALF + wr * 64 + m * 16 + fr) * 4 + wc] = v; }
    XBAR();
#pragma unroll
    for (int ai = 0; ai < 2; ++ai)
#pragma unroll
        for (int m = 0; m < 4; ++m) { const f32x4 p = *(const LAS f32x4*)(P + (ai * HALF + wr * 64 + m * 16 + fr) * 4); s[ai][m] = fmaxf(fmaxf(p[0], p[1]), fmaxf(p[2], p[3])); }
    XBAR();
}

template <class Epi, class Sched, bool GATHER = false>
__device__ __forceinline__ void gemm_phase(LAS unsigned char* lds, LAS unsigned char* xl, int lda, int ldb, int K, const Sched& S, const Epi& E) {
    const int tid = threadIdx.x, wid = __builtin_amdgcn_readfirstlane(tid >> 6), lane = tid & 63, wr = wid >> 2, wc = wid & 3, fr = lane & 15, fq = lane >> 4;
    asm volatile("" : "+s"(K));
    const int nt = K / BK;
    int sR[2], sC[2];
    unsigned voffA[2], voffB[2];
#pragma unroll
    for (int i = 0; i < 2; ++i) { int R, C; stage_rc(tid * 16 + i * 8192, R, C); const int Rb = Epi::PERM ? ((R & ~31) + perm32(R & 31)) : R; sR[i] = R; sC[i] = C;
        voffA[i] = (unsigned)(R * lda + C) * 2u; voffB[i] = (unsigned)(Rb * ldb + C) * 2u; }
    const size_t kstep = (size_t)(BK * 2);
    const size_t hstepA = (size_t)HALF * lda * 2, hstepB = (size_t)HALF * ldb * 2;
    const unsigned ldsw = (unsigned)wid * 1024u;
    const int aoff = lds_byte(wr * 64 + fr, fq * 8), boff = lds_byte(wc * 32 + fr, fq * 8);
#define PG8_SA(b, h) (((b) * 2 + (h)) * HTB)
#define PG8_SB(b, h) ((4 + (b) * 2 + (h)) * HTB)
#define PG8_STAGE(bufoff, gbase, voff) do { _Pragma("unroll") for (int _i = 0; _i < 2; ++_i) \
        __builtin_amdgcn_global_load_lds((const unsigned*)((const char*)(gbase) + (voff)[_i]), (LAS unsigned*)(lds + (bufoff) + ldsw + _i * 8192), 16, 0, 0); } while (0)
#define PG8_LDA(dst, b, h) do { _Pragma("unroll") for (int m = 0; m < 4; ++m) _Pragma("unroll") for (int k = 0; k < 2; ++k) dst[m][k] = *(const LAS bf16x8*)(lds + PG8_SA(b, h) + aoff + m * 2048 + k * 1024); } while (0)
#define PG8_LDB(dst, b, h) do { _Pragma("unroll") for (int n = 0; n < 2; ++n) _Pragma("unroll") for (int k = 0; k < 2; ++k) dst[n][k] = *(const LAS bf16x8*)(lds + PG8_SB(b, h) + boff + n * 2048 + k * 1024); } while (0)
#define PG8_MMA(ai, bj, At, Bt) do { __builtin_amdgcn_s_setprio(1); _Pragma("unroll") for (int m = 0; m < 4; ++m) _Pragma("unroll") for (int n = 0; n < 2; ++n) _Pragma("unroll") for (int k = 0; k < 2; ++k) \
        acc[ai][bj][m][n] = __builtin_amdgcn_mfma_f32_16x16x32_bf16(Bt[n][k], At[m][k], acc[ai][bj][m][n], 0, 0, 0); __builtin_amdgcn_s_setprio(0); } while (0)
#define PG8_WAIT_V(n) asm volatile("s_waitcnt vmcnt(" #n ")" ::: "memory")
#define PG8_WAIT_L(n) asm volatile("s_waitcnt lgkmcnt(" #n ")" ::: "memory")
#define PG8_BAR __builtin_amdgcn_s_barrier()
#define PG8_SCHED __builtin_amdgcn_sched_barrier(0)
    LAS unsigned char* gl = xl + 8192 + tid * 16;
    int gA0 = 0, gA1 = 8192;
#define PG8_GATH(T, u) do { u32x4 _o; { int _r[4]; _Pragma("unroll") for (int _q = 0; _q < 4; ++_q) { const int _rl = (_q >> 1) * HALF + sR[_q & 1]; _r[_q] = (_rl < (u).nvalid) ? (u).rows[_rl] : 0; } \
        _Pragma("unroll") for (int _q = 0; _q < 4; ++_q) _o[_q] = (unsigned)(_r[_q] * lda + sC[_q & 1]) * 2u; } *(LAS u32x4*)(gl + (T)) = _o; } while (0)
#define PG8_STAGE_A(bufoff, base, h, kbytes, T) do { if constexpr (GATHER) { const u32x2 _g = *(const LAS u32x2*)(gl + (T) + (h) * 8); PG8_STAGE(bufoff, (base) + (kbytes), _g); } else { PG8_STAGE(bufoff, (base) + (size_t)(h) * hstepA + (kbytes), voffA); } } while (0)
    Unit cur, nxt; int ui = 0;
    if (!S.next(0, cur)) return;
    f32x4 acc[2][2][4][2];
#pragma unroll
    for (int a = 0; a < 2; ++a)
#pragma unroll
        for (int b = 0; b < 2; ++b)
#pragma unroll
            for (int m = 0; m < 4; ++m)
#pragma unroll
                for (int n = 0; n < 2; ++n) acc[a][b][m][n] = (f32x4){0.f, 0.f, 0.f, 0.f};
    bf16x8 At[4][2], B0[2][2], B1[2][2];
    const char* cA = cur.a; const char* cB = cur.b;
    if constexpr (GATHER) { PG8_GATH(gA0, cur); }
    PG8_STAGE(PG8_SB(0, 0), cB, voffB); PG8_STAGE(PG8_SB(0, 1), cB + hstepB, voffB); PG8_STAGE_A(PG8_SA(0, 0), cA, 0, 0, gA0); PG8_STAGE_A(PG8_SA(0, 1), cA, 1, 0, gA0);
    if (wr == 1) PG8_BAR;
    PG8_WAIT_V(2); PG8_BAR;
    PG8_STAGE(PG8_SB(1, 0), cB + kstep, voffB); PG8_STAGE_A(PG8_SA(1, 0), cA, 0, kstep, gA0); PG8_STAGE(PG8_SB(1, 1), cB + hstepB + kstep, voffB);
    PG8_WAIT_V(6); PG8_BAR;
    for (;;) {
        const bool has_next = S.next(ui + 1, nxt);
        const char* nA = has_next ? nxt.a : cA; const char* nB = has_next ? nxt.b : cB;
        if constexpr (GATHER) { if (has_next) { PG8_GATH(gA1, nxt); } else { PG8_GATH(gA1, cur); } }
#pragma unroll 1
        for (int t = 0; t < nt; t += 2) {
            const bool last = (t == nt - 2);
            const size_t k1 = (size_t)(t + 1) * kstep;
            const char* a2 = last ? nA : cA; const char* b2 = last ? nB : cB + (size_t)(t + 2) * kstep;
            const size_t ka2 = last ? 0 : (size_t)(t + 2) * kstep;
            const char* b3 = b2 + kstep; const size_t ka3 = ka2 + kstep;
            PG8_LDB(B0, 0, 0); PG8_LDB(B1, 0, 1); PG8_SCHED; PG8_LDA(At, 0, 0); PG8_STAGE_A(PG8_SA(1, 1), cA, 1, k1, gA0);
            PG8_WAIT_V(8); PG8_WAIT_L(0); PG8_BAR; PG8_MMA(0, 0, At, B0); PG8_MMA(0, 1, At, B1); PG8_BAR; PG8_SCHED;
            PG8_LDA(At, 0, 1); PG8_STAGE(PG8_SB(0, 0), b2, voffB); PG8_STAGE(PG8_SB(0, 1), b2 + hstepB, voffB);
            if (last) { PG8_STAGE_A(PG8_SA(0, 0), a2, 0, ka2, gA1); } else { PG8_STAGE_A(PG8_SA(0, 0), a2, 0, ka2, gA0); }
            PG8_WAIT_V(8); PG8_WAIT_L(0); PG8_BAR; PG8_MMA(1, 0, At, B0); PG8_MMA(1, 1, At, B1); PG8_BAR; PG8_SCHED;
            PG8_LDB(B0, 1, 0); PG8_LDB(B1, 1, 1); PG8_SCHED; PG8_LDA(At, 1, 0);
            if (last) { PG8_STAGE_A(PG8_SA(0, 1), a2, 1, ka2, gA1); } else { PG8_STAGE_A(PG8_SA(0, 1), a2, 1, ka2, gA0); }
            PG8_WAIT_V(8); PG8_WAIT_L(0); PG8_BAR; PG8_MMA(0, 0, At, B0); PG8_MMA(0, 1, At, B1); PG8_BAR; PG8_SCHED;
            PG8_LDA(At, 1, 1); PG8_STAGE(PG8_SB(1, 0), b3, voffB); PG8_STAGE(PG8_SB(1, 1), b3 + hstepB, voffB);
            if (last) { PG8_STAGE_A(PG8_SA(1, 0), a2, 0, ka3, gA1); } else { PG8_STAGE_A(PG8_SA(1, 0), a2, 0, ka3, gA0); }
            PG8_WAIT_V(8); PG8_WAIT_L(0); PG8_BAR; PG8_MMA(1, 0, At, B0); PG8_MMA(1, 1, At, B1); PG8_BAR; PG8_SCHED;
        }
        if (wr == 0) PG8_BAR;
        E(acc, cur, wr, wc, fr, fq, xl);
        if (!has_next) break;
#pragma unroll
        for (int a = 0; a < 2; ++a)
#pragma unroll
            for (int b = 0; b < 2; ++b)
#pragma unroll
                for (int m = 0; m < 4; ++m)
#pragma unroll
                    for (int n = 0; n < 2; ++n) acc[a][b][m][n] = (f32x4){0.f, 0.f, 0.f, 0.f};
        cur = nxt; cA = nA; cB = nB; ++ui;
        if constexpr (GATHER) { const int _t = gA0; gA0 = gA1; gA1 = _t; }
        if (wr == 1) PG8_BAR;
    }
    PG8_WAIT_V(0);
    PG8_BAR;
#undef PG8_SA
#undef PG8_SB
#undef PG8_STAGE
#undef PG8_STAGE_A
#undef PG8_GATH
#undef PG8_LDA
#undef PG8_LDB
#undef PG8_MMA
#undef PG8_WAIT_V
#undef PG8_WAIT_L
#undef PG8_BAR
#undef PG8_SCHED
}
}
namespace fx {
using pg8::Unit; using pg8::cvt_pk_bf16;
constexpr int HALF = 128;
__device__ __forceinline__ u32x4 pack8(const f32x4 a, const f32x4 b) { u32x4 w; w.x = cvt_pk_bf16(a[0], a[1]); w.y = cvt_pk_bf16(a[2], a[3]); w.z = cvt_pk_bf16(b[0], b[1]); w.w = cvt_pk_bf16(b[2], b[3]); return w; }
__device__ __forceinline__ u32x2 pack4(const f32x4 a) { u32x2 w; w.x = cvt_pk_bf16(a[0], a[1]); w.y = cvt_pk_bf16(a[2], a[3]); return w; }
__device__ __forceinline__ float sq4(const f32x4 a) { return (a[0] * a[0] + a[1] * a[1]) + (a[2] * a[2] + a[3] * a[3]); }
__device__ __forceinline__ float quad_sum(float v) { v += __shfl_xor(v, 16); v += __shfl_xor(v, 32); return v; }
__device__ __forceinline__ float gamma_log2(int h) { return __log2f(1.f - exp2f(-5.f - (float)h)); }
__device__ __forceinline__ void rope4(f32x4& a, f32x4& b, const f32x4 cs0, const f32x4 cs1) {
    const f32x4 c = {cs0[0], cs0[2], cs1[0], cs1[2]}, s = {cs0[1], cs0[3], cs1[1], cs1[3]};
    const f32x4 ra = a * c - b * s, rb = b * c + a * s; a = ra; b = rb;
}

struct EpiInProj {
    static constexpr bool PERM = false;
    bf16_t *CQ, *CKV, *RQ, *RK, *RV, *RG; float *ssq_cq, *ssq_ckv, *ssq_kpe; const float* cs  ; const float* kg  ;
    __device__ __forceinline__ void operator()(f32x4 (&acc)[2][2][4][2], const Unit& u, int wr, int wc, int fr, int fq, LAS unsigned char*) const {
        const int row0 = u.pm * 256 + wr * 64 + fr, pn = u.pn;
        if (pn == 0) {
#pragma unroll
            for (int ai = 0; ai < 2; ++ai)
#pragma unroll
                for (int m = 0; m < 4; ++m) { const int row = row0 + ai * HALF + m * 16; float s = 0.f;
#pragma unroll
                    for (int bj = 0; bj < 2; ++bj) { s += sq4(acc[ai][bj][m][0]) + sq4(acc[ai][bj][m][1]);
                        *(u32x4*)(CQ + (size_t)row * 256 + bj * HALF + wc * 32 + 8 * fq) = pack8(acc[ai][bj][m][0], acc[ai][bj][m][1]); }
                    s = quad_sum(s); if (fq == 0) atomicAdd(ssq_cq + row, s); }
        } else if (pn == 1) {
            const int i0 = 16 * wc + 4 * fq;
            f32x4 g0 = {0.f, 0.f, 0.f, 0.f}, g1 = g0;
            if (wc < 2) { g0 = *(const f32x4*)(kg + 128 + i0); g1 = *(const f32x4*)(kg + 160 + i0); }
#pragma unroll
            for (int ai = 0; ai < 2; ++ai)
#pragma unroll
                for (int m = 0; m < 4; ++m) { const int row = row0 + ai * HALF + m * 16;
                    float s0 = sq4(acc[ai][0][m][0]) + sq4(acc[ai][0][m][1]), s1 = sq4(acc[ai][1][m][0]) + sq4(acc[ai][1][m][1]);
                    *(u32x4*)(CKV + (size_t)row * 256 + wc * 32 + 8 * fq) = pack8(acc[ai][0][m][0], acc[ai][0][m][1]);
                    s0 = quad_sum(s0); s1 = quad_sum(s1);
                    if (fq == 0) { atomicAdd(ssq_ckv + row, s0); if (wc < 2) atomicAdd(ssq_kpe + row, s1); }
                    if (wc < 2) {
                        f32x4 a = acc[ai][1][m][0] * g0, b = acc[ai][1][m][1] * g1;
                        const float* cp = cs + ((size_t)row * 64 + 2 * i0) * 2;
                        const f32x4 c0 = *(const f32x4*)(cp), c1 = *(const f32x4*)(cp + 4), c2 = *(const f32x4*)(cp + 8), c3 = *(const f32x4*)(cp + 12);
                        const f32x4 cc = {c0[0], c1[0], c2[0], c3[0]}, ss = {c0[1], c1[1], c2[1], c3[1]};
                        const f32x4 ra = a * cc - b * ss, rb = b * cc + a * ss;
                        *(u32x2*)(CKV + (size_t)row * 256 + 128 + i0) = pack4(ra); *(u32x2*)(CKV + (size_t)row * 256 + 160 + i0) = pack4(rb);
                    } else {
                        *(u32x4*)(CKV + (size_t)row * 256 + 192 + (wc - 2) * 32 + 8 * fq) = (u32x4){0u, 0u, 0u, 0u};
                    }
                    asm volatile("" ::: "memory"); }
        } else if (pn < 6) {
            bf16_t* O = (pn < 4) ? RQ : RK; const float sc = (pn < 4) ? 1.f : 0.08838834764831845f;
            const int i0 = 16 * wc + 4 * fq;
            const float sgn = (pn < 4) ? 1.f : -1.f; const float lgh[2] = {sgn * gamma_log2((pn & 1) * 2), sgn * gamma_log2((pn & 1) * 2 + 1)};
#pragma unroll
            for (int ai = 0; ai < 2; ++ai)
#pragma unroll
                for (int m = 0; m < 4; ++m) { const int row = row0 + ai * HALF + m * 16;
                    const float* cp = cs + ((size_t)row * 64 + i0) * 2;
                    const f32x4 c0 = *(const f32x4*)(cp), c1 = *(const f32x4*)(cp + 4);
#pragma unroll
                    for (int bj = 0; bj < 2; ++bj) { f32x4 a = acc[ai][bj][m][0], b = acc[ai][bj][m][1]; rope4(a, b, c0, c1); const float dc = sc * exp2f((float)(row & 127) * lgh[bj]); a = a * dc; b = b * dc;
                        bf16_t* o = O + (size_t)row * 512 + ((pn & 1) * 2 + bj) * 128 + i0;
                        *(u32x2*)(o) = pack4(a); *(u32x2*)(o + 64) = pack4(b); }
                    asm volatile("" ::: "memory"); }
        } else {
            bf16_t* O = (pn < 8) ? RV : RG;
#pragma unroll
            for (int ai = 0; ai < 2; ++ai)
#pragma unroll
                for (int m = 0; m < 4; ++m) { const int row = row0 + ai * HALF + m * 16;
#pragma unroll
                    for (int bj = 0; bj < 2; ++bj) *(u32x4*)(O + (size_t)row * 512 + (pn & 1) * 256 + bj * HALF + wc * 32 + 8 * fq) = pack8(acc[ai][bj][m][0], acc[ai][bj][m][1]); }
        }
    }
};
__device__ __forceinline__ int inproj_src(int n) {
    const int pn = n >> 8, p = n & 255;
    const int plain = (p & ~31) + pg8::perm32(p & 31);
    if (pn == 0) return plain;
    if (pn == 1) { if (p < 128) return 256 + plain; const int q = p - 128, wc = q >> 5; if (wc >= 2) return -1; return 384 + 32 * ((q >> 4) & 1) + 16 * wc + (q & 15); }
    if (pn < 6) { const int bj = p >> 7, q = p & 127, wc = q >> 5, nn = (q >> 4) & 1; const int d = 64 * nn + 16 * wc + (q & 15); return (pn < 4 ? 448 : 960) + ((pn & 1) * 2 + bj) * 128 + d; }
    return (pn < 8 ? 1472 : 1984) + (pn & 1) * 256 + plain;
}

struct EpiMlaQ {
    static constexpr bool PERM = false;
    bf16_t* QM; const float* ssq_cq; const float* qg; const float* cs;
    __device__ __forceinline__ void operator()(f32x4 (&acc)[2][2][4][2], const Unit& u, int wr, int wc, int fr, int fq, LAS unsigned char* xl) const {
        const int row0 = u.pm * 256 + wr * 64 + fr, h = u.pn;
        float s[2][4], rsr[2][4];
#pragma unroll
        for (int ai = 0; ai < 2; ++ai)
#pragma unroll
            for (int m = 0; m < 4; ++m) { const int row = row0 + ai * HALF + m * 16; rsr[ai][m] = rsqrtf(ssq_cq[row] * (1.f / 256.f) + EPS);
                s[ai][m] = (sq4(acc[ai][0][m][0]) + sq4(acc[ai][0][m][1]) + sq4(acc[ai][1][m][0]) + sq4(acc[ai][1][m][1])) * rsr[ai][m] * rsr[ai][m]; }
        pg8::row_allreduce_sum(s, wr, wc, fr, fq, xl);
        const int c0 = 32 * wc + 8 * fq, i0 = 16 * wc + 4 * fq;
        const f32x4 gA = *(const f32x4*)(qg + c0), gB = *(const f32x4*)(qg + c0 + 4);
        f32x4 g0 = {0.f, 0.f, 0.f, 0.f}, g1 = g0;
        if (wc < 2) { g0 = *(const f32x4*)(qg + 128 + i0); g1 = *(const f32x4*)(qg + 160 + i0); }
#pragma unroll
        for (int ai = 0; ai < 2; ++ai)
#pragma unroll
            for (int m = 0; m < 4; ++m) { const int row = row0 + ai * HALF + m * 16; const float rq = rsqrtf(s[ai][m] * (1.f / 192.f) + EPS) * rsr[ai][m];
                bf16_t* o = QM + (size_t)row * 768 + h * 192;
                *(u32x4*)(o + c0) = pack8(acc[ai][0][m][0] * rq * gA, acc[ai][0][m][1] * rq * gB);
                if (wc < 2) {
                    const f32x4 a = acc[ai][1][m][0] * rq * g0, b = acc[ai][1][m][1] * rq * g1;
                    const float* cp = cs + ((size_t)row * 64 + 2 * i0) * 2;
                    const f32x4 c0v = *(const f32x4*)(cp), c1v = *(const f32x4*)(cp + 4), c2v = *(const f32x4*)(cp + 8), c3v = *(const f32x4*)(cp + 12);
                    const f32x4 cc = {c0v[0], c1v[0], c2v[0], c3v[0]}, ss = {c0v[1], c1v[1], c2v[1], c3v[1]};
                    *(u32x2*)(o + 128 + i0) = pack4(a * cc - b * ss); *(u32x2*)(o + 160 + i0) = pack4(b * cc + a * ss);
                }
                asm volatile("" ::: "memory"); }
    }
};
__device__ __forceinline__ int mlaq_src(int n) {
    const int h = n >> 8, p = n & 255;
    if (p < 128) return h * 192 + (p & ~31) + pg8::perm32(p & 31);
    const int q = p - 128, wc = q >> 5; if (wc >= 2) return -1;
    return h * 192 + 128 + 32 * ((q >> 4) & 1) + 16 * wc + (q & 15);
}
struct EpiMlaKV {
    static constexpr bool PERM = false;
    bf16_t *KM, *VM; const bf16_t* CKV; const float *ssq_ckv, *ssq_kpe, *kg;
    __device__ __forceinline__ void operator()(f32x4 (&acc)[2][2][4][2], const Unit& u, int wr, int wc, int fr, int fq, LAS unsigned char* xl) const {
        const int row0 = u.pm * 256 + wr * 64 + fr, h = u.pn;
        float s[2][4], rsr[2][4];
#pragma unroll
        for (int ai = 0; ai < 2; ++ai)
#pragma unroll
            for (int m = 0; m < 4; ++m) { const int row = row0 + ai * HALF + m * 16; rsr[ai][m] = rsqrtf(ssq_ckv[row] * (1.f / 128.f) + EPS);
                s[ai][m] = (sq4(acc[ai][0][m][0]) + sq4(acc[ai][0][m][1])) * rsr[ai][m] * rsr[ai][m]; }
        pg8::row_allreduce_sum(s, wr, wc, fr, fq, xl);
        const int c0 = 32 * wc + 8 * fq, i0 = 16 * wc + 4 * fq;
        const f32x4 gA = *(const f32x4*)(kg + c0), gB = *(const f32x4*)(kg + c0 + 4);
#pragma unroll
        for (int ai = 0; ai < 2; ++ai)
#pragma unroll
            for (int m = 0; m < 4; ++m) { const int row = row0 + ai * HALF + m * 16; const float rk = rsqrtf((s[ai][m] + ssq_kpe[row]) * (1.f / 192.f) + EPS), rr = rsr[ai][m];
                bf16_t* ko = KM + (size_t)row * 768 + h * 192;
                *(u32x4*)(ko + c0) = pack8(acc[ai][0][m][0] * (rr * rk) * gA, acc[ai][0][m][1] * (rr * rk) * gB);
                *(u32x4*)(VM + (size_t)row * 512 + h * 128 + c0) = pack8(acc[ai][1][m][0] * rr, acc[ai][1][m][1] * rr);
                const u32x2 kp = *(const u32x2*)(CKV + (size_t)row * 256 + 128 + i0);
                const f32x4 kf = {__uint_as_float(kp.x << 16), __uint_as_float(kp.x & 0xffff0000u), __uint_as_float(kp.y << 16), __uint_as_float(kp.y & 0xffff0000u)};
                *(u32x2*)(ko + 128 + i0) = pack4(kf * rk); asm volatile("" ::: "memory"); }
    }
};
struct EpiResid {
    static constexpr bool PERM = false;
    const float* base; float* out; bf16_t* xb; float* ssq;
    __device__ __forceinline__ void operator()(f32x4 (&acc)[2][2][4][2], const Unit& u, int wr, int wc, int fr, int fq, LAS unsigned char*) const {
        const int row0 = u.pm * 256 + wr * 64 + fr, col0 = u.pn * 256 + wc * 32 + 4 * fq;
#pragma unroll
        for (int ai = 0; ai < 2; ++ai)
#pragma unroll
            for (int m = 0; m < 4; ++m) { const int row = row0 + ai * HALF + m * 16; float s = 0.f;
#pragma unroll
                for (int bj = 0; bj < 2; ++bj)
#pragma unroll
                    for (int n = 0; n < 2; ++n) { const size_t off = (size_t)row * 1024 + col0 + bj * HALF + n * 16;
                        const f32x4 o = *(const f32x4*)(base + off) + acc[ai][bj][m][n]; *(f32x4*)(out + off) = o; *(u32x2*)(xb + off) = pack4(o); s += sq4(o); }
                s = quad_sum(s); if (fq == 0) atomicAdd(ssq + row, s); }
    }
};
struct EpiHeadNorm {
    static constexpr bool PERM = false;
    bf16_t* O; const float* ssq_in  ; const float* g  ; float inv_n_in;
    __device__ __forceinline__ void operator()(f32x4 (&acc)[2][2][4][2], const Unit& u, int wr, int wc, int fr, int fq, LAS unsigned char* xl) const {
        const int row0 = u.pm * 256 + wr * 64 + fr, h = u.pn;
        float s[2][4], rsr[2][4];
#pragma unroll
        for (int ai = 0; ai < 2; ++ai)
#pragma unroll
            for (int m = 0; m < 4; ++m) { const int row = row0 + ai * HALF + m * 16; rsr[ai][m] = ssq_in ? rsqrtf(ssq_in[row] * inv_n_in + EPS) : 1.f;
                s[ai][m] = (sq4(acc[ai][0][m][0]) + sq4(acc[ai][0][m][1]) + sq4(acc[ai][1][m][0]) + sq4(acc[ai][1][m][1])) * rsr[ai][m] * rsr[ai][m]; }
        pg8::row_allreduce_sum(s, wr, wc, fr, fq, xl);
        const int c0 = 32 * wc + 8 * fq;
        f32x4 gv[2][2];
#pragma unroll
        for (int bj = 0; bj < 2; ++bj) { gv[bj][0] = *(const f32x4*)(g + bj * HALF + c0); gv[bj][1] = *(const f32x4*)(g + bj * HALF + c0 + 4); }
#pragma unroll
        for (int ai = 0; ai < 2; ++ai)
#pragma unroll
            for (int m = 0; m < 4; ++m) { const int row = row0 + ai * HALF + m * 16; const float rq = rsqrtf(s[ai][m] * (1.f / 256.f) + EPS) * rsr[ai][m];
#pragma unroll
                for (int bj = 0; bj < 2; ++bj) *(u32x4*)(O + (size_t)row * 1024 + h * 256 + bj * HALF + c0) = pack8(acc[ai][bj][m][0] * rq * gv[bj][0], acc[ai][bj][m][1] * rq * gv[bj][1]); }
    }
};
struct EpiStoreT {
    static constexpr bool PERM = true;
    bf16_t* O; int ldc; int tile_stride; float scale; int pad;
    __device__ __forceinline__ void operator()(f32x4 (&acc)[2][2][4][2], const Unit& u, int wr, int wc, int fr, int fq, LAS unsigned char*) const {
        const int row0 = u.pm * 256 + wr * 64 + fr;
#pragma unroll
        for (int ai = 0; ai < 2; ++ai)
#pragma unroll
            for (int m = 0; m < 4; ++m) { const int row = row0 + ai * HALF + m * 16;
#pragma unroll
                for (int bj = 0; bj < 2; ++bj) *(u32x4*)(O + (size_t)u.pn * tile_stride + (size_t)row * ldc + bj * HALF + wc * 32 + 8 * fq) = pack8(acc[ai][bj][m][0] * scale, acc[ai][bj][m][1] * scale); }
    }
};
struct EpiSoftmax {
    static constexpr bool PERM = true;
    bf16_t* PC;
    __device__ __forceinline__ void operator()(f32x4 (&acc)[2][2][4][2], const Unit& u, int wr, int wc, int fr, int fq, LAS unsigned char* xl) const {
        const int row0 = u.pm * 256 + wr * 64 + fr, h = u.pn;
        float mx[2][4], sm[2][4];
#pragma unroll
        for (int ai = 0; ai < 2; ++ai)
#pragma unroll
            for (int m = 0; m < 4; ++m) { float v = -3.0e38f;
#pragma unroll
                for (int bj = 0; bj < 2; ++bj)
#pragma unroll
                    for (int n = 0; n < 2; ++n) { const f32x4 a = acc[ai][bj][m][n]; v = fmaxf(v, fmaxf(fmaxf(a[0], a[1]), fmaxf(a[2], a[3]))); }
                mx[ai][m] = v; }
        pg8::row_allreduce_max(mx, wr, wc, fr, fq, xl);
        const float c2 = 0.0625f * 1.4426950408889634f;
#pragma unroll
        for (int ai = 0; ai < 2; ++ai)
#pragma unroll
            for (int m = 0; m < 4; ++m) { float t = 0.f; const float mm = mx[ai][m] * c2;
#pragma unroll
                for (int bj = 0; bj < 2; ++bj)
#pragma unroll
                    for (int n = 0; n < 2; ++n) { f32x4 a = acc[ai][bj][m][n] * c2 - mm;
                        a[0] = __builtin_amdgcn_exp2f(a[0]); a[1] = __builtin_amdgcn_exp2f(a[1]); a[2] = __builtin_amdgcn_exp2f(a[2]); a[3] = __builtin_amdgcn_exp2f(a[3]);
                        acc[ai][bj][m][n] = a; t += (a[0] + a[1]) + (a[2] + a[3]); }
                sm[ai][m] = t; }
        pg8::row_allreduce_sum(sm, wr, wc, fr, fq, xl);
#pragma unroll
        for (int ai = 0; ai < 2; ++ai)
#pragma unroll
            for (int m = 0; m < 4; ++m) { const int row = row0 + ai * HALF + m * 16; const float il = 1.f / sm[ai][m];
#pragma unroll
                for (int bj = 0; bj < 2; ++bj) *(u32x4*)(PC + (size_t)row * 1024 + h * 256 + bj * HALF + wc * 32 + 8 * fq) = pack8(acc[ai][bj][m][0] * il, acc[ai][bj][m][1] * il); }
    }
};
struct EpiStoreBf16 {
    static constexpr bool PERM = true;
    bf16_t* O; int ldc; int pad;
    __device__ __forceinline__ void operator()(f32x4 (&acc)[2][2][4][2], const Unit& u, int wr, int wc, int fr, int fq, LAS unsigned char*) const {
        const int row0 = u.pm * 256 + wr * 64 + fr;
#pragma unroll
        for (int ai = 0; ai < 2; ++ai)
#pragma unroll
            for (int m = 0; m < 4; ++m) { const int row = row0 + ai * HALF + m * 16;
#pragma unroll
                for (int bj = 0; bj < 2; ++bj) *(u32x4*)(O + (size_t)row * ldc + u.pn * 256 + bj * HALF + wc * 32 + 8 * fq) = pack8(acc[ai][bj][m][0], acc[ai][bj][m][1]); }
    }
};
struct HeadOrder {
    int G, c, nunits; const char* A; const char* B; size_t strideA, a_h, b_b, b_h;
    __device__ bool next(int i, Unit& u) const {
        const long L = (long)i * G + c; if (L >= nunits) return false;
        u.pm = (int)(L >> 2); u.pn = (int)(L & 3); const int b = u.pm >> 4;
        u.a = A + (size_t)u.pm * strideA + (size_t)u.pn * a_h; u.b = B + (size_t)b * b_b + (size_t)u.pn * b_h; u.rows = nullptr; u.nvalid = 256; u.seg = 0; return true;
    }
};
constexpr int MOE_CAP = 32768;
struct MoeOrder {
    int G, c, seg_lo, seg_hi, ntn; const int* cnt; const int* lists; const char* A; const char* B; size_t a_tile  , b_exp  , b_tile  ;
    __device__ bool next(int i, Unit& u) const {
        const long L = (long)i * G + c; const int rt = (int)(L / ntn), pn = (int)(L % ntn);
        int base = 0, gbase = 0;
        for (int sgm = 0; sgm < seg_lo; ++sgm) gbase += (__hip_atomic_load(cnt + sgm, __ATOMIC_RELAXED, __HIP_MEMORY_SCOPE_AGENT) + 255) >> 8;
        for (int sgm = seg_lo; sgm < seg_hi; ++sgm) { const int n = __hip_atomic_load(cnt + sgm, __ATOMIC_RELAXED, __HIP_MEMORY_SCOPE_AGENT), nt = (n + 255) >> 8;
            if (rt < base + nt) { const int j = rt - base; u.pm = gbase + rt; u.pn = pn; u.seg = sgm; u.nvalid = (n - j * 256) < 256 ? (n - j * 256) : 256; u.rows = lists + (size_t)sgm * MOE_CAP + j * 256;
                u.a = A + (size_t)u.pm * a_tile; u.b = B + (size_t)(sgm & 31) * b_exp + (size_t)pn * b_tile; return true; }
            base += nt; }
        return false;
    }
};
struct EpiGlu {
    static constexpr bool PERM = false;
    bf16_t* H; const float* ssq2; const float* roww; const int* lists0;
    __device__ __forceinline__ void operator()(f32x4 (&acc)[2][2][4][2], const Unit& u, int wr, int wc, int fr, int fq, LAS unsigned char*) const {
#pragma unroll
        for (int ai = 0; ai < 2; ++ai)
#pragma unroll
            for (int m = 0; m < 4; ++m) { const int rl = ai * HALF + wr * 64 + m * 16 + fr; const bool valid = rl < u.nvalid;
                const int tok = valid ? u.rows[rl] : 0;
                const float wgt = valid ? *(roww + ((u.rows + rl) - lists0)) : 0.f;
                const float rs = rsqrtf(ssq2[tok] * (1.f / 1024.f) + EPS);
                f32x4 hv[2];
#pragma unroll
                for (int n = 0; n < 2; ++n) { const f32x4 a = acc[ai][0][m][n] * rs, uu = acc[ai][1][m][n] * rs; f32x4 r;
#pragma unroll
                    for (int j = 0; j < 4; ++j) r[j] = a[j] / (1.f + __expf(-a[j])) * uu[j] * wgt;
                    hv[n] = r; }
                *(u32x4*)(H + ((size_t)u.pm * 256 + rl) * 256 + u.pn * 128 + wc * 32 + 8 * fq) = pack8(hv[0], hv[1]); }
    }
};
struct EpiScatterAdd {
    static constexpr bool PERM = false;
    float* out;
    __device__ __forceinline__ void operator()(f32x4 (&acc)[2][2][4][2], const Unit& u, int wr, int wc, int fr, int fq, LAS unsigned char*) const {
        const int col0 = u.pn * 256 + wc * 32 + 4 * fq;
#pragma unroll
        for (int ai = 0; ai < 2; ++ai)
#pragma unroll
            for (int m = 0; m < 4; ++m) { const int rl = ai * HALF + wr * 64 + m * 16 + fr;
                if (rl < u.nvalid) { const int tok = u.rows[rl]; float* o = out + (size_t)tok * 1024 + col0;
#pragma unroll
                    for (int bj = 0; bj < 2; ++bj)
#pragma unroll
                        for (int n = 0; n < 2; ++n) { f32x4* q = (f32x4*)(o + bj * HALF + n * 16); *q = *q + acc[ai][bj][m][n]; } } }
    }
};
}
namespace at {
typedef float f32x16 __attribute__((ext_vector_type(16)));
typedef short s16x4 __attribute__((ext_vector_type(4)));
constexpr int NW = 8, QBLK = 32, KVBLK = 64, QB = 256;
constexpr int KROW = 400;
constexpr int SHM_V = KVBLK * 128 * 2, SHM_K = KVBLK * KROW;
constexpr int LDS_V = 0, LDS_K = 2 * SHM_V, LDS_WS = LDS_K + 2 * SHM_K, LDS_BYTES = LDS_WS + NW * 64 * 4;
constexpr float SCALE = 0.07216878364870322f;
constexpr float THR = 8.f;
#define SBAR() __builtin_amdgcn_sched_barrier(0)
__device__ __forceinline__ int v_st(int k, int c) { const int kk = (k & ~0xC) | ((k & 4) << 1) | ((k & 8) >> 1); return ((kk >> 3) * 4 + (c >> 5)) * 512 + ((kk & 7) * 32 + (c & 31)) * 2; }
__device__ __forceinline__ int v_rd_base(int lane) { return ((lane & 3) << 3) | (((lane >> 2) & 3) << 6) | (((lane >> 4) & 1) << 5) | (((lane >> 5) & 1) << 8); }
constexpr int v_rd_off(int d0, int ks, int half) { return d0 * 512 + ks * 4096 + half * 2048; }
__device__ __forceinline__ int crow(int r, int hi) { return (r & 3) + 8 * (r >> 2) + 4 * hi; }
__device__ __forceinline__ unsigned cvtpk(float lo, float hi) { unsigned r; asm volatile("v_cvt_pk_bf16_f32 %0, %1, %2" : "=v"(r) : "v"(lo), "v"(hi)); return r; }
__device__ __forceinline__ void mask_tile(f32x16& p0, f32x16& p1, int dq) {
    const float NEG = -__builtin_inff();
#pragma unroll
    for (int r = 0; r < 16; ++r) {
        const int c = (r & 3) + 8 * (r >> 2);
        if (dq - c < 0) p0[r] = NEG;
        if (dq - c - 32 < 0) p1[r] = NEG;
    }
}
__device__ __forceinline__ void partialSM(f32x16& p0, f32x16& p1, float& m_reg, float& mn, float& alpha) {
    float pmax = p0[0];
#pragma unroll
    for (int r = 1; r < 16; ++r) pmax = fmaxf(pmax, p0[r]);
#pragma unroll
    for (int r = 0; r < 16; ++r) pmax = fmaxf(pmax, p1[r]);
    { auto rr = __builtin_amdgcn_permlane32_swap(__float_as_uint(pmax), __float_as_uint(pmax), false, false);
      pmax = fmaxf(__uint_as_float(rr[0]), __uint_as_float(rr[1])); }
    constexpr float C2 = 1.4426950408889634f * SCALE;
    if (__builtin_expect(__all((pmax - m_reg) * SCALE <= THR), 1)) { mn = m_reg; alpha = 1.f; }
    else { mn = fmaxf(m_reg, pmax); alpha = __builtin_amdgcn_exp2f((m_reg - mn) * C2); m_reg = mn; }
    const float mnL = -mn * C2;
#pragma unroll
    for (int r = 0; r < 16; ++r) p0[r] = fmaf(p0[r], C2, mnL);
#pragma unroll
    for (int r = 0; r < 16; ++r) p1[r] = fmaf(p1[r], C2, mnL);
#pragma unroll
    for (int r = 0; r < 16; ++r) p0[r] = __builtin_amdgcn_exp2f(p0[r]);
}
__device__ __forceinline__ void finishSM(f32x16& p0, f32x16& p1, float alpha, float& l_reg, bf16x8& pa0, bf16x8& pa1, bf16x8& pa2, bf16x8& pa3) {
#pragma unroll
    for (int r = 0; r < 16; ++r) p1[r] = __builtin_amdgcn_exp2f(p1[r]);
    float ps = 0;
#pragma unroll
    for (int r = 0; r < 16; ++r) ps += p0[r];
#pragma unroll
    for (int r = 0; r < 16; ++r) ps += p1[r];
    { auto rr = __builtin_amdgcn_permlane32_swap(__float_as_uint(ps), __float_as_uint(ps), false, false);
      ps = __uint_as_float(rr[0]) + __uint_as_float(rr[1]); }
    l_reg = l_reg * alpha + ps;
#define PK4(P, B_, OUT) do { unsigned a0 = cvtpk(P[B_+0], P[B_+1]), a1 = cvtpk(P[B_+2], P[B_+3]);                          \
        unsigned b0 = cvtpk(P[B_+4], P[B_+5]), b1 = cvtpk(P[B_+6], P[B_+7]);                                             \
        auto r0 = __builtin_amdgcn_permlane32_swap(a0, b0, false, false); auto r1 = __builtin_amdgcn_permlane32_swap(a1, b1, false, false); \
        u32x4 w = {r0[0], r1[0], r0[1], r1[1]}; OUT = *reinterpret_cast<bf16x8*>(&w); } while (0)
    PK4(p0, 0, pa0); PK4(p0, 8, pa1); PK4(p1, 0, pa2); PK4(p1, 8, pa3);
#undef PK4
}
template <int KB>
__device__ __forceinline__ void qkt(f32x16& p0, f32x16& p1, const char* K_lds, int r32, int hi, const bf16x8* qr) {
    p0 = f32x16{}; p1 = f32x16{};
    const char* kb = K_lds + KB * SHM_K + r32 * KROW + hi * 16;
#pragma unroll
    for (int d0 = 0; d0 < 12; ++d0) {
        const bf16x8 b0 = *reinterpret_cast<const bf16x8*>(kb + d0 * 32);
        const bf16x8 b1 = *reinterpret_cast<const bf16x8*>(kb + 32 * KROW + d0 * 32);
        p0 = __builtin_amdgcn_mfma_f32_32x32x16_bf16(b0, qr[d0], p0, 0, 0, 0);
        p1 = __builtin_amdgcn_mfma_f32_32x32x16_bf16(b1, qr[d0], p1, 0, 0, 0);
    }
}
template <int VB>
__device__ __forceinline__ void pv_tile(f32x16* o, int vb0, bf16x8 pa0, bf16x8 pa1, bf16x8 pa2, bf16x8 pa3) {
#define TRRD(dst, off) asm volatile("ds_read_b64_tr_b16 %0, %1 offset:%2" : "=&v"(dst) : "v"(vb0), "i"(off) : "memory")
#define PV_D0(d0) do { s16x4 l0, l1, l2, l3, h0, h1, h2, h3; constexpr int b_ = VB * SHM_V + v_rd_off(d0, 0, 0);   \
        TRRD(l0, b_); TRRD(h0, b_ + 2048); TRRD(l1, b_ + 4096); TRRD(h1, b_ + 6144); TRRD(l2, b_ + 8192); TRRD(h2, b_ + 10240); TRRD(l3, b_ + 12288); TRRD(h3, b_ + 14336); \
        asm volatile("s_waitcnt lgkmcnt(0)" ::: "memory"); SBAR();   \
        o[d0] = __builtin_amdgcn_mfma_f32_32x32x16_bf16(pa0, (bf16x8){l0[0], l0[1], l0[2], l0[3], h0[0], h0[1], h0[2], h0[3]}, o[d0], 0, 0, 0);   \
        o[d0] = __builtin_amdgcn_mfma_f32_32x32x16_bf16(pa1, (bf16x8){l1[0], l1[1], l1[2], l1[3], h1[0], h1[1], h1[2], h1[3]}, o[d0], 0, 0, 0);   \
        o[d0] = __builtin_amdgcn_mfma_f32_32x32x16_bf16(pa2, (bf16x8){l2[0], l2[1], l2[2], l2[3], h2[0], h2[1], h2[2], h2[3]}, o[d0], 0, 0, 0);   \
        o[d0] = __builtin_amdgcn_mfma_f32_32x32x16_bf16(pa3, (bf16x8){l3[0], l3[1], l3[2], l3[3], h3[0], h3[1], h3[2], h3[3]}, o[d0], 0, 0, 0); } while (0)
    PV_D0(0); PV_D0(1); PV_D0(2); PV_D0(3);
#undef PV_D0
#undef TRRD
}

__device__ __forceinline__ void attn_block(const bf16_t* Q, const bf16_t* K, const bf16_t* V, bf16_t* O, size_t tb, int h, int P0, char* lds) {
    const int tid = threadIdx.x, wid = __builtin_amdgcn_readfirstlane(tid >> 6), lane = tid & 63, r32 = lane & 31, hi = lane >> 5;
    const int NT = (P0 + QB) / KVBLK;
    const int qlo = P0 + wid * QBLK, qm = qlo + r32 - 4 * hi;
    char* V_lds = lds + LDS_V; char* K_lds = lds + LDS_K;
    float* ws = (float*)(lds + LDS_WS) + wid * 64; float* li_l = ws, * al_l = ws + 32;
    float m_reg = -1e30f, l_reg = 0; f32x16 o[4] = {};
    const bf16_t* Kh = K + tb * 768 + h * 192; const bf16_t* Vh = V + tb * 512 + h * 128;
    const int sr = tid >> 4, sc = (tid & 15) * 8, vst0 = v_st(sr, sc), vst1 = v_st(32 + sr, sc);
    const int kgo = (tid >> 3) * 768 + (tid & 7) * 8, klo = (tid >> 3) * KROW + (tid & 7) * 16;
    const int vb0 = (int)(uintptr_t)V_lds + v_rd_base(lane);
    bf16x8 st_k0, st_k1, st_k2, st_v0, st_v1;
#define VMW() asm volatile("s_waitcnt vmcnt(0)" ::: "memory")
#define SLOAD(k0) do { const bf16_t* kp_ = Kh + (size_t)(k0) * 768 + kgo; st_k0 = *(const bf16x8*)(kp_); st_k1 = *(const bf16x8*)(kp_ + 64); st_k2 = *(const bf16x8*)(kp_ + 128); \
        st_v0 = *(const bf16x8*)(Vh + (size_t)((k0) + sr) * 512 + sc); st_v1 = *(const bf16x8*)(Vh + (size_t)((k0) + 32 + sr) * 512 + sc); } while (0)
#define SWRITE(bf) do { char* kw_ = K_lds + (bf) * SHM_K + klo; *(bf16x8*)(kw_) = st_k0; *(bf16x8*)(kw_ + 128) = st_k1; *(bf16x8*)(kw_ + 256) = st_k2; \
        *(bf16x8*)(V_lds + (bf) * SHM_V + vst0) = st_v0; *(bf16x8*)(V_lds + (bf) * SHM_V + vst1) = st_v1; } while (0)
#define RESC(a) do { if (__any((a) < 1.f)) { if (hi == 0) al_l[r32] = (a); asm volatile("s_waitcnt lgkmcnt(0)" ::: "memory");              \
                     for (int d_ = 0; d_ < 4; ++d_) for (int r = 0; r < 16; ++r) o[d_][r] *= al_l[crow(r, hi)]; } } while (0)
#define KBASE(t) ((t) * KVBLK)
#define MASKT(P0_, P1_, t) do { const int kb_ = KBASE(t); if (kb_ + KVBLK - 1 > qlo) mask_tile(P0_, P1_, qm - kb_); } while (0)
    bf16x8 qr[12];
    { const bf16_t* Qw = Q + (tb + qlo + r32) * 768 + h * 192 + hi * 8;
#pragma unroll
      for (int d0 = 0; d0 < 12; ++d0) qr[d0] = *(const bf16x8*)(Qw + d0 * 16); }
    SLOAD(0); VMW(); SWRITE(0);
    __syncthreads();
    f32x16 p0, p1; float mn, al; bf16x8 pa0, pa1, pa2, pa3;
#define TILE_STEP(t, BUF) do {                                                                   \
        if ((t) + 1 < NT) { SLOAD(KBASE((t) + 1)); }                                              \
        SBAR(); qkt<BUF>(p0, p1, K_lds, r32, hi, qr);                                             \
        MASKT(p0, p1, (t)); partialSM(p0, p1, m_reg, mn, al); RESC(al);                           \
        finishSM(p0, p1, al, l_reg, pa0, pa1, pa2, pa3); SBAR();                                  \
        pv_tile<BUF>(o, vb0, pa0, pa1, pa2, pa3);                                                 \
        if ((t) + 1 < NT) { VMW(); SWRITE(1 - BUF); }                                             \
        __syncthreads(); } while (0)
    for (int t = 0; t < NT; t += 2) { TILE_STEP(t, 0); TILE_STEP(t + 1, 1); }
    if (hi == 0) li_l[r32] = l_reg; asm volatile("s_waitcnt lgkmcnt(0)" ::: "memory");
    float rli[16];
#pragma unroll
    for (int r = 0; r < 16; ++r) rli[r] = __builtin_amdgcn_rcpf(li_l[crow(r, hi)]);
    bf16_t* Ow = O + (tb + qlo) * 1024 + h * 128;
#pragma unroll
    for (int r = 0; r < 16; ++r) { const int orow = crow(r, hi);
#pragma unroll
        for (int d0 = 0; d0 < 4; ++d0) { const float v = o[d0][r] * rli[r];
            const float vn = __shfl_xor(v, 1);
            if ((r32 & 1) == 0) *(unsigned*)(Ow + (size_t)orow * 1024 + d0 * 32 + r32) = cvtpk(v, vn); } }
#undef VMW
#undef SLOAD
#undef SWRITE
#undef RESC
#undef KBASE
#undef MASKT
#undef TILE_STEP
}
#undef SBAR

__device__ __forceinline__ void attn_phase(const bf16_t* Q, const bf16_t* K, const bf16_t* V, bf16_t* O, char* lds) {
    for (int L = blockIdx.x; L < 256; L += gridDim.x) {
        const int xcd = L & 7, k = L >> 3, bh = (k >> 3) * 8 + xcd, x = k & 7;
        const int b = bh >> 2, h = bh & 3; const size_t tb = (size_t)b * 4096;
        attn_block(Q, K, V, O, tb, h, (15 - x) * QB, lds);
        attn_block(Q, K, V, O, tb, h, x * QB, lds);
    }
}
}
namespace rt {
using at::f32x16; using at::s16x4; using at::v_st; using at::v_rd_base; using at::v_rd_off; using at::crow; using at::cvtpk;
constexpr int PITCH = 272;
constexpr int L_Q = 0, L_K = 128 * PITCH, L_V = 2 * 128 * PITCH, L_S = L_V + 32768, L_END = L_S + 128 * PITCH;
#define TRRD(dst, base, off) asm volatile("ds_read_b64_tr_b16 %0, %1 offset:%2" : "=&v"(dst) : "v"(base), "i"(off) : "memory")
#define FRAG(l, h) ((bf16x8){l[0], l[1], l[2], l[3], h[0], h[1], h[2], h[3]})
using fx::gamma_log2;

__device__ __forceinline__ void ret_kv_unit(const bf16_t* RK, const bf16_t* RV, bf16_t* KVS, int bh, int c, char* lds) {
    const int tid = threadIdx.x, wid = __builtin_amdgcn_readfirstlane(tid >> 6), lane = tid & 63, r32 = lane & 31, hi = lane >> 5;
    const int b = bh >> 2, h = bh & 3; const size_t t0 = (size_t)b * 4096 + (size_t)c * 128;
    char* Kl = lds; char* Vl = lds + 32768;
#pragma unroll
    for (int i = 0; i < 4; ++i) { const int q = tid + 512 * i, row = q >> 4, cc = (q & 15) * 8; const int lo = (row >> 6) * 16384 + v_st(row & 63, cc);
        *(bf16x8*)(Kl + lo) = *(const bf16x8*)(RK + (t0 + row) * 512 + h * 128 + cc);
        *(bf16x8*)(Vl + lo) = *(const bf16x8*)(RV + (t0 + row) * 512 + h * 128 + cc); }
    __syncthreads();
    const int dvb = wid >> 1, dkb = 2 * (wid & 1);
    const int vbase = (int)(uintptr_t)Vl + v_rd_base(lane) + dvb * 512, kbase = (int)(uintptr_t)Kl + v_rd_base(lane) + dkb * 512;
    f32x16 acc0 = {}, acc1 = {};
#define KVSTEP(sub, ks) do { s16x4 al, ah, b0l, b0h, b1l, b1h; constexpr int o_ = (sub) * 16384 + v_rd_off(0, ks, 0);   \
        TRRD(al, vbase, o_); TRRD(ah, vbase, o_ + 2048); TRRD(b0l, kbase, o_); TRRD(b0h, kbase, o_ + 2048); TRRD(b1l, kbase, o_ + 512); TRRD(b1h, kbase, o_ + 512 + 2048); \
        asm volatile("s_waitcnt lgkmcnt(0)" ::: "memory"); __builtin_amdgcn_sched_barrier(0);   \
        acc0 = __builtin_amdgcn_mfma_f32_32x32x16_bf16(FRAG(al, ah), FRAG(b0l, b0h), acc0, 0, 0, 0);   \
        acc1 = __builtin_amdgcn_mfma_f32_32x32x16_bf16(FRAG(al, ah), FRAG(b1l, b1h), acc1, 0, 0, 0); } while (0)
    KVSTEP(0, 0); KVSTEP(0, 1); KVSTEP(0, 2); KVSTEP(0, 3); KVSTEP(1, 0); KVSTEP(1, 1); KVSTEP(1, 2); KVSTEP(1, 3);
#undef KVSTEP
    const float sc = exp2f(127.f * gamma_log2(h));
    bf16_t* O = KVS + ((size_t)(bh * 32 + c) * 128 + dvb * 32) * 128 + dkb * 32;
#pragma unroll
    for (int r = 0; r < 16; ++r) { const int dv = crow(r, hi);
        const float v0 = acc0[r] * sc, v1 = acc1[r] * sc; const float n0 = __shfl_xor(v0, 1), n1 = __shfl_xor(v1, 1);
        if ((r32 & 1) == 0) { *(unsigned*)(O + (size_t)dv * 128 + r32) = cvtpk(v0, n0); *(unsigned*)(O + (size_t)dv * 128 + 32 + r32) = cvtpk(v1, n1); } }
    __syncthreads();
}
__device__ __forceinline__ void ret_kv_phase(const bf16_t* RK, const bf16_t* RV, bf16_t* KVS, char* lds) {
    for (int u = blockIdx.x; u < 1024; u += gridDim.x) ret_kv_unit(RK, RV, KVS, u >> 5, u & 31, lds);
}

__device__ __forceinline__ void ret_out_unit(const bf16_t* RQ, const bf16_t* RK, const bf16_t* RV, const bf16_t* RG, const bf16_t* KVS, const float* gn_g, bf16_t* AO, int bh, int c, char* lds) {
    const int tid = threadIdx.x, wid = __builtin_amdgcn_readfirstlane(tid >> 6), lane = tid & 63, r32 = lane & 31, hi = lane >> 5;
    const int b = bh >> 2, h = bh & 3; const size_t t0 = (size_t)b * 4096 + (size_t)c * 128;
    const float lg = gamma_log2(h);
#pragma unroll
    for (int i = 0; i < 4; ++i) { const int q = tid + 512 * i, row = q >> 4, cc = (q & 15) * 8;
        *(bf16x8*)(lds + L_Q + row * PITCH + cc * 2) = *(const bf16x8*)(RQ + (t0 + row) * 512 + h * 128 + cc);
        *(bf16x8*)(lds + L_K + row * PITCH + cc * 2) = *(const bf16x8*)(RK + (t0 + row) * 512 + h * 128 + cc);
        *(bf16x8*)(lds + L_V + (row >> 6) * 16384 + v_st(row & 63, cc)) = *(const bf16x8*)(RV + (t0 + row) * 512 + h * 128 + cc); }
    { f32x4 sa[4][2];
#pragma unroll
      for (int i = 0; i < 4; ++i) { sa[i][0] = (f32x4){0.f, 0.f, 0.f, 0.f}; sa[i][1] = sa[i][0]; }
      float w = 1.f; const float cd = exp2f(128.f * lg);
      for (int j = c - 1; j >= 0; --j) { const bf16_t* src = KVS + (size_t)(bh * 32 + j) * 16384 + tid * 8;
#pragma unroll
          for (int i = 0; i < 4; ++i) { const u32x4 v = *(const u32x4*)(src + 4096 * i);
              sa[i][0] += w * (f32x4){__uint_as_float(v.x << 16), __uint_as_float(v.x & 0xffff0000u), __uint_as_float(v.y << 16), __uint_as_float(v.y & 0xffff0000u)};
              sa[i][1] += w * (f32x4){__uint_as_float(v.z << 16), __uint_as_float(v.z & 0xffff0000u), __uint_as_float(v.w << 16), __uint_as_float(v.w & 0xffff0000u)}; }
          w *= cd; }
#pragma unroll
      for (int i = 0; i < 4; ++i) { const int e8 = tid + 512 * i, dv = e8 >> 4, dk0 = (e8 & 15) * 8; *(u32x4*)(lds + L_S + dv * PITCH + dk0 * 2) = fx::pack8(sa[i][0], sa[i][1]); } }
    __syncthreads();
    const int qg = wid & 3, dh = wid >> 2;
    bf16x8 qr[8];
#pragma unroll
    for (int d0 = 0; d0 < 8; ++d0) qr[d0] = *(const bf16x8*)(lds + L_Q + (32 * qg + r32) * PITCH + d0 * 32 + hi * 16);
    f32x16 o[2] = {};
#pragma unroll
    for (int dd = 0; dd < 2; ++dd) { const char* sb = lds + L_S + ((2 * dh + dd) * 32 + r32) * PITCH + hi * 16;
#pragma unroll
        for (int d0 = 0; d0 < 8; ++d0) o[dd] = __builtin_amdgcn_mfma_f32_32x32x16_bf16(qr[d0], *(const bf16x8*)(sb + d0 * 32), o[dd], 0, 0, 0); }
    { const float g1 = exp2f(lg);
#pragma unroll
      for (int dd = 0; dd < 2; ++dd)
#pragma unroll
          for (int r = 0; r < 16; ++r) o[dd][r] *= g1; }
    const int vb = (int)(uintptr_t)(lds + L_V) + v_rd_base(lane) + (2 * dh) * 512;
    const int qpos = 32 * qg + r32;
#define INTRA(kt) do { if (64 * (kt) <= 32 * qg + 31) { f32x16 p0 = {}, p1 = {}; const char* kb = lds + L_K + (64 * (kt) + r32) * PITCH + hi * 16;   \
        _Pragma("unroll") for (int d0 = 0; d0 < 8; ++d0) { p0 = __builtin_amdgcn_mfma_f32_32x32x16_bf16(*(const bf16x8*)(kb + d0 * 32), qr[d0], p0, 0, 0, 0);   \
                                                          p1 = __builtin_amdgcn_mfma_f32_32x32x16_bf16(*(const bf16x8*)(kb + 32 * PITCH + d0 * 32), qr[d0], p1, 0, 0, 0); }   \
        _Pragma("unroll") for (int r = 0; r < 16; ++r) { const int key = 64 * (kt) + crow(r, hi); if (key > qpos) p0[r] = 0.f; if (key + 32 > qpos) p1[r] = 0.f; }   \
        bf16x8 pa0, pa1, pa2, pa3;   \
        PK4(p0, 0, pa0); PK4(p0, 8, pa1); PK4(p1, 0, pa2); PK4(p1, 8, pa3);   \
        PVD(kt, 0); PVD(kt, 1); } } while (0)
#define PK4(P, B_, OUT) do { unsigned a0 = cvtpk(P[B_+0], P[B_+1]), a1 = cvtpk(P[B_+2], P[B_+3]); unsigned b0 = cvtpk(P[B_+4], P[B_+5]), b1 = cvtpk(P[B_+6], P[B_+7]);   \
        auto r0 = __builtin_amdgcn_permlane32_swap(a0, b0, false, false); auto r1 = __builtin_amdgcn_permlane32_swap(a1, b1, false, false);   \
        u32x4 w_ = {r0[0], r1[0], r0[1], r1[1]}; OUT = *reinterpret_cast<bf16x8*>(&w_); } while (0)
#define PVD(kt, dd) do { s16x4 l0, l1, l2, l3, h0, h1, h2, h3; constexpr int b_ = (kt) * 16384 + v_rd_off(dd, 0, 0);   \
        TRRD(l0, vb, b_); TRRD(h0, vb, b_ + 2048); TRRD(l1, vb, b_ + 4096); TRRD(h1, vb, b_ + 6144); TRRD(l2, vb, b_ + 8192); TRRD(h2, vb, b_ + 10240); TRRD(l3, vb, b_ + 12288); TRRD(h3, vb, b_ + 14336);   \
        asm volatile("s_waitcnt lgkmcnt(0)" ::: "memory"); __builtin_amdgcn_sched_barrier(0);   \
        o[dd] = __builtin_amdgcn_mfma_f32_32x32x16_bf16(pa0, FRAG(l0, h0), o[dd], 0, 0, 0); o[dd] = __builtin_amdgcn_mfma_f32_32x32x16_bf16(pa1, FRAG(l1, h1), o[dd], 0, 0, 0);   \
        o[dd] = __builtin_amdgcn_mfma_f32_32x32x16_bf16(pa2, FRAG(l2, h2), o[dd], 0, 0, 0); o[dd] = __builtin_amdgcn_mfma_f32_32x32x16_bf16(pa3, FRAG(l3, h3), o[dd], 0, 0, 0); } while (0)
    INTRA(0); INTRA(1);
#undef INTRA
#undef PK4
#undef PVD
    __syncthreads();
    float* Os = (float*)lds;
#pragma unroll
    for (int dd = 0; dd < 2; ++dd)
#pragma unroll
        for (int r = 0; r < 16; ++r) Os[(32 * qg + crow(r, hi)) * 132 + (2 * dh + dd) * 32 + r32] = o[dd][r];
    __syncthreads();
    { const int q = tid >> 2, seg = tid & 3; const float* orow = Os + q * 132 + seg * 32;
      f32x4 v[8]; float s1 = 0.f, s2 = 0.f;
#pragma unroll
      for (int i = 0; i < 8; ++i) { v[i] = *(const f32x4*)(orow + 4 * i); s1 += (v[i][0] + v[i][1]) + (v[i][2] + v[i][3]); s2 += fx::sq4(v[i]); }
      s1 += __shfl_xor(s1, 1); s1 += __shfl_xor(s1, 2); s2 += __shfl_xor(s2, 1); s2 += __shfl_xor(s2, 2);
      const float mean = s1 * (1.f / 128.f); const float var = fmaxf(s2 * (1.f / 128.f) - mean * mean, 0.f); const float rs = rsqrtf(var + EPS);
      const bf16_t* gp = RG + (t0 + q) * 512 + h * 128 + seg * 32; const float* gg = gn_g + h * 128 + seg * 32;
      bf16_t* op = AO + (t0 + q) * 1024 + 512 + h * 128 + seg * 32;
#pragma unroll
      for (int i = 0; i < 4; ++i) { const u32x4 gr = *(const u32x4*)(gp + 8 * i); const f32x4 g0 = *(const f32x4*)(gg + 8 * i), g1 = *(const f32x4*)(gg + 8 * i + 4);
          const f32x4 ga = {__uint_as_float(gr.x << 16), __uint_as_float(gr.x & 0xffff0000u), __uint_as_float(gr.y << 16), __uint_as_float(gr.y & 0xffff0000u)};
          const f32x4 gb = {__uint_as_float(gr.z << 16), __uint_as_float(gr.z & 0xffff0000u), __uint_as_float(gr.w << 16), __uint_as_float(gr.w & 0xffff0000u)};
          f32x4 ya = (v[2 * i] - mean) * rs * g0, yb = (v[2 * i + 1] - mean) * rs * g1;
#pragma unroll
          for (int k = 0; k < 4; ++k) { ya[k] *= ga[k] / (1.f + __expf(-ga[k])); yb[k] *= gb[k] / (1.f + __expf(-gb[k])); }
          *(u32x4*)(op + 8 * i) = fx::pack8(ya, yb); } }
    __syncthreads();
}
__device__ __forceinline__ void ret_out_phase(const bf16_t* RQ, const bf16_t* RK, const bf16_t* RV, const bf16_t* RG, const bf16_t* KVS, const float* gn_g, bf16_t* AO, char* lds) {
    for (int it = blockIdx.x; it < 512; it += gridDim.x) { const int bh = it >> 4, x = it & 15;
        ret_out_unit(RQ, RK, RV, RG, KVS, gn_g, AO, bh, 31 - x, lds);
        ret_out_unit(RQ, RK, RV, RG, KVS, gn_g, AO, bh, x, lds); }
}
#undef TRRD
#undef FRAG
}
namespace cg = cooperative_groups;
constexpr int NWAVES = 8;
constexpr int RING_BYTES = 131072, XL_OFF = RING_BYTES, XL_BYTES = 8192, LDS_BYTES = RING_BYTES + 8192 + 16384;

struct Params {
    const float* in[28]; float* out; unsigned char* ws; int ph_lo, ph_hi; int coop; int pad;
};
#define P_X(p) ((p).in[0])
#define WSP(T_, off) ((T_*)(p.ws + (off)))

constexpr size_t WB_IN = WS_WB, WB_UQ = WB_IN + (size_t)2560 * 1024 * 2, WB_UKV = WB_UQ + (size_t)1024 * 256 * 2, WB_OUT = WB_UKV + (size_t)1024 * 256 * 2,
                 WB_CQ = WB_OUT + (size_t)1024 * 1024 * 2, WB_CKV = WB_CQ + (size_t)1024 * 1024 * 2, WB_CO = WB_CKV + (size_t)2048 * 1024 * 2,
                 WB_GU = WB_CO + (size_t)1024 * 1024 * 2, WB_D = WB_GU + (size_t)32 * 512 * 1024 * 2, WB_END = WB_D + (size_t)32 * 1024 * 256 * 2;
static_assert(WB_END <= WS_RQ, "weight copies overflow their region");

__device__ __forceinline__ float wave_sum64(float v) {
#pragma unroll
    for (int o = 1; o < 64; o <<= 1) v += __shfl_xor(v, o);
    return v;
}
__device__ __forceinline__ int plain_src(int n) { return (n & ~31) + pg8::perm32(n & 31); }

template <class SrcFn, class DstFn>
__device__ __forceinline__ void wprep_item(const float* __restrict__ W, int ldw, int Kreal, const float* __restrict__ gain, bf16_t* __restrict__ WT, int ldt,
                                           LAS float* scr, int kb, int nb, int lane, SrcFn src, DstFn dst) {
    const int k0 = 64 * kb, n0 = 32 * nb;
    const int sc = src(n0 + (lane & 31));
#pragma unroll 8
    for (int i = 0; i < 32; ++i) { const int kk = 2 * i + (lane >> 5); float v = 0.f;
        if (sc >= 0 && k0 + kk < Kreal) { v = W[(size_t)(k0 + kk) * ldw + sc]; if (gain) v *= gain[k0 + kk]; }
        scr[kk * 33 + (lane & 31)] = v; }
    asm volatile("s_waitcnt lgkmcnt(0)" ::: "memory");
    const int c = lane & 7;
#pragma unroll
    for (int j = 0; j < 4; ++j) { const int n = (lane >> 3) + 8 * j; const LAS float* s = scr + (8 * c) * 33 + n;
        u32x4 o; o.x = pg8::cvt_pk_bf16(s[0 * 33], s[1 * 33]); o.y = pg8::cvt_pk_bf16(s[2 * 33], s[3 * 33]); o.z = pg8::cvt_pk_bf16(s[4 * 33], s[5 * 33]); o.w = pg8::cvt_pk_bf16(s[6 * 33], s[7 * 33]);
        *(u32x4*)(WT + (size_t)dst(n0 + n) * ldt + k0 + 8 * c) = o; }
    asm volatile("s_waitcnt lgkmcnt(0)" ::: "memory");
}
template <class SrcFn, class DstFn>
__device__ __forceinline__ void wprep_matrix(const float* W, int ldw, int Kreal, int Kpad, int Nitems32, const float* gain, bf16_t* WT, int ldt, LAS float* scr, int gw, int NGW, int lane, SrcFn src, DstFn dst) {
    const int nkb = Kpad / 64, total = nkb * Nitems32;
    for (int it = gw; it < total; it += NGW) wprep_item(W, ldw, Kreal, gain, WT, ldt, scr, it / Nitems32, it % Nitems32, lane, src, dst);
}
__device__ __forceinline__ void rms_row_to_bf16(const float* xrow, const float* g, bf16_t* orow, int lane) {
    const f32x4* xr = (const f32x4*)xrow + lane; const f32x4* gr = (const f32x4*)g + lane;
    f32x4 v[4]; float s = 0.f;
#pragma unroll
    for (int j = 0; j < 4; ++j) { v[j] = xr[64 * j]; s += fx::sq4(v[j]); }
    const float rs = rsqrtf(wave_sum64(s) * (1.f / 1024.f) + EPS);
    u32x2* o8 = (u32x2*)orow + lane;
#pragma unroll
    for (int j = 0; j < 4; ++j) { const f32x4 w = v[j] * rs * gr[64 * j]; o8[64 * j] = fx::pack4(w); }
}

__device__ __forceinline__ void p0_prologue(const Params& p, LAS unsigned char* lds, int wave, int lane) {
    LAS float* scr = (LAS float*)(lds + wave * 16384);
    const int gw = blockIdx.x * NWAVES + wave, NGW = gridDim.x * NWAVES;
    auto ident = [](int n) { return n; };
    wprep_matrix(p.in[4], 2496, 1024, 1024, 2560 / 32, nullptr, WSP(bf16_t, WB_IN), 1024, scr, gw, NGW, lane, [](int n) { return fx::inproj_src(n); }, ident);
    wprep_matrix(p.in[12], 1024, 1024, 1024, 1024 / 32, nullptr, WSP(bf16_t, WB_OUT), 1024, scr, gw, NGW, lane, ident, ident);
    wprep_matrix(p.in[19], 1024, 1024, 1024, 1024 / 32, nullptr, WSP(bf16_t, WB_CO), 1024, scr, gw, NGW, lane, ident, ident);
    wprep_matrix(p.in[6], 768, 256, 256, 1024 / 32, p.in[5], WSP(bf16_t, WB_UQ), 256, scr, gw, NGW, lane, [](int n) { return fx::mlaq_src(n); }, ident);
    wprep_matrix(p.in[8], 1024, 128, 256, 1024 / 32, p.in[7], WSP(bf16_t, WB_UKV), 256, scr, gw, NGW, lane, [](int n) { return plain_src(n); }, ident);
    wprep_matrix(p.in[15], 1024, 1024, 1024, 1024 / 32, p.in[13], WSP(bf16_t, WB_CQ), 1024, scr, gw, NGW, lane, [](int n) { return plain_src(n); }, ident);
    wprep_matrix(p.in[16], 2048, 1024, 1024, 2048 / 32, nullptr, WSP(bf16_t, WB_CKV), 1024, scr, gw, NGW, lane, [](int n) { return n < 1024 ? plain_src(n) : n; }, ident);
    for (int it = gw; it < 32 * 128; it += NGW) { const int e = it >> 7, r = it & 127, kb = r >> 3, nb = r & 7;
        auto srcf = [](int n) { return (n >> 7) * 128 + plain_src(n & 127); };
        wprep_item(p.in[25] + (size_t)e * 1024 * 256, 256, 1024, p.in[20], WSP(bf16_t, WB_GU) + (size_t)e * 512 * 1024, 1024, scr, kb, nb, lane, srcf, [](int n) { return (n >> 7) * 256 + (n & 127); });
        wprep_item(p.in[26] + (size_t)e * 1024 * 256, 256, 1024, p.in[20], WSP(bf16_t, WB_GU) + (size_t)e * 512 * 1024, 1024, scr, kb, nb, lane, srcf, [](int n) { return (n >> 7) * 256 + 128 + (n & 127); }); }
    for (int it = gw; it < 32 * 128; it += NGW) { const int e = it >> 7, r = it & 127, kb = r >> 5, nb = r & 31;
        wprep_item(p.in[27] + (size_t)e * 256 * 1024, 1024, 256, nullptr, WSP(bf16_t, WB_D) + (size_t)e * 1024 * 256, 256, scr, kb, nb, lane, ident, ident); }
    for (int m = gw; m < T_TOK; m += NGW) rms_row_to_bf16(p.in[0] + (size_t)m * 1024, p.in[3], WSP(bf16_t, WS_HB) + (size_t)m * 1024, lane);
    for (int m = gw; m < 2048; m += NGW) rms_row_to_bf16(p.in[1] + (size_t)m * 1024, p.in[14], WSP(bf16_t, WS_MB) + (size_t)m * 1024, lane);
    { const int* pos = (const int*)p.in[2]; float* cs = WSP(float, WS_CS);
      const int gt = blockIdx.x * (NWAVES * 64) + threadIdx.x, NT = gridDim.x * NWAVES * 64;
      for (int idx = gt; idx < T_TOK * 64; idx += NT) { const int t = idx >> 6, i = idx & 63; const float inv = powf(10000.f, -(float)i * (1.f / 64.f)); float sn, c; sincosf((float)pos[t] * inv, &sn, &c);
          *(f32x2*)(cs + (size_t)idx * 2) = (f32x2){c, sn}; }
      float* z = WSP(float, WS_SSQ_CQ);
      for (int idx = gt; idx < 5 * 32768; idx += NT) z[idx] = 0.f;
      if (gt < 64) WSP(int, WS_CNT)[gt] = 0;
      float* wr = WSP(float, WS_RW);
      for (int idx = gt; idx < 64 * 1024; idx += NT) { const int n = idx >> 10, k = idx & 1023; float v = 0.f;
          if (n < 4) v = p.in[20][k] * p.in[21][k * 4 + n]; else if (n < 36) v = p.in[20][k] * p.in[23][k * 32 + n - 4];
          wr[idx] = v; } }
}

__device__ __forceinline__ void router_phase(const Params& p, LAS unsigned char* lds, int wave, int lane) {
    const float* x2 = p.out; const float* WR = WSP(float, WS_RW);
    int* cnt = WSP(int, WS_CNT); int* lists = WSP(int, WS_LISTS); float* roww = WSP(float, WS_ROWW);
    const float* bg = p.in[22]; const float* be = p.in[24];
    LAS float* lg = (LAS float*)(lds + wave * 4096);
    const int i = lane & 15, kq = lane >> 4;
    for (int item = blockIdx.x * NWAVES + wave; item < T_TOK / 16; item += gridDim.x * NWAVES) {
        const int t0 = item * 16;
        const float* xr = x2 + (size_t)(t0 + i) * 1024 + 4 * kq;
        const float* w0 = WR + (size_t)i * 1024 + 4 * kq;
        f32x4 c0 = {0.f, 0.f, 0.f, 0.f}, c1 = c0, c2 = c0; float ss = 0.f;
#pragma unroll 4
        for (int c = 0; c < 64; ++c) {
            const f32x4 a = *(const f32x4*)(xr + 16 * c), b0 = *(const f32x4*)(w0 + 16 * c), b1 = *(const f32x4*)(w0 + 16 * 1024 + 16 * c), b2 = *(const f32x4*)(w0 + 32 * 1024 + 16 * c);
            ss += fx::sq4(a);
#pragma unroll
            for (int s = 0; s < 4; ++s) { c0 = __builtin_amdgcn_mfma_f32_16x16x4f32(a[s], b0[s], c0, 0, 0, 0); c1 = __builtin_amdgcn_mfma_f32_16x16x4f32(a[s], b1[s], c1, 0, 0, 0); c2 = __builtin_amdgcn_mfma_f32_16x16x4f32(a[s], b2[s], c2, 0, 0, 0); }
        }
        ss = fx::quad_sum(ss);
        const float rs = rsqrtf(ss * (1.f / 1024.f) + EPS);
#pragma unroll
        for (int r = 0; r < 4; ++r) { lg[(4 * kq + r) * 48 + i] = c0[r]; lg[(4 * kq + r) * 48 + 16 + i] = c1[r]; lg[(4 * kq + r) * 48 + 32 + i] = c2[r]; }
        asm volatile("s_waitcnt lgkmcnt(0)" ::: "memory");
        if (lane < 16) {
            const int t = t0 + lane; float L[36];
#pragma unroll
            for (int j = 0; j < 36; ++j) L[j] = lg[lane * 48 + j] * rs;
            float mx = fmaxf(fmaxf(L[0], L[1]), fmaxf(L[2], L[3]));
            float den = 0.f;
#pragma unroll
            for (int j = 0; j < 4; ++j) den += expf(L[j] - mx);
            int gs = 0; float best = L[0] + bg[0];
#pragma unroll
            for (int j = 1; j < 4; ++j) { const float v = L[j] + bg[j]; if (v > best) { best = v; gs = j; } }
            float el[8], lgs = 0.f;
#pragma unroll
            for (int g4 = 0; g4 < 4; ++g4) if (g4 == gs) { lgs = L[g4];
#pragma unroll
                for (int j = 0; j < 8; ++j) el[j] = L[4 + g4 * 8 + j]; }
            const float gw = expf(lgs - mx) / den;
            float emx = el[0];
#pragma unroll
            for (int j = 1; j < 8; ++j) emx = fmaxf(emx, el[j]);
            float eden = 0.f;
#pragma unroll
            for (int j = 0; j < 8; ++j) eden += expf(el[j] - emx);
            float sc[8];
#pragma unroll
            for (int j = 0; j < 8; ++j) sc[j] = el[j] + be[gs * 8 + j];
            int i0 = 0; float b0 = sc[0], e0v = el[0];
#pragma unroll
            for (int j = 1; j < 8; ++j) if (sc[j] > b0) { b0 = sc[j]; i0 = j; e0v = el[j]; }
            int i1 = -1; float b1 = -3.0e38f, e1v = 0.f;
#pragma unroll
            for (int j = 0; j < 8; ++j) if (j != i0 && sc[j] > b1) { b1 = sc[j]; i1 = j; e1v = el[j]; }
            const float p0 = expf(e0v - emx) / eden, p1 = expf(e1v - emx) / eden, sm = p0 + p1;
            const int sg0 = gs * 8 + i0, sg1 = 32 + gs * 8 + i1;
            const int q0 = atomicAdd(cnt + sg0, 1), q1 = atomicAdd(cnt + sg1, 1);
            lists[(size_t)sg0 * fx::MOE_CAP + q0] = t; roww[(size_t)sg0 * fx::MOE_CAP + q0] = p0 / sm * gw;
            lists[(size_t)sg1 * fx::MOE_CAP + q1] = t; roww[(size_t)sg1 * fx::MOE_CAP + q1] = p1 / sm * gw;
        }
        asm volatile("s_waitcnt lgkmcnt(0)" ::: "memory");
    }
}

__global__ void __launch_bounds__(NWAVES * 64, 2) mk_fwd(Params p) {
    extern __shared__ __attribute__((aligned(16))) unsigned char lds_raw[];
    LAS unsigned char* lds = (LAS unsigned char*)lds_raw;
    LAS unsigned char* xl = lds + XL_OFF;
    const int tid = threadIdx.x, lane = tid & 63, wave = __builtin_amdgcn_readfirstlane(tid >> 6);
    const int lo = p.ph_lo, hi = p.ph_hi;
#ifndef PHMASK
#define PHMASK 0xffffffffu
#endif
#define IN(k) (((PHMASK >> (k)) & 1u) && lo <= (k) && (k) < hi)
#define SEAM(k) do { if (IN(k) && IN((k) + 1)) { asm volatile("s_waitcnt vmcnt(0)" ::: "memory"); cg::this_grid().sync(); } } while (0)
    if (IN(0)) { p0_prologue(p, lds, wave, lane); }
    SEAM(0);
    if (IN(1)) {
        pg8::GridOrder S; S.init(WSP(bf16_t, WS_HB), 1024, WSP(bf16_t, WB_IN), 1024, T_TOK, 2560, gridDim.x, blockIdx.x);
        fx::EpiInProj E{WSP(bf16_t, WS_CQ), WSP(bf16_t, WS_CKV), WSP(bf16_t, WS_RQ), WSP(bf16_t, WS_RK), WSP(bf16_t, WS_RV), WSP(bf16_t, WS_RG),
                        WSP(float, WS_SSQ_CQ), WSP(float, WS_SSQ_CKV), WSP(float, WS_SSQ_KPE), WSP(float, WS_CS), p.in[10]};
        pg8::gemm_phase<fx::EpiInProj, pg8::GridOrder>(lds, xl, 1024, 1024, 1024, S, E);
        { pg8::GridOrder S2; S2.init(WSP(bf16_t, WS_MB), 1024, WSP(bf16_t, WB_CKV), 1024, 2048, 1024, gridDim.x, blockIdx.x);
          fx::EpiHeadNorm E2{WSP(bf16_t, WS_KC), nullptr, p.in[18], 0.f};
          pg8::gemm_phase<fx::EpiHeadNorm, pg8::GridOrder>(lds, xl, 1024, 1024, 1024, S2, E2); }
        { pg8::GridOrder S3; S3.init(WSP(bf16_t, WB_CKV) + (size_t)1024 * 1024, 1024, WSP(bf16_t, WS_MB), 1024, 1024, 2048, gridDim.x, blockIdx.x);
          fx::EpiStoreT E3{WSP(bf16_t, WS_VC), 256, 1024 * 256, 1.f, 0};
          pg8::gemm_phase<fx::EpiStoreT, pg8::GridOrder>(lds, xl, 1024, 1024, 1024, S3, E3); }
    }
    SEAM(1);
    if (IN(2)) {
        { pg8::GridOrder S; S.init(WSP(bf16_t, WS_CQ), 256, WSP(bf16_t, WB_UQ), 256, T_TOK, 1024, gridDim.x, blockIdx.x);
          fx::EpiMlaQ E{WSP(bf16_t, WS_QM), WSP(float, WS_SSQ_CQ), p.in[9], WSP(float, WS_CS)};
          pg8::gemm_phase<fx::EpiMlaQ, pg8::GridOrder>(lds, xl, 256, 256, 256, S, E); }
        { pg8::GridOrder S; S.init(WSP(bf16_t, WS_CKV), 256, WSP(bf16_t, WB_UKV), 256, T_TOK, 1024, gridDim.x, blockIdx.x);
          fx::EpiMlaKV E{WSP(bf16_t, WS_KM), WSP(bf16_t, WS_VM), WSP(bf16_t, WS_CKV), WSP(float, WS_SSQ_CKV), WSP(float, WS_SSQ_KPE), p.in[10]};
          pg8::gemm_phase<fx::EpiMlaKV, pg8::GridOrder>(lds, xl, 256, 256, 256, S, E); }
        rt::ret_kv_phase(WSP(bf16_t, WS_RK), WSP(bf16_t, WS_RV), WSP(bf16_t, WS_KVS), (char*)lds_raw);
    }
    SEAM(2);
    if (IN(3)) { at::attn_phase(WSP(bf16_t, WS_QM), WSP(bf16_t, WS_KM), WSP(bf16_t, WS_VM), WSP(bf16_t, WS_AO), (char*)lds_raw);
                 rt::ret_out_phase(WSP(bf16_t, WS_RQ), WSP(bf16_t, WS_RK), WSP(bf16_t, WS_RV), WSP(bf16_t, WS_RG), WSP(bf16_t, WS_KVS), p.in[11], WSP(bf16_t, WS_AO), (char*)lds_raw); }
    SEAM(3);
    if (IN(4)) {
        pg8::GridOrder S; S.init(WSP(bf16_t, WS_AO), 1024, WSP(bf16_t, WB_OUT), 1024, T_TOK, 1024, gridDim.x, blockIdx.x);
        fx::EpiResid E{p.in[0], p.out, WSP(bf16_t, WS_XB), WSP(float, WS_SSQ1)};
        pg8::gemm_phase<fx::EpiResid, pg8::GridOrder>(lds, xl, 1024, 1024, 1024, S, E);
    }
    SEAM(4);
    if (IN(5)) {
        pg8::GridOrder S; S.init(WSP(bf16_t, WS_XB), 1024, WSP(bf16_t, WB_CQ), 1024, T_TOK, 1024, gridDim.x, blockIdx.x);
        fx::EpiHeadNorm E{WSP(bf16_t, WS_QC), WSP(float, WS_SSQ1), p.in[17], 1.f / 1024.f};
        pg8::gemm_phase<fx::EpiHeadNorm, pg8::GridOrder>(lds, xl, 1024, 1024, 1024, S, E);
    }
    SEAM(5);
    if (IN(6)) {
        fx::HeadOrder S{(int)gridDim.x, (int)blockIdx.x, 512, (const char*)WSP(bf16_t, WS_QC), (const char*)WSP(bf16_t, WS_KC), (size_t)256 * 1024 * 2, (size_t)256 * 2, (size_t)256 * 1024 * 2, (size_t)256 * 2};
        fx::EpiSoftmax E{WSP(bf16_t, WS_PC)};
        pg8::gemm_phase<fx::EpiSoftmax, fx::HeadOrder>(lds, xl, 1024, 1024, 256, S, E);
    }
    SEAM(6);
    if (IN(7)) {
        fx::HeadOrder S{(int)gridDim.x, (int)blockIdx.x, 512, (const char*)WSP(bf16_t, WS_PC), (const char*)WSP(bf16_t, WS_VC), (size_t)256 * 1024 * 2, (size_t)256 * 2, (size_t)1024 * 256 * 2, (size_t)256 * 256 * 2};
        fx::EpiStoreBf16 E{WSP(bf16_t, WS_OC), 1024, 0};
        pg8::gemm_phase<fx::EpiStoreBf16, fx::HeadOrder>(lds, xl, 1024, 256, 256, S, E);
    }
    SEAM(7);
    if (IN(8)) {
        pg8::GridOrder S; S.init(WSP(bf16_t, WS_OC), 1024, WSP(bf16_t, WB_CO), 1024, T_TOK, 1024, gridDim.x, blockIdx.x);
        fx::EpiResid E{p.out, p.out, WSP(bf16_t, WS_XB), WSP(float, WS_SSQ2)};
        pg8::gemm_phase<fx::EpiResid, pg8::GridOrder>(lds, xl, 1024, 1024, 1024, S, E);
    }
    SEAM(8);
    if (IN(9)) { router_phase(p, lds, wave, lane); }
    SEAM(9);
    if (IN(10)) {
        fx::MoeOrder S{(int)gridDim.x, (int)blockIdx.x, 0, 64, 2, WSP(int, WS_CNT), WSP(int, WS_LISTS), (const char*)WSP(bf16_t, WS_XB), (const char*)WSP(bf16_t, WB_GU), 0, (size_t)512 * 1024 * 2, (size_t)256 * 1024 * 2};
        fx::EpiGlu E{WSP(bf16_t, WS_H), WSP(float, WS_SSQ2), WSP(float, WS_ROWW), WSP(int, WS_LISTS)};
        pg8::gemm_phase<fx::EpiGlu, fx::MoeOrder, true>(lds, xl, 1024, 1024, 1024, S, E);
    }
    SEAM(10);
    if (IN(11)) {
        fx::MoeOrder S{(int)gridDim.x, (int)blockIdx.x, 0, 32, 4, WSP(int, WS_CNT), WSP(int, WS_LISTS), (const char*)WSP(bf16_t, WS_H), (const char*)WSP(bf16_t, WB_D), (size_t)256 * 256 * 2, (size_t)1024 * 256 * 2, (size_t)256 * 256 * 2};
        fx::EpiScatterAdd E{p.out};
        pg8::gemm_phase<fx::EpiScatterAdd, fx::MoeOrder>(lds, xl, 256, 256, 256, S, E);
    }
    SEAM(11);
    if (IN(12)) {
        fx::MoeOrder S{(int)gridDim.x, (int)blockIdx.x, 32, 64, 4, WSP(int, WS_CNT), WSP(int, WS_LISTS), (const char*)WSP(bf16_t, WS_H), (const char*)WSP(bf16_t, WB_D), (size_t)256 * 256 * 2, (size_t)1024 * 256 * 2, (size_t)256 * 256 * 2};
        fx::EpiScatterAdd E{p.out};
        pg8::gemm_phase<fx::EpiScatterAdd, fx::MoeOrder>(lds, xl, 256, 256, 256, S, E);
    }
#undef IN
#undef SEAM
}

extern "C" void kernel_launch(void* const* d_in, const int* in_sizes, int n_in, void* d_out, int out_size, void* d_ws, size_t ws_size, hipStream_t stream) {
    static int grid = 0;
    if (grid == 0) {
        if (n_in != 28 || out_size != T_TOK * 1024 || ws_size < WS_NEED) { fprintf(stderr, "kernel_launch: unexpected shapes n_in %d out %d ws %zu\n", n_in, out_size, ws_size); grid = -1; return; }
        int dev = 0, cus = 0, per_cu = 0;
        if (hipGetDevice(&dev) != hipSuccess || hipDeviceGetAttribute(&cus, hipDeviceAttributeMultiprocessorCount, dev) != hipSuccess) { grid = -1; return; }
        if (hipFuncSetAttribute((const void*)mk_fwd, hipFuncAttributeMaxDynamicSharedMemorySize, LDS_BYTES) != hipSuccess) { fprintf(stderr, "hipFuncSetAttribute failed\n"); grid = -1; return; }
        if (hipOccupancyMaxActiveBlocksPerMultiprocessor(&per_cu, (const void*)mk_fwd, NWAVES * 64, LDS_BYTES) != hipSuccess || per_cu < 1) { fprintf(stderr, "occupancy query failed (%d)\n", per_cu); grid = -1; return; }
        grid = cus;
        (void)hipGetLastError();
    }
    if (grid < 0) return;
    Params p; memset(&p, 0, sizeof(p));
    for (int i = 0; i < 28; ++i) p.in[i] = (const float*)d_in[i];
    p.out = (float*)d_out; p.ws = (unsigned char*)d_ws; p.ph_lo = 0; p.ph_hi = 13; p.coop = 1;
    void* args[] = {&p};
    hipError_t e = hipLaunchCooperativeKernel((const void*)mk_fwd, dim3(grid), dim3(NWAVES * 64), args, LDS_BYTES, stream);
    if (e != hipSuccess) fprintf(stderr, "cooperative launch failed: %s (grid %d)\n", hipGetErrorString(e), grid);
}
```

```cpp
#include <hip/hip_runtime.h>
#include <hip/hip_cooperative_groups.h>
#include <cstdint>
#include <cstdio>
#include <cmath>
#include <cstring>

typedef unsigned short bf16_t;
constexpr float EPS = 1e-6f;
constexpr int T_TOK = 32768;
__device__ __forceinline__ float bf2f(bf16_t h) { return __uint_as_float((unsigned)h << 16); }
__device__ __forceinline__ bf16_t f2bf(float f) { const unsigned u = __float_as_uint(f); return (bf16_t)((u + 0x7fffu + ((u >> 16) & 1u)) >> 16); }

constexpr size_t MiB = (size_t)1 << 20;
constexpr size_t WS_CTL = 0;
constexpr size_t WS_SSQ_CQ = 1 * MiB, WS_SSQ_CKV = WS_SSQ_CQ + 128 * 1024, WS_SSQ_KPE = WS_SSQ_CKV + 128 * 1024, WS_SSQ1 = WS_SSQ_KPE + 128 * 1024, WS_SSQ2 = WS_SSQ1 + 128 * 1024;
constexpr size_t WS_SEL = 2 * MiB, WS_WTS = WS_SEL + 256 * 1024;
constexpr size_t WS_RW = 4 * MiB;
constexpr size_t WS_CS = 5 * MiB;
constexpr size_t WS_MB = 21 * MiB, WS_KC = 25 * MiB, WS_VC = 29 * MiB;
constexpr size_t WS_WB = 33 * MiB;
constexpr size_t WS_RQ = 97 * MiB, WS_RK = 129 * MiB, WS_RV = 161 * MiB, WS_RG = 193 * MiB;
constexpr size_t WS_HB = 225 * MiB;
constexpr size_t WS_QM = 225 * MiB, WS_KM = 273 * MiB, WS_VM = 321 * MiB;
constexpr size_t WS_KVS = 353 * MiB;
constexpr size_t WS_AO = 385 * MiB;
constexpr size_t WS_CQ = 449 * MiB, WS_CKV = 465 * MiB;
constexpr size_t WS_PJ = 289 * MiB;
constexpr size_t WS_RAW = 353 * MiB;
constexpr size_t WS_XB = 97 * MiB;
constexpr size_t WS_QCR = 161 * MiB;
constexpr size_t WS_PC = 161 * MiB;
constexpr size_t WS_QC = 225 * MiB;
constexpr size_t WS_OC = 289 * MiB;
constexpr size_t WS_KVR = 353 * MiB;
constexpr size_t WS_BAR = 16 * 1024;
constexpr size_t WS_CNT = 64 * 1024;
constexpr size_t WS_LISTS = 353 * MiB, WS_ROWW = 361 * MiB;
constexpr size_t WS_H = 161 * MiB;
constexpr size_t WS_NEED = 481 * MiB;
#define LAS __attribute__((address_space(3)))
typedef short bf16x8 __attribute__((ext_vector_type(8)));
typedef float f32x4 __attribute__((ext_vector_type(4)));
typedef float f32x2 __attribute__((ext_vector_type(2)));
typedef unsigned u32x4 __attribute__((ext_vector_type(4)));
typedef unsigned u32x2 __attribute__((ext_vector_type(2)));

namespace pg8 {
constexpr int BM = 256, BK = 64, HALF = 128, HTB = HALF * BK * 2, STAGE_BYTES = 8 * HTB, NXCD = 8, WGM = 8;
__host__ __device__ __forceinline__ int lds_byte(int r, int c) { const int st = (r >> 4) * 2 + (c >> 5), rr = r & 15, cc = c & 31, ob = rr * 64 + cc * 2; return st * 1024 + (ob ^ (((ob >> 9) & 1) << 5)); }
__host__ __device__ __forceinline__ void stage_rc(int b, int& R, int& C) { const int st = b / 1024, sb = b % 1024, swz = sb ^ (((sb >> 9) & 1) << 5); R = (st >> 1) * 16 + swz / 64; C = (st & 1) * 32 + (swz % 64) / 2; }
__host__ __device__ __forceinline__ int perm32(int rho) { const int n = rho >> 4, i = rho & 15; return 8 * (i >> 2) + 4 * n + (i & 3); }
__device__ __forceinline__ unsigned cvt_pk_bf16(float lo, float hi) { unsigned r; asm volatile("v_cvt_pk_bf16_f32 %0, %1, %2" : "=v"(r) : "v"(lo), "v"(hi)); return r; }

struct Unit { int pm, pn; const char* a; const char* b; const int* rows; int nvalid, seg; };

struct GridOrder {
    int nM, nN, nwg, G, c; const char* A; const char* B; size_t strideA, strideB;
    __device__ void init(const bf16_t* A_, int lda, const bf16_t* B_, int ldb, int M, int N, int G_, int c_) {
        nM = M / BM; nN = N / BM; nwg = nM * nN; G = G_; c = c_; A = (const char*)A_; B = (const char*)B_; strideA = (size_t)BM * lda * 2; strideB = (size_t)BM * ldb * 2; }
    __device__ bool next(int i, Unit& u) const {
        const long L = (long)i * G + c; if (L >= nwg) return false;
        int wgid = (int)L; { const int q = nwg / NXCD, r = nwg % NXCD, xcd = wgid % NXCD, off = wgid / NXCD; wgid = (xcd < r ? xcd * (q + 1) : r * (q + 1) + (xcd - r) * q) + off; }
        const int nig = WGM * nN, gid = wgid / nig, fm = gid * WGM, gsz = (nM - fm) < WGM ? (nM - fm) : WGM;
        u.pm = fm + ((wgid % nig) % gsz); u.pn = (wgid % nig) / gsz; u.a = A + (size_t)u.pm * strideA; u.b = B + (size_t)u.pn * strideB; u.rows = nullptr; u.nvalid = 256; u.seg = 0; return true;
    }
};

#define XBAR() do { asm volatile("s_waitcnt lgkmcnt(0)" ::: "memory"); __builtin_amdgcn_s_barrier(); asm volatile("" ::: "memory"); } while (0)

__device__ __forceinline__ void row_allreduce_sum(float (&s)[2][4], int wr, int wc, int fr, int fq, LAS unsigned char* xl) {
    LAS float* P = (LAS float*)xl;
#pragma unroll
    for (int ai = 0; ai < 2; ++ai)
#pragma unroll
        for (int m = 0; m < 4; ++m) { float v = s[ai][m]; v += __shfl_xor(v, 16); v += __shfl_xor(v, 32); if (fq == 0) P[(ai * HALF + wr * 64 + m * 16 + fr) * 4 + wc] = v; }
    XBAR();
#pragma unroll
    for (int ai = 0; ai < 2; ++ai)
#pragma unroll
        for (int m = 0; m < 4; ++m) { const f32x4 p = *(const LAS f32x4*)(P + (ai * HALF + wr * 64 + m * 16 + fr) * 4); s[ai][m] = (p[0] + p[1]) + (p[2] + p[3]); }
    XBAR();
}
__device__ __forceinline__ void row_allreduce_max(float (&s)[2][4], int wr, int wc, int fr, int fq, LAS unsigned char* xl) {
    LAS float* P = (LAS float*)xl;
#pragma unroll
    for (int ai = 0; ai < 2; ++ai)
#pragma unroll
        for (int m = 0; m < 4; ++m) { float v = s[ai][m]; v = fmaxf(v, __shfl_xor(v, 16)); v = fmaxf(v, __shfl_xor(v, 32)); if (fq == 0) P[(ai * HALF + wr * 64 + m * 16 + fr) * 4 + wc] = v; }
    XBAR();
#pragma unroll
    for (int ai = 0; ai < 2; ++ai)
#pragma unroll
        for (int m = 0; m < 4; ++m) { const f32x4 p = *(const LAS f32x4*)(P + (ai * HALF + wr * 64 + m * 16 + fr) * 4); s[ai][m] = fmaxf(fmaxf(p[0], p[1]), fmaxf(p[2], p[3])); }
    XBAR();
}

template <class Epi, class Sched, bool GATHER = false>
__device__ __forceinline__ void gemm_phase(LAS unsigned char* lds, LAS unsigned char* xl, int lda, int ldb, int K, const Sched& S, const Epi& E) {
    const int tid = threadIdx.x, wid = __builtin_amdgcn_readfirstlane(tid >> 6), lane = tid & 63, wr = wid >> 2, wc = wid & 3, fr = lane & 15, fq = lane >> 4;
    asm volatile("" : "+s"(K));
    const int nt = K / BK;
    int sR[2], sC[2];
    unsigned voffA[2], voffB[2];
#pragma unroll
    for (int i = 0; i < 2; ++i) { int R, C; stage_rc(tid * 16 + i * 8192, R, C); const int Rb = Epi::PERM ? ((R & ~31) + perm32(R & 31)) : R; sR[i] = R; sC[i] = C;
        voffA[i] = (unsigned)(R * lda + C) * 2u; voffB[i] = (unsigned)(Rb * ldb + C) * 2u; }
    const size_t kstep = (size_t)(BK * 2);
    const size_t hstepA = (size_t)HALF * lda * 2, hstepB = (size_t)HALF * ldb * 2;
    const unsigned ldsw = (unsigned)wid * 1024u;
    const int aoff = lds_byte(wr * 64 + fr, fq * 8), boff = lds_byte(wc * 32 + fr, fq * 8);
#define PG8_SA(b, h) (((b) * 2 + (h)) * HTB)
#define PG8_SB(b, h) ((4 + (b) * 2 + (h)) * HTB)
#define PG8_STAGE(bufoff, gbase, voff) do { _Pragma("unroll") for (int _i = 0; _i < 2; ++_i) \
        __builtin_amdgcn_global_load_lds((const unsigned*)((const char*)(gbase) + (voff)[_i]), (LAS unsigned*)(lds + (bufoff) + ldsw + _i * 8192), 16, 0, 0); } while (0)
#define PG8_LDA(dst, b, h) do { _Pragma("unroll") for (int m = 0; m < 4; ++m) _Pragma("unroll") for (int k = 0; k < 2; ++k) dst[m][k] = *(const LAS bf16x8*)(lds + PG8_SA(b, h) + aoff + m * 2048 + k * 1024); } while (0)
#define PG8_LDB(dst, b, h) do { _Pragma("unroll") for (int n = 0; n < 2; ++n) _Pragma("unroll") for (int k = 0; k < 2; ++k) dst[n][k] = *(const LAS bf16x8*)(lds + PG8_SB(b, h) + boff + n * 2048 + k * 1024); } while (0)
#define PG8_MMA(ai, bj, At, Bt) do { __builtin_amdgcn_s_setprio(1); _Pragma("unroll") for (int m = 0; m < 4; ++m) _Pragma("unroll") for (int n = 0; n < 2; ++n) _Pragma("unroll") for (int k = 0; k < 2; ++k) \
        acc[ai][bj][m][n] = __builtin_amdgcn_mfma_f32_16x16x32_bf16(Bt[n][k], At[m][k], acc[ai][bj][m][n], 0, 0, 0); __builtin_amdgcn_s_setprio(0); } while (0)
#define PG8_WAIT_V(n) asm volatile("s_waitcnt vmcnt(" #n ")" ::: "memory")
#define PG8_WAIT_L(n) asm volatile("s_waitcnt lgkmcnt(" #n ")" ::: "memory")
#define PG8_BAR __builtin_amdgcn_s_barrier()
#define PG8_SCHED __builtin_amdgcn_sched_barrier(0)
    LAS unsigned char* gl = xl + 8192 + tid * 16;
    int gA0 = 0, gA1 = 8192;
#define PG8_GATH(T, u) do { u32x4 _o; { int _r[4]; _Pragma("unroll") for (int _q = 0; _q < 4; ++_q) { const int _rl = (_q >> 1) * HALF + sR[_q & 1]; _r[_q] = (_rl < (u).nvalid) ? (u).rows[_rl] : 0; } \
        _Pragma("unroll") for (int _q = 0; _q < 4; ++_q) _o[_q] = (unsigned)(_r[_q] * lda + sC[_q & 1]) * 2u; } *(LAS u32x4*)(gl + (T)) = _o; } while (0)
#define PG8_STAGE_A(bufoff, base, h, kbytes, T) do { if constexpr (GATHER) { const u32x2 _g = *(const LAS u32x2*)(gl + (T) + (h) * 8); PG8_STAGE(bufoff, (base) + (kbytes), _g); } else { PG8_STAGE(bufoff, (base) + (size_t)(h) * hstepA + (kbytes), voffA); } } while (0)
    Unit cur, nxt; int ui = 0;
    if (!S.next(0, cur)) return;
    f32x4 acc[2][2][4][2];
#pragma unroll
    for (int a = 0; a < 2; ++a)
#pragma unroll
        for (int b = 0; b < 2; ++b)
#pragma unroll
            for (int m = 0; m < 4; ++m)
#pragma unroll
                for (int n = 0; n < 2; ++n) acc[a][b][m][n] = (f32x4){0.f, 0.f, 0.f, 0.f};
    bf16x8 At[4][2], B0[2][2], B1[2][2];
    const char* cA = cur.a; const char* cB = cur.b;
    if constexpr (GATHER) { PG8_GATH(gA0, cur); }
    PG8_STAGE(PG8_SB(0, 0), cB, voffB); PG8_STAGE(PG8_SB(0, 1), cB + hstepB, voffB); PG8_STAGE_A(PG8_SA(0, 0), cA, 0, 0, gA0); PG8_STAGE_A(PG8_SA(0, 1), cA, 1, 0, gA0);
    if (wr == 1) PG8_BAR;
    PG8_WAIT_V(2); PG8_BAR;
    PG8_STAGE(PG8_SB(1, 0), cB + kstep, voffB); PG8_STAGE_A(PG8_SA(1, 0), cA, 0, kstep, gA0); PG8_STAGE(PG8_SB(1, 1), cB + hstepB + kstep, voffB);
    PG8_WAIT_V(6); PG8_BAR;
    for (;;) {
        const bool has_next = S.next(ui + 1, nxt);
        const char* nA = has_next ? nxt.a : cA; const char* nB = has_next ? nxt.b : cB;
        if constexpr (GATHER) { if (has_next) { PG8_GATH(gA1, nxt); } else { PG8_GATH(gA1, cur); } }
#pragma unroll 1
        for (int t = 0; t < nt; t += 2) {
            const bool last = (t == nt - 2);
            const size_t k1 = (size_t)(t + 1) * kstep;
            const char* a2 = last ? nA : cA; const char* b2 = last ? nB : cB + (size_t)(t + 2) * kstep;
            const size_t ka2 = last ? 0 : (size_t)(t + 2) * kstep;
            const char* b3 = b2 + kstep; const size_t ka3 = ka2 + kstep;
            PG8_LDB(B0, 0, 0); PG8_LDB(B1, 0, 1); PG8_SCHED; PG8_LDA(At, 0, 0); PG8_STAGE_A(PG8_SA(1, 1), cA, 1, k1, gA0);
            PG8_WAIT_V(8); PG8_WAIT_L(0); PG8_BAR; PG8_MMA(0, 0, At, B0); PG8_MMA(0, 1, At, B1); PG8_BAR; PG8_SCHED;
            PG8_LDA(At, 0, 1); PG8_STAGE(PG8_SB(0, 0), b2, voffB); PG8_STAGE(PG8_SB(0, 1), b2 + hstepB, voffB);
            if (last) { PG8_STAGE_A(PG8_SA(0, 0), a2, 0, ka2, gA1); } else { PG8_STAGE_A(PG8_SA(0, 0), a2, 0, ka2, gA0); }
            PG8_WAIT_V(8); PG8_WAIT_L(0); PG8_BAR; PG8_MMA(1, 0, At, B0); PG8_MMA(1, 1, At, B1); PG8_BAR; PG8_SCHED;
            PG8_LDB(B0, 1, 0); PG8_LDB(B1, 1, 1); PG8_SCHED; PG8_LDA(At, 1, 0);
            if (last) { PG8_STAGE_A(PG8_SA(0, 1), a2, 1, ka2, gA1); } else { PG8_STAGE_A(PG8_SA(0, 1), a2, 1, ka2, gA0); }
            PG8_WAIT_V(8); PG8_WAIT_L(0); PG8_BAR; PG8_MMA(0, 0, At, B0); PG8_MMA(0, 1, At, B1); PG8_BAR; PG8_SCHED;
            PG8_LDA(At, 1, 1); PG8_STAGE(PG8_SB(1, 0), b3, voffB); PG8_STAGE(PG8_SB(1, 1), b3 + hstepB, voffB);
            if (last) { PG8_STAGE_A(PG8_SA(1, 0), a2, 0, ka3, gA1); } else { PG8_STAGE_A(PG8_SA(1, 0), a2, 0, ka3, gA0); }
            PG8_WAIT_V(8); PG8_WAIT_L(0); PG8_BAR; PG8_MMA(1, 0, At, B0); PG8_MMA(1, 1, At, B1); PG8_BAR; PG8_SCHED;
        }
        if (wr == 0) PG8_BAR;
        E(acc, cur, wr, wc, fr, fq, xl);
        if (!has_next) break;
#pragma unroll
        for (int a = 0; a < 2; ++a)
#pragma unroll
            for (int b = 0; b < 2; ++b)
#pragma unroll
                for (int m = 0; m < 4; ++m)
#pragma unroll
                    for (int n = 0; n < 2; ++n) acc[a][b][m][n] = (f32x4){0.f, 0.f, 0.f, 0.f};
        cur = nxt; cA = nA; cB = nB; ++ui;
        if constexpr (GATHER) { const int _t = gA0; gA0 = gA1; gA1 = _t; }
        if (wr == 1) PG8_BAR;
    }
    PG8_WAIT_V(0);
    PG8_BAR;
#undef PG8_SA
#undef PG8_SB
#undef PG8_STAGE
#undef PG8_STAGE_A
#undef PG8_GATH
#undef PG8_LDA
#undef PG8_LDB
#undef PG8_MMA
#undef PG8_WAIT_V
#undef PG8_WAIT_L
#undef PG8_BAR
#undef PG8_SCHED
}
}
namespace fx {
using pg8::Unit; using pg8::cvt_pk_bf16;
constexpr int HALF = 128;
__device__ __forceinline__ u32x4 pack8(const f32x4 a, const f32x4 b) { u32x4 w; w.x = cvt_pk_bf16(a[0], a[1]); w.y = cvt_pk_bf16(a[2], a[3]); w.z = cvt_pk_bf16(b[0], b[1]); w.w = cvt_pk_bf16(b[2], b[3]); return w; }
__device__ __forceinline__ u32x2 pack4(const f32x4 a) { u32x2 w; w.x = cvt_pk_bf16(a[0], a[1]); w.y = cvt_pk_bf16(a[2], a[3]); return w; }
__device__ __forceinline__ float sq4(const f32x4 a) { return (a[0] * a[0] + a[1] * a[1]) + (a[2] * a[2] + a[3] * a[3]); }
__device__ __forceinline__ float quad_sum(float v) { v += __shfl_xor(v, 16); v += __shfl_xor(v, 32); return v; }
__device__ __forceinline__ float gamma_log2(int h) { return __log2f(1.f - exp2f(-5.f - (float)h)); }
__device__ __forceinline__ void rope4(f32x4& a, f32x4& b, const f32x4 cs0, const f32x4 cs1) {
    const f32x4 c = {cs0[0], cs0[2], cs1[0], cs1[2]}, s = {cs0[1], cs0[3], cs1[1], cs1[3]};
    const f32x4 ra = a * c - b * s, rb = b * c + a * s; a = ra; b = rb;
}

struct EpiInProj {
    static constexpr bool PERM = false;
    bf16_t *CQ, *CKV, *RQ, *RK, *RV, *RG; float *ssq_cq, *ssq_ckv, *ssq_kpe; const float* cs  ; const float* kg  ;
    __device__ __forceinline__ void operator()(f32x4 (&acc)[2][2][4][2], const Unit& u, int wr, int wc, int fr, int fq, LAS unsigned char*) const {
        asm volatile("" : "+v"(fr), "+v"(fq));
        const int row0 = u.pm * 256 + wr * 64 + fr, pn = u.pn;
        if (pn == 0) {
#pragma unroll
            for (int ai = 0; ai < 2; ++ai)
#pragma unroll
                for (int m = 0; m < 4; ++m) { const int row = row0 + ai * HALF + m * 16; float s = 0.f;
#pragma unroll
                    for (int bj = 0; bj < 2; ++bj) { s += sq4(acc[ai][bj][m][0]) + sq4(acc[ai][bj][m][1]);
                        *(u32x4*)(CQ + (size_t)row * 256 + bj * HALF + wc * 32 + 8 * fq) = pack8(acc[ai][bj][m][0], acc[ai][bj][m][1]); }
                    s = quad_sum(s); if (fq == 0) atomicAdd(ssq_cq + row, s); }
        } else if (pn == 1) {
            const int i0 = 16 * wc + 4 * fq;
            f32x4 g0 = {0.f, 0.f, 0.f, 0.f}, g1 = g0;
            if (wc < 2) { g0 = *(const f32x4*)(kg + 128 + i0); g1 = *(const f32x4*)(kg + 160 + i0); }
#pragma unroll
            for (int ai = 0; ai < 2; ++ai)
#pragma unroll
                for (int m = 0; m < 4; ++m) { const int row = row0 + ai * HALF + m * 16;
                    float s0 = sq4(acc[ai][0][m][0]) + sq4(acc[ai][0][m][1]), s1 = sq4(acc[ai][1][m][0]) + sq4(acc[ai][1][m][1]);
                    *(u32x4*)(CKV + (size_t)row * 256 + wc * 32 + 8 * fq) = pack8(acc[ai][0][m][0], acc[ai][0][m][1]);
                    s0 = quad_sum(s0); s1 = quad_sum(s1);
                    if (fq == 0) { atomicAdd(ssq_ckv + row, s0); if (wc < 2) atomicAdd(ssq_kpe + row, s1); }
                    if (wc < 2) {
                        f32x4 a = acc[ai][1][m][0] * g0, b = acc[ai][1][m][1] * g1;
                        const float* cp = cs + ((size_t)row * 64 + 2 * i0) * 2;
                        const f32x4 c0 = *(const f32x4*)(cp), c1 = *(const f32x4*)(cp + 4), c2 = *(const f32x4*)(cp + 8), c3 = *(const f32x4*)(cp + 12);
                        const f32x4 cc = {c0[0], c1[0], c2[0], c3[0]}, ss = {c0[1], c1[1], c2[1], c3[1]};
                        const f32x4 ra = a * cc - b * ss, rb = b * cc + a * ss;
                        *(u32x2*)(CKV + (size_t)row * 256 + 128 + i0) = pack4(ra); *(u32x2*)(CKV + (size_t)row * 256 + 160 + i0) = pack4(rb);
                    } else {
                        *(u32x4*)(CKV + (size_t)row * 256 + 192 + (wc - 2) * 32 + 8 * fq) = (u32x4){0u, 0u, 0u, 0u};
                    }
                    asm volatile("" ::: "memory"); __builtin_amdgcn_sched_barrier(0); }
        } else if (pn < 6) {
            bf16_t* O = (pn < 4) ? RQ : RK; const float sc = (pn < 4) ? 1.f : 0.08838834764831845f;
            const int i0 = 16 * wc + 4 * fq;
            const float sgn = (pn < 4) ? 1.f : -1.f; const float lgh[2] = {sgn * gamma_log2((pn & 1) * 2), sgn * gamma_log2((pn & 1) * 2 + 1)};
#pragma unroll
            for (int ai = 0; ai < 2; ++ai)
#pragma unroll
                for (int m = 0; m < 4; ++m) { const int row = row0 + ai * HALF + m * 16;
                    const float* cp = cs + ((size_t)row * 64 + i0) * 2;
                    const f32x4 c0 = *(const f32x4*)(cp), c1 = *(const f32x4*)(cp + 4);
#pragma unroll
                    for (int bj = 0; bj < 2; ++bj) { f32x4 a = acc[ai][bj][m][0], b = acc[ai][bj][m][1]; rope4(a, b, c0, c1); const float dc = sc * exp2f((float)(row & 127) * lgh[bj]); a = a * dc; b = b * dc;
                        bf16_t* o = O + (size_t)row * 512 + ((pn & 1) * 2 + bj) * 128 + i0;
                        *(u32x2*)(o) = pack4(a); *(u32x2*)(o + 64) = pack4(b); }
                    asm volatile("" ::: "memory"); __builtin_amdgcn_sched_barrier(0); }
        } else {
            bf16_t* O = (pn < 8) ? RV : RG;
#pragma unroll
            for (int ai = 0; ai < 2; ++ai)
#pragma unroll
                for (int m = 0; m < 4; ++m) { const int row = row0 + ai * HALF + m * 16;
#pragma unroll
                    for (int bj = 0; bj < 2; ++bj) *(u32x4*)(O + (size_t)row * 512 + (pn & 1) * 256 + bj * HALF + wc * 32 + 8 * fq) = pack8(acc[ai][bj][m][0], acc[ai][bj][m][1]); }
        }
    }
};
__device__ __forceinline__ int inproj_src(int n) {
    const int pn = n >> 8, p = n & 255;
    const int plain = (p & ~31) + pg8::perm32(p & 31);
    if (pn == 0) return plain;
    if (pn == 1) { if (p < 128) return 256 + plain; const int q = p - 128, wc = q >> 5; if (wc >= 2) return -1; return 384 + 32 * ((q >> 4) & 1) + 16 * wc + (q & 15); }
    if (pn < 6) { const int bj = p >> 7, q = p & 127, wc = q >> 5, nn = (q >> 4) & 1; const int d = 64 * nn + 16 * wc + (q & 15); return (pn < 4 ? 448 : 960) + ((pn & 1) * 2 + bj) * 128 + d; }
    return (pn < 8 ? 1472 : 1984) + (pn & 1) * 256 + plain;
}

struct EpiMlaQ {
    static constexpr bool PERM = false;
    bf16_t* QM; const float* ssq_cq; const float* qg; const float* cs;
    __device__ __forceinline__ void operator()(f32x4 (&acc)[2][2][4][2], const Unit& u, int wr, int wc, int fr, int fq, LAS unsigned char* xl) const {
        asm volatile("" : "+v"(fr), "+v"(fq));
        const int row0 = u.pm * 256 + wr * 64 + fr, h = u.pn;
        float s[2][4], rsr[2][4];
#pragma unroll
        for (int ai = 0; ai < 2; ++ai)
#pragma unroll
            for (int m = 0; m < 4; ++m) { const int row = row0 + ai * HALF + m * 16; rsr[ai][m] = rsqrtf(ssq_cq[row] * (1.f / 256.f) + EPS);
                s[ai][m] = (sq4(acc[ai][0][m][0]) + sq4(acc[ai][0][m][1]) + sq4(acc[ai][1][m][0]) + sq4(acc[ai][1][m][1])) * rsr[ai][m] * rsr[ai][m]; }
        pg8::row_allreduce_sum(s, wr, wc, fr, fq, xl);
        const int c0 = 32 * wc + 8 * fq, i0 = 16 * wc + 4 * fq;
        const f32x4 gA = *(const f32x4*)(qg + c0), gB = *(const f32x4*)(qg + c0 + 4);
        f32x4 g0 = {0.f, 0.f, 0.f, 0.f}, g1 = g0;
        if (wc < 2) { g0 = *(const f32x4*)(qg + 128 + i0); g1 = *(const f32x4*)(qg + 160 + i0); }
#pragma unroll
        for (int ai = 0; ai < 2; ++ai)
#pragma unroll
            for (int m = 0; m < 4; ++m) { const int row = row0 + ai * HALF + m * 16; const float rq = rsqrtf(s[ai][m] * (1.f / 192.f) + EPS) * rsr[ai][m];
                bf16_t* o = QM + (size_t)row * 768 + h * 192;
                *(u32x4*)(o + c0) = pack8(acc[ai][0][m][0] * rq * gA, acc[ai][0][m][1] * rq * gB);
                if (wc < 2) {
                    const f32x4 a = acc[ai][1][m][0] * rq * g0, b = acc[ai][1][m][1] * rq * g1;
                    const float* cp = cs + ((size_t)row * 64 + 2 * i0) * 2;
                    const f32x4 c0v = *(const f32x4*)(cp), c1v = *(const f32x4*)(cp + 4), c2v = *(const f32x4*)(cp + 8), c3v = *(const f32x4*)(cp + 12);
                    const f32x4 cc = {c0v[0], c1v[0], c2v[0], c3v[0]}, ss = {c0v[1], c1v[1], c2v[1], c3v[1]};
                    *(u32x2*)(o + 128 + i0) = pack4(a * cc - b * ss); *(u32x2*)(o + 160 + i0) = pack4(b * cc + a * ss);
                }
                asm volatile("" ::: "memory"); __builtin_amdgcn_sched_barrier(0); }
    }
};
__device__ __forceinline__ int mlaq_src(int n) {
    const int h = n >> 8, p = n & 255;
    if (p < 128) return h * 192 + (p & ~31) + pg8::perm32(p & 31);
    const int q = p - 128, wc = q >> 5; if (wc >= 2) return -1;
    return h * 192 + 128 + 32 * ((q >> 4) & 1) + 16 * wc + (q & 15);
}
struct EpiMlaKV {
    static constexpr bool PERM = false;
    bf16_t *KM, *VM; const bf16_t* CKV; const float *ssq_ckv, *ssq_kpe, *kg;
    __device__ __forceinline__ void operator()(f32x4 (&acc)[2][2][4][2], const Unit& u, int wr, int wc, int fr, int fq, LAS unsigned char* xl) const {
        asm volatile("" : "+v"(fr), "+v"(fq));
        const int row0 = u.pm * 256 + wr * 64 + fr, h = u.pn;
        float s[2][4], rsr[2][4];
#pragma unroll
        for (int ai = 0; ai < 2; ++ai)
#pragma unroll
            for (int m = 0; m < 4; ++m) { const int row = row0 + ai * HALF + m * 16; rsr[ai][m] = rsqrtf(ssq_ckv[row] * (1.f / 128.f) + EPS);
                s[ai][m] = (sq4(acc[ai][0][m][0]) + sq4(acc[ai][0][m][1])) * rsr[ai][m] * rsr[ai][m]; }
        pg8::row_allreduce_sum(s, wr, wc, fr, fq, xl);
        const int c0 = 32 * wc + 8 * fq, i0 = 16 * wc + 4 * fq;
        const f32x4 gA = *(const f32x4*)(kg + c0), gB = *(const f32x4*)(kg + c0 + 4);
#pragma unroll
        for (int ai = 0; ai < 2; ++ai)
#pragma unroll
            for (int m = 0; m < 4; ++m) { const int row = row0 + ai * HALF + m * 16; const float rk = rsqrtf((s[ai][m] + ssq_kpe[row]) * (1.f / 192.f) + EPS), rr = rsr[ai][m];
                bf16_t* ko = KM + (size_t)row * 768 + h * 192;
                *(u32x4*)(ko + c0) = pack8(acc[ai][0][m][0] * (rr * rk) * gA, acc[ai][0][m][1] * (rr * rk) * gB);
                *(u32x4*)(VM + (size_t)row * 512 + h * 128 + c0) = pack8(acc[ai][1][m][0] * rr, acc[ai][1][m][1] * rr);
                const u32x2 kp = *(const u32x2*)(CKV + (size_t)row * 256 + 128 + i0);
                const f32x4 kf = {__uint_as_float(kp.x << 16), __uint_as_float(kp.x & 0xffff0000u), __uint_as_float(kp.y << 16), __uint_as_float(kp.y & 0xffff0000u)};
                *(u32x2*)(ko + 128 + i0) = pack4(kf * rk); asm volatile("" ::: "memory"); __builtin_amdgcn_sched_barrier(0); }
    }
};
struct EpiResid {
    static constexpr bool PERM = false;
    const float* base; float* out; bf16_t* xb; float* ssq;
    __device__ __forceinline__ void operator()(f32x4 (&acc)[2][2][4][2], const Unit& u, int wr, int wc, int fr, int fq, LAS unsigned char*) const {
        asm volatile("" : "+v"(fr), "+v"(fq));
        const int row0 = u.pm * 256 + wr * 64 + fr, col0 = u.pn * 256 + wc * 32 + 4 * fq;
#pragma unroll
        for (int ai = 0; ai < 2; ++ai)
#pragma unroll
            for (int m = 0; m < 4; ++m) { const int row = row0 + ai * HALF + m * 16; float s = 0.f;
#pragma unroll
                for (int bj = 0; bj < 2; ++bj)
#pragma unroll
                    for (int n = 0; n < 2; ++n) { const size_t off = (size_t)row * 1024 + col0 + bj * HALF + n * 16;
                        const f32x4 o = *(const f32x4*)(base + off) + acc[ai][bj][m][n]; *(f32x4*)(out + off) = o; *(u32x2*)(xb + off) = pack4(o); s += sq4(o); }
                s = quad_sum(s); if (fq == 0) atomicAdd(ssq + row, s); }
    }
};
struct EpiHeadNorm {
    static constexpr bool PERM = false;
    bf16_t* O; const float* ssq_in  ; const float* g  ; float inv_n_in;
    __device__ __forceinline__ void operator()(f32x4 (&acc)[2][2][4][2], const Unit& u, int wr, int wc, int fr, int fq, LAS unsigned char* xl) const {
        asm volatile("" : "+v"(fr), "+v"(fq));
        const int row0 = u.pm * 256 + wr * 64 + fr, h = u.pn;
        float s[2][4], rsr[2][4];
#pragma unroll
        for (int ai = 0; ai < 2; ++ai)
#pragma unroll
            for (int m = 0; m < 4; ++m) { const int row = row0 + ai * HALF + m * 16; rsr[ai][m] = ssq_in ? rsqrtf(ssq_in[row] * inv_n_in + EPS) : 1.f;
                s[ai][m] = (sq4(acc[ai][0][m][0]) + sq4(acc[ai][0][m][1]) + sq4(acc[ai][1][m][0]) + sq4(acc[ai][1][m][1])) * rsr[ai][m] * rsr[ai][m]; }
        pg8::row_allreduce_sum(s, wr, wc, fr, fq, xl);
        const int c0 = 32 * wc + 8 * fq;
        f32x4 gv[2][2];
#pragma unroll
        for (int bj = 0; bj < 2; ++bj) { gv[bj][0] = *(const f32x4*)(g + bj * HALF + c0); gv[bj][1] = *(const f32x4*)(g + bj * HALF + c0 + 4); }
#pragma unroll
        for (int ai = 0; ai < 2; ++ai)
#pragma unroll
            for (int m = 0; m < 4; ++m) { const int row = row0 + ai * HALF + m * 16; const float rq = rsqrtf(s[ai][m] * (1.f / 256.f) + EPS) * rsr[ai][m];
#pragma unroll
                for (int bj = 0; bj < 2; ++bj) *(u32x4*)(O + (size_t)row * 1024 + h * 256 + bj * HALF + c0) = pack8(acc[ai][bj][m][0] * rq * gv[bj][0], acc[ai][bj][m][1] * rq * gv[bj][1]); }
    }
};
struct EpiStoreT {
    static constexpr bool PERM = true;
    bf16_t* O; int ldc; int tile_stride; float scale; int pad;
    __device__ __forceinline__ void operator()(f32x4 (&acc)[2][2][4][2], const Unit& u, int wr, int wc, int fr, int fq, LAS unsigned char*) const {
        asm volatile("" : "+v"(fr), "+v"(fq));
        const int row0 = u.pm * 256 + wr * 64 + fr;
#pragma unroll
        for (int ai = 0; ai < 2; ++ai)
#pragma unroll
            for (int m = 0; m < 4; ++m) { const int row = row0 + ai * HALF + m * 16;
#pragma unroll
                for (int bj = 0; bj < 2; ++bj) *(u32x4*)(O + (size_t)u.pn * tile_stride + (size_t)row * ldc + bj * HALF + wc * 32 + 8 * fq) = pack8(acc[ai][bj][m][0] * scale, acc[ai][bj][m][1] * scale); }
    }
};
struct EpiSoftmax {
    static constexpr bool PERM = true;
    bf16_t* PC;
    __device__ __forceinline__ void operator()(f32x4 (&acc)[2][2][4][2], const Unit& u, int wr, int wc, int fr, int fq, LAS unsigned char* xl) const {
        asm volatile("" : "+v"(fr), "+v"(fq));
        const int row0 = u.pm * 256 + wr * 64 + fr, h = u.pn;
        float mx[2][4], sm[2][4];
#pragma unroll
        for (int ai = 0; ai < 2; ++ai)
#pragma unroll
            for (int m = 0; m < 4; ++m) { float v = -3.0e38f;
#pragma unroll
                for (int bj = 0; bj < 2; ++bj)
#pragma unroll
                    for (int n = 0; n < 2; ++n) { const f32x4 a = acc[ai][bj][m][n]; v = fmaxf(v, fmaxf(fmaxf(a[0], a[1]), fmaxf(a[2], a[3]))); }
                mx[ai][m] = v; }
        pg8::row_allreduce_max(mx, wr, wc, fr, fq, xl);
        const float c2 = 0.0625f * 1.4426950408889634f;
#pragma unroll
        for (int ai = 0; ai < 2; ++ai)
#pragma unroll
            for (int m = 0; m < 4; ++m) { float t = 0.f; const float mm = mx[ai][m] * c2;
#pragma unroll
                for (int bj = 0; bj < 2; ++bj)
#pragma unroll
                    for (int n = 0; n < 2; ++n) { f32x4 a = acc[ai][bj][m][n] * c2 - mm;
                        a[0] = __builtin_amdgcn_exp2f(a[0]); a[1] = __builtin_amdgcn_exp2f(a[1]); a[2] = __builtin_amdgcn_exp2f(a[2]); a[3] = __builtin_amdgcn_exp2f(a[3]);
                        acc[ai][bj][m][n] = a; t += (a[0] + a[1]) + (a[2] + a[3]); }
                sm[ai][m] = t; }
        pg8::row_allreduce_sum(sm, wr, wc, fr, fq, xl);
#pragma unroll
        for (int ai = 0; ai < 2; ++ai)
#pragma unroll
            for (int m = 0; m < 4; ++m) { const int row = row0 + ai * HALF + m * 16; const float il = 1.f / sm[ai][m];
#pragma unroll
                for (int bj = 0; bj < 2; ++bj) *(u32x4*)(PC + (size_t)row * 1024 + h * 256 + bj * HALF + wc * 32 + 8 * fq) = pack8(acc[ai][bj][m][0] * il, acc[ai][bj][m][1] * il); }
    }
};
struct EpiStoreBf16 {
    static constexpr bool PERM = true;
    bf16_t* O; int ldc; int pad;
    __device__ __forceinline__ void operator()(f32x4 (&acc)[2][2][4][2], const Unit& u, int wr, int wc, int fr, int fq, LAS unsigned char*) const {
        asm volatile("" : "+v"(fr), "+v"(fq));
        const int row0 = u.pm * 256 + wr * 64 + fr;
#pragma unroll
        for (int ai = 0; ai < 2; ++ai)
#pragma unroll
            for (int m = 0; m < 4; ++m) { const int row = row0 + ai * HALF + m * 16;
#pragma unroll
                for (int bj = 0; bj < 2; ++bj) *(u32x4*)(O + (size_t)row * ldc + u.pn * 256 + bj * HALF + wc * 32 + 8 * fq) = pack8(acc[ai][bj][m][0], acc[ai][bj][m][1]); }
    }
};
struct HeadOrder {
    int G, c, nunits; const char* A; const char* B; size_t strideA, a_h, b_b, b_h;
    __device__ bool next(int i, Unit& u) const {
        const long L = (long)i * G + c; if (L >= nunits) return false;
        u.pm = (int)(L >> 2); u.pn = (int)(L & 3); const int b = u.pm >> 4;
        u.a = A + (size_t)u.pm * strideA + (size_t)u.pn * a_h; u.b = B + (size_t)b * b_b + (size_t)u.pn * b_h; u.rows = nullptr; u.nvalid = 256; u.seg = 0; return true;
    }
};
constexpr int MOE_CAP = 32768;
struct MoeOrder {
    int G, c, seg_lo, seg_hi, ntn; const int* cnt; const int* lists; const char* A; const char* B; size_t a_tile  , b_exp  , b_tile  ;
    __device__ bool next(int i, Unit& u) const {
        const long L = (long)i * G + c; const int rt = (int)(L / ntn), pn = (int)(L % ntn);
        int base = 0, gbase = 0;
        for (int sgm = 0; sgm < seg_lo; ++sgm) gbase += (__hip_atomic_load(cnt + sgm, __ATOMIC_RELAXED, __HIP_MEMORY_SCOPE_AGENT) + 255) >> 8;
        for (int sgm = seg_lo; sgm < seg_hi; ++sgm) { const int n = __hip_atomic_load(cnt + sgm, __ATOMIC_RELAXED, __HIP_MEMORY_SCOPE_AGENT), nt = (n + 255) >> 8;
            if (rt < base + nt) { const int j = rt - base; u.pm = gbase + rt; u.pn = pn; u.seg = sgm; u.nvalid = (n - j * 256) < 256 ? (n - j * 256) : 256; u.rows = lists + (size_t)sgm * MOE_CAP + j * 256;
                u.a = A + (size_t)u.pm * a_tile; u.b = B + (size_t)(sgm & 31) * b_exp + (size_t)pn * b_tile; return true; }
            base += nt; }
        return false;
    }
};
struct EpiGlu {
    static constexpr bool PERM = false;
    bf16_t* H; const float* ssq2; const float* roww; const int* lists0;
    __device__ __forceinline__ void operator()(f32x4 (&acc)[2][2][4][2], const Unit& u, int wr, int wc, int fr, int fq, LAS unsigned char*) const {
        asm volatile("" : "+v"(fr), "+v"(fq));
#pragma unroll
        for (int ai = 0; ai < 2; ++ai)
#pragma unroll
            for (int m = 0; m < 4; ++m) { const int rl = ai * HALF + wr * 64 + m * 16 + fr; const bool valid = rl < u.nvalid;
                const int tok = valid ? u.rows[rl] : 0;
                const float wgt = valid ? *(roww + ((u.rows + rl) - lists0)) : 0.f;
                const float rs = rsqrtf(ssq2[tok] * (1.f / 1024.f) + EPS);
                f32x4 hv[2];
#pragma unroll
                for (int n = 0; n < 2; ++n) { const f32x4 a = acc[ai][0][m][n] * rs, uu = acc[ai][1][m][n] * rs; f32x4 r;
#pragma unroll
                    for (int j = 0; j < 4; ++j) r[j] = a[j] / (1.f + __expf(-a[j])) * uu[j] * wgt;
                    hv[n] = r; }
                *(u32x4*)(H + ((size_t)u.pm * 256 + rl) * 256 + u.pn * 128 + wc * 32 + 8 * fq) = pack8(hv[0], hv[1]); }
    }
};
struct EpiScatterAdd {
    static constexpr bool PERM = false;
    float* out;
    __device__ __forceinline__ void operator()(f32x4 (&acc)[2][2][4][2], const Unit& u, int wr, int wc, int fr, int fq, LAS unsigned char*) const {
        asm volatile("" : "+v"(fr), "+v"(fq));
        const int col0 = u.pn * 256 + wc * 32 + 4 * fq;
#pragma unroll
        for (int ai = 0; ai < 2; ++ai)
#pragma unroll
            for (int m = 0; m < 4; ++m) { const int rl = ai * HALF + wr * 64 + m * 16 + fr;
                if (rl < u.nvalid) { const int tok = u.rows[rl]; float* o = out + (size_t)tok * 1024 + col0;
#pragma unroll
                    for (int bj = 0; bj < 2; ++bj)
#pragma unroll
                        for (int n = 0; n < 2; ++n) { f32x4* q = (f32x4*)(o + bj * HALF + n * 16); *q = *q + acc[ai][bj][m][n]; } } }
    }
};
}
namespace at {
typedef float f32x16 __attribute__((ext_vector_type(16)));
typedef short s16x4 __attribute__((ext_vector_type(4)));
constexpr int NW = 8, QBLK = 32, KVBLK = 64, QB = 256;
constexpr int KROW = 400;
constexpr int SHM_V = KVBLK * 128 * 2, SHM_K = KVBLK * KROW;
constexpr int LDS_V = 0, LDS_K = 2 * SHM_V, LDS_WS = LDS_K + 2 * SHM_K, LDS_BYTES = LDS_WS + NW * 64 * 4;
constexpr float SCALE = 0.07216878364870322f;
constexpr float THR = 8.f;
#define SBAR() __builtin_amdgcn_sched_barrier(0)
__device__ __forceinline__ int v_st(int k, int c) { const int kk = (k & ~0xC) | ((k & 4) << 1) | ((k & 8) >> 1); return ((kk >> 3) * 4 + (c >> 5)) * 512 + ((kk & 7) * 32 + (c & 31)) * 2; }
__device__ __forceinline__ int v_rd_base(int lane) { return ((lane & 3) << 3) | (((lane >> 2) & 3) << 6) | (((lane >> 4) & 1) << 5) | (((lane >> 5) & 1) << 8); }
constexpr int v_rd_off(int d0, int ks, int half) { return d0 * 512 + ks * 4096 + half * 2048; }
__device__ __forceinline__ int crow(int r, int hi) { return (r & 3) + 8 * (r >> 2) + 4 * hi; }
__device__ __forceinline__ unsigned cvtpk(float lo, float hi) { unsigned r; asm volatile("v_cvt_pk_bf16_f32 %0, %1, %2" : "=v"(r) : "v"(lo), "v"(hi)); return r; }
__device__ __forceinline__ void mask_tile(f32x16& p0, f32x16& p1, int dq) {
    const float NEG = -__builtin_inff();
#pragma unroll
    for (int r = 0; r < 16; ++r) {
        const int c = (r & 3) + 8 * (r >> 2);
        if (dq - c < 0) p0[r] = NEG;
        if (dq - c - 32 < 0) p1[r] = NEG;
    }
}
__device__ __forceinline__ void partialSM(f32x16& p0, f32x16& p1, float& m_reg, float& mn, float& alpha) {
    float pmax = p0[0];
#pragma unroll
    for (int r = 1; r < 16; ++r) pmax = fmaxf(pmax, p0[r]);
#pragma unroll
    for (int r = 0; r < 16; ++r) pmax = fmaxf(pmax, p1[r]);
    { auto rr = __builtin_amdgcn_permlane32_swap(__float_as_uint(pmax), __float_as_uint(pmax), false, false);
      pmax = fmaxf(__uint_as_float(rr[0]), __uint_as_float(rr[1])); }
    constexpr float C2 = 1.4426950408889634f * SCALE;
    if (__builtin_expect(__all((pmax - m_reg) * SCALE <= THR), 1)) { mn = m_reg; alpha = 1.f; }
    else { mn = fmaxf(m_reg, pmax); alpha = __builtin_amdgcn_exp2f((m_reg - mn) * C2); m_reg = mn; }
    const float mnL = -mn * C2;
#pragma unroll
    for (int r = 0; r < 16; ++r) p0[r] = fmaf(p0[r], C2, mnL);
#pragma unroll
    for (int r = 0; r < 16; ++r) p1[r] = fmaf(p1[r], C2, mnL);
#pragma unroll
    for (int r = 0; r < 16; ++r) p0[r] = __builtin_amdgcn_exp2f(p0[r]);
}
__device__ __forceinline__ void finishSM(f32x16& p0, f32x16& p1, float alpha, float& l_reg, bf16x8& pa0, bf16x8& pa1, bf16x8& pa2, bf16x8& pa3) {
#pragma unroll
    for (int r = 0; r < 16; ++r) p1[r] = __builtin_amdgcn_exp2f(p1[r]);
    float ps = 0;
#pragma unroll
    for (int r = 0; r < 16; ++r) ps += p0[r];
#pragma unroll
    for (int r = 0; r < 16; ++r) ps += p1[r];
    { auto rr = __builtin_amdgcn_permlane32_swap(__float_as_uint(ps), __float_as_uint(ps), false, false);
      ps = __uint_as_float(rr[0]) + __uint_as_float(rr[1]); }
    l_reg = l_reg * alpha + ps;
#define PK4(P, B_, OUT) do { unsigned a0 = cvtpk(P[B_+0], P[B_+1]), a1 = cvtpk(P[B_+2], P[B_+3]);                          \
        unsigned b0 = cvtpk(P[B_+4], P[B_+5]), b1 = cvtpk(P[B_+6], P[B_+7]);                                             \
        auto r0 = __builtin_amdgcn_permlane32_swap(a0, b0, false, false); auto r1 = __builtin_amdgcn_permlane32_swap(a1, b1, false, false); \
        u32x4 w = {r0[0], r1[0], r0[1], r1[1]}; OUT = *reinterpret_cast<bf16x8*>(&w); } while (0)
    PK4(p0, 0, pa0); PK4(p0, 8, pa1); PK4(p1, 0, pa2); PK4(p1, 8, pa3);
#undef PK4
}
template <int KB>
__device__ __forceinline__ void qkt(f32x16& p0, f32x16& p1, const char* K_lds, int r32, int hi, const bf16x8* qr) {
    p0 = f32x16{}; p1 = f32x16{};
    const char* kb = K_lds + KB * SHM_K + r32 * KROW + hi * 16;
#pragma unroll
    for (int d0 = 0; d0 < 12; ++d0) {
        const bf16x8 b0 = *reinterpret_cast<const bf16x8*>(kb + d0 * 32);
        const bf16x8 b1 = *reinterpret_cast<const bf16x8*>(kb + 32 * KROW + d0 * 32);
        p0 = __builtin_amdgcn_mfma_f32_32x32x16_bf16(b0, qr[d0], p0, 0, 0, 0);
        p1 = __builtin_amdgcn_mfma_f32_32x32x16_bf16(b1, qr[d0], p1, 0, 0, 0);
    }
}
template <int VB>
__device__ __forceinline__ void pv_tile(f32x16* o, int vb0, bf16x8 pa0, bf16x8 pa1, bf16x8 pa2, bf16x8 pa3) {
#define TRRD(dst, off) asm volatile("ds_read_b64_tr_b16 %0, %1 offset:%2" : "=&v"(dst) : "v"(vb0), "i"(off) : "memory")
#define PV_D0(d0) do { s16x4 l0, l1, l2, l3, h0, h1, h2, h3; constexpr int b_ = VB * SHM_V + v_rd_off(d0, 0, 0);   \
        TRRD(l0, b_); TRRD(h0, b_ + 2048); TRRD(l1, b_ + 4096); TRRD(h1, b_ + 6144); TRRD(l2, b_ + 8192); TRRD(h2, b_ + 10240); TRRD(l3, b_ + 12288); TRRD(h3, b_ + 14336); \
        asm volatile("s_waitcnt lgkmcnt(0)" ::: "memory"); SBAR();   \
        o[d0] = __builtin_amdgcn_mfma_f32_32x32x16_bf16(pa0, (bf16x8){l0[0], l0[1], l0[2], l0[3], h0[0], h0[1], h0[2], h0[3]}, o[d0], 0, 0, 0);   \
        o[d0] = __builtin_amdgcn_mfma_f32_32x32x16_bf16(pa1, (bf16x8){l1[0], l1[1], l1[2], l1[3], h1[0], h1[1], h1[2], h1[3]}, o[d0], 0, 0, 0);   \
        o[d0] = __builtin_amdgcn_mfma_f32_32x32x16_bf16(pa2, (bf16x8){l2[0], l2[1], l2[2], l2[3], h2[0], h2[1], h2[2], h2[3]}, o[d0], 0, 0, 0);   \
        o[d0] = __builtin_amdgcn_mfma_f32_32x32x16_bf16(pa3, (bf16x8){l3[0], l3[1], l3[2], l3[3], h3[0], h3[1], h3[2], h3[3]}, o[d0], 0, 0, 0); } while (0)
    PV_D0(0); PV_D0(1); PV_D0(2); PV_D0(3);
#undef PV_D0
#undef TRRD
}

__device__ __forceinline__ void attn_block(const bf16_t* Q, const bf16_t* K, const bf16_t* V, bf16_t* O, size_t tb, int h, int P0, char* lds) {
    const int tid = threadIdx.x, wid = __builtin_amdgcn_readfirstlane(tid >> 6), lane = tid & 63, r32 = lane & 31, hi = lane >> 5;
    const int NT = (P0 + QB) / KVBLK;
    const int qlo = P0 + wid * QBLK, qm = qlo + r32 - 4 * hi;
    char* V_lds = lds + LDS_V; char* K_lds = lds + LDS_K;
    float* ws = (float*)(lds + LDS_WS) + wid * 64; float* li_l = ws, * al_l = ws + 32;
    float m_reg = -1e30f, l_reg = 0; f32x16 o[4] = {};
    const bf16_t* Kh = K + tb * 768 + h * 192; const bf16_t* Vh = V + tb * 512 + h * 128;
    const int sr = tid >> 4, sc = (tid & 15) * 8, vst0 = v_st(sr, sc), vst1 = v_st(32 + sr, sc);
    const int kgo = (tid >> 3) * 768 + (tid & 7) * 8, klo = (tid >> 3) * KROW + (tid & 7) * 16;
    const int vb0 = (int)(uintptr_t)V_lds + v_rd_base(lane);
    bf16x8 st_k0, st_k1, st_k2, st_v0, st_v1;
#define VMW() asm volatile("s_waitcnt vmcnt(0)" ::: "memory")
#define SLOAD(k0) do { const bf16_t* kp_ = Kh + (size_t)(k0) * 768 + kgo; st_k0 = *(const bf16x8*)(kp_); st_k1 = *(const bf16x8*)(kp_ + 64); st_k2 = *(const bf16x8*)(kp_ + 128); \
        st_v0 = *(const bf16x8*)(Vh + (size_t)((k0) + sr) * 512 + sc); st_v1 = *(const bf16x8*)(Vh + (size_t)((k0) + 32 + sr) * 512 + sc); } while (0)
#define SWRITE(bf) do { char* kw_ = K_lds + (bf) * SHM_K + klo; *(bf16x8*)(kw_) = st_k0; *(bf16x8*)(kw_ + 128) = st_k1; *(bf16x8*)(kw_ + 256) = st_k2; \
        *(bf16x8*)(V_lds + (bf) * SHM_V + vst0) = st_v0; *(bf16x8*)(V_lds + (bf) * SHM_V + vst1) = st_v1; } while (0)
#define RESC(a) do { if (__any((a) < 1.f)) { if (hi == 0) al_l[r32] = (a); asm volatile("s_waitcnt lgkmcnt(0)" ::: "memory");              \
                     for (int d_ = 0; d_ < 4; ++d_) for (int r = 0; r < 16; ++r) o[d_][r] *= al_l[crow(r, hi)]; } } while (0)
#define KBASE(t) ((t) * KVBLK)
#define MASKT(P0_, P1_, t) do { const int kb_ = KBASE(t); if (kb_ + KVBLK - 1 > qlo) mask_tile(P0_, P1_, qm - kb_); } while (0)
    bf16x8 qr[12];
    { const bf16_t* Qw = Q + (tb + qlo + r32) * 768 + h * 192 + hi * 8;
#pragma unroll
      for (int d0 = 0; d0 < 12; ++d0) qr[d0] = *(const bf16x8*)(Qw + d0 * 16); }
    SLOAD(0); VMW(); SWRITE(0);
    __syncthreads();
    f32x16 p0, p1; float mn, al; bf16x8 pa0, pa1, pa2, pa3;
#define TILE_STEP(t, BUF) do {                                                                   \
        if ((t) + 1 < NT) { SLOAD(KBASE((t) + 1)); }                                              \
        SBAR(); qkt<BUF>(p0, p1, K_lds, r32, hi, qr);                                             \
        MASKT(p0, p1, (t)); partialSM(p0, p1, m_reg, mn, al); RESC(al);                           \
        finishSM(p0, p1, al, l_reg, pa0, pa1, pa2, pa3); SBAR();                                  \
        pv_tile<BUF>(o, vb0, pa0, pa1, pa2, pa3);                                                 \
        if ((t) + 1 < NT) { VMW(); SWRITE(1 - BUF); }                                             \
        __syncthreads(); } while (0)
    for (int t = 0; t < NT; t += 2) { TILE_STEP(t, 0); TILE_STEP(t + 1, 1); }
    if (hi == 0) li_l[r32] = l_reg; asm volatile("s_waitcnt lgkmcnt(0)" ::: "memory");
    float rli[16];
#pragma unroll
    for (int r = 0; r < 16; ++r) rli[r] = __builtin_amdgcn_rcpf(li_l[crow(r, hi)]);
    bf16_t* Ow = O + (tb + qlo) * 1024 + h * 128;
#pragma unroll
    for (int r = 0; r < 16; ++r) { const int orow = crow(r, hi);
#pragma unroll
        for (int d0 = 0; d0 < 4; ++d0) { const float v = o[d0][r] * rli[r];
            const float vn = __shfl_xor(v, 1);
            if ((r32 & 1) == 0) *(unsigned*)(Ow + (size_t)orow * 1024 + d0 * 32 + r32) = cvtpk(v, vn); } }
#undef VMW
#undef SLOAD
#undef SWRITE
#undef RESC
#undef KBASE
#undef MASKT
#undef TILE_STEP
}
#undef SBAR

__device__ __forceinline__ void attn_phase(const bf16_t* Q, const bf16_t* K, const bf16_t* V, bf16_t* O, char* lds) {
    for (int L = blockIdx.x; L < 256; L += gridDim.x) {
        const int xcd = L & 7, k = L >> 3, bh = (k >> 3) * 8 + xcd, x = k & 7;
        const int b = bh >> 2, h = bh & 3; const size_t tb = (size_t)b * 4096;
        attn_block(Q, K, V, O, tb, h, (15 - x) * QB, lds);
        attn_block(Q, K, V, O, tb, h, x * QB, lds);
    }
}
}
namespace rt {
using at::f32x16; using at::s16x4; using at::v_st; using at::v_rd_base; using at::v_rd_off; using at::crow; using at::cvtpk;
constexpr int PITCH = 272;
constexpr int L_Q = 0, L_K = 128 * PITCH, L_V = 2 * 128 * PITCH, L_S = L_V + 32768, L_END = L_S + 128 * PITCH;
#define TRRD(dst, base, off) asm volatile("ds_read_b64_tr_b16 %0, %1 offset:%2" : "=&v"(dst) : "v"(base), "i"(off) : "memory")
#define FRAG(l, h) ((bf16x8){l[0], l[1], l[2], l[3], h[0], h[1], h[2], h[3]})
using fx::gamma_log2;

__device__ __forceinline__ void ret_kv_unit(const bf16_t* RK, const bf16_t* RV, bf16_t* KVS, int bh, int c, char* lds) {
    const int tid = threadIdx.x, wid = __builtin_amdgcn_readfirstlane(tid >> 6), lane = tid & 63, r32 = lane & 31, hi = lane >> 5;
    const int b = bh >> 2, h = bh & 3; const size_t t0 = (size_t)b * 4096 + (size_t)c * 128;
    char* Kl = lds; char* Vl = lds + 32768;
#pragma unroll
    for (int i = 0; i < 4; ++i) { const int q = tid + 512 * i, row = q >> 4, cc = (q & 15) * 8; const int lo = (row >> 6) * 16384 + v_st(row & 63, cc);
        *(bf16x8*)(Kl + lo) = *(const bf16x8*)(RK + (t0 + row) * 512 + h * 128 + cc);
        *(bf16x8*)(Vl + lo) = *(const bf16x8*)(RV + (t0 + row) * 512 + h * 128 + cc); }
    __syncthreads();
    const int dvb = wid >> 1, dkb = 2 * (wid & 1);
    const int vbase = (int)(uintptr_t)Vl + v_rd_base(lane) + dvb * 512, kbase = (int)(uintptr_t)Kl + v_rd_base(lane) + dkb * 512;
    f32x16 acc0 = {}, acc1 = {};
#define KVSTEP(sub, ks) do { s16x4 al, ah, b0l, b0h, b1l, b1h; constexpr int o_ = (sub) * 16384 + v_rd_off(0, ks, 0);   \
        TRRD(al, vbase, o_); TRRD(ah, vbase, o_ + 2048); TRRD(b0l, kbase, o_); TRRD(b0h, kbase, o_ + 2048); TRRD(b1l, kbase, o_ + 512); TRRD(b1h, kbase, o_ + 512 + 2048); \
        asm volatile("s_waitcnt lgkmcnt(0)" ::: "memory"); __builtin_amdgcn_sched_barrier(0);   \
        acc0 = __builtin_amdgcn_mfma_f32_32x32x16_bf16(FRAG(al, ah), FRAG(b0l, b0h), acc0, 0, 0, 0);   \
        acc1 = __builtin_amdgcn_mfma_f32_32x32x16_bf16(FRAG(al, ah), FRAG(b1l, b1h), acc1, 0, 0, 0); } while (0)
    KVSTEP(0, 0); KVSTEP(0, 1); KVSTEP(0, 2); KVSTEP(0, 3); KVSTEP(1, 0); KVSTEP(1, 1); KVSTEP(1, 2); KVSTEP(1, 3);
#undef KVSTEP
    const float sc = exp2f(127.f * gamma_log2(h));
    bf16_t* O = KVS + ((size_t)(bh * 32 + c) * 128 + dvb * 32) * 128 + dkb * 32;
#pragma unroll
    for (int r = 0; r < 16; ++r) { const int dv = crow(r, hi);
        const float v0 = acc0[r] * sc, v1 = acc1[r] * sc; const float n0 = __shfl_xor(v0, 1), n1 = __shfl_xor(v1, 1);
        if ((r32 & 1) == 0) { *(unsigned*)(O + (size_t)dv * 128 + r32) = cvtpk(v0, n0); *(unsigned*)(O + (size_t)dv * 128 + 32 + r32) = cvtpk(v1, n1); } }
    __syncthreads();
}
__device__ __forceinline__ void ret_kv_phase(const bf16_t* RK, const bf16_t* RV, bf16_t* KVS, char* lds) {
    for (int u = blockIdx.x; u < 1024; u += gridDim.x) ret_kv_unit(RK, RV, KVS, u >> 5, u & 31, lds);
}

__device__ __forceinline__ void ret_out_unit(const bf16_t* RQ, const bf16_t* RK, const bf16_t* RV, const bf16_t* RG, const bf16_t* KVS, const float* gn_g, bf16_t* AO, int bh, int c, char* lds) {
    const int tid = threadIdx.x, wid = __builtin_amdgcn_readfirstlane(tid >> 6), lane = tid & 63, r32 = lane & 31, hi = lane >> 5;
    const int b = bh >> 2, h = bh & 3; const size_t t0 = (size_t)b * 4096 + (size_t)c * 128;
    const float lg = gamma_log2(h);
#pragma unroll
    for (int i = 0; i < 4; ++i) { const int q = tid + 512 * i, row = q >> 4, cc = (q & 15) * 8;
        *(bf16x8*)(lds + L_Q + row * PITCH + cc * 2) = *(const bf16x8*)(RQ + (t0 + row) * 512 + h * 128 + cc);
        *(bf16x8*)(lds + L_K + row * PITCH + cc * 2) = *(const bf16x8*)(RK + (t0 + row) * 512 + h * 128 + cc);
        *(bf16x8*)(lds + L_V + (row >> 6) * 16384 + v_st(row & 63, cc)) = *(const bf16x8*)(RV + (t0 + row) * 512 + h * 128 + cc); }
    { f32x4 sa[4][2];
#pragma unroll
      for (int i = 0; i < 4; ++i) { sa[i][0] = (f32x4){0.f, 0.f, 0.f, 0.f}; sa[i][1] = sa[i][0]; }
      float w = 1.f; const float cd = exp2f(128.f * lg);
      for (int j = c - 1; j >= 0; --j) { const bf16_t* src = KVS + (size_t)(bh * 32 + j) * 16384 + tid * 8;
#pragma unroll
          for (int i = 0; i < 4; ++i) { const u32x4 v = *(const u32x4*)(src + 4096 * i);
              sa[i][0] += w * (f32x4){__uint_as_float(v.x << 16), __uint_as_float(v.x & 0xffff0000u), __uint_as_float(v.y << 16), __uint_as_float(v.y & 0xffff0000u)};
              sa[i][1] += w * (f32x4){__uint_as_float(v.z << 16), __uint_as_float(v.z & 0xffff0000u), __uint_as_float(v.w << 16), __uint_as_float(v.w & 0xffff0000u)}; }
          w *= cd; }
#pragma unroll
      for (int i = 0; i < 4; ++i) { const int e8 = tid + 512 * i, dv = e8 >> 4, dk0 = (e8 & 15) * 8; *(u32x4*)(lds + L_S + dv * PITCH + dk0 * 2) = fx::pack8(sa[i][0], sa[i][1]); } }
    __syncthreads();
    const int qg = wid & 3, dh = wid >> 2;
    bf16x8 qr[8];
#pragma unroll
    for (int d0 = 0; d0 < 8; ++d0) qr[d0] = *(const bf16x8*)(lds + L_Q + (32 * qg + r32) * PITCH + d0 * 32 + hi * 16);
    f32x16 o[2] = {};
#pragma unroll
    for (int dd = 0; dd < 2; ++dd) { const char* sb = lds + L_S + ((2 * dh + dd) * 32 + r32) * PITCH + hi * 16;
#pragma unroll
        for (int d0 = 0; d0 < 8; ++d0) o[dd] = __builtin_amdgcn_mfma_f32_32x32x16_bf16(qr[d0], *(const bf16x8*)(sb + d0 * 32), o[dd], 0, 0, 0); }
    { const float g1 = exp2f(lg);
#pragma unroll
      for (int dd = 0; dd < 2; ++dd)
#pragma unroll
          for (int r = 0; r < 16; ++r) o[dd][r] *= g1; }
    const int vb = (int)(uintptr_t)(lds + L_V) + v_rd_base(lane) + (2 * dh) * 512;
    const int qpos = 32 * qg + r32;
#define INTRA(kt) do { if (64 * (kt) <= 32 * qg + 31) { f32x16 p0 = {}, p1 = {}; const char* kb = lds + L_K + (64 * (kt) + r32) * PITCH + hi * 16;   \
        _Pragma("unroll") for (int d0 = 0; d0 < 8; ++d0) { p0 = __builtin_amdgcn_mfma_f32_32x32x16_bf16(*(const bf16x8*)(kb + d0 * 32), qr[d0], p0, 0, 0, 0);   \
                                                          p1 = __builtin_amdgcn_mfma_f32_32x32x16_bf16(*(const bf16x8*)(kb + 32 * PITCH + d0 * 32), qr[d0], p1, 0, 0, 0); }   \
        _Pragma("unroll") for (int r = 0; r < 16; ++r) { const int key = 64 * (kt) + crow(r, hi); if (key > qpos) p0[r] = 0.f; if (key + 32 > qpos) p1[r] = 0.f; }   \
        bf16x8 pa0, pa1, pa2, pa3;   \
        PK4(p0, 0, pa0); PK4(p0, 8, pa1); PK4(p1, 0, pa2); PK4(p1, 8, pa3);   \
        PVD(kt, 0); PVD(kt, 1); } } while (0)
#define PK4(P, B_, OUT) do { unsigned a0 = cvtpk(P[B_+0], P[B_+1]), a1 = cvtpk(P[B_+2], P[B_+3]); unsigned b0 = cvtpk(P[B_+4], P[B_+5]), b1 = cvtpk(P[B_+6], P[B_+7]);   \
        auto r0 = __builtin_amdgcn_permlane32_swap(a0, b0, false, false); auto r1 = __builtin_amdgcn_permlane32_swap(a1, b1, false, false);   \
        u32x4 w_ = {r0[0], r1[0], r0[1], r1[1]}; OUT = *reinterpret_cast<bf16x8*>(&w_); } while (0)
#define PVD(kt, dd) do { s16x4 l0, l1, l2, l3, h0, h1, h2, h3; constexpr int b_ = (kt) * 16384 + v_rd_off(dd, 0, 0);   \
        TRRD(l0, vb, b_); TRRD(h0, vb, b_ + 2048); TRRD(l1, vb, b_ + 4096); TRRD(h1, vb, b_ + 6144); TRRD(l2, vb, b_ + 8192); TRRD(h2, vb, b_ + 10240); TRRD(l3, vb, b_ + 12288); TRRD(h3, vb, b_ + 14336);   \
        asm volatile("s_waitcnt lgkmcnt(0)" ::: "memory"); __builtin_amdgcn_sched_barrier(0);   \
        o[dd] = __builtin_amdgcn_mfma_f32_32x32x16_bf16(pa0, FRAG(l0, h0), o[dd], 0, 0, 0); o[dd] = __builtin_amdgcn_mfma_f32_32x32x16_bf16(pa1, FRAG(l1, h1), o[dd], 0, 0, 0);   \
        o[dd] = __builtin_amdgcn_mfma_f32_32x32x16_bf16(pa2, FRAG(l2, h2), o[dd], 0, 0, 0); o[dd] = __builtin_amdgcn_mfma_f32_32x32x16_bf16(pa3, FRAG(l3, h3), o[dd], 0, 0, 0); } while (0)
    INTRA(0); INTRA(1);
#undef INTRA
#undef PK4
#undef PVD
    __syncthreads();
    float* Os = (float*)lds;
#pragma unroll
    for (int dd = 0; dd < 2; ++dd)
#pragma unroll
        for (int r = 0; r < 16; ++r) Os[(32 * qg + crow(r, hi)) * 132 + (2 * dh + dd) * 32 + r32] = o[dd][r];
    __syncthreads();
    { const int q = tid >> 2, seg = tid & 3; const float* orow = Os + q * 132 + seg * 32;
      f32x4 v[8]; float s1 = 0.f, s2 = 0.f;
#pragma unroll
      for (int i = 0; i < 8; ++i) { v[i] = *(const f32x4*)(orow + 4 * i); s1 += (v[i][0] + v[i][1]) + (v[i][2] + v[i][3]); s2 += fx::sq4(v[i]); }
      s1 += __shfl_xor(s1, 1); s1 += __shfl_xor(s1, 2); s2 += __shfl_xor(s2, 1); s2 += __shfl_xor(s2, 2);
      const float mean = s1 * (1.f / 128.f); const float var = fmaxf(s2 * (1.f / 128.f) - mean * mean, 0.f); const float rs = rsqrtf(var + EPS);
      const bf16_t* gp = RG + (t0 + q) * 512 + h * 128 + seg * 32; const float* gg = gn_g + h * 128 + seg * 32;
      bf16_t* op = AO + (t0 + q) * 1024 + 512 + h * 128 + seg * 32;
#pragma unroll
      for (int i = 0; i < 4; ++i) { const u32x4 gr = *(const u32x4*)(gp + 8 * i); const f32x4 g0 = *(const f32x4*)(gg + 8 * i), g1 = *(const f32x4*)(gg + 8 * i + 4);
          const f32x4 ga = {__uint_as_float(gr.x << 16), __uint_as_float(gr.x & 0xffff0000u), __uint_as_float(gr.y << 16), __uint_as_float(gr.y & 0xffff0000u)};
          const f32x4 gb = {__uint_as_float(gr.z << 16), __uint_as_float(gr.z & 0xffff0000u), __uint_as_float(gr.w << 16), __uint_as_float(gr.w & 0xffff0000u)};
          f32x4 ya = (v[2 * i] - mean) * rs * g0, yb = (v[2 * i + 1] - mean) * rs * g1;
#pragma unroll
          for (int k = 0; k < 4; ++k) { ya[k] *= ga[k] / (1.f + __expf(-ga[k])); yb[k] *= gb[k] / (1.f + __expf(-gb[k])); }
          *(u32x4*)(op + 8 * i) = fx::pack8(ya, yb); } }
    __syncthreads();
}
__device__ __forceinline__ void ret_out_phase(const bf16_t* RQ, const bf16_t* RK, const bf16_t* RV, const bf16_t* RG, const bf16_t* KVS, const float* gn_g, bf16_t* AO, char* lds) {
    for (int it = blockIdx.x; it < 512; it += gridDim.x) { const int bh = it >> 4, x = it & 15;
        ret_out_unit(RQ, RK, RV, RG, KVS, gn_g, AO, bh, 31 - x, lds);
        ret_out_unit(RQ, RK, RV, RG, KVS, gn_g, AO, bh, x, lds); }
}
#undef TRRD
#undef FRAG
}
namespace cg = cooperative_groups;
#ifndef DUP
#define DUP (-1)
#endif
constexpr int NWAVES = 8;
constexpr int RING_BYTES = 131072, XL_OFF = RING_BYTES, XL_BYTES = 8192, LDS_BYTES = RING_BYTES + 8192 + 16384;

struct Params {
    const float* in[28]; float* out; unsigned char* ws; int ph_lo, ph_hi; int coop; int pad;
};
typedef const Params __attribute__((address_space(4)))* KParams;
#define WSP(T_, off) ((T_*)(p->ws + (off)))

constexpr size_t WB_IN = WS_WB, WB_UQ = WB_IN + (size_t)2560 * 1024 * 2, WB_UKV = WB_UQ + (size_t)1024 * 256 * 2, WB_OUT = WB_UKV + (size_t)1024 * 256 * 2,
                 WB_CQ = WB_OUT + (size_t)1024 * 1024 * 2, WB_CKV = WB_CQ + (size_t)1024 * 1024 * 2, WB_CO = WB_CKV + (size_t)2048 * 1024 * 2,
                 WB_GU = WB_CO + (size_t)1024 * 1024 * 2, WB_D = WB_GU + (size_t)32 * 512 * 1024 * 2, WB_END = WB_D + (size_t)32 * 1024 * 256 * 2;
static_assert(WB_END <= WS_RQ, "weight copies overflow their region");

__device__ __forceinline__ float wave_sum64(float v) {
#pragma unroll
    for (int o = 1; o < 64; o <<= 1) v += __shfl_xor(v, o);
    return v;
}
__device__ __forceinline__ int plain_src(int n) { return (n & ~31) + pg8::perm32(n & 31); }

template <class SrcFn, class DstFn>
__device__ __forceinline__ void wprep_item(const float* __restrict__ W, int ldw, int Kreal, const float* __restrict__ gain, bf16_t* __restrict__ WT, int ldt,
                                           LAS float* scr, int kb, int nb, int lane, SrcFn src, DstFn dst) {
    const int k0 = 64 * kb, n0 = 32 * nb;
    const int sc = src(n0 + (lane & 31));
#pragma unroll 8
    for (int i = 0; i < 32; ++i) { const int kk = 2 * i + (lane >> 5); float v = 0.f;
        if (sc >= 0 && k0 + kk < Kreal) { v = W[(size_t)(k0 + kk) * ldw + sc]; if (gain) v *= gain[k0 + kk]; }
        scr[kk * 33 + (lane & 31)] = v; }
    asm volatile("s_waitcnt lgkmcnt(0)" ::: "memory");
    const int c = lane & 7;
#pragma unroll
    for (int j = 0; j < 4; ++j) { const int n = (lane >> 3) + 8 * j; const LAS float* s = scr + (8 * c) * 33 + n;
        u32x4 o; o.x = pg8::cvt_pk_bf16(s[0 * 33], s[1 * 33]); o.y = pg8::cvt_pk_bf16(s[2 * 33], s[3 * 33]); o.z = pg8::cvt_pk_bf16(s[4 * 33], s[5 * 33]); o.w = pg8::cvt_pk_bf16(s[6 * 33], s[7 * 33]);
        *(u32x4*)(WT + (size_t)dst(n0 + n) * ldt + k0 + 8 * c) = o; }
    asm volatile("s_waitcnt lgkmcnt(0)" ::: "memory");
}
template <class SrcFn, class DstFn>
__device__ __forceinline__ void wprep_matrix(const float* W, int ldw, int Kreal, int Kpad, int Nitems32, const float* gain, bf16_t* WT, int ldt, LAS float* scr, int gw, int NGW, int lane, SrcFn src, DstFn dst) {
    const int nkb = Kpad / 64, total = nkb * Nitems32;
    for (int it = gw; it < total; it += NGW) wprep_item(W, ldw, Kreal, gain, WT, ldt, scr, it / Nitems32, it % Nitems32, lane, src, dst);
}
__device__ __forceinline__ void rms_row_to_bf16(const float* xrow, const float* g, bf16_t* orow, int lane) {
    const f32x4* xr = (const f32x4*)xrow + lane; const f32x4* gr = (const f32x4*)g + lane;
    f32x4 v[4]; float s = 0.f;
#pragma unroll
    for (int j = 0; j < 4; ++j) { v[j] = xr[64 * j]; s += fx::sq4(v[j]); }
    const float rs = rsqrtf(wave_sum64(s) * (1.f / 1024.f) + EPS);
    u32x2* o8 = (u32x2*)orow + lane;
#pragma unroll
    for (int j = 0; j < 4; ++j) { const f32x4 w = v[j] * rs * gr[64 * j]; o8[64 * j] = fx::pack4(w); }
}

__device__ __forceinline__ void p0_prologue(KParams p, LAS unsigned char* lds, int wave, int lane) {
    LAS float* scr = (LAS float*)(lds + wave * 16384);
    const int gw = blockIdx.x * NWAVES + wave, NGW = gridDim.x * NWAVES;
    auto ident = [](int n) { return n; };
    wprep_matrix(p->in[4], 2496, 1024, 1024, 2560 / 32, nullptr, WSP(bf16_t, WB_IN), 1024, scr, gw, NGW, lane, [](int n) { return fx::inproj_src(n); }, ident);
    wprep_matrix(p->in[12], 1024, 1024, 1024, 1024 / 32, nullptr, WSP(bf16_t, WB_OUT), 1024, scr, gw, NGW, lane, ident, ident);
    wprep_matrix(p->in[19], 1024, 1024, 1024, 1024 / 32, nullptr, WSP(bf16_t, WB_CO), 1024, scr, gw, NGW, lane, ident, ident);
    wprep_matrix(p->in[6], 768, 256, 256, 1024 / 32, p->in[5], WSP(bf16_t, WB_UQ), 256, scr, gw, NGW, lane, [](int n) { return fx::mlaq_src(n); }, ident);
    wprep_matrix(p->in[8], 1024, 128, 256, 1024 / 32, p->in[7], WSP(bf16_t, WB_UKV), 256, scr, gw, NGW, lane, [](int n) { return plain_src(n); }, ident);
    wprep_matrix(p->in[15], 1024, 1024, 1024, 1024 / 32, p->in[13], WSP(bf16_t, WB_CQ), 1024, scr, gw, NGW, lane, [](int n) { return plain_src(n); }, ident);
    wprep_matrix(p->in[16], 2048, 1024, 1024, 2048 / 32, nullptr, WSP(bf16_t, WB_CKV), 1024, scr, gw, NGW, lane, [](int n) { return n < 1024 ? plain_src(n) : n; }, ident);
    for (int it = gw; it < 32 * 128; it += NGW) { const int e = it >> 7, r = it & 127, kb = r >> 3, nb = r & 7;
        auto srcf = [](int n) { return (n >> 7) * 128 + plain_src(n & 127); };
        wprep_item(p->in[25] + (size_t)e * 1024 * 256, 256, 1024, p->in[20], WSP(bf16_t, WB_GU) + (size_t)e * 512 * 1024, 1024, scr, kb, nb, lane, srcf, [](int n) { return (n >> 7) * 256 + (n & 127); });
        wprep_item(p->in[26] + (size_t)e * 1024 * 256, 256, 1024, p->in[20], WSP(bf16_t, WB_GU) + (size_t)e * 512 * 1024, 1024, scr, kb, nb, lane, srcf, [](int n) { return (n >> 7) * 256 + 128 + (n & 127); }); }
    for (int it = gw; it < 32 * 128; it += NGW) { const int e = it >> 7, r = it & 127, kb = r >> 5, nb = r & 31;
        wprep_item(p->in[27] + (size_t)e * 256 * 1024, 1024, 256, nullptr, WSP(bf16_t, WB_D) + (size_t)e * 1024 * 256, 256, scr, kb, nb, lane, ident, ident); }
    for (int m = gw; m < T_TOK; m += NGW) rms_row_to_bf16(p->in[0] + (size_t)m * 1024, p->in[3], WSP(bf16_t, WS_HB) + (size_t)m * 1024, lane);
    for (int m = gw; m < 2048; m += NGW) rms_row_to_bf16(p->in[1] + (size_t)m * 1024, p->in[14], WSP(bf16_t, WS_MB) + (size_t)m * 1024, lane);
    { const int* pos = (const int*)p->in[2]; float* cs = WSP(float, WS_CS);
      const int gt = blockIdx.x * (NWAVES * 64) + threadIdx.x, NT = gridDim.x * NWAVES * 64;
      for (int idx = gt; idx < T_TOK * 64; idx += NT) { const int t = idx >> 6, i = idx & 63; const float inv = powf(10000.f, -(float)i * (1.f / 64.f)); float sn, c; sincosf((float)pos[t] * inv, &sn, &c);
          *(f32x2*)(cs + (size_t)idx * 2) = (f32x2){c, sn}; }
      float* z = WSP(float, WS_SSQ_CQ);
      for (int idx = gt; idx < 5 * 32768; idx += NT) z[idx] = 0.f;
      if (gt < 64) WSP(int, WS_CNT)[gt] = 0;
      float* wr = WSP(float, WS_RW);
      for (int idx = gt; idx < 64 * 1024; idx += NT) { const int n = idx >> 10, k = idx & 1023; float v = 0.f;
          if (n < 4) v = p->in[20][k] * p->in[21][k * 4 + n]; else if (n < 36) v = p->in[20][k] * p->in[23][k * 32 + n - 4];
          wr[idx] = v; } }
}


#define GAS __attribute__((address_space(1)))
#define XB_TMO      128
#define XB_XCNT(j)  (256  + 64 * (j))
#define XB_XSUB(j)  (1280 + 64 * (j))
#define XB_XGEN(j)  (2304 + 64 * (j))
#define XB_TOP      3328
#define XB_TOPGEN   3392
#define XCD_BAR_WORDS 3456
#define XB_SPIN_CAP (1u << 18)
__device__ __forceinline__ unsigned xb_ld(unsigned* p)              { return __hip_atomic_load(p, __ATOMIC_RELAXED, __HIP_MEMORY_SCOPE_AGENT); }
__device__ __forceinline__ unsigned xb_add(unsigned* p, unsigned v) { return __hip_atomic_fetch_add(p, v, __ATOMIC_RELAXED, __HIP_MEMORY_SCOPE_AGENT); }
__device__ __forceinline__ unsigned xb_xcc_id() { return (unsigned)__builtin_amdgcn_s_getreg((3 << 11) | 20) & 0xFu; }
#define XB_SPIN(cond, bar) do { unsigned _sp = 0; while (cond) { __builtin_amdgcn_s_sleep(1); \
    if ((++_sp & 255u) == 0u) { if (xb_ld(&(bar)[XB_TMO])) break; if (_sp > XB_SPIN_CAP) { atomicAdd(&(bar)[XB_TMO], 1u); break; } } } } while (0)
struct XcdBarrier { unsigned* bar; unsigned x; volatile LAS unsigned* st; };
__device__ __forceinline__ XcdBarrier xcd_barrier_post(unsigned* bar, volatile LAS unsigned* st) {
    XcdBarrier b; b.bar = bar; b.x = xb_xcc_id(); b.st = st;
    if (threadIdx.x == 0) (void)xb_add(&bar[XB_XCNT(b.x)], 1u);
    return b;
}
__device__ __forceinline__ void xcd_barrier_complete(unsigned* bar, unsigned x, unsigned& nloc, unsigned& nx) {
    const unsigned G = gridDim.x * gridDim.y * gridDim.z;
    unsigned sum, cnt, mine, sp = 0u;
    for (;;) {
        sum = 0u; cnt = 0u; mine = 0u;
#pragma unroll
        for (unsigned j = 0; j < 16; ++j) { const unsigned c = xb_ld(&bar[XB_XCNT(j)]); sum += c; cnt += (c > 0u) ? 1u : 0u; mine = (j == x) ? c : mine; }
        if (sum == G) break;
        __builtin_amdgcn_s_sleep(1);
        if ((++sp & 255u) == 0u) { if (xb_ld(&bar[XB_TMO])) break; if (sp > XB_SPIN_CAP) { atomicAdd(&bar[XB_TMO], 1u); break; } }
    }
    nloc = mine > 0u ? mine : 1u; nx = cnt > 0u ? cnt : 1u;
}
__device__ __forceinline__ void xcd_barrier(const XcdBarrier& b) {
    asm volatile("s_waitcnt vmcnt(0)" ::: "memory");
    __syncthreads();
    if (threadIdx.x == 0) {
        unsigned* bar = b.bar;
        __builtin_amdgcn_s_waitcnt(0);
        unsigned nloc = b.st[0], nx = b.st[1];
        if (nloc == 0u) { xcd_barrier_complete(bar, b.x, nloc, nx); b.st[0] = nloc; b.st[1] = nx; }
        const unsigned old = xb_add(&bar[XB_XSUB(b.x)], 1u);
        const unsigned gen = old / nloc;
        if (old + 1u == (gen + 1u) * nloc) {
            __builtin_amdgcn_fence(__ATOMIC_RELEASE, "agent");
            asm volatile("s_waitcnt vmcnt(0)" ::: "memory");
            const unsigned og = xb_add(&bar[XB_TOP], 1u);
            const unsigned tg = og / nx;
            if (og + 1u == (tg + 1u) * nx) xb_add(&bar[XB_TOPGEN], 1u);
            else XB_SPIN(xb_ld(&bar[XB_TOPGEN]) == tg, bar);
            __builtin_amdgcn_fence(__ATOMIC_ACQUIRE, "agent");
            xb_add(&bar[XB_XGEN(b.x)], 1u);
            asm volatile("s_waitcnt vmcnt(0)" ::: "memory");
        } else {
            XB_SPIN(xb_ld(&bar[XB_XGEN(b.x)]) == gen, bar);
            __builtin_amdgcn_fence(__ATOMIC_ACQUIRE, "agent");
            asm volatile("s_waitcnt vmcnt(0)" ::: "memory");
        }
    }
    __syncthreads();
}

__device__ __forceinline__ void router_phase(KParams p, LAS unsigned char* lds, int wave, int lane, int* cnt, int* lists, float* roww) {
    const float* x2 = p->out; const float* WR = WSP(float, WS_RW);
    const float* bg = p->in[22]; const float* be = p->in[24];
    LAS float* lg = (LAS float*)(lds + wave * 4096);
    const int i = lane & 15, kq = lane >> 4;
    for (int item = blockIdx.x * NWAVES + wave; item < T_TOK / 16; item += gridDim.x * NWAVES) {
        const int t0 = item * 16;
        const float* xr = x2 + (size_t)(t0 + i) * 1024 + 4 * kq;
        const float* w0 = WR + (size_t)i * 1024 + 4 * kq;
        f32x4 c0 = {0.f, 0.f, 0.f, 0.f}, c1 = c0, c2 = c0; float ss = 0.f;
#pragma unroll 4
        for (int c = 0; c < 64; ++c) {
            const f32x4 a = *(const f32x4*)(xr + 16 * c), b0 = *(const f32x4*)(w0 + 16 * c), b1 = *(const f32x4*)(w0 + 16 * 1024 + 16 * c), b2 = *(const f32x4*)(w0 + 32 * 1024 + 16 * c);
            ss += fx::sq4(a);
#pragma unroll
            for (int s = 0; s < 4; ++s) { c0 = __builtin_amdgcn_mfma_f32_16x16x4f32(a[s], b0[s], c0, 0, 0, 0); c1 = __builtin_amdgcn_mfma_f32_16x16x4f32(a[s], b1[s], c1, 0, 0, 0); c2 = __builtin_amdgcn_mfma_f32_16x16x4f32(a[s], b2[s], c2, 0, 0, 0); }
        }
        ss = fx::quad_sum(ss);
        const float rs = rsqrtf(ss * (1.f / 1024.f) + EPS);
#pragma unroll
        for (int r = 0; r < 4; ++r) { lg[(4 * kq + r) * 48 + i] = c0[r]; lg[(4 * kq + r) * 48 + 16 + i] = c1[r]; lg[(4 * kq + r) * 48 + 32 + i] = c2[r]; }
        asm volatile("s_waitcnt lgkmcnt(0)" ::: "memory");
        if (lane < 16) {
            const int t = t0 + lane; float L[36];
#pragma unroll
            for (int j = 0; j < 36; ++j) L[j] = lg[lane * 48 + j] * rs;
            float mx = fmaxf(fmaxf(L[0], L[1]), fmaxf(L[2], L[3]));
            float den = 0.f;
#pragma unroll
            for (int j = 0; j < 4; ++j) den += expf(L[j] - mx);
            int gs = 0; float best = L[0] + bg[0];
#pragma unroll
            for (int j = 1; j < 4; ++j) { const float v = L[j] + bg[j]; if (v > best) { best = v; gs = j; } }
            float el[8], lgs = 0.f;
#pragma unroll
            for (int g4 = 0; g4 < 4; ++g4) if (g4 == gs) { lgs = L[g4];
#pragma unroll
                for (int j = 0; j < 8; ++j) el[j] = L[4 + g4 * 8 + j]; }
            const float gw = expf(lgs - mx) / den;
            float emx = el[0];
#pragma unroll
            for (int j = 1; j < 8; ++j) emx = fmaxf(emx, el[j]);
            float eden = 0.f;
#pragma unroll
            for (int j = 0; j < 8; ++j) eden += expf(el[j] - emx);
            float sc[8];
#pragma unroll
            for (int j = 0; j < 8; ++j) sc[j] = el[j] + be[gs * 8 + j];
            int i0 = 0; float b0 = sc[0], e0v = el[0];
#pragma unroll
            for (int j = 1; j < 8; ++j) if (sc[j] > b0) { b0 = sc[j]; i0 = j; e0v = el[j]; }
            int i1 = -1; float b1 = -3.0e38f, e1v = 0.f;
#pragma unroll
            for (int j = 0; j < 8; ++j) if (j != i0 && sc[j] > b1) { b1 = sc[j]; i1 = j; e1v = el[j]; }
            const float p0 = expf(e0v - emx) / eden, p1 = expf(e1v - emx) / eden, sm = p0 + p1;
            const int sg0 = gs * 8 + i0, sg1 = 32 + gs * 8 + i1;
            const int q0 = atomicAdd(cnt + sg0, 1), q1 = atomicAdd(cnt + sg1, 1);
            lists[(size_t)sg0 * fx::MOE_CAP + q0] = t; roww[(size_t)sg0 * fx::MOE_CAP + q0] = p0 / sm * gw;
            lists[(size_t)sg1 * fx::MOE_CAP + q1] = t; roww[(size_t)sg1 * fx::MOE_CAP + q1] = p1 / sm * gw;
        }
        asm volatile("s_waitcnt lgkmcnt(0)" ::: "memory");
    }
}

__global__ void __launch_bounds__(NWAVES * 64, 2) mk_fwd(Params p_arg) {
    KParams p = (KParams)__builtin_amdgcn_kernarg_segment_ptr();
    extern __shared__ __attribute__((aligned(16))) unsigned char lds_raw[];
    LAS unsigned char* lds = (LAS unsigned char*)lds_raw;
    LAS unsigned char* xl = lds + XL_OFF;
    const int tid = threadIdx.x, lane = tid & 63, wave = __builtin_amdgcn_readfirstlane(tid >> 6);
    const int lo = p->ph_lo, hi = p->ph_hi;
#ifndef PHMASK
#define PHMASK 0xffffffffu
#endif
#define IN(k) (((PHMASK >> (k)) & 1u) && lo <= (k) && (k) < hi)
#define SEAM(k) do { if (IN(k) && IN((k) + 1)) { if ((k) == 0) { asm volatile("s_waitcnt vmcnt(0)" ::: "memory"); cg::this_grid().sync(); if (DUP == 1000) cg::this_grid().sync(); } \
                                                  else { xcd_barrier(xbar); if (DUP == 1000) xcd_barrier(xbar); } } } while (0)
    volatile LAS unsigned* xst = (volatile LAS unsigned*)(xl + 8192 - 16);
    if (tid == 0) { xst[0] = 0u; xst[1] = 0u; }
    __syncthreads();
    XcdBarrier xbar = xcd_barrier_post(WSP(unsigned, WS_BAR), xst);
#define REPS(code) for (int rep = 0; rep < ((DUP == (code)) ? 2 : 1); ++rep)
    float* const dummyf = WSP(float, 512 * 1024);
    REPS(0) if (IN(0)) { p0_prologue(p, lds, wave, lane); }
    SEAM(0);
    if (IN(1)) {
        REPS(1) {
        pg8::GridOrder S; S.init(WSP(bf16_t, WS_HB), 1024, WSP(bf16_t, WB_IN), 1024, T_TOK, 2560, gridDim.x, blockIdx.x);
        fx::EpiInProj E{WSP(bf16_t, WS_CQ), WSP(bf16_t, WS_CKV), WSP(bf16_t, WS_RQ), WSP(bf16_t, WS_RK), WSP(bf16_t, WS_RV), WSP(bf16_t, WS_RG),
                        rep ? dummyf : WSP(float, WS_SSQ_CQ), rep ? dummyf : WSP(float, WS_SSQ_CKV), rep ? dummyf : WSP(float, WS_SSQ_KPE), WSP(float, WS_CS), p->in[10]};
        pg8::gemm_phase<fx::EpiInProj, pg8::GridOrder>(lds, xl, 1024, 1024, 1024, S, E); }
        REPS(101) {
        { pg8::GridOrder S2; S2.init(WSP(bf16_t, WS_MB), 1024, WSP(bf16_t, WB_CKV), 1024, 2048, 1024, gridDim.x, blockIdx.x);
          fx::EpiHeadNorm E2{WSP(bf16_t, WS_KC), nullptr, p->in[18], 0.f};
          pg8::gemm_phase<fx::EpiHeadNorm, pg8::GridOrder>(lds, xl, 1024, 1024, 1024, S2, E2); }
        { pg8::GridOrder S3; S3.init(WSP(bf16_t, WB_CKV) + (size_t)1024 * 1024, 1024, WSP(bf16_t, WS_MB), 1024, 1024, 2048, gridDim.x, blockIdx.x);
          fx::EpiStoreT E3{WSP(bf16_t, WS_VC), 256, 1024 * 256, 1.f, 0};
          pg8::gemm_phase<fx::EpiStoreT, pg8::GridOrder>(lds, xl, 1024, 1024, 1024, S3, E3); } }
    }
    SEAM(1);
    if (IN(2)) {
        REPS(2) {
        { pg8::GridOrder S; S.init(WSP(bf16_t, WS_CQ), 256, WSP(bf16_t, WB_UQ), 256, T_TOK, 1024, gridDim.x, blockIdx.x);
          fx::EpiMlaQ E{WSP(bf16_t, WS_QM), WSP(float, WS_SSQ_CQ), p->in[9], WSP(float, WS_CS)};
          pg8::gemm_phase<fx::EpiMlaQ, pg8::GridOrder>(lds, xl, 256, 256, 256, S, E); }
        { pg8::GridOrder S; S.init(WSP(bf16_t, WS_CKV), 256, WSP(bf16_t, WB_UKV), 256, T_TOK, 1024, gridDim.x, blockIdx.x);
          fx::EpiMlaKV E{WSP(bf16_t, WS_KM), WSP(bf16_t, WS_VM), WSP(bf16_t, WS_CKV), WSP(float, WS_SSQ_CKV), WSP(float, WS_SSQ_KPE), p->in[10]};
          pg8::gemm_phase<fx::EpiMlaKV, pg8::GridOrder>(lds, xl, 256, 256, 256, S, E); } }
        REPS(201) rt::ret_kv_phase(WSP(bf16_t, WS_RK), WSP(bf16_t, WS_RV), WSP(bf16_t, WS_KVS), (char*)lds_raw);
    }
    SEAM(2);
    if (IN(3)) { REPS(3) at::attn_phase(WSP(bf16_t, WS_QM), WSP(bf16_t, WS_KM), WSP(bf16_t, WS_VM), WSP(bf16_t, WS_AO), (char*)lds_raw);
                 REPS(301) rt::ret_out_phase(WSP(bf16_t, WS_RQ), WSP(bf16_t, WS_RK), WSP(bf16_t, WS_RV), WSP(bf16_t, WS_RG), WSP(bf16_t, WS_KVS), p->in[11], WSP(bf16_t, WS_AO), (char*)lds_raw); }
    SEAM(3);
    if (IN(4)) REPS(4) {
        pg8::GridOrder S; S.init(WSP(bf16_t, WS_AO), 1024, WSP(bf16_t, WB_OUT), 1024, T_TOK, 1024, gridDim.x, blockIdx.x);
        fx::EpiResid E{p->in[0], p->out, WSP(bf16_t, WS_XB), rep ? dummyf : WSP(float, WS_SSQ1)};
        pg8::gemm_phase<fx::EpiResid, pg8::GridOrder>(lds, xl, 1024, 1024, 1024, S, E);
    }
    SEAM(4);
    if (IN(5)) REPS(5) {
        pg8::GridOrder S; S.init(WSP(bf16_t, WS_XB), 1024, WSP(bf16_t, WB_CQ), 1024, T_TOK, 1024, gridDim.x, blockIdx.x);
        fx::EpiHeadNorm E{WSP(bf16_t, WS_QC), WSP(float, WS_SSQ1), p->in[17], 1.f / 1024.f};
        pg8::gemm_phase<fx::EpiHeadNorm, pg8::GridOrder>(lds, xl, 1024, 1024, 1024, S, E);
    }
    SEAM(5);
    if (IN(6)) REPS(6) {
        fx::HeadOrder S{(int)gridDim.x, (int)blockIdx.x, 512, (const char*)WSP(bf16_t, WS_QC), (const char*)WSP(bf16_t, WS_KC), (size_t)256 * 1024 * 2, (size_t)256 * 2, (size_t)256 * 1024 * 2, (size_t)256 * 2};
        fx::EpiSoftmax E{WSP(bf16_t, WS_PC)};
        pg8::gemm_phase<fx::EpiSoftmax, fx::HeadOrder>(lds, xl, 1024, 1024, 256, S, E);
    }
    SEAM(6);
    if (IN(7)) REPS(7) {
        fx::HeadOrder S{(int)gridDim.x, (int)blockIdx.x, 512, (const char*)WSP(bf16_t, WS_PC), (const char*)WSP(bf16_t, WS_VC), (size_t)256 * 1024 * 2, (size_t)256 * 2, (size_t)1024 * 256 * 2, (size_t)256 * 256 * 2};
        fx::EpiStoreBf16 E{WSP(bf16_t, WS_OC), 1024, 0};
        pg8::gemm_phase<fx::EpiStoreBf16, fx::HeadOrder>(lds, xl, 1024, 256, 256, S, E);
    }
    SEAM(7);
    if (IN(8)) {
        pg8::GridOrder S; S.init(WSP(bf16_t, WS_OC), 1024, WSP(bf16_t, WB_CO), 1024, T_TOK, 1024, gridDim.x, blockIdx.x);
        fx::EpiResid E{p->out, p->out, WSP(bf16_t, WS_XB), WSP(float, WS_SSQ2)};
        pg8::gemm_phase<fx::EpiResid, pg8::GridOrder>(lds, xl, 1024, 1024, 1024, S, E);
    }
    SEAM(8);
    if (IN(9)) REPS(9) { router_phase(p, lds, wave, lane, rep ? WSP(int, 128 * 1024) : WSP(int, WS_CNT), rep ? WSP(int, WS_AO) : WSP(int, WS_LISTS), rep ? WSP(float, WS_AO + 8 * MiB) : WSP(float, WS_ROWW)); }
    SEAM(9);
    if (IN(10)) REPS(10) {
        fx::MoeOrder S{(int)gridDim.x, (int)blockIdx.x, 0, 64, 2, WSP(int, WS_CNT), WSP(int, WS_LISTS), (const char*)WSP(bf16_t, WS_XB), (const char*)WSP(bf16_t, WB_GU), 0, (size_t)512 * 1024 * 2, (size_t)256 * 1024 * 2};
        fx::EpiGlu E{WSP(bf16_t, WS_H), WSP(float, WS_SSQ2), WSP(float, WS_ROWW), WSP(int, WS_LISTS)};
        pg8::gemm_phase<fx::EpiGlu, fx::MoeOrder, true>(lds, xl, 1024, 1024, 1024, S, E);
    }
    SEAM(10);
    if (IN(11)) {
        fx::MoeOrder S{(int)gridDim.x, (int)blockIdx.x, 0, 32, 4, WSP(int, WS_CNT), WSP(int, WS_LISTS), (const char*)WSP(bf16_t, WS_H), (const char*)WSP(bf16_t, WB_D), (size_t)256 * 256 * 2, (size_t)1024 * 256 * 2, (size_t)256 * 256 * 2};
        fx::EpiScatterAdd E{p->out};
        pg8::gemm_phase<fx::EpiScatterAdd, fx::MoeOrder>(lds, xl, 256, 256, 256, S, E);
    }
    SEAM(11);
    if (IN(12)) {
        fx::MoeOrder S{(int)gridDim.x, (int)blockIdx.x, 32, 64, 4, WSP(int, WS_CNT), WSP(int, WS_LISTS), (const char*)WSP(bf16_t, WS_H), (const char*)WSP(bf16_t, WB_D), (size_t)256 * 256 * 2, (size_t)1024 * 256 * 2, (size_t)256 * 256 * 2};
        fx::EpiScatterAdd E{p->out};
        pg8::gemm_phase<fx::EpiScatterAdd, fx::MoeOrder>(lds, xl, 256, 256, 256, S, E);
    }
#undef REPS
#undef IN
#undef SEAM
}

extern "C" void kernel_launch(void* const* d_in, const int* in_sizes, int n_in, void* d_out, int out_size, void* d_ws, size_t ws_size, hipStream_t stream) {
    static int grid = 0;
    if (grid == 0) {
        if (n_in != 28 || out_size != T_TOK * 1024 || ws_size < WS_NEED) { fprintf(stderr, "kernel_launch: unexpected shapes n_in %d out %d ws %zu\n", n_in, out_size, ws_size); grid = -1; return; }
        int dev = 0, cus = 0, per_cu = 0;
        if (hipGetDevice(&dev) != hipSuccess || hipDeviceGetAttribute(&cus, hipDeviceAttributeMultiprocessorCount, dev) != hipSuccess) { grid = -1; return; }
        if (hipFuncSetAttribute((const void*)mk_fwd, hipFuncAttributeMaxDynamicSharedMemorySize, LDS_BYTES) != hipSuccess) { fprintf(stderr, "hipFuncSetAttribute failed\n"); grid = -1; return; }
        if (hipOccupancyMaxActiveBlocksPerMultiprocessor(&per_cu, (const void*)mk_fwd, NWAVES * 64, LDS_BYTES) != hipSuccess || per_cu < 1) { fprintf(stderr, "occupancy query failed (%d)\n", per_cu); grid = -1; return; }
        grid = cus;
        (void)hipGetLastError();
    }
    if (grid < 0) return;
    if (hipMemsetAsync(d_ws, 0, 65536, stream) != hipSuccess) { fprintf(stderr, "hipMemsetAsync failed\n"); return; }
    Params p; memset(&p, 0, sizeof(p));
    for (int i = 0; i < 28; ++i) p.in[i] = (const float*)d_in[i];
    p.out = (float*)d_out; p.ws = (unsigned char*)d_ws; p.ph_lo = 0; p.ph_hi = 13; p.coop = 1;
    void* args[] = {&p};
    hipError_t e = hipLaunchCooperativeKernel((const void*)mk_fwd, dim3(grid), dim3(NWAVES * 64), args, LDS_BYTES, stream);
    if (e != hipSuccess) fprintf(stderr, "cooperative launch failed: %s (grid %d)\n", hipGetErrorString(e), grid);
}
```

```cpp
#include <hip/hip_runtime.h>
#include <hip/hip_cooperative_groups.h>
#include <cstdint>
#include <cstdio>
#include <cmath>
#include <cstring>

typedef unsigned short bf16_t;
constexpr float EPS = 1e-6f;
constexpr int T_TOK = 32768;
__device__ __forceinline__ float bf2f(bf16_t h) { return __uint_as_float((unsigned)h << 16); }
__device__ __forceinline__ bf16_t f2bf(float f) { const unsigned u = __float_as_uint(f); return (bf16_t)((u + 0x7fffu + ((u >> 16) & 1u)) >> 16); }

constexpr size_t MiB = (size_t)1 << 20;
constexpr size_t WS_CTL = 0;
constexpr size_t WS_SSQ_CQ = 1 * MiB, WS_SSQ_CKV = WS_SSQ_CQ + 128 * 1024, WS_SSQ_KPE = WS_SSQ_CKV + 128 * 1024, WS_SSQ1 = WS_SSQ_KPE + 128 * 1024, WS_SSQ2 = WS_SSQ1 + 128 * 1024;
constexpr size_t WS_SEL = 2 * MiB, WS_WTS = WS_SEL + 256 * 1024;
constexpr size_t WS_RW = 4 * MiB;
constexpr size_t WS_CS = 5 * MiB;
constexpr size_t WS_MB = 21 * MiB, WS_KC = 25 * MiB, WS_VC = 29 * MiB;
constexpr size_t WS_WB = 33 * MiB;
constexpr size_t WS_RQ = 97 * MiB, WS_RK = 129 * MiB, WS_RV = 161 * MiB, WS_RG = 193 * MiB;
constexpr size_t WS_HB = 225 * MiB;
constexpr size_t WS_QM = 225 * MiB, WS_KM = 273 * MiB, WS_VM = 321 * MiB;
constexpr size_t WS_KVS = 353 * MiB;
constexpr size_t WS_AO = 385 * MiB;
constexpr size_t WS_CQ = 449 * MiB, WS_CKV = 465 * MiB;
constexpr size_t WS_PJ = 289 * MiB;
constexpr size_t WS_RAW = 353 * MiB;
constexpr size_t WS_XB = 97 * MiB;
constexpr size_t WS_QCR = 161 * MiB;
constexpr size_t WS_PC = 161 * MiB;
constexpr size_t WS_QC = 225 * MiB;
constexpr size_t WS_OC = 289 * MiB;
constexpr size_t WS_KVR = 353 * MiB;
constexpr size_t WS_BAR = 16 * 1024;
constexpr size_t WS_CNT = 64 * 1024;
constexpr size_t WS_LISTS = 353 * MiB, WS_ROWW = 361 * MiB;
constexpr size_t WS_Y0 = 225 * MiB;
constexpr size_t WS_H = 161 * MiB;
constexpr size_t WS_NEED = 481 * MiB;
#define LAS __attribute__((address_space(3)))
typedef short bf16x8 __attribute__((ext_vector_type(8)));
typedef float f32x4 __attribute__((ext_vector_type(4)));
typedef float f32x2 __attribute__((ext_vector_type(2)));
typedef unsigned u32x4 __attribute__((ext_vector_type(4)));
typedef unsigned u32x2 __attribute__((ext_vector_type(2)));

namespace pg8 {
constexpr int BM = 256, BK = 64, HALF = 128, HTB = HALF * BK * 2, STAGE_BYTES = 8 * HTB, NXCD = 8, WGM = 8;
__host__ __device__ __forceinline__ int lds_byte(int r, int c) { const int st = (r >> 4) * 2 + (c >> 5), rr = r & 15, cc = c & 31, ob = rr * 64 + cc * 2; return st * 1024 + (ob ^ (((ob >> 9) & 1) << 5)); }
__host__ __device__ __forceinline__ void stage_rc(int b, int& R, int& C) { const int st = b / 1024, sb = b % 1024, swz = sb ^ (((sb >> 9) & 1) << 5); R = (st >> 1) * 16 + swz / 64; C = (st & 1) * 32 + (swz % 64) / 2; }
__host__ __device__ __forceinline__ int perm32(int rho) { const int n = rho >> 4, i = rho & 15; return 8 * (i >> 2) + 4 * n + (i & 3); }
__device__ __forceinline__ unsigned cvt_pk_bf16(float lo, float hi) { unsigned r; asm volatile("v_cvt_pk_bf16_f32 %0, %1, %2" : "=v"(r) : "v"(lo), "v"(hi)); return r; }

struct Unit { int pm, pn; const char* a; const char* b; const int* rows; int nvalid, seg; };

struct GridOrder {
    int nM, nN, nwg, G, c; const char* A; const char* B; size_t strideA, strideB;
    __device__ void init(const bf16_t* A_, int lda, const bf16_t* B_, int ldb, int M, int N, int G_, int c_) {
        nM = M / BM; nN = N / BM; nwg = nM * nN; G = G_; c = c_; A = (const char*)A_; B = (const char*)B_; strideA = (size_t)BM * lda * 2; strideB = (size_t)BM * ldb * 2; }
    __device__ bool next(int i, Unit& u) const {
        const long L = (long)i * G + c; if (L >= nwg) return false;
        int wgid = (int)L; { const int q = nwg / NXCD, r = nwg % NXCD, xcd = wgid % NXCD, off = wgid / NXCD; wgid = (xcd < r ? xcd * (q + 1) : r * (q + 1) + (xcd - r) * q) + off; }
        const int nig = WGM * nN, gid = wgid / nig, fm = gid * WGM, gsz = (nM - fm) < WGM ? (nM - fm) : WGM;
        u.pm = fm + ((wgid % nig) % gsz); u.pn = (wgid % nig) / gsz; u.a = A + (size_t)u.pm * strideA; u.b = B + (size_t)u.pn * strideB; u.rows = nullptr; u.nvalid = 256; u.seg = 0; return true;
    }
};

#define XBAR() do { asm volatile("s_waitcnt lgkmcnt(0)" ::: "memory"); __builtin_amdgcn_s_barrier(); asm volatile("" ::: "memory"); } while (0)

__device__ __forceinline__ void row_allreduce_sum(float (&s)[2][4], int wr, int wc, int fr, int fq, LAS unsigned char* xl) {
    LAS float* P = (LAS float*)xl;
#pragma unroll
    for (int ai = 0; ai < 2; ++ai)
#pragma unroll
        for (int m = 0; m < 4; ++m) { float v = s[ai][m]; v += __shfl_xor(v, 16); v += __shfl_xor(v, 32); if (fq == 0) P[(ai * HALF + wr * 64 + m * 16 + fr) * 4 + wc] = v; }
    XBAR();
#pragma unroll
    for (int ai = 0; ai < 2; ++ai)
#pragma unroll
        for (int m = 0; m < 4; ++m) { const f32x4 p = *(const LAS f32x4*)(P + (ai * HALF + wr * 64 + m * 16 + fr) * 4); s[ai][m] = (p[0] + p[1]) + (p[2] + p[3]); }
    XBAR();
}
__device__ __forceinline__ void row_allreduce_max(float (&s)[2][4], int wr, int wc, int fr, int fq, LAS unsigned char* xl) {
    LAS float* P = (LAS float*)xl;
#pragma unroll
    for (int ai = 0; ai < 2; ++ai)
#pragma unroll
        for (int m = 0; m < 4; ++m) { float v = s[ai][m]; v = fmaxf(v, __shfl_xor(v, 16)); v = fmaxf(v, __shfl_xor(v, 32)); if (fq == 0) P[(ai * HALF + wr * 64 + m * 16 + fr) * 4 + wc] = v; }
    XBAR();
#pragma unroll
    for (int ai = 0; ai < 2; ++ai)
#pragma unroll
        for (int m = 0; m < 4; ++m) { const f32x4 p = *(const LAS f32x4*)(P + (ai * HALF + wr * 64 + m * 16 + fr) * 4); s[ai][m] = fmaxf(fmaxf(p[0], p[1]), fmaxf(p[2], p[3])); }
    XBAR();
}

template <class Epi, class Sched, bool GATHER = false>
__device__ __forceinline__ void gemm_phase(LAS unsigned char* lds, LAS unsigned char* xl, int lda, int ldb, int K, const Sched& S, const Epi& E) {
    const int tid = threadIdx.x, wid = __builtin_amdgcn_readfirstlane(tid >> 6), lane = tid & 63, wr = wid >> 2, wc = wid & 3, fr = lane & 15, fq = lane >> 4;
    asm volatile("" : "+s"(K));
    const int nt = K / BK;
    int sR[2], sC[2];
    unsigned voffA[2], voffB[2];
#pragma unroll
    for (int i = 0; i < 2; ++i) { int R, C; stage_rc(tid * 16 + i * 8192, R, C); const int Rb = Epi::PERM ? ((R & ~31) + perm32(R & 31)) : R; sR[i] = R; sC[i] = C;
        voffA[i] = (unsigned)(R * lda + C) * 2u; voffB[i] = (unsigned)(Rb * ldb + C) * 2u; }
    const size_t kstep = (size_t)(BK * 2);
    const size_t hstepA = (size_t)HALF * lda * 2, hstepB = (size_t)HALF * ldb * 2;
    const unsigned ldsw = (unsigned)wid * 1024u;
    const int aoff = lds_byte(wr * 64 + fr, fq * 8), boff = lds_byte(wc * 32 + fr, fq * 8);
#define PG8_SA(b, h) (((b) * 2 + (h)) * HTB)
#define PG8_SB(b, h) ((4 + (b) * 2 + (h)) * HTB)
#define PG8_STAGE(bufoff, gbase, voff) do { _Pragma("unroll") for (int _i = 0; _i < 2; ++_i) \
        __builtin_amdgcn_global_load_lds((const unsigned*)((const char*)(gbase) + (voff)[_i]), (LAS unsigned*)(lds + (bufoff) + ldsw + _i * 8192), 16, 0, 0); } while (0)
#define PG8_LDA(dst, b, h) do { _Pragma("unroll") for (int m = 0; m < 4; ++m) _Pragma("unroll") for (int k = 0; k < 2; ++k) dst[m][k] = *(const LAS bf16x8*)(lds + PG8_SA(b, h) + aoff + m * 2048 + k * 1024); } while (0)
#define PG8_LDB(dst, b, h) do { _Pragma("unroll") for (int n = 0; n < 2; ++n) _Pragma("unroll") for (int k = 0; k < 2; ++k) dst[n][k] = *(const LAS bf16x8*)(lds + PG8_SB(b, h) + boff + n * 2048 + k * 1024); } while (0)
#define PG8_MMA(ai, bj, At, Bt) do { __builtin_amdgcn_s_setprio(1); _Pragma("unroll") for (int m = 0; m < 4; ++m) _Pragma("unroll") for (int n = 0; n < 2; ++n) _Pragma("unroll") for (int k = 0; k < 2; ++k) \
        acc[ai][bj][m][n] = __builtin_amdgcn_mfma_f32_16x16x32_bf16(Bt[n][k], At[m][k], acc[ai][bj][m][n], 0, 0, 0); __builtin_amdgcn_s_setprio(0); } while (0)
#define PG8_WAIT_V(n) asm volatile("s_waitcnt vmcnt(" #n ")" ::: "memory")
#define PG8_WAIT_L(n) asm volatile("s_waitcnt lgkmcnt(" #n ")" ::: "memory")
#define PG8_BAR __builtin_amdgcn_s_barrier()
#define PG8_SCHED __builtin_amdgcn_sched_barrier(0)
    LAS unsigned char* gl = xl + 8192 + tid * 16;
    int gA0 = 0, gA1 = 8192;
#define PG8_GATH(T, u) do { u32x4 _o; { int _r[4]; _Pragma("unroll") for (int _q = 0; _q < 4; ++_q) { const int _rl = (_q >> 1) * HALF + sR[_q & 1]; _r[_q] = (_rl < (u).nvalid) ? (u).rows[_rl] : 0; } \
        _Pragma("unroll") for (int _q = 0; _q < 4; ++_q) _o[_q] = (unsigned)(_r[_q] * lda + sC[_q & 1]) * 2u; } *(LAS u32x4*)(gl + (T)) = _o; } while (0)
#define PG8_STAGE_A(bufoff, base, h, kbytes, T) do { if constexpr (GATHER) { const u32x2 _g = *(const LAS u32x2*)(gl + (T) + (h) * 8); PG8_STAGE(bufoff, (base) + (kbytes), _g); } else { PG8_STAGE(bufoff, (base) + (size_t)(h) * hstepA + (kbytes), voffA); } } while (0)
    Unit cur, nxt; int ui = 0;
    if (!S.next(0, cur)) return;
    f32x4 acc[2][2][4][2];
#pragma unroll
    for (int a = 0; a < 2; ++a)
#pragma unroll
        for (int b = 0; b < 2; ++b)
#pragma unroll
            for (int m = 0; m < 4; ++m)
#pragma unroll
                for (int n = 0; n < 2; ++n) acc[a][b][m][n] = (f32x4){0.f, 0.f, 0.f, 0.f};
    bf16x8 At[4][2], B0[2][2], B1[2][2];
    const char* cA = cur.a; const char* cB = cur.b;
    if constexpr (GATHER) { PG8_GATH(gA0, cur); }
    PG8_STAGE(PG8_SB(0, 0), cB, voffB); PG8_STAGE(PG8_SB(0, 1), cB + hstepB, voffB); PG8_STAGE_A(PG8_SA(0, 0), cA, 0, 0, gA0); PG8_STAGE_A(PG8_SA(0, 1), cA, 1, 0, gA0);
    if (wr == 1) PG8_BAR;
    PG8_WAIT_V(2); PG8_BAR;
    PG8_STAGE(PG8_SB(1, 0), cB + kstep, voffB); PG8_STAGE_A(PG8_SA(1, 0), cA, 0, kstep, gA0); PG8_STAGE(PG8_SB(1, 1), cB + hstepB + kstep, voffB);
    PG8_WAIT_V(6); PG8_BAR;
    for (;;) {
        const bool has_next = S.next(ui + 1, nxt);
        const char* nA = has_next ? nxt.a : cA; const char* nB = has_next ? nxt.b : cB;
        if constexpr (GATHER) { if (has_next) { PG8_GATH(gA1, nxt); } else { PG8_GATH(gA1, cur); } }
#pragma unroll 1
        for (int t = 0; t < nt; t += 2) {
            const bool last = (t == nt - 2);
            const size_t k1 = (size_t)(t + 1) * kstep;
            const char* a2 = last ? nA : cA; const char* b2 = last ? nB : cB + (size_t)(t + 2) * kstep;
            const size_t ka2 = last ? 0 : (size_t)(t + 2) * kstep;
            const char* b3 = b2 + kstep; const size_t ka3 = ka2 + kstep;
            PG8_LDB(B0, 0, 0); PG8_LDB(B1, 0, 1); PG8_SCHED; PG8_LDA(At, 0, 0); PG8_STAGE_A(PG8_SA(1, 1), cA, 1, k1, gA0);
            PG8_WAIT_V(8); PG8_WAIT_L(0); PG8_BAR; PG8_MMA(0, 0, At, B0); PG8_MMA(0, 1, At, B1); PG8_BAR; PG8_SCHED;
            PG8_LDA(At, 0, 1); PG8_STAGE(PG8_SB(0, 0), b2, voffB); PG8_STAGE(PG8_SB(0, 1), b2 + hstepB, voffB);
            if (last) { PG8_STAGE_A(PG8_SA(0, 0), a2, 0, ka2, gA1); } else { PG8_STAGE_A(PG8_SA(0, 0), a2, 0, ka2, gA0); }
            PG8_WAIT_V(8); PG8_WAIT_L(0); PG8_BAR; PG8_MMA(1, 0, At, B0); PG8_MMA(1, 1, At, B1); PG8_BAR; PG8_SCHED;
            PG8_LDB(B0, 1, 0); PG8_LDB(B1, 1, 1); PG8_SCHED; PG8_LDA(At, 1, 0);
            if (last) { PG8_STAGE_A(PG8_SA(0, 1), a2, 1, ka2, gA1); } else { PG8_STAGE_A(PG8_SA(0, 1), a2, 1, ka2, gA0); }
            PG8_WAIT_V(8); PG8_WAIT_L(0); PG8_BAR; PG8_MMA(0, 0, At, B0); PG8_MMA(0, 1, At, B1); PG8_BAR; PG8_SCHED;
            PG8_LDA(At, 1, 1); PG8_STAGE(PG8_SB(1, 0), b3, voffB); PG8_STAGE(PG8_SB(1, 1), b3 + hstepB, voffB);
            if (last) { PG8_STAGE_A(PG8_SA(1, 0), a2, 0, ka3, gA1); } else { PG8_STAGE_A(PG8_SA(1, 0), a2, 0, ka3, gA0); }
            PG8_WAIT_V(8); PG8_WAIT_L(0); PG8_BAR; PG8_MMA(1, 0, At, B0); PG8_MMA(1, 1, At, B1); PG8_BAR; PG8_SCHED;
        }
        if (wr == 0) PG8_BAR;
        E(acc, cur, wr, wc, fr, fq, xl);
        if (!has_next) break;
#pragma unroll
        for (int a = 0; a < 2; ++a)
#pragma unroll
            for (int b = 0; b < 2; ++b)
#pragma unroll
                for (int m = 0; m < 4; ++m)
#pragma unroll
                    for (int n = 0; n < 2; ++n) acc[a][b][m][n] = (f32x4){0.f, 0.f, 0.f, 0.f};
        cur = nxt; cA = nA; cB = nB; ++ui;
        if constexpr (GATHER) { const int _t = gA0; gA0 = gA1; gA1 = _t; }
        if (wr == 1) PG8_BAR;
    }
    PG8_WAIT_V(0);
    PG8_BAR;
#undef PG8_SA
#undef PG8_SB
#undef PG8_STAGE
#undef PG8_STAGE_A
#undef PG8_GATH
#undef PG8_LDA
#undef PG8_LDB
#undef PG8_MMA
#undef PG8_WAIT_V
#undef PG8_WAIT_L
#undef PG8_BAR
#undef PG8_SCHED
}
}
namespace fx {
using pg8::Unit; using pg8::cvt_pk_bf16;
constexpr int HALF = 128;
__device__ __forceinline__ u32x4 pack8(const f32x4 a, const f32x4 b) { u32x4 w; w.x = cvt_pk_bf16(a[0], a[1]); w.y = cvt_pk_bf16(a[2], a[3]); w.z = cvt_pk_bf16(b[0], b[1]); w.w = cvt_pk_bf16(b[2], b[3]); return w; }
__device__ __forceinline__ u32x2 pack4(const f32x4 a) { u32x2 w; w.x = cvt_pk_bf16(a[0], a[1]); w.y = cvt_pk_bf16(a[2], a[3]); return w; }
__device__ __forceinline__ float sq4(const f32x4 a) { return (a[0] * a[0] + a[1] * a[1]) + (a[2] * a[2] + a[3] * a[3]); }
__device__ __forceinline__ float quad_sum(float v) { v += __shfl_xor(v, 16); v += __shfl_xor(v, 32); return v; }
__device__ __forceinline__ float gamma_log2(int h) { return __log2f(1.f - exp2f(-5.f - (float)h)); }
__device__ __forceinline__ void rope4(f32x4& a, f32x4& b, const f32x4 cs0, const f32x4 cs1) {
    const f32x4 c = {cs0[0], cs0[2], cs1[0], cs1[2]}, s = {cs0[1], cs0[3], cs1[1], cs1[3]};
    const f32x4 ra = a * c - b * s, rb = b * c + a * s; a = ra; b = rb;
}

struct EpiInProj {
    static constexpr bool PERM = false;
    bf16_t *CQ, *CKV, *RQ, *RK, *RV, *RG; float *ssq_cq, *ssq_ckv, *ssq_kpe; const float* cs  ; const float* kg  ;
    __device__ __forceinline__ void operator()(f32x4 (&acc)[2][2][4][2], const Unit& u, int wr, int wc, int fr, int fq, LAS unsigned char*) const {
        asm volatile("" : "+v"(fr), "+v"(fq));
        const int row0 = u.pm * 256 + wr * 64 + fr, pn = u.pn;
        if (pn == 0) {
#pragma unroll
            for (int ai = 0; ai < 2; ++ai)
#pragma unroll
                for (int m = 0; m < 4; ++m) { const int row = row0 + ai * HALF + m * 16; float s = 0.f;
#pragma unroll
                    for (int bj = 0; bj < 2; ++bj) { s += sq4(acc[ai][bj][m][0]) + sq4(acc[ai][bj][m][1]);
                        *(u32x4*)(CQ + (size_t)row * 256 + bj * HALF + wc * 32 + 8 * fq) = pack8(acc[ai][bj][m][0], acc[ai][bj][m][1]); }
                    s = quad_sum(s); if (fq == 0) atomicAdd(ssq_cq + row, s); }
        } else if (pn == 1) {
            const int i0 = 16 * wc + 4 * fq;
            f32x4 g0 = {0.f, 0.f, 0.f, 0.f}, g1 = g0;
            if (wc < 2) { g0 = *(const f32x4*)(kg + 128 + i0); g1 = *(const f32x4*)(kg + 160 + i0); }
#pragma unroll
            for (int ai = 0; ai < 2; ++ai)
#pragma unroll
                for (int m = 0; m < 4; ++m) { const int row = row0 + ai * HALF + m * 16;
                    float s0 = sq4(acc[ai][0][m][0]) + sq4(acc[ai][0][m][1]), s1 = sq4(acc[ai][1][m][0]) + sq4(acc[ai][1][m][1]);
                    *(u32x4*)(CKV + (size_t)row * 256 + wc * 32 + 8 * fq) = pack8(acc[ai][0][m][0], acc[ai][0][m][1]);
                    s0 = quad_sum(s0); s1 = quad_sum(s1);
                    if (fq == 0) { atomicAdd(ssq_ckv + row, s0); if (wc < 2) atomicAdd(ssq_kpe + row, s1); }
                    if (wc < 2) {
                        f32x4 a = acc[ai][1][m][0] * g0, b = acc[ai][1][m][1] * g1;
                        const float* cp = cs + ((size_t)row * 64 + 2 * i0) * 2;
                        const f32x4 c0 = *(const f32x4*)(cp), c1 = *(const f32x4*)(cp + 4), c2 = *(const f32x4*)(cp + 8), c3 = *(const f32x4*)(cp + 12);
                        const f32x4 cc = {c0[0], c1[0], c2[0], c3[0]}, ss = {c0[1], c1[1], c2[1], c3[1]};
                        const f32x4 ra = a * cc - b * ss, rb = b * cc + a * ss;
                        *(u32x2*)(CKV + (size_t)row * 256 + 128 + i0) = pack4(ra); *(u32x2*)(CKV + (size_t)row * 256 + 160 + i0) = pack4(rb);
                    } else {
                        *(u32x4*)(CKV + (size_t)row * 256 + 192 + (wc - 2) * 32 + 8 * fq) = (u32x4){0u, 0u, 0u, 0u};
                    }
                    asm volatile("" ::: "memory"); __builtin_amdgcn_sched_barrier(0); }
        } else if (pn < 6) {
            bf16_t* O = (pn < 4) ? RQ : RK; const float sc = (pn < 4) ? 1.f : 0.08838834764831845f;
            const int i0 = 16 * wc + 4 * fq;
            const float sgn = (pn < 4) ? 1.f : -1.f; const float lgh[2] = {sgn * gamma_log2((pn & 1) * 2), sgn * gamma_log2((pn & 1) * 2 + 1)};
#pragma unroll
            for (int ai = 0; ai < 2; ++ai)
#pragma unroll
                for (int m = 0; m < 4; ++m) { const int row = row0 + ai * HALF + m * 16;
                    const float* cp = cs + ((size_t)row * 64 + i0) * 2;
                    const f32x4 c0 = *(const f32x4*)(cp), c1 = *(const f32x4*)(cp + 4);
#pragma unroll
                    for (int bj = 0; bj < 2; ++bj) { f32x4 a = acc[ai][bj][m][0], b = acc[ai][bj][m][1]; rope4(a, b, c0, c1); const float dc = sc * exp2f((float)(row & 127) * lgh[bj]); a = a * dc; b = b * dc;
                        bf16_t* o = O + (size_t)row * 512 + ((pn & 1) * 2 + bj) * 128 + i0;
                        *(u32x2*)(o) = pack4(a); *(u32x2*)(o + 64) = pack4(b); }
                    asm volatile("" ::: "memory"); __builtin_amdgcn_sched_barrier(0); }
        } else {
            bf16_t* O = (pn < 8) ? RV : RG;
#pragma unroll
            for (int ai = 0; ai < 2; ++ai)
#pragma unroll
                for (int m = 0; m < 4; ++m) { const int row = row0 + ai * HALF + m * 16;
#pragma unroll
                    for (int bj = 0; bj < 2; ++bj) *(u32x4*)(O + (size_t)row * 512 + (pn & 1) * 256 + bj * HALF + wc * 32 + 8 * fq) = pack8(acc[ai][bj][m][0], acc[ai][bj][m][1]); }
        }
    }
};
__device__ __forceinline__ int inproj_src(int n) {
    const int pn = n >> 8, p = n & 255;
    const int plain = (p & ~31) + pg8::perm32(p & 31);
    if (pn == 0) return plain;
    if (pn == 1) { if (p < 128) return 256 + plain; const int q = p - 128, wc = q >> 5; if (wc >= 2) return -1; return 384 + 32 * ((q >> 4) & 1) + 16 * wc + (q & 15); }
    if (pn < 6) { const int bj = p >> 7, q = p & 127, wc = q >> 5, nn = (q >> 4) & 1; const int d = 64 * nn + 16 * wc + (q & 15); return (pn < 4 ? 448 : 960) + ((pn & 1) * 2 + bj) * 128 + d; }
    return (pn < 8 ? 1472 : 1984) + (pn & 1) * 256 + plain;
}

struct EpiMlaQ {
    static constexpr bool PERM = false;
    bf16_t* QM; const float* ssq_cq; const float* qg; const float* cs;
    __device__ __forceinline__ void operator()(f32x4 (&acc)[2][2][4][2], const Unit& u, int wr, int wc, int fr, int fq, LAS unsigned char* xl) const {
        asm volatile("" : "+v"(fr), "+v"(fq));
        const int row0 = u.pm * 256 + wr * 64 + fr, h = u.pn;
        float s[2][4], rsr[2][4];
#pragma unroll
        for (int ai = 0; ai < 2; ++ai)
#pragma unroll
            for (int m = 0; m < 4; ++m) { const int row = row0 + ai * HALF + m * 16; rsr[ai][m] = rsqrtf(ssq_cq[row] * (1.f / 256.f) + EPS);
                s[ai][m] = (sq4(acc[ai][0][m][0]) + sq4(acc[ai][0][m][1]) + sq4(acc[ai][1][m][0]) + sq4(acc[ai][1][m][1])) * rsr[ai][m] * rsr[ai][m]; }
        pg8::row_allreduce_sum(s, wr, wc, fr, fq, xl);
        const int c0 = 32 * wc + 8 * fq, i0 = 16 * wc + 4 * fq;
        const f32x4 gA = *(const f32x4*)(qg + c0), gB = *(const f32x4*)(qg + c0 + 4);
        f32x4 g0 = {0.f, 0.f, 0.f, 0.f}, g1 = g0;
        if (wc < 2) { g0 = *(const f32x4*)(qg + 128 + i0); g1 = *(const f32x4*)(qg + 160 + i0); }
#pragma unroll
        for (int ai = 0; ai < 2; ++ai)
#pragma unroll
            for (int m = 0; m < 4; ++m) { const int row = row0 + ai * HALF + m * 16; const float rq = rsqrtf(s[ai][m] * (1.f / 192.f) + EPS) * rsr[ai][m];
                bf16_t* o = QM + (size_t)row * 768 + h * 192;
                *(u32x4*)(o + c0) = pack8(acc[ai][0][m][0] * rq * gA, acc[ai][0][m][1] * rq * gB);
                if (wc < 2) {
                    const f32x4 a = acc[ai][1][m][0] * rq * g0, b = acc[ai][1][m][1] * rq * g1;
                    const float* cp = cs + ((size_t)row * 64 + 2 * i0) * 2;
                    const f32x4 c0v = *(const f32x4*)(cp), c1v = *(const f32x4*)(cp + 4), c2v = *(const f32x4*)(cp + 8), c3v = *(const f32x4*)(cp + 12);
                    const f32x4 cc = {c0v[0], c1v[0], c2v[0], c3v[0]}, ss = {c0v[1], c1v[1], c2v[1], c3v[1]};
                    *(u32x2*)(o + 128 + i0) = pack4(a * cc - b * ss); *(u32x2*)(o + 160 + i0) = pack4(b * cc + a * ss);
                }
                asm volatile("" ::: "memory"); __builtin_amdgcn_sched_barrier(0); }
    }
};
__device__ __forceinline__ int mlaq_src(int n) {
    const int h = n >> 8, p = n & 255;
    if (p < 128) return h * 192 + (p & ~31) + pg8::perm32(p & 31);
    const int q = p - 128, wc = q >> 5; if (wc >= 2) return -1;
    return h * 192 + 128 + 32 * ((q >> 4) & 1) + 16 * wc + (q & 15);
}
struct EpiMlaKV {
    static constexpr bool PERM = false;
    bf16_t *KM, *VM; const bf16_t* CKV; const float *ssq_ckv, *ssq_kpe, *kg;
    __device__ __forceinline__ void operator()(f32x4 (&acc)[2][2][4][2], const Unit& u, int wr, int wc, int fr, int fq, LAS unsigned char* xl) const {
        asm volatile("" : "+v"(fr), "+v"(fq));
        const int row0 = u.pm * 256 + wr * 64 + fr, h = u.pn;
        float s[2][4], rsr[2][4];
#pragma unroll
        for (int ai = 0; ai < 2; ++ai)
#pragma unroll
            for (int m = 0; m < 4; ++m) { const int row = row0 + ai * HALF + m * 16; rsr[ai][m] = rsqrtf(ssq_ckv[row] * (1.f / 128.f) + EPS);
                s[ai][m] = (sq4(acc[ai][0][m][0]) + sq4(acc[ai][0][m][1])) * rsr[ai][m] * rsr[ai][m]; }
        pg8::row_allreduce_sum(s, wr, wc, fr, fq, xl);
        const int c0 = 32 * wc + 8 * fq, i0 = 16 * wc + 4 * fq;
        const f32x4 gA = *(const f32x4*)(kg + c0), gB = *(const f32x4*)(kg + c0 + 4);
#pragma unroll
        for (int ai = 0; ai < 2; ++ai)
#pragma unroll
            for (int m = 0; m < 4; ++m) { const int row = row0 + ai * HALF + m * 16; const float rk = rsqrtf((s[ai][m] + ssq_kpe[row]) * (1.f / 192.f) + EPS), rr = rsr[ai][m];
                bf16_t* ko = KM + (size_t)row * 768 + h * 192;
                *(u32x4*)(ko + c0) = pack8(acc[ai][0][m][0] * (rr * rk) * gA, acc[ai][0][m][1] * (rr * rk) * gB);
                *(u32x4*)(VM + (size_t)row * 512 + h * 128 + c0) = pack8(acc[ai][1][m][0] * rr, acc[ai][1][m][1] * rr);
                const u32x2 kp = *(const u32x2*)(CKV + (size_t)row * 256 + 128 + i0);
                const f32x4 kf = {__uint_as_float(kp.x << 16), __uint_as_float(kp.x & 0xffff0000u), __uint_as_float(kp.y << 16), __uint_as_float(kp.y & 0xffff0000u)};
                *(u32x2*)(ko + 128 + i0) = pack4(kf * rk); asm volatile("" ::: "memory"); __builtin_amdgcn_sched_barrier(0); }
    }
};
template <bool BASE_BF16, bool WRITE_F32>
struct EpiResid {
    static constexpr bool PERM = false;
    const float* base; float* out; bf16_t* xb; float* ssq;
    __device__ __forceinline__ void operator()(f32x4 (&acc)[2][2][4][2], const Unit& u, int wr, int wc, int fr, int fq, LAS unsigned char*) const {
        asm volatile("" : "+v"(fr), "+v"(fq));
        if (ssq == nullptr) { asm volatile("" :: "v"(acc[0][0][0][0]), "v"(acc[1][1][3][1])); return; }
        const int row0 = u.pm * 256 + wr * 64 + fr, col0 = u.pn * 256 + wc * 32 + 4 * fq;
#pragma unroll
        for (int ai = 0; ai < 2; ++ai)
#pragma unroll
            for (int m = 0; m < 4; ++m) { const int row = row0 + ai * HALF + m * 16; float s = 0.f;
#pragma unroll
                for (int bj = 0; bj < 2; ++bj)
#pragma unroll
                    for (int n = 0; n < 2; ++n) { const size_t off = (size_t)row * 1024 + col0 + bj * HALF + n * 16;
                        f32x4 bs;
                        if constexpr (BASE_BF16) { const u32x2 w = *(const u32x2*)(xb + off); bs = (f32x4){__uint_as_float(w.x << 16), __uint_as_float(w.x & 0xffff0000u), __uint_as_float(w.y << 16), __uint_as_float(w.y & 0xffff0000u)}; }
                        else bs = *(const f32x4*)(base + off);
                        const f32x4 o = bs + acc[ai][bj][m][n]; if constexpr (WRITE_F32) *(f32x4*)(out + off) = o; *(u32x2*)(xb + off) = pack4(o); s += sq4(o); }
                s = quad_sum(s); if (fq == 0) atomicAdd(ssq + row, s); }
    }
};
struct EpiHeadNorm {
    static constexpr bool PERM = false;
    bf16_t* O; const float* ssq_in  ; const float* g  ; float inv_n_in;
    __device__ __forceinline__ void operator()(f32x4 (&acc)[2][2][4][2], const Unit& u, int wr, int wc, int fr, int fq, LAS unsigned char* xl) const {
        asm volatile("" : "+v"(fr), "+v"(fq));
        const int row0 = u.pm * 256 + wr * 64 + fr, h = u.pn;
        float s[2][4], rsr[2][4];
#pragma unroll
        for (int ai = 0; ai < 2; ++ai)
#pragma unroll
            for (int m = 0; m < 4; ++m) { const int row = row0 + ai * HALF + m * 16; rsr[ai][m] = ssq_in ? rsqrtf(ssq_in[row] * inv_n_in + EPS) : 1.f;
                s[ai][m] = (sq4(acc[ai][0][m][0]) + sq4(acc[ai][0][m][1]) + sq4(acc[ai][1][m][0]) + sq4(acc[ai][1][m][1])) * rsr[ai][m] * rsr[ai][m]; }
        pg8::row_allreduce_sum(s, wr, wc, fr, fq, xl);
        const int c0 = 32 * wc + 8 * fq;
        f32x4 gv[2][2];
#pragma unroll
        for (int bj = 0; bj < 2; ++bj) { gv[bj][0] = *(const f32x4*)(g + bj * HALF + c0); gv[bj][1] = *(const f32x4*)(g + bj * HALF + c0 + 4); }
#pragma unroll
        for (int ai = 0; ai < 2; ++ai)
#pragma unroll
            for (int m = 0; m < 4; ++m) { const int row = row0 + ai * HALF + m * 16; const float rq = rsqrtf(s[ai][m] * (1.f / 256.f) + EPS) * rsr[ai][m];
#pragma unroll
                for (int bj = 0; bj < 2; ++bj) *(u32x4*)(O + (size_t)row * 1024 + h * 256 + bj * HALF + c0) = pack8(acc[ai][bj][m][0] * rq * gv[bj][0], acc[ai][bj][m][1] * rq * gv[bj][1]); }
    }
};
struct EpiStoreT {
    static constexpr bool PERM = true;
    bf16_t* O; int ldc; int tile_stride; float scale; int pad;
    __device__ __forceinline__ void operator()(f32x4 (&acc)[2][2][4][2], const Unit& u, int wr, int wc, int fr, int fq, LAS unsigned char*) const {
        asm volatile("" : "+v"(fr), "+v"(fq));
        const int row0 = u.pm * 256 + wr * 64 + fr;
#pragma unroll
        for (int ai = 0; ai < 2; ++ai)
#pragma unroll
            for (int m = 0; m < 4; ++m) { const int row = row0 + ai * HALF + m * 16;
#pragma unroll
                for (int bj = 0; bj < 2; ++bj) *(u32x4*)(O + (size_t)u.pn * tile_stride + (size_t)row * ldc + bj * HALF + wc * 32 + 8 * fq) = pack8(acc[ai][bj][m][0] * scale, acc[ai][bj][m][1] * scale); }
    }
};
struct EpiSoftmax {
    static constexpr bool PERM = true;
    bf16_t* PC;
    __device__ __forceinline__ void operator()(f32x4 (&acc)[2][2][4][2], const Unit& u, int wr, int wc, int fr, int fq, LAS unsigned char* xl) const {
        asm volatile("" : "+v"(fr), "+v"(fq));
        const int row0 = u.pm * 256 + wr * 64 + fr, h = u.pn;
        float mx[2][4], sm[2][4];
#pragma unroll
        for (int ai = 0; ai < 2; ++ai)
#pragma unroll
            for (int m = 0; m < 4; ++m) { float v = -3.0e38f;
#pragma unroll
                for (int bj = 0; bj < 2; ++bj)
#pragma unroll
                    for (int n = 0; n < 2; ++n) { const f32x4 a = acc[ai][bj][m][n]; v = fmaxf(v, fmaxf(fmaxf(a[0], a[1]), fmaxf(a[2], a[3]))); }
                mx[ai][m] = v; }
        pg8::row_allreduce_max(mx, wr, wc, fr, fq, xl);
        const float c2 = 0.0625f * 1.4426950408889634f;
#pragma unroll
        for (int ai = 0; ai < 2; ++ai)
#pragma unroll
            for (int m = 0; m < 4; ++m) { float t = 0.f; const float mm = mx[ai][m] * c2;
#pragma unroll
                for (int bj = 0; bj < 2; ++bj)
#pragma unroll
                    for (int n = 0; n < 2; ++n) { f32x4 a = acc[ai][bj][m][n] * c2 - mm;
                        a[0] = __builtin_amdgcn_exp2f(a[0]); a[1] = __builtin_amdgcn_exp2f(a[1]); a[2] = __builtin_amdgcn_exp2f(a[2]); a[3] = __builtin_amdgcn_exp2f(a[3]);
                        acc[ai][bj][m][n] = a; t += (a[0] + a[1]) + (a[2] + a[3]); }
                sm[ai][m] = t; }
        pg8::row_allreduce_sum(sm, wr, wc, fr, fq, xl);
#pragma unroll
        for (int ai = 0; ai < 2; ++ai)
#pragma unroll
            for (int m = 0; m < 4; ++m) { const int row = row0 + ai * HALF + m * 16; const float il = 1.f / sm[ai][m];
#pragma unroll
                for (int bj = 0; bj < 2; ++bj) *(u32x4*)(PC + (size_t)row * 1024 + h * 256 + bj * HALF + wc * 32 + 8 * fq) = pack8(acc[ai][bj][m][0] * il, acc[ai][bj][m][1] * il); }
    }
};
struct EpiStoreBf16 {
    static constexpr bool PERM = true;
    bf16_t* O; int ldc; int pad;
    __device__ __forceinline__ void operator()(f32x4 (&acc)[2][2][4][2], const Unit& u, int wr, int wc, int fr, int fq, LAS unsigned char*) const {
        asm volatile("" : "+v"(fr), "+v"(fq));
        const int row0 = u.pm * 256 + wr * 64 + fr;
#pragma unroll
        for (int ai = 0; ai < 2; ++ai)
#pragma unroll
            for (int m = 0; m < 4; ++m) { const int row = row0 + ai * HALF + m * 16;
#pragma unroll
                for (int bj = 0; bj < 2; ++bj) *(u32x4*)(O + (size_t)row * ldc + u.pn * 256 + bj * HALF + wc * 32 + 8 * fq) = pack8(acc[ai][bj][m][0], acc[ai][bj][m][1]); }
    }
};
struct HeadOrder {
    int G, c, nunits; const char* A; const char* B; size_t strideA, a_h, b_b, b_h;
    __device__ bool next(int i, Unit& u) const {
        const long L = (long)i * G + c; if (L >= nunits) return false;
        u.pm = (int)(L >> 2); u.pn = (int)(L & 3); const int b = u.pm >> 4;
        u.a = A + (size_t)u.pm * strideA + (size_t)u.pn * a_h; u.b = B + (size_t)b * b_b + (size_t)u.pn * b_h; u.rows = nullptr; u.nvalid = 256; u.seg = 0; return true;
    }
};
constexpr int MOE_CAP = 32768;
struct MoeOrder {
    int G, c, seg_lo, seg_hi, ntn; const int* cnt; const int* lists; const char* A; const char* B; size_t a_tile  , b_exp  , b_tile  ;
    __device__ bool next(int i, Unit& u) const {
        int ntl = 0, gbase = 0;
        for (int sgm = 0; sgm < seg_lo; ++sgm) gbase += (__hip_atomic_load(cnt + sgm, __ATOMIC_RELAXED, __HIP_MEMORY_SCOPE_AGENT) + 255) >> 8;
        for (int sgm = seg_lo; sgm < seg_hi; ++sgm) ntl += (__hip_atomic_load(cnt + sgm, __ATOMIC_RELAXED, __HIP_MEMORY_SCOPE_AGENT) + 255) >> 8;
        int rt, pn;
        if ((G & 7) == 0) { const int per = (ntl + 7) >> 3, xcd = c & 7, uu = (c >> 3) + (G >> 3) * i; const int rl_ = uu / ntn; if (rl_ >= per) return false; rt = xcd * per + rl_; pn = uu % ntn; }
        else { const long L = (long)i * G + c; rt = (int)(L / ntn); pn = (int)(L % ntn); }
        int base = 0;
        for (int sgm = seg_lo; sgm < seg_hi; ++sgm) { const int n = __hip_atomic_load(cnt + sgm, __ATOMIC_RELAXED, __HIP_MEMORY_SCOPE_AGENT), nt = (n + 255) >> 8;
            if (rt < base + nt) { const int j = rt - base; u.pm = gbase + rt; u.pn = pn; u.seg = sgm; u.nvalid = (n - j * 256) < 256 ? (n - j * 256) : 256; u.rows = lists + (size_t)sgm * MOE_CAP + j * 256;
                u.a = A + (size_t)u.pm * a_tile; u.b = B + (size_t)(sgm & 31) * b_exp + (size_t)pn * b_tile; return true; }
            base += nt; }
        return false;
    }
};
struct EpiGlu {
    static constexpr bool PERM = false;
    bf16_t* H; const float* ssq2; const float* roww; const int* lists0;
    __device__ __forceinline__ void operator()(f32x4 (&acc)[2][2][4][2], const Unit& u, int wr, int wc, int fr, int fq, LAS unsigned char*) const {
        asm volatile("" : "+v"(fr), "+v"(fq));
#pragma unroll
        for (int ai = 0; ai < 2; ++ai)
#pragma unroll
            for (int m = 0; m < 4; ++m) { const int rl = ai * HALF + wr * 64 + m * 16 + fr; const bool valid = rl < u.nvalid;
                const int tok = valid ? u.rows[rl] : 0;
                const float wgt = valid ? *(roww + ((u.rows + rl) - lists0)) : 0.f;
                const float rs = rsqrtf(ssq2[tok] * (1.f / 1024.f) + EPS);
                f32x4 hv[2];
#pragma unroll
                for (int n = 0; n < 2; ++n) { const f32x4 a = acc[ai][0][m][n] * rs, uu = acc[ai][1][m][n] * rs; f32x4 r;
#pragma unroll
                    for (int j = 0; j < 4; ++j) r[j] = a[j] / (1.f + __expf(-a[j])) * uu[j] * wgt;
                    hv[n] = r; }
                *(u32x4*)(H + ((size_t)u.pm * 256 + rl) * 256 + u.pn * 128 + wc * 32 + 8 * fq) = pack8(hv[0], hv[1]); }
    }
};
template <int SLOT>
struct EpiScatter {
    static constexpr bool PERM = false;
    float* out; bf16_t* y0;
    __device__ __forceinline__ void operator()(f32x4 (&acc)[2][2][4][2], const Unit& u, int wr, int wc, int fr, int fq, LAS unsigned char*) const {
        asm volatile("" : "+v"(fr), "+v"(fq));
        const int col0 = u.pn * 256 + wc * 32 + 4 * fq;
#pragma unroll
        for (int ai = 0; ai < 2; ++ai)
#pragma unroll
            for (int m = 0; m < 4; ++m) { const int rl = ai * HALF + wr * 64 + m * 16 + fr;
                if (rl < u.nvalid) { const int tok = u.rows[rl]; const size_t o = (size_t)tok * 1024 + col0;
#pragma unroll
                    for (int bj = 0; bj < 2; ++bj)
#pragma unroll
                        for (int n = 0; n < 2; ++n) { const size_t oo = o + bj * HALF + n * 16;
                            if constexpr (SLOT == 0) { *(u32x2*)(y0 + oo) = pack4(acc[ai][bj][m][n]); }
                            else { const u32x2 w = *(const u32x2*)(y0 + oo); const f32x4 yv = {__uint_as_float(w.x << 16), __uint_as_float(w.x & 0xffff0000u), __uint_as_float(w.y << 16), __uint_as_float(w.y & 0xffff0000u)};
                                   f32x4* q = (f32x4*)(out + oo); *q = (*q + yv) + acc[ai][bj][m][n]; } } } }
    }
};
struct MemKVOrder {
    int G, c; const char* MB; const char* W;
    __device__ bool next(int i, Unit& u) const {
        const long L = (long)i * G + c; if (L >= 64) return false;
        const int r = (int)L & 31; u.rows = nullptr; u.nvalid = 256;
        if (L < 32) { u.seg = 0; u.pm = r >> 2; u.pn = r & 3; u.a = MB + (size_t)u.pm * 256 * 2048; u.b = W + (size_t)u.pn * 256 * 2048; }
        else { u.seg = 1; u.pm = r >> 3; u.pn = r & 7; u.a = W + (size_t)(1024 + u.pm * 256) * 2048; u.b = MB + (size_t)u.pn * 256 * 2048; }
        return true;
    }
};
struct EpiMemKV {
    static constexpr bool PERM = false;
    bf16_t* KC; bf16_t* VCT; const float* g;
    __device__ __forceinline__ void operator()(f32x4 (&acc)[2][2][4][2], const Unit& u, int wr, int wc, int fr, int fq, LAS unsigned char* xl) const {
        if (u.seg == 0) { EpiHeadNorm e{KC, nullptr, g, 0.f}; e(acc, u, wr, wc, fr, fq, xl); return; }
        asm volatile("" : "+v"(fr), "+v"(fq));
        const int row0 = u.pm * 256 + wr * 64 + fr;
#pragma unroll
        for (int ai = 0; ai < 2; ++ai)
#pragma unroll
            for (int m = 0; m < 4; ++m) { const int row = row0 + ai * HALF + m * 16;
#pragma unroll
                for (int bj = 0; bj < 2; ++bj)
#pragma unroll
                    for (int n = 0; n < 2; ++n) *(u32x2*)(VCT + (size_t)u.pn * 1024 * 256 + (size_t)row * 256 + bj * HALF + wc * 32 + n * 16 + 4 * fq) = pack4(acc[ai][bj][m][n]); }
    }
};
}
namespace at {
typedef float f32x16 __attribute__((ext_vector_type(16)));
typedef short s16x4 __attribute__((ext_vector_type(4)));
constexpr int NW = 8, QBLK = 32, KVBLK = 64, QB = 256;
constexpr int KROW = 400;
constexpr int SHM_V = KVBLK * 128 * 2, SHM_K = KVBLK * KROW;
constexpr int LDS_V = 0, LDS_K = 2 * SHM_V, LDS_WS = LDS_K + 2 * SHM_K, LDS_BYTES = LDS_WS + NW * 64 * 4;
constexpr float SCALE = 0.07216878364870322f;
constexpr float THR = 8.f;
#define SBAR() __builtin_amdgcn_sched_barrier(0)
__device__ __forceinline__ int v_st(int k, int c) { const int kk = (k & ~0xC) | ((k & 4) << 1) | ((k & 8) >> 1); return ((kk >> 3) * 4 + (c >> 5)) * 512 + ((kk & 7) * 32 + (c & 31)) * 2; }
__device__ __forceinline__ int v_rd_base(int lane) { return ((lane & 3) << 3) | (((lane >> 2) & 3) << 6) | (((lane >> 4) & 1) << 5) | (((lane >> 5) & 1) << 8); }
constexpr int v_rd_off(int d0, int ks, int half) { return d0 * 512 + ks * 4096 + half * 2048; }
__device__ __forceinline__ int crow(int r, int hi) { return (r & 3) + 8 * (r >> 2) + 4 * hi; }
__device__ __forceinline__ unsigned cvtpk(float lo, float hi) { unsigned r; asm volatile("v_cvt_pk_bf16_f32 %0, %1, %2" : "=v"(r) : "v"(lo), "v"(hi)); return r; }
__device__ __forceinline__ void mask_tile(f32x16& p0, f32x16& p1, int dq) {
    const float NEG = -__builtin_inff();
#pragma unroll
    for (int r = 0; r < 16; ++r) {
        const int c = (r & 3) + 8 * (r >> 2);
        if (dq - c < 0) p0[r] = NEG;
        if (dq - c - 32 < 0) p1[r] = NEG;
    }
}
__device__ __forceinline__ void partialSM(f32x16& p0, f32x16& p1, float& m_reg, float& mn, float& alpha) {
    float pmax = p0[0];
#pragma unroll
    for (int r = 1; r < 16; ++r) pmax = fmaxf(pmax, p0[r]);
#pragma unroll
    for (int r = 0; r < 16; ++r) pmax = fmaxf(pmax, p1[r]);
    { auto rr = __builtin_amdgcn_permlane32_swap(__float_as_uint(pmax), __float_as_uint(pmax), false, false);
      pmax = fmaxf(__uint_as_float(rr[0]), __uint_as_float(rr[1])); }
    constexpr float C2 = 1.4426950408889634f * SCALE;
    if (__builtin_expect(__all((pmax - m_reg) * SCALE <= THR), 1)) { mn = m_reg; alpha = 1.f; }
    else { mn = fmaxf(m_reg, pmax); alpha = __builtin_amdgcn_exp2f((m_reg - mn) * C2); m_reg = mn; }
    const float mnL = -mn * C2;
#pragma unroll
    for (int r = 0; r < 16; ++r) p0[r] = fmaf(p0[r], C2, mnL);
#pragma unroll
    for (int r = 0; r < 16; ++r) p1[r] = fmaf(p1[r], C2, mnL);
#pragma unroll
    for (int r = 0; r < 16; ++r) p0[r] = __builtin_amdgcn_exp2f(p0[r]);
}
__device__ __forceinline__ void finishSM(f32x16& p0, f32x16& p1, float alpha, float& l_reg, bf16x8& pa0, bf16x8& pa1, bf16x8& pa2, bf16x8& pa3) {
#pragma unroll
    for (int r = 0; r < 16; ++r) p1[r] = __builtin_amdgcn_exp2f(p1[r]);
    float ps = 0;
#pragma unroll
    for (int r = 0; r < 16; ++r) ps += p0[r];
#pragma unroll
    for (int r = 0; r < 16; ++r) ps += p1[r];
    { auto rr = __builtin_amdgcn_permlane32_swap(__float_as_uint(ps), __float_as_uint(ps), false, false);
      ps = __uint_as_float(rr[0]) + __uint_as_float(rr[1]); }
    l_reg = l_reg * alpha + ps;
#define PK4(P, B_, OUT) do { unsigned a0 = cvtpk(P[B_+0], P[B_+1]), a1 = cvtpk(P[B_+2], P[B_+3]);                          \
        unsigned b0 = cvtpk(P[B_+4], P[B_+5]), b1 = cvtpk(P[B_+6], P[B_+7]);                                             \
        auto r0 = __builtin_amdgcn_permlane32_swap(a0, b0, false, false); auto r1 = __builtin_amdgcn_permlane32_swap(a1, b1, false, false); \
        u32x4 w = {r0[0], r1[0], r0[1], r1[1]}; OUT = *reinterpret_cast<bf16x8*>(&w); } while (0)
    PK4(p0, 0, pa0); PK4(p0, 8, pa1); PK4(p1, 0, pa2); PK4(p1, 8, pa3);
#undef PK4
}
template <int KB>
__device__ __forceinline__ void qkt(f32x16& p0, f32x16& p1, const char* K_lds, int r32, int hi, const bf16x8* qr) {
    p0 = f32x16{}; p1 = f32x16{};
    const char* kb = K_lds + KB * SHM_K + r32 * KROW + hi * 16;
#pragma unroll
    for (int d0 = 0; d0 < 12; ++d0) {
        const bf16x8 b0 = *reinterpret_cast<const bf16x8*>(kb + d0 * 32);
        const bf16x8 b1 = *reinterpret_cast<const bf16x8*>(kb + 32 * KROW + d0 * 32);
        p0 = __builtin_amdgcn_mfma_f32_32x32x16_bf16(b0, qr[d0], p0, 0, 0, 0);
        p1 = __builtin_amdgcn_mfma_f32_32x32x16_bf16(b1, qr[d0], p1, 0, 0, 0);
    }
}
template <int VB>
__device__ __forceinline__ void pv_tile(f32x16* o, int vb0, bf16x8 pa0, bf16x8 pa1, bf16x8 pa2, bf16x8 pa3) {
#define TRRD(dst, off) asm volatile("ds_read_b64_tr_b16 %0, %1 offset:%2" : "=&v"(dst) : "v"(vb0), "i"(off) : "memory")
#define PV_D0(d0) do { s16x4 l0, l1, l2, l3, h0, h1, h2, h3; constexpr int b_ = VB * SHM_V + v_rd_off(d0, 0, 0);   \
        TRRD(l0, b_); TRRD(h0, b_ + 2048); TRRD(l1, b_ + 4096); TRRD(h1, b_ + 6144); TRRD(l2, b_ + 8192); TRRD(h2, b_ + 10240); TRRD(l3, b_ + 12288); TRRD(h3, b_ + 14336); \
        asm volatile("s_waitcnt lgkmcnt(0)" ::: "memory"); SBAR();   \
        o[d0] = __builtin_amdgcn_mfma_f32_32x32x16_bf16(pa0, (bf16x8){l0[0], l0[1], l0[2], l0[3], h0[0], h0[1], h0[2], h0[3]}, o[d0], 0, 0, 0);   \
        o[d0] = __builtin_amdgcn_mfma_f32_32x32x16_bf16(pa1, (bf16x8){l1[0], l1[1], l1[2], l1[3], h1[0], h1[1], h1[2], h1[3]}, o[d0], 0, 0, 0);   \
        o[d0] = __builtin_amdgcn_mfma_f32_32x32x16_bf16(pa2, (bf16x8){l2[0], l2[1], l2[2], l2[3], h2[0], h2[1], h2[2], h2[3]}, o[d0], 0, 0, 0);   \
        o[d0] = __builtin_amdgcn_mfma_f32_32x32x16_bf16(pa3, (bf16x8){l3[0], l3[1], l3[2], l3[3], h3[0], h3[1], h3[2], h3[3]}, o[d0], 0, 0, 0); } while (0)
    PV_D0(0); PV_D0(1); PV_D0(2); PV_D0(3);
#undef PV_D0
#undef TRRD
}

__device__ __forceinline__ void attn_block(const bf16_t* Q, const bf16_t* K, const bf16_t* V, bf16_t* O, size_t tb, int h, int P0, char* lds) {
    const int tid = threadIdx.x, wid = __builtin_amdgcn_readfirstlane(tid >> 6), lane = tid & 63, r32 = lane & 31, hi = lane >> 5;
    const int NT = (P0 + QB) / KVBLK;
    const int qlo = P0 + wid * QBLK, qm = qlo + r32 - 4 * hi;
    char* V_lds = lds + LDS_V; char* K_lds = lds + LDS_K;
    float* ws = (float*)(lds + LDS_WS) + wid * 64; float* li_l = ws, * al_l = ws + 32;
    float m_reg = -1e30f, l_reg = 0; f32x16 o[4] = {};
    const bf16_t* Kh = K + tb * 768 + h * 192; const bf16_t* Vh = V + tb * 512 + h * 128;
    const int sr = tid >> 4, sc = (tid & 15) * 8, vst0 = v_st(sr, sc), vst1 = v_st(32 + sr, sc);
    const int kgo = (tid >> 3) * 768 + (tid & 7) * 8, klo = (tid >> 3) * KROW + (tid & 7) * 16;
    const int vb0 = (int)(uintptr_t)V_lds + v_rd_base(lane);
    bf16x8 st_k0, st_k1, st_k2, st_v0, st_v1;
#define VMW() asm volatile("s_waitcnt vmcnt(0)" ::: "memory")
#define SLOAD(k0) do { const bf16_t* kp_ = Kh + (size_t)(k0) * 768 + kgo; st_k0 = *(const bf16x8*)(kp_); st_k1 = *(const bf16x8*)(kp_ + 64); st_k2 = *(const bf16x8*)(kp_ + 128); \
        st_v0 = *(const bf16x8*)(Vh + (size_t)((k0) + sr) * 512 + sc); st_v1 = *(const bf16x8*)(Vh + (size_t)((k0) + 32 + sr) * 512 + sc); } while (0)
#define SWRITE(bf) do { char* kw_ = K_lds + (bf) * SHM_K + klo; *(bf16x8*)(kw_) = st_k0; *(bf16x8*)(kw_ + 128) = st_k1; *(bf16x8*)(kw_ + 256) = st_k2; \
        *(bf16x8*)(V_lds + (bf) * SHM_V + vst0) = st_v0; *(bf16x8*)(V_lds + (bf) * SHM_V + vst1) = st_v1; } while (0)
#define RESC(a) do { if (__any((a) < 1.f)) { if (hi == 0) al_l[r32] = (a); asm volatile("s_waitcnt lgkmcnt(0)" ::: "memory");              \
                     for (int d_ = 0; d_ < 4; ++d_) for (int r = 0; r < 16; ++r) o[d_][r] *= al_l[crow(r, hi)]; } } while (0)
#define KBASE(t) ((t) * KVBLK)
#define MASKT(P0_, P1_, t) do { const int kb_ = KBASE(t); if (kb_ + KVBLK - 1 > qlo) mask_tile(P0_, P1_, qm - kb_); } while (0)
    bf16x8 qr[12];
    { const bf16_t* Qw = Q + (tb + qlo + r32) * 768 + h * 192 + hi * 8;
#pragma unroll
      for (int d0 = 0; d0 < 12; ++d0) qr[d0] = *(const bf16x8*)(Qw + d0 * 16); }
    SLOAD(0); VMW(); SWRITE(0);
    __syncthreads();
    f32x16 p0, p1; float mn, al; bf16x8 pa0, pa1, pa2, pa3;
#define TILE_STEP(t, BUF) do {                                                                   \
        if ((t) + 1 < NT) { SLOAD(KBASE((t) + 1)); }                                              \
        SBAR(); qkt<BUF>(p0, p1, K_lds, r32, hi, qr);                                             \
        MASKT(p0, p1, (t)); partialSM(p0, p1, m_reg, mn, al); RESC(al);                           \
        finishSM(p0, p1, al, l_reg, pa0, pa1, pa2, pa3); SBAR();                                  \
        pv_tile<BUF>(o, vb0, pa0, pa1, pa2, pa3);                                                 \
        if ((t) + 1 < NT) { VMW(); SWRITE(1 - BUF); }                                             \
        __syncthreads(); } while (0)
    for (int t = 0; t < NT; t += 2) { TILE_STEP(t, 0); TILE_STEP(t + 1, 1); }
    if (hi == 0) li_l[r32] = l_reg; asm volatile("s_waitcnt lgkmcnt(0)" ::: "memory");
    float rli[16];
#pragma unroll
    for (int r = 0; r < 16; ++r) rli[r] = __builtin_amdgcn_rcpf(li_l[crow(r, hi)]);
    bf16_t* Ow = O + (tb + qlo) * 1024 + h * 128;
#pragma unroll
    for (int r = 0; r < 16; ++r) { const int orow = crow(r, hi);
#pragma unroll
        for (int d0 = 0; d0 < 4; ++d0) { const float v = o[d0][r] * rli[r];
            const float vn = __shfl_xor(v, 1);
            if ((r32 & 1) == 0) *(unsigned*)(Ow + (size_t)orow * 1024 + d0 * 32 + r32) = cvtpk(v, vn); } }
#undef VMW
#undef SLOAD
#undef SWRITE
#undef RESC
#undef KBASE
#undef MASKT
#undef TILE_STEP
}
#undef SBAR

__device__ __forceinline__ void attn_phase(const bf16_t* Q, const bf16_t* K, const bf16_t* V, bf16_t* O, char* lds) {
    for (int L = blockIdx.x; L < 256; L += gridDim.x) {
        const int xcd = L & 7, k = L >> 3, bh = (k >> 3) * 8 + xcd, x = k & 7;
        const int b = bh >> 2, h = bh & 3; const size_t tb = (size_t)b * 4096;
        attn_block(Q, K, V, O, tb, h, (15 - x) * QB, lds);
        attn_block(Q, K, V, O, tb, h, x * QB, lds);
    }
}
}
namespace rt {
using at::f32x16; using at::s16x4; using at::v_st; using at::v_rd_base; using at::v_rd_off; using at::crow; using at::cvtpk;
constexpr int PITCH = 272;
constexpr int L_Q = 0, L_K = 128 * PITCH, L_V = 2 * 128 * PITCH, L_S = L_V + 32768, L_END = L_S + 128 * PITCH;
#define TRRD(dst, base, off) asm volatile("ds_read_b64_tr_b16 %0, %1 offset:%2" : "=&v"(dst) : "v"(base), "i"(off) : "memory")
#define FRAG(l, h) ((bf16x8){l[0], l[1], l[2], l[3], h[0], h[1], h[2], h[3]})
using fx::gamma_log2;

__device__ __forceinline__ void ret_kv_unit(const bf16_t* RK, const bf16_t* RV, bf16_t* KVS, int bh, int c, char* lds) {
    const int tid = threadIdx.x, wid = __builtin_amdgcn_readfirstlane(tid >> 6), lane = tid & 63, r32 = lane & 31, hi = lane >> 5;
    const int b = bh >> 2, h = bh & 3; const size_t t0 = (size_t)b * 4096 + (size_t)c * 128;
    char* Kl = lds; char* Vl = lds + 32768;
#pragma unroll
    for (int i = 0; i < 4; ++i) { const int q = tid + 512 * i, row = q >> 4, cc = (q & 15) * 8; const int lo = (row >> 6) * 16384 + v_st(row & 63, cc);
        *(bf16x8*)(Kl + lo) = *(const bf16x8*)(RK + (t0 + row) * 512 + h * 128 + cc);
        *(bf16x8*)(Vl + lo) = *(const bf16x8*)(RV + (t0 + row) * 512 + h * 128 + cc); }
    __syncthreads();
    const int dvb = wid >> 1, dkb = 2 * (wid & 1);
    const int vbase = (int)(uintptr_t)Vl + v_rd_base(lane) + dvb * 512, kbase = (int)(uintptr_t)Kl + v_rd_base(lane) + dkb * 512;
    f32x16 acc0 = {}, acc1 = {};
#define KVSTEP(sub, ks) do { s16x4 al, ah, b0l, b0h, b1l, b1h; constexpr int o_ = (sub) * 16384 + v_rd_off(0, ks, 0);   \
        TRRD(al, vbase, o_); TRRD(ah, vbase, o_ + 2048); TRRD(b0l, kbase, o_); TRRD(b0h, kbase, o_ + 2048); TRRD(b1l, kbase, o_ + 512); TRRD(b1h, kbase, o_ + 512 + 2048); \
        asm volatile("s_waitcnt lgkmcnt(0)" ::: "memory"); __builtin_amdgcn_sched_barrier(0);   \
        acc0 = __builtin_amdgcn_mfma_f32_32x32x16_bf16(FRAG(al, ah), FRAG(b0l, b0h), acc0, 0, 0, 0);   \
        acc1 = __builtin_amdgcn_mfma_f32_32x32x16_bf16(FRAG(al, ah), FRAG(b1l, b1h), acc1, 0, 0, 0); } while (0)
    KVSTEP(0, 0); KVSTEP(0, 1); KVSTEP(0, 2); KVSTEP(0, 3); KVSTEP(1, 0); KVSTEP(1, 1); KVSTEP(1, 2); KVSTEP(1, 3);
#undef KVSTEP
    const float sc = exp2f(127.f * gamma_log2(h));
    bf16_t* O = KVS + ((size_t)(bh * 32 + c) * 128 + dvb * 32) * 128 + dkb * 32;
#pragma unroll
    for (int r = 0; r < 16; ++r) { const int dv = crow(r, hi);
        const float v0 = acc0[r] * sc, v1 = acc1[r] * sc; const float n0 = __shfl_xor(v0, 1), n1 = __shfl_xor(v1, 1);
        if ((r32 & 1) == 0) { *(unsigned*)(O + (size_t)dv * 128 + r32) = cvtpk(v0, n0); *(unsigned*)(O + (size_t)dv * 128 + 32 + r32) = cvtpk(v1, n1); } }
    __syncthreads();
}
__device__ __forceinline__ void ret_kv_phase(const bf16_t* RK, const bf16_t* RV, bf16_t* KVS, char* lds) {
    for (int u = blockIdx.x; u < 1024; u += gridDim.x) ret_kv_unit(RK, RV, KVS, u >> 5, u & 31, lds);
}

__device__ __forceinline__ void ret_out_unit(const bf16_t* RQ, const bf16_t* RK, const bf16_t* RV, const bf16_t* RG, const bf16_t* KVS, const float* gn_g, bf16_t* AO, int bh, int c, char* lds) {
    const int tid = threadIdx.x, wid = __builtin_amdgcn_readfirstlane(tid >> 6), lane = tid & 63, r32 = lane & 31, hi = lane >> 5;
    const int b = bh >> 2, h = bh & 3; const size_t t0 = (size_t)b * 4096 + (size_t)c * 128;
    const float lg = gamma_log2(h);
#pragma unroll
    for (int i = 0; i < 4; ++i) { const int q = tid + 512 * i, row = q >> 4, cc = (q & 15) * 8;
        *(bf16x8*)(lds + L_Q + row * PITCH + cc * 2) = *(const bf16x8*)(RQ + (t0 + row) * 512 + h * 128 + cc);
        *(bf16x8*)(lds + L_K + row * PITCH + cc * 2) = *(const bf16x8*)(RK + (t0 + row) * 512 + h * 128 + cc);
        *(bf16x8*)(lds + L_V + (row >> 6) * 16384 + v_st(row & 63, cc)) = *(const bf16x8*)(RV + (t0 + row) * 512 + h * 128 + cc); }
    { f32x4 sa[4][2];
#pragma unroll
      for (int i = 0; i < 4; ++i) { sa[i][0] = (f32x4){0.f, 0.f, 0.f, 0.f}; sa[i][1] = sa[i][0]; }
      float w = 1.f; const float cd = exp2f(128.f * lg);
      for (int j = c - 1; j >= 0; --j) { const bf16_t* src = KVS + (size_t)(bh * 32 + j) * 16384 + tid * 8;
#pragma unroll
          for (int i = 0; i < 4; ++i) { const u32x4 v = *(const u32x4*)(src + 4096 * i);
              sa[i][0] += w * (f32x4){__uint_as_float(v.x << 16), __uint_as_float(v.x & 0xffff0000u), __uint_as_float(v.y << 16), __uint_as_float(v.y & 0xffff0000u)};
              sa[i][1] += w * (f32x4){__uint_as_float(v.z << 16), __uint_as_float(v.z & 0xffff0000u), __uint_as_float(v.w << 16), __uint_as_float(v.w & 0xffff0000u)}; }
          w *= cd; }
#pragma unroll
      for (int i = 0; i < 4; ++i) { const int e8 = tid + 512 * i, dv = e8 >> 4, dk0 = (e8 & 15) * 8; *(u32x4*)(lds + L_S + dv * PITCH + dk0 * 2) = fx::pack8(sa[i][0], sa[i][1]); } }
    __syncthreads();
    const int qg = wid & 3, dh = wid >> 2;
    bf16x8 qr[8];
#pragma unroll
    for (int d0 = 0; d0 < 8; ++d0) qr[d0] = *(const bf16x8*)(lds + L_Q + (32 * qg + r32) * PITCH + d0 * 32 + hi * 16);
    f32x16 o[2] = {};
#pragma unroll
    for (int dd = 0; dd < 2; ++dd) { const char* sb = lds + L_S + ((2 * dh + dd) * 32 + r32) * PITCH + hi * 16;
#pragma unroll
        for (int d0 = 0; d0 < 8; ++d0) o[dd] = __builtin_amdgcn_mfma_f32_32x32x16_bf16(qr[d0], *(const bf16x8*)(sb + d0 * 32), o[dd], 0, 0, 0); }
    { const float g1 = exp2f(lg);
#pragma unroll
      for (int dd = 0; dd < 2; ++dd)
#pragma unroll
          for (int r = 0; r < 16; ++r) o[dd][r] *= g1; }
    const int vb = (int)(uintptr_t)(lds + L_V) + v_rd_base(lane) + (2 * dh) * 512;
    const int qpos = 32 * qg + r32;
#define INTRA(kt) do { if (64 * (kt) <= 32 * qg + 31) { f32x16 p0 = {}, p1 = {}; const char* kb = lds + L_K + (64 * (kt) + r32) * PITCH + hi * 16;   \
        _Pragma("unroll") for (int d0 = 0; d0 < 8; ++d0) { p0 = __builtin_amdgcn_mfma_f32_32x32x16_bf16(*(const bf16x8*)(kb + d0 * 32), qr[d0], p0, 0, 0, 0);   \
                                                          p1 = __builtin_amdgcn_mfma_f32_32x32x16_bf16(*(const bf16x8*)(kb + 32 * PITCH + d0 * 32), qr[d0], p1, 0, 0, 0); }   \
        _Pragma("unroll") for (int r = 0; r < 16; ++r) { const int key = 64 * (kt) + crow(r, hi); if (key > qpos) p0[r] = 0.f; if (key + 32 > qpos) p1[r] = 0.f; }   \
        bf16x8 pa0, pa1, pa2, pa3;   \
        PK4(p0, 0, pa0); PK4(p0, 8, pa1); PK4(p1, 0, pa2); PK4(p1, 8, pa3);   \
        PVD(kt, 0); PVD(kt, 1); } } while (0)
#define PK4(P, B_, OUT) do { unsigned a0 = cvtpk(P[B_+0], P[B_+1]), a1 = cvtpk(P[B_+2], P[B_+3]); unsigned b0 = cvtpk(P[B_+4], P[B_+5]), b1 = cvtpk(P[B_+6], P[B_+7]);   \
        auto r0 = __builtin_amdgcn_permlane32_swap(a0, b0, false, false); auto r1 = __builtin_amdgcn_permlane32_swap(a1, b1, false, false);   \
        u32x4 w_ = {r0[0], r1[0], r0[1], r1[1]}; OUT = *reinterpret_cast<bf16x8*>(&w_); } while (0)
#define PVD(kt, dd) do { s16x4 l0, l1, l2, l3, h0, h1, h2, h3; constexpr int b_ = (kt) * 16384 + v_rd_off(dd, 0, 0);   \
        TRRD(l0, vb, b_); TRRD(h0, vb, b_ + 2048); TRRD(l1, vb, b_ + 4096); TRRD(h1, vb, b_ + 6144); TRRD(l2, vb, b_ + 8192); TRRD(h2, vb, b_ + 10240); TRRD(l3, vb, b_ + 12288); TRRD(h3, vb, b_ + 14336);   \
        asm volatile("s_waitcnt lgkmcnt(0)" ::: "memory"); __builtin_amdgcn_sched_barrier(0);   \
        o[dd] = __builtin_amdgcn_mfma_f32_32x32x16_bf16(pa0, FRAG(l0, h0), o[dd], 0, 0, 0); o[dd] = __builtin_amdgcn_mfma_f32_32x32x16_bf16(pa1, FRAG(l1, h1), o[dd], 0, 0, 0);   \
        o[dd] = __builtin_amdgcn_mfma_f32_32x32x16_bf16(pa2, FRAG(l2, h2), o[dd], 0, 0, 0); o[dd] = __builtin_amdgcn_mfma_f32_32x32x16_bf16(pa3, FRAG(l3, h3), o[dd], 0, 0, 0); } while (0)
    INTRA(0); INTRA(1);
#undef INTRA
#undef PK4
#undef PVD
    __syncthreads();
    float* Os = (float*)lds;
#pragma unroll
    for (int dd = 0; dd < 2; ++dd)
#pragma unroll
        for (int r = 0; r < 16; ++r) Os[(32 * qg + crow(r, hi)) * 132 + (2 * dh + dd) * 32 + r32] = o[dd][r];
    __syncthreads();
    { const int q = tid >> 2, seg = tid & 3; const float* orow = Os + q * 132 + seg * 32;
      f32x4 v[8]; float s1 = 0.f, s2 = 0.f;
#pragma unroll
      for (int i = 0; i < 8; ++i) { v[i] = *(const f32x4*)(orow + 4 * i); s1 += (v[i][0] + v[i][1]) + (v[i][2] + v[i][3]); s2 += fx::sq4(v[i]); }
      s1 += __shfl_xor(s1, 1); s1 += __shfl_xor(s1, 2); s2 += __shfl_xor(s2, 1); s2 += __shfl_xor(s2, 2);
      const float mean = s1 * (1.f / 128.f); const float var = fmaxf(s2 * (1.f / 128.f) - mean * mean, 0.f); const float rs = rsqrtf(var + EPS);
      const bf16_t* gp = RG + (t0 + q) * 512 + h * 128 + seg * 32; const float* gg = gn_g + h * 128 + seg * 32;
      bf16_t* op = AO + (t0 + q) * 1024 + 512 + h * 128 + seg * 32;
#pragma unroll
      for (int i = 0; i < 4; ++i) { const u32x4 gr = *(const u32x4*)(gp + 8 * i); const f32x4 g0 = *(const f32x4*)(gg + 8 * i), g1 = *(const f32x4*)(gg + 8 * i + 4);
          const f32x4 ga = {__uint_as_float(gr.x << 16), __uint_as_float(gr.x & 0xffff0000u), __uint_as_float(gr.y << 16), __uint_as_float(gr.y & 0xffff0000u)};
          const f32x4 gb = {__uint_as_float(gr.z << 16), __uint_as_float(gr.z & 0xffff0000u), __uint_as_float(gr.w << 16), __uint_as_float(gr.w & 0xffff0000u)};
          f32x4 ya = (v[2 * i] - mean) * rs * g0, yb = (v[2 * i + 1] - mean) * rs * g1;
#pragma unroll
          for (int k = 0; k < 4; ++k) { ya[k] *= ga[k] / (1.f + __expf(-ga[k])); yb[k] *= gb[k] / (1.f + __expf(-gb[k])); }
          *(u32x4*)(op + 8 * i) = fx::pack8(ya, yb); } }
    __syncthreads();
}
__device__ __forceinline__ void ret_out_phase(const bf16_t* RQ, const bf16_t* RK, const bf16_t* RV, const bf16_t* RG, const bf16_t* KVS, const float* gn_g, bf16_t* AO, char* lds) {
    for (int it = blockIdx.x; it < 512; it += gridDim.x) { const int bh = it >> 4, x = it & 15;
        ret_out_unit(RQ, RK, RV, RG, KVS, gn_g, AO, bh, 31 - x, lds);
        ret_out_unit(RQ, RK, RV, RG, KVS, gn_g, AO, bh, x, lds); }
}
#undef TRRD
#undef FRAG
}
namespace cg = cooperative_groups;
#ifndef DUP
#define DUP (-1)
#endif
__device__ __forceinline__ int opaque_reps(int n) { asm volatile("" : "+s"(n)); return n; }
#define REPS(code) for (int rep = 0; rep < ((DUP == (code)) ? 2 : 1); ++rep)
constexpr int NWAVES = 8;
constexpr int RING_BYTES = 131072, XL_OFF = RING_BYTES, XL_BYTES = 8192, XST_OFF = RING_BYTES + 8192 + 16384, LDS_BYTES = XST_OFF + 64;

struct Params {
    const float* in[28]; float* out; unsigned char* ws; int ph_lo, ph_hi; int coop; int pad;
};
typedef const Params __attribute__((address_space(4)))* KParams;
#define WSP(T_, off) ((T_*)(p->ws + (off)))

constexpr size_t WB_IN = WS_WB, WB_UQ = WB_IN + (size_t)2560 * 1024 * 2, WB_UKV = WB_UQ + (size_t)1024 * 256 * 2, WB_OUT = WB_UKV + (size_t)1024 * 256 * 2,
                 WB_CQ = WB_OUT + (size_t)1024 * 1024 * 2, WB_CKV = WB_CQ + (size_t)1024 * 1024 * 2, WB_CO = WB_CKV + (size_t)2048 * 1024 * 2,
                 WB_GU = WB_CO + (size_t)1024 * 1024 * 2, WB_D = WB_GU + (size_t)32 * 512 * 1024 * 2, WB_END = WB_D + (size_t)32 * 1024 * 256 * 2;
static_assert(WB_END <= WS_RQ, "weight copies overflow their region");

__device__ __forceinline__ float wave_sum64(float v) {
#pragma unroll
    for (int o = 1; o < 64; o <<= 1) v += __shfl_xor(v, o);
    return v;
}
__device__ __forceinline__ int plain_src(int n) { return (n & ~31) + pg8::perm32(n & 31); }

template <class SrcFn, class DstFn>
__device__ __forceinline__ void wprep_item(const float* __restrict__ W, int ldw, int Kreal, const float* __restrict__ gain, bf16_t* __restrict__ WT, int ldt,
                                           LAS float* scr, int kb, int nb, int lane, SrcFn src, DstFn dst) {
    const int k0 = 64 * kb, n0 = 64 * nb;
    u32x4* orow = (u32x4*)(WT + (size_t)dst(n0 + lane) * ldt + k0);
    if (k0 >= Kreal) {
#pragma unroll
        for (int c = 0; c < 8; ++c) orow[c] = (u32x4){0u, 0u, 0u, 0u};
        return; }
    const int krow = lane >> 4, n4 = lane & 15;
    int sc = src(n0 + 4 * n4); sc = sc < 0 ? 0 : sc;
    const float* wp = W + (size_t)(k0 + krow) * ldw + sc;
    f32x4 v[16];
#pragma unroll
    for (int i = 0; i < 16; ++i) v[i] = *(const f32x4*)(wp + (size_t)(4 * i) * ldw);
#pragma unroll
    for (int i = 0; i < 16; ++i) *(LAS f32x4*)(scr + (4 * i + krow) * 68 + 4 * n4) = v[i];
    asm volatile("s_waitcnt lgkmcnt(0)" ::: "memory");
    const bool zero = src(n0 + lane) < 0;
#pragma unroll
    for (int c = 0; c < 8; ++c) { float t[8];
#pragma unroll
        for (int j = 0; j < 8; ++j) { t[j] = scr[(8 * c + j) * 68 + lane]; if (gain) t[j] *= gain[k0 + 8 * c + j]; if (zero) t[j] = 0.f; }
        u32x4 o; o.x = pg8::cvt_pk_bf16(t[0], t[1]); o.y = pg8::cvt_pk_bf16(t[2], t[3]); o.z = pg8::cvt_pk_bf16(t[4], t[5]); o.w = pg8::cvt_pk_bf16(t[6], t[7]);
        orow[c] = o; }
    asm volatile("s_waitcnt lgkmcnt(0)" ::: "memory");
}
template <class SrcFn, class DstFn>
__device__ __forceinline__ void wprep_matrix(const float* W, int ldw, int Kreal, int Kpad, int Nitems64, const float* gain, bf16_t* WT, int ldt, LAS float* scr, int gw, int NGW, int lane, SrcFn src, DstFn dst) {
    const int nkb = Kpad / 64, total = nkb * Nitems64;
    for (int it = gw; it < total; it += NGW) wprep_item(W, ldw, Kreal, gain, WT, ldt, scr, it / Nitems64, it % Nitems64, lane, src, dst);
}
__device__ __forceinline__ void rms_row_to_bf16(const float* xrow, const float* g, bf16_t* orow, int lane) {
    const f32x4* xr = (const f32x4*)xrow + lane; const f32x4* gr = (const f32x4*)g + lane;
    f32x4 v[4]; float s = 0.f;
#pragma unroll
    for (int j = 0; j < 4; ++j) { v[j] = xr[64 * j]; s += fx::sq4(v[j]); }
    const float rs = rsqrtf(wave_sum64(s) * (1.f / 1024.f) + EPS);
    u32x2* o8 = (u32x2*)orow + lane;
#pragma unroll
    for (int j = 0; j < 4; ++j) { const f32x4 w = v[j] * rs * gr[64 * j]; o8[64 * j] = fx::pack4(w); }
}

__device__ __forceinline__ void p0_prologue(KParams p, LAS unsigned char* lds, int wave, int lane) {
    LAS float* scr = (LAS float*)(lds + wave * 17408);
    const int gw = blockIdx.x * NWAVES + wave, NGW = gridDim.x * NWAVES;
    auto ident = [](int n) { return n; };
    REPS(1004) {
    for (int it = gw; it < 2048; it += NGW) { int r = it;
        if (r < 640) { wprep_item(p->in[4], 2496, 1024, nullptr, WSP(bf16_t, WB_IN), 1024, scr, r / 40, r % 40, lane, [](int n) { return fx::inproj_src(n); }, ident); continue; } r -= 640;
        if (r < 256) { wprep_item(p->in[12], 1024, 1024, nullptr, WSP(bf16_t, WB_OUT), 1024, scr, r >> 4, r & 15, lane, ident, ident); continue; } r -= 256;
        if (r < 256) { wprep_item(p->in[19], 1024, 1024, nullptr, WSP(bf16_t, WB_CO), 1024, scr, r >> 4, r & 15, lane, ident, ident); continue; } r -= 256;
        if (r < 64) { wprep_item(p->in[6], 768, 256, p->in[5], WSP(bf16_t, WB_UQ), 256, scr, r >> 4, r & 15, lane, [](int n) { return fx::mlaq_src(n); }, ident); continue; } r -= 64;
        if (r < 64) { wprep_item(p->in[8], 1024, 128, p->in[7], WSP(bf16_t, WB_UKV), 256, scr, r >> 4, r & 15, lane, [](int n) { return plain_src(n); }, ident); continue; } r -= 64;
        if (r < 256) { wprep_item(p->in[15], 1024, 1024, p->in[13], WSP(bf16_t, WB_CQ), 1024, scr, r >> 4, r & 15, lane, [](int n) { return plain_src(n); }, ident); continue; } r -= 256;
        wprep_item(p->in[16], 2048, 1024, nullptr, WSP(bf16_t, WB_CKV), 1024, scr, r >> 5, r & 31, lane, [](int n) { return n < 1024 ? plain_src(n) : n; }, ident);
    }
    }
    REPS(1003) {
    for (int it = gw; it < 32 * 64; it += NGW) { const int e = it >> 6, r = it & 63, kb = r >> 2, nb = r & 3;
        auto srcf = [](int n) { return (n >> 7) * 128 + plain_src(n & 127); };
        wprep_item(p->in[25] + (size_t)e * 1024 * 256, 256, 1024, p->in[20], WSP(bf16_t, WB_GU) + (size_t)e * 512 * 1024, 1024, scr, kb, nb, lane, srcf, [](int n) { return (n >> 7) * 256 + (n & 127); });
        wprep_item(p->in[26] + (size_t)e * 1024 * 256, 256, 1024, p->in[20], WSP(bf16_t, WB_GU) + (size_t)e * 512 * 1024, 1024, scr, kb, nb, lane, srcf, [](int n) { return (n >> 7) * 256 + 128 + (n & 127); }); }
    for (int it = gw; it < 32 * 64; it += NGW) { const int e = it >> 6, r = it & 63, kb = r >> 4, nb = r & 15;
        wprep_item(p->in[27] + (size_t)e * 256 * 1024, 1024, 256, nullptr, WSP(bf16_t, WB_D) + (size_t)e * 1024 * 256, 256, scr, kb, nb, lane, ident, ident); }
    }
    REPS(1001) {
    for (int m = gw; m < T_TOK; m += 2 * NGW) {
        const f32x4* xr0 = (const f32x4*)(p->in[0] + (size_t)m * 1024) + lane; const f32x4* xr1 = (const f32x4*)(p->in[0] + (size_t)(m + NGW) * 1024) + lane; const f32x4* gr = (const f32x4*)p->in[3] + lane;
        f32x4 v0[4], v1[4]; float s0 = 0.f, s1 = 0.f;
#pragma unroll
        for (int j = 0; j < 4; ++j) { v0[j] = xr0[64 * j]; v1[j] = xr1[64 * j]; }
#pragma unroll
        for (int j = 0; j < 4; ++j) { s0 += fx::sq4(v0[j]); s1 += fx::sq4(v1[j]); }
        const float r0 = rsqrtf(wave_sum64(s0) * (1.f / 1024.f) + EPS), r1 = rsqrtf(wave_sum64(s1) * (1.f / 1024.f) + EPS);
        u32x2* o0 = (u32x2*)(WSP(bf16_t, WS_HB) + (size_t)m * 1024) + lane; u32x2* o1 = (u32x2*)(WSP(bf16_t, WS_HB) + (size_t)(m + NGW) * 1024) + lane;
#pragma unroll
        for (int j = 0; j < 4; ++j) { const f32x4 g = gr[64 * j]; o0[64 * j] = fx::pack4(v0[j] * r0 * g); o1[64 * j] = fx::pack4(v1[j] * r1 * g); } }
    for (int m = gw; m < 2048; m += NGW) rms_row_to_bf16(p->in[1] + (size_t)m * 1024, p->in[14], WSP(bf16_t, WS_MB) + (size_t)m * 1024, lane);
    }
    REPS(1002) {
    { const int* pos = (const int*)p->in[2]; float* cs = WSP(float, WS_CS);
      const int gt = blockIdx.x * (NWAVES * 64) + threadIdx.x, NT = gridDim.x * NWAVES * 64;
      { const int i = gt & 63; const float inv = powf(10000.f, -(float)i * (1.f / 64.f));
        for (int idx = gt; idx < T_TOK * 64; idx += NT) { const int t = idx >> 6; const float ang = (float)pos[t] * inv;
            const float n = rintf(ang * 0.15915494309189535f); float r = fmaf(-n, 6.2831854820251465f, ang); r = fmaf(-n, -1.7484555e-7f, r);
            *(f32x2*)(cs + (size_t)idx * 2) = (f32x2){__cosf(r), __sinf(r)}; } }
      float* z = WSP(float, WS_SSQ_CQ);
      for (int idx = gt; idx < 5 * 32768; idx += NT) z[idx] = 0.f;
      if (gt < 64) WSP(int, WS_CNT)[gt] = 0;
      bf16_t* wrh = WSP(bf16_t, WS_RW); bf16_t* wrl = wrh + 36 * 1032;
      for (int idx = gt; idx < 36 * 1032; idx += NT) { const int n = idx / 1032, k = idx % 1032; float v = 0.f;
          if (k < 1024) v = (n < 4) ? p->in[20][k] * p->in[21][k * 4 + n] : p->in[20][k] * p->in[23][k * 32 + n - 4];
          const bf16_t hh = f2bf(v); wrh[idx] = hh; wrl[idx] = f2bf(v - bf2f(hh)); } }
    }
}


#define GAS __attribute__((address_space(1)))
#define XB_TMO      128
#define XB_XCNT(j)  (256  + 64 * (j))
#define XB_XSUB(j)  (1280 + 64 * (j))
#define XB_XGEN(j)  (2304 + 64 * (j))
#define XB_TOP      3328
#define XB_TOPGEN   3392
#define XCD_BAR_WORDS 3456
#define XB_SPIN_CAP (1u << 18)
__device__ __forceinline__ unsigned xb_ld(unsigned* p)              { return __hip_atomic_load(p, __ATOMIC_RELAXED, __HIP_MEMORY_SCOPE_AGENT); }
__device__ __forceinline__ unsigned xb_add(unsigned* p, unsigned v) { return __hip_atomic_fetch_add(p, v, __ATOMIC_RELAXED, __HIP_MEMORY_SCOPE_AGENT); }
__device__ __forceinline__ unsigned xb_xcc_id() { return (unsigned)__builtin_amdgcn_s_getreg((3 << 11) | 20) & 0xFu; }
#define XB_SPIN(cond, bar) do { unsigned _sp = 0; while (cond) { __builtin_amdgcn_s_sleep(1); \
    if ((++_sp & 255u) == 0u) { if (xb_ld(&(bar)[XB_TMO])) break; if (_sp > XB_SPIN_CAP) { atomicAdd(&(bar)[XB_TMO], 1u); break; } } } } while (0)
struct XcdBarrier { unsigned* bar; unsigned x; volatile LAS unsigned* st; };
__device__ __forceinline__ XcdBarrier xcd_barrier_post(unsigned* bar, volatile LAS unsigned* st) {
    XcdBarrier b; b.bar = bar; b.x = xb_xcc_id(); b.st = st;
    if (threadIdx.x == 0) (void)xb_add(&bar[XB_XCNT(b.x)], 1u);
    return b;
}
__device__ __forceinline__ void xcd_barrier_complete(unsigned* bar, unsigned x, unsigned& nloc, unsigned& nx) {
    const unsigned G = gridDim.x * gridDim.y * gridDim.z;
    unsigned sum, cnt, mine, sp = 0u;
    for (;;) {
        sum = 0u; cnt = 0u; mine = 0u;
#pragma unroll
        for (unsigned j = 0; j < 16; ++j) { const unsigned c = xb_ld(&bar[XB_XCNT(j)]); sum += c; cnt += (c > 0u) ? 1u : 0u; mine = (j == x) ? c : mine; }
        if (sum == G) break;
        __builtin_amdgcn_s_sleep(1);
        if ((++sp & 255u) == 0u) { if (xb_ld(&bar[XB_TMO])) break; if (sp > XB_SPIN_CAP) { atomicAdd(&bar[XB_TMO], 1u); break; } }
    }
    nloc = mine > 0u ? mine : 1u; nx = cnt > 0u ? cnt : 1u;
}
__device__ __forceinline__ void xcd_barrier(const XcdBarrier& b) {
    asm volatile("s_waitcnt vmcnt(0)" ::: "memory");
    __syncthreads();
    if (threadIdx.x == 0) {
        unsigned* bar = b.bar;
        __builtin_amdgcn_s_waitcnt(0);
        unsigned nloc = b.st[0], nx = b.st[1];
        if (nloc == 0u) { xcd_barrier_complete(bar, b.x, nloc, nx); b.st[0] = nloc; b.st[1] = nx; }
        const unsigned old = xb_add(&bar[XB_XSUB(b.x)], 1u);
        const unsigned gen = old / nloc;
        if (old + 1u == (gen + 1u) * nloc) {
            __builtin_amdgcn_fence(__ATOMIC_RELEASE, "agent");
            asm volatile("s_waitcnt vmcnt(0)" ::: "memory");
            const unsigned og = xb_add(&bar[XB_TOP], 1u);
            const unsigned tg = og / nx;
            if (og + 1u == (tg + 1u) * nx) xb_add(&bar[XB_TOPGEN], 1u);
            else XB_SPIN(xb_ld(&bar[XB_TOPGEN]) == tg, bar);
            __builtin_amdgcn_fence(__ATOMIC_ACQUIRE, "agent");
            xb_add(&bar[XB_XGEN(b.x)], 1u);
            asm volatile("s_waitcnt vmcnt(0)" ::: "memory");
        } else {
            XB_SPIN(xb_ld(&bar[XB_XGEN(b.x)]) == gen, bar);
            __builtin_amdgcn_fence(__ATOMIC_ACQUIRE, "agent");
            asm volatile("s_waitcnt vmcnt(0)" ::: "memory");
        }
    }
    __syncthreads();
}

__device__ __forceinline__ void router_phase(KParams p, LAS unsigned char* lds, int wave, int lane, int* cnt, int* lists, float* roww) {
    const float* x2 = p->out;
    const float* bg = p->in[22]; const float* be = p->in[24];
    constexpr int RP = 2064;
    { const u32x4* src = WSP(u32x4, WS_RW); LAS u32x4* dst = (LAS u32x4*)lds;
      for (int i = threadIdx.x; i < 2 * 36 * RP / 16; i += NWAVES * 64) dst[i] = src[i]; }
    __syncthreads();
    const int tok = lane & 15, kq = lane >> 4;
    LAS unsigned char* wh = lds + tok * RP + kq * 16; LAS unsigned char* wl = wh + 36 * RP;
    const bool t2 = tok < 4;
    for (int item = blockIdx.x * NWAVES + wave; item < T_TOK / 16; item += gridDim.x * NWAVES) {
        const int t0 = item * 16;
        const float* xr = x2 + (size_t)(t0 + tok) * 1024 + 8 * kq;
        f32x4 c[3]; c[0] = (f32x4){0.f, 0.f, 0.f, 0.f}; c[1] = c[0]; c[2] = c[0]; float ss = 0.f;
#pragma unroll 8
        for (int ks = 0; ks < 32; ++ks) {
            const f32x4 xa = *(const f32x4*)(xr + 32 * ks), xb = *(const f32x4*)(xr + 32 * ks + 4);
            ss += fx::sq4(xa) + fx::sq4(xb);
            u32x4 hw = fx::pack8(xa, xb);
            const f32x4 ha = {__uint_as_float(hw.x << 16), __uint_as_float(hw.x & 0xffff0000u), __uint_as_float(hw.y << 16), __uint_as_float(hw.y & 0xffff0000u)};
            const f32x4 hb = {__uint_as_float(hw.z << 16), __uint_as_float(hw.z & 0xffff0000u), __uint_as_float(hw.w << 16), __uint_as_float(hw.w & 0xffff0000u)};
            u32x4 lw = fx::pack8(xa - ha, xb - hb);
            const bf16x8 xh = *reinterpret_cast<bf16x8*>(&hw), xl = *reinterpret_cast<bf16x8*>(&lw);
#pragma unroll
            for (int t = 0; t < 3; ++t) {
                bf16x8 ah, al;
                if (t < 2) { ah = *(const LAS bf16x8*)(wh + t * 16 * RP + ks * 64); al = *(const LAS bf16x8*)(wl + t * 16 * RP + ks * 64); }
                else { ah = *(const LAS bf16x8*)(wh + (t2 ? 32 * RP : 0) + ks * 64); al = *(const LAS bf16x8*)(wl + (t2 ? 32 * RP : 0) + ks * 64);
                       if (!t2) { ah = (bf16x8){0, 0, 0, 0, 0, 0, 0, 0}; al = ah; } }
                c[t] = __builtin_amdgcn_mfma_f32_16x16x32_bf16(ah, xh, c[t], 0, 0, 0);
                c[t] = __builtin_amdgcn_mfma_f32_16x16x32_bf16(ah, xl, c[t], 0, 0, 0);
                c[t] = __builtin_amdgcn_mfma_f32_16x16x32_bf16(al, xh, c[t], 0, 0, 0);
            }
        }
        ss = fx::quad_sum(ss);
        const float rs = rsqrtf(ss * (1.f / 1024.f) + EPS);
#pragma unroll
        for (int t = 0; t < 3; ++t) c[t] = c[t] * rs;
        float g[4];
#pragma unroll
        for (int r = 0; r < 4; ++r) g[r] = __shfl(c[0][r], tok);
        const float mx = fmaxf(fmaxf(g[0], g[1]), fmaxf(g[2], g[3]));
        float den = 0.f;
#pragma unroll
        for (int j = 0; j < 4; ++j) den += expf(g[j] - mx);
        int gs = 0; float best = g[0] + bg[0], lgs = g[0];
#pragma unroll
        for (int j = 1; j < 4; ++j) { const float v = g[j] + bg[j]; if (v > best) { best = v; gs = j; lgs = g[j]; } }
        const float gw = expf(lgs - mx) / den;
        const int qA = 1 + 2 * gs, qB = qA + 1;
        f32x4 sA = (qA >> 2) == 0 ? c[0] : ((qA >> 2) == 1 ? c[1] : c[2]);
        f32x4 sB = (qB >> 2) == 0 ? c[0] : ((qB >> 2) == 1 ? c[1] : c[2]);
        float el[8];
#pragma unroll
        for (int r = 0; r < 4; ++r) { el[r] = __shfl(sA[r], tok + 16 * (qA & 3)); el[4 + r] = __shfl(sB[r], tok + 16 * (qB & 3)); }
        float emx = el[0];
#pragma unroll
        for (int j = 1; j < 8; ++j) emx = fmaxf(emx, el[j]);
        float eden = 0.f;
#pragma unroll
        for (int j = 0; j < 8; ++j) eden += expf(el[j] - emx);
        float sc[8];
#pragma unroll
        for (int j = 0; j < 8; ++j) sc[j] = el[j] + be[gs * 8 + j];
        int i0 = 0; float b0 = sc[0], e0v = el[0];
#pragma unroll
        for (int j = 1; j < 8; ++j) if (sc[j] > b0) { b0 = sc[j]; i0 = j; e0v = el[j]; }
        int i1 = -1; float b1 = -3.0e38f, e1v = 0.f;
#pragma unroll
        for (int j = 0; j < 8; ++j) if (j != i0 && sc[j] > b1) { b1 = sc[j]; i1 = j; e1v = el[j]; }
        LAS int* hist = (LAS int*)(lds + 2 * 36 * RP + 128); LAS int* hbase = hist + 64;
        if (threadIdx.x < 64) hist[threadIdx.x] = 0;
        __syncthreads();
        const float p0 = expf(e0v - emx) / eden, p1 = expf(e1v - emx) / eden, sm = p0 + p1;
        const int sg0 = gs * 8 + i0, sg1 = 32 + gs * 8 + i1;
        int r0 = 0, r1 = 0;
        if (kq == 0) { r0 = __hip_atomic_fetch_add(hist + sg0, 1, __ATOMIC_RELAXED, __HIP_MEMORY_SCOPE_WORKGROUP); r1 = __hip_atomic_fetch_add(hist + sg1, 1, __ATOMIC_RELAXED, __HIP_MEMORY_SCOPE_WORKGROUP); }
        __syncthreads();
        if (threadIdx.x < 64) { const int n = hist[threadIdx.x]; hbase[threadIdx.x] = n > 0 ? atomicAdd(cnt + threadIdx.x, n) : 0; }
        __syncthreads();
        if (kq == 0) {
            const int t = t0 + tok; const int q0 = hbase[sg0] + r0, q1 = hbase[sg1] + r1;
            lists[(size_t)sg0 * fx::MOE_CAP + q0] = t; roww[(size_t)sg0 * fx::MOE_CAP + q0] = p0 / sm * gw;
            lists[(size_t)sg1 * fx::MOE_CAP + q1] = t; roww[(size_t)sg1 * fx::MOE_CAP + q1] = p1 / sm * gw;
        }
    }
    __syncthreads();
}

__global__ void __launch_bounds__(NWAVES * 64, 2) mk_fwd(Params p_arg) {
    KParams p = (KParams)__builtin_amdgcn_kernarg_segment_ptr();
    extern __shared__ __attribute__((aligned(16))) unsigned char lds_raw[];
    LAS unsigned char* lds = (LAS unsigned char*)lds_raw;
    LAS unsigned char* xl = lds + XL_OFF;
    const int tid = threadIdx.x, lane = tid & 63, wave = __builtin_amdgcn_readfirstlane(tid >> 6);
    const int lo = p->ph_lo, hi = p->ph_hi;
#ifndef PHMASK
#define PHMASK 0xffffffffu
#endif
#define IN(k) (((PHMASK >> (k)) & 1u) && lo <= (k) && (k) < hi)
#define SEAM(k) do { if (IN(k) && IN((k) + 1)) { xcd_barrier(xbar); if (DUP == 1000) xcd_barrier(xbar); } } while (0)
    volatile LAS unsigned* xst = (volatile LAS unsigned*)(lds + XST_OFF);
    if (tid == 0) { xst[0] = 0u; xst[1] = 0u; }
    __syncthreads();
    XcdBarrier xbar = xcd_barrier_post(WSP(unsigned, WS_BAR), xst);
    if (lo < 0) cg::this_grid().sync();
    float* const dummyf = WSP(float, 512 * 1024);
    REPS(0) if (IN(0)) { p0_prologue(p, lds, wave, lane); }
    SEAM(0);
    if (IN(1)) {
        REPS(1) {
        pg8::GridOrder S; S.init(WSP(bf16_t, WS_HB), 1024, WSP(bf16_t, WB_IN), 1024, T_TOK, 2560, gridDim.x, blockIdx.x);
        fx::EpiInProj E{WSP(bf16_t, WS_CQ), WSP(bf16_t, WS_CKV), WSP(bf16_t, WS_RQ), WSP(bf16_t, WS_RK), WSP(bf16_t, WS_RV), WSP(bf16_t, WS_RG),
                        rep ? dummyf : WSP(float, WS_SSQ_CQ), rep ? dummyf : WSP(float, WS_SSQ_CKV), rep ? dummyf : WSP(float, WS_SSQ_KPE), WSP(float, WS_CS), p->in[10]};
        pg8::gemm_phase<fx::EpiInProj, pg8::GridOrder>(lds, xl, 1024, 1024, 1024, S, E); }
        REPS(101) { fx::MemKVOrder S2{(int)gridDim.x, (int)blockIdx.x, (const char*)WSP(bf16_t, WS_MB), (const char*)WSP(bf16_t, WB_CKV)};
          fx::EpiMemKV E2{WSP(bf16_t, WS_KC), WSP(bf16_t, WS_VC), p->in[18]};
          pg8::gemm_phase<fx::EpiMemKV, fx::MemKVOrder>(lds, xl, 1024, 1024, 1024, S2, E2); }
    }
    SEAM(1);
    if (IN(2)) {
        REPS(2) {
        { pg8::GridOrder S; S.init(WSP(bf16_t, WS_CQ), 256, WSP(bf16_t, WB_UQ), 256, T_TOK, 1024, gridDim.x, blockIdx.x);
          fx::EpiMlaQ E{WSP(bf16_t, WS_QM), WSP(float, WS_SSQ_CQ), p->in[9], WSP(float, WS_CS)};
          pg8::gemm_phase<fx::EpiMlaQ, pg8::GridOrder>(lds, xl, 256, 256, 256, S, E); }
        { pg8::GridOrder S; S.init(WSP(bf16_t, WS_CKV), 256, WSP(bf16_t, WB_UKV), 256, T_TOK, 1024, gridDim.x, blockIdx.x);
          fx::EpiMlaKV E{WSP(bf16_t, WS_KM), WSP(bf16_t, WS_VM), WSP(bf16_t, WS_CKV), WSP(float, WS_SSQ_CKV), WSP(float, WS_SSQ_KPE), p->in[10]};
          pg8::gemm_phase<fx::EpiMlaKV, pg8::GridOrder>(lds, xl, 256, 256, 256, S, E); } }
        REPS(201) rt::ret_kv_phase(WSP(bf16_t, WS_RK), WSP(bf16_t, WS_RV), WSP(bf16_t, WS_KVS), (char*)lds_raw);
    }
    SEAM(2);
    if (IN(3)) { REPS(3) at::attn_phase(WSP(bf16_t, WS_QM), WSP(bf16_t, WS_KM), WSP(bf16_t, WS_VM), WSP(bf16_t, WS_AO), (char*)lds_raw);
                 REPS(301) rt::ret_out_phase(WSP(bf16_t, WS_RQ), WSP(bf16_t, WS_RK), WSP(bf16_t, WS_RV), WSP(bf16_t, WS_RG), WSP(bf16_t, WS_KVS), p->in[11], WSP(bf16_t, WS_AO), (char*)lds_raw); }
    SEAM(3);
    if (IN(4)) for (int rep = 0; rep < ((DUP == 4 || DUP == 1004 + 1000) ? 2 : 1); ++rep) {
        pg8::GridOrder S; S.init(WSP(bf16_t, WS_AO), 1024, WSP(bf16_t, WB_OUT), 1024, T_TOK, 1024, gridDim.x, blockIdx.x);
        fx::EpiResid<false, false> E{p->in[0], p->out, WSP(bf16_t, WS_XB), rep ? ((DUP == 4) ? dummyf : (float*)nullptr) : WSP(float, WS_SSQ1)};
        pg8::gemm_phase<fx::EpiResid<false, false>, pg8::GridOrder>(lds, xl, 1024, 1024, 1024, S, E);
    }
    SEAM(4);
    if (IN(5)) REPS(5) {
        pg8::GridOrder S; S.init(WSP(bf16_t, WS_XB), 1024, WSP(bf16_t, WB_CQ), 1024, T_TOK, 1024, gridDim.x, blockIdx.x);
        fx::EpiHeadNorm E{WSP(bf16_t, WS_QC), WSP(float, WS_SSQ1), p->in[17], 1.f / 1024.f};
        pg8::gemm_phase<fx::EpiHeadNorm, pg8::GridOrder>(lds, xl, 1024, 1024, 1024, S, E);
    }
    SEAM(5);
    if (IN(6)) REPS(6) {
        fx::HeadOrder S{(int)gridDim.x, (int)blockIdx.x, 512, (const char*)WSP(bf16_t, WS_QC), (const char*)WSP(bf16_t, WS_KC), (size_t)256 * 1024 * 2, (size_t)256 * 2, (size_t)256 * 1024 * 2, (size_t)256 * 2};
        fx::EpiSoftmax E{WSP(bf16_t, WS_PC)};
        pg8::gemm_phase<fx::EpiSoftmax, fx::HeadOrder>(lds, xl, 1024, 1024, 256, S, E);
    }
    SEAM(6);
    if (IN(7)) REPS(7) {
        fx::HeadOrder S{(int)gridDim.x, (int)blockIdx.x, 512, (const char*)WSP(bf16_t, WS_PC), (const char*)WSP(bf16_t, WS_VC), (size_t)256 * 1024 * 2, (size_t)256 * 2, (size_t)1024 * 256 * 2, (size_t)256 * 256 * 2};
        fx::EpiStoreBf16 E{WSP(bf16_t, WS_OC), 1024, 0};
        pg8::gemm_phase<fx::EpiStoreBf16, fx::HeadOrder>(lds, xl, 1024, 256, 256, S, E);
    }
    SEAM(7);
    if (IN(8)) {
        pg8::GridOrder S; S.init(WSP(bf16_t, WS_OC), 1024, WSP(bf16_t, WB_CO), 1024, T_TOK, 1024, gridDim.x, blockIdx.x);
        fx::EpiResid<true, true> E{nullptr, p->out, WSP(bf16_t, WS_XB), WSP(float, WS_SSQ2)};
        pg8::gemm_phase<fx::EpiResid<true, true>, pg8::GridOrder>(lds, xl, 1024, 1024, 1024, S, E);
    }
    SEAM(8);
    if (IN(9)) REPS(9) { router_phase(p, lds, wave, lane, rep ? WSP(int, 32 * 1024) : WSP(int, WS_CNT), rep ? WSP(int, WS_AO) : WSP(int, WS_LISTS), rep ? WSP(float, WS_AO + 8 * MiB) : WSP(float, WS_ROWW)); }
    SEAM(9);
    if (IN(10)) REPS(10) {
        fx::MoeOrder S{(int)gridDim.x, (int)blockIdx.x, 0, 64, 2, WSP(int, WS_CNT), WSP(int, WS_LISTS), (const char*)WSP(bf16_t, WS_XB), (const char*)WSP(bf16_t, WB_GU), 0, (size_t)512 * 1024 * 2, (size_t)256 * 1024 * 2};
        fx::EpiGlu E{WSP(bf16_t, WS_H), WSP(float, WS_SSQ2), WSP(float, WS_ROWW), WSP(int, WS_LISTS)};
        pg8::gemm_phase<fx::EpiGlu, fx::MoeOrder, true>(lds, xl, 1024, 1024, 1024, S, E);
    }
    SEAM(10);
    if (IN(11)) {
        fx::MoeOrder S{(int)gridDim.x, (int)blockIdx.x, 0, 32, 4, WSP(int, WS_CNT), WSP(int, WS_LISTS), (const char*)WSP(bf16_t, WS_H), (const char*)WSP(bf16_t, WB_D), (size_t)256 * 256 * 2, (size_t)1024 * 256 * 2, (size_t)256 * 256 * 2};
        fx::EpiScatter<0> E{p->out, WSP(bf16_t, WS_Y0)};
        pg8::gemm_phase<fx::EpiScatter<0>, fx::MoeOrder>(lds, xl, 256, 256, 256, S, E);
    }
    SEAM(11);
    if (IN(12)) {
        fx::MoeOrder S{(int)gridDim.x, (int)blockIdx.x, 32, 64, 4, WSP(int, WS_CNT), WSP(int, WS_LISTS), (const char*)WSP(bf16_t, WS_H), (const char*)WSP(bf16_t, WB_D), (size_t)256 * 256 * 2, (size_t)1024 * 256 * 2, (size_t)256 * 256 * 2};
        fx::EpiScatter<1> E{p->out, WSP(bf16_t, WS_Y0)};
        pg8::gemm_phase<fx::EpiScatter<1>, fx::MoeOrder>(lds, xl, 256, 256, 256, S, E);
    }
#undef IN
#undef SEAM
}

extern "C" void kernel_launch(void* const* d_in, const int* in_sizes, int n_in, void* d_out, int out_size, void* d_ws, size_t ws_size, hipStream_t stream) {
    static int grid = 0;
    if (grid == 0) {
        if (n_in != 28 || out_size != T_TOK * 1024 || ws_size < WS_NEED) { fprintf(stderr, "kernel_launch: unexpected shapes n_in %d out %d ws %zu\n", n_in, out_size, ws_size); grid = -1; return; }
        int dev = 0, cus = 0, per_cu = 0;
        if (hipGetDevice(&dev) != hipSuccess || hipDeviceGetAttribute(&cus, hipDeviceAttributeMultiprocessorCount, dev) != hipSuccess) { grid = -1; return; }
        if (hipFuncSetAttribute((const void*)mk_fwd, hipFuncAttributeMaxDynamicSharedMemorySize, LDS_BYTES) != hipSuccess) { fprintf(stderr, "hipFuncSetAttribute failed\n"); grid = -1; return; }
        if (hipOccupancyMaxActiveBlocksPerMultiprocessor(&per_cu, (const void*)mk_fwd, NWAVES * 64, LDS_BYTES) != hipSuccess || per_cu < 1) { fprintf(stderr, "occupancy query failed (%d)\n", per_cu); grid = -1; return; }
        grid = cus;
        (void)hipGetLastError();
    }
    if (grid < 0) return;
    if (hipMemsetAsync(d_ws, 0, 65536, stream) != hipSuccess) { fprintf(stderr, "hipMemsetAsync failed\n"); return; }
    Params p; memset(&p, 0, sizeof(p));
    for (int i = 0; i < 28; ++i) p.in[i] = (const float*)d_in[i];
    p.out = (float*)d_out; p.ws = (unsigned char*)d_ws; p.ph_lo = 0; p.ph_hi = 13; p.coop = 1;
    void* args[] = {&p};
    hipError_t e = hipLaunchCooperativeKernel((const void*)mk_fwd, dim3(grid), dim3(NWAVES * 64), args, LDS_BYTES, stream);
    if (e != hipSuccess) fprintf(stderr, "cooperative launch failed: %s (grid %d)\n", hipGetErrorString(e), grid);
}
```

```cpp
#include <hip/hip_runtime.h>
#include <hip/hip_cooperative_groups.h>
#include <cstdint>
#include <cstdio>
#include <cmath>
#include <cstring>

typedef unsigned short bf16_t;
constexpr float EPS = 1e-6f;
constexpr int T_TOK = 32768;
__device__ __forceinline__ float bf2f(bf16_t h) { return __uint_as_float((unsigned)h << 16); }
__device__ __forceinline__ bf16_t f2bf(float f) { const unsigned u = __float_as_uint(f); return (bf16_t)((u + 0x7fffu + ((u >> 16) & 1u)) >> 16); }

constexpr size_t MiB = (size_t)1 << 20;
constexpr size_t WS_CTL = 0;
constexpr size_t WS_SSQ_CQ = 1 * MiB, WS_SSQ_CKV = WS_SSQ_CQ + 128 * 1024, WS_SSQ_KPE = WS_SSQ_CKV + 128 * 1024, WS_SSQ1 = WS_SSQ_KPE + 128 * 1024, WS_SSQ2 = WS_SSQ1 + 128 * 1024;
constexpr size_t WS_SEL = 2 * MiB, WS_WTS = WS_SEL + 256 * 1024;
constexpr size_t WS_RW = 4 * MiB;
constexpr size_t WS_CS = 5 * MiB;
constexpr size_t WS_MB = 21 * MiB, WS_KC = 25 * MiB, WS_VC = 29 * MiB;
constexpr size_t WS_WB = 33 * MiB;
constexpr size_t WS_RQ = 97 * MiB, WS_RK = 129 * MiB, WS_RV = 161 * MiB, WS_RG = 193 * MiB;
constexpr size_t WS_HB = 225 * MiB;
constexpr size_t WS_QM = 225 * MiB, WS_KM = 273 * MiB, WS_VM = 321 * MiB;
constexpr size_t WS_KVS = 353 * MiB;
constexpr size_t WS_AO = 385 * MiB;
constexpr size_t WS_CQ = 449 * MiB, WS_CKV = 465 * MiB;
constexpr size_t WS_PJ = 289 * MiB;
constexpr size_t WS_RAW = 353 * MiB;
constexpr size_t WS_XB = 97 * MiB;
constexpr size_t WS_QCR = 161 * MiB;
constexpr size_t WS_PC = 161 * MiB;
constexpr size_t WS_QC = 225 * MiB;
constexpr size_t WS_OC = 289 * MiB;
constexpr size_t WS_KVR = 353 * MiB;
constexpr size_t WS_BAR = 16 * 1024;
constexpr size_t WS_CNT = 64 * 1024;
constexpr size_t WS_LISTS = 353 * MiB, WS_ROWW = 361 * MiB;
constexpr size_t WS_Y0 = 225 * MiB;
constexpr size_t WS_H = 161 * MiB;
constexpr size_t WS_NEED = 481 * MiB;
#define LAS __attribute__((address_space(3)))
typedef short bf16x8 __attribute__((ext_vector_type(8)));
typedef float f32x4 __attribute__((ext_vector_type(4)));
typedef float f32x2 __attribute__((ext_vector_type(2)));
typedef unsigned u32x4 __attribute__((ext_vector_type(4)));
typedef unsigned u32x2 __attribute__((ext_vector_type(2)));

namespace pg8 {
constexpr int BM = 256, BK = 64, HALF = 128, HTB = HALF * BK * 2, STAGE_BYTES = 8 * HTB, NXCD = 8, WGM = 8;
__host__ __device__ __forceinline__ int lds_byte(int r, int c) { const int st = (r >> 4) * 2 + (c >> 5), rr = r & 15, cc = c & 31, ob = rr * 64 + cc * 2; return st * 1024 + (ob ^ (((ob >> 9) & 1) << 5)); }
__host__ __device__ __forceinline__ void stage_rc(int b, int& R, int& C) { const int st = b / 1024, sb = b % 1024, swz = sb ^ (((sb >> 9) & 1) << 5); R = (st >> 1) * 16 + swz / 64; C = (st & 1) * 32 + (swz % 64) / 2; }
__host__ __device__ __forceinline__ int perm32(int rho) { const int n = rho >> 4, i = rho & 15; return 8 * (i >> 2) + 4 * n + (i & 3); }
__device__ __forceinline__ unsigned cvt_pk_bf16(float lo, float hi) { unsigned r; asm volatile("v_cvt_pk_bf16_f32 %0, %1, %2" : "=v"(r) : "v"(lo), "v"(hi)); return r; }

struct Unit { int pm, pn; const char* a; const char* b; const int* rows; int nvalid, seg; };

struct GridOrder {
    int nM, nN, nwg, G, c; const char* A; const char* B; size_t strideA, strideB;
    __device__ __forceinline__ void init(const bf16_t* A_, int lda, const bf16_t* B_, int ldb, int M, int N, int G_, int c_) {
        nM = M / BM; nN = N / BM; nwg = nM * nN; G = G_; c = c_; A = (const char*)A_; B = (const char*)B_; strideA = (size_t)BM * lda * 2; strideB = (size_t)BM * ldb * 2; }
    __device__ __forceinline__ bool next(int i, Unit& u) const {
        const long L = (long)i * G + c; if (L >= nwg) return false;
        int wgid = (int)L; { const int q = nwg / NXCD, r = nwg % NXCD, xcd = wgid % NXCD, off = wgid / NXCD; wgid = (xcd < r ? xcd * (q + 1) : r * (q + 1) + (xcd - r) * q) + off; }
        const int nig = WGM * nN, gid = wgid / nig, fm = gid * WGM, gsz = (nM - fm) < WGM ? (nM - fm) : WGM;
        u.pm = fm + ((wgid % nig) % gsz); u.pn = (wgid % nig) / gsz; u.a = A + (size_t)u.pm * strideA; u.b = B + (size_t)u.pn * strideB; u.rows = nullptr; u.nvalid = 256; u.seg = 0; return true;
    }
};

#define XBAR() do { asm volatile("s_waitcnt lgkmcnt(0)" ::: "memory"); __builtin_amdgcn_s_barrier(); asm volatile("" ::: "memory"); } while (0)

__device__ __forceinline__ void row_allreduce_sum(float (&s)[2][4], int wr, int wc, int fr, int fq, LAS unsigned char* xl) {
    LAS float* P = (LAS float*)xl;
#pragma unroll
    for (int ai = 0; ai < 2; ++ai)
#pragma unroll
        for (int m = 0; m < 4; ++m) { float v = s[ai][m]; v += __shfl_xor(v, 16); v += __shfl_xor(v, 32); if (fq == 0) P[(ai * HALF + wr * 64 + m * 16 + fr) * 4 + wc] = v; }
    XBAR();
#pragma unroll
    for (int ai = 0; ai < 2; ++ai)
#pragma unroll
        for (int m = 0; m < 4; ++m) { const f32x4 p = *(const LAS f32x4*)(P + (ai * HALF + wr * 64 + m * 16 + fr) * 4); s[ai][m] = (p[0] + p[1]) + (p[2] + p[3]); }
    XBAR();
}
__device__ __forceinline__ void row_allreduce_max(float (&s)[2][4], int wr, int wc, int fr, int fq, LAS unsigned char* xl) {
    LAS float* P = (LAS float*)xl;
#pragma unroll
    for (int ai = 0; ai < 2; ++ai)
#pragma unroll
        for (int m = 0; m < 4; ++m) { float v = s[ai][m]; v = fmaxf(v, __shfl_xor(v, 16)); v = fmaxf(v, __shfl_xor(v, 32)); if (fq == 0) P[(ai * HALF + wr * 64 + m * 16 + fr) * 4 + wc] = v; }
    XBAR();
#pragma unroll
    for (int ai = 0; ai < 2; ++ai)
#pragma unroll
        for (int m = 0; m < 4; ++m) { const f32x4 p = *(const LAS f32x4*)(P + (ai * HALF + wr * 64 + m * 16 + fr) * 4); s[ai][m] = fmaxf(fmaxf(p[0], p[1]), fmaxf(p[2], p[3])); }
    XBAR();
}

template <class Epi, class Sched, bool GATHER = false>
__device__ __forceinline__ void gemm_phase(LAS unsigned char* lds, LAS unsigned char* xl, int lda, int ldb, int K, const Sched& S, const Epi& E) {
    const int tid = threadIdx.x, wid = __builtin_amdgcn_readfirstlane(tid >> 6), lane = tid & 63, wr = wid >> 2, wc = wid & 3, fr = lane & 15, fq = lane >> 4;
    asm volatile("" : "+s"(K));
    const int nt = K / BK;
    int sR[2], sC[2];
    unsigned voffA[2], voffB[2];
#pragma unroll
    for (int i = 0; i < 2; ++i) { int R, C; stage_rc(tid * 16 + i * 8192, R, C); const int Rb = Epi::PERM ? ((R & ~31) + perm32(R & 31)) : R; sR[i] = R; sC[i] = C;
        voffA[i] = (unsigned)(R * lda + C) * 2u; voffB[i] = (unsigned)(Rb * ldb + C) * 2u; }
    const size_t kstep = (size_t)(BK * 2);
    const size_t hstepA = (size_t)HALF * lda * 2, hstepB = (size_t)HALF * ldb * 2;
    const unsigned ldsw = (unsigned)wid * 1024u;
    const int aoff = lds_byte(wr * 64 + fr, fq * 8), boff = lds_byte(wc * 32 + fr, fq * 8);
#define PG8_SA(b, h) (((b) * 2 + (h)) * HTB)
#define PG8_SB(b, h) ((4 + (b) * 2 + (h)) * HTB)
#define PG8_STAGE(bufoff, gbase, voff) do { _Pragma("unroll") for (int _i = 0; _i < 2; ++_i) \
        __builtin_amdgcn_global_load_lds((const unsigned*)((const char*)(gbase) + (voff)[_i]), (LAS unsigned*)(lds + (bufoff) + ldsw + _i * 8192), 16, 0, 0); } while (0)
#define PG8_LDA(dst, b, h) do { _Pragma("unroll") for (int m = 0; m < 4; ++m) _Pragma("unroll") for (int k = 0; k < 2; ++k) dst[m][k] = *(const LAS bf16x8*)(lds + PG8_SA(b, h) + aoff + m * 2048 + k * 1024); } while (0)
#define PG8_LDB(dst, b, h) do { _Pragma("unroll") for (int n = 0; n < 2; ++n) _Pragma("unroll") for (int k = 0; k < 2; ++k) dst[n][k] = *(const LAS bf16x8*)(lds + PG8_SB(b, h) + boff + n * 2048 + k * 1024); } while (0)
#define PG8_MMA(ai, bj, At, Bt) do { __builtin_amdgcn_s_setprio(1); _Pragma("unroll") for (int m = 0; m < 4; ++m) _Pragma("unroll") for (int n = 0; n < 2; ++n) _Pragma("unroll") for (int k = 0; k < 2; ++k) \
        acc[ai][bj][m][n] = __builtin_amdgcn_mfma_f32_16x16x32_bf16(Bt[n][k], At[m][k], acc[ai][bj][m][n], 0, 0, 0); __builtin_amdgcn_s_setprio(0); } while (0)
#define PG8_WAIT_V(n) asm volatile("s_waitcnt vmcnt(" #n ")" ::: "memory")
#define PG8_WAIT_L(n) asm volatile("s_waitcnt lgkmcnt(" #n ")" ::: "memory")
#define PG8_BAR __builtin_amdgcn_s_barrier()
#define PG8_SCHED __builtin_amdgcn_sched_barrier(0)
    LAS unsigned char* gl = xl + 8192 + tid * 16;
    int gA0 = 0, gA1 = 8192;
#define PG8_GATH(T, u) do { u32x4 _o; { int _r[4]; _Pragma("unroll") for (int _q = 0; _q < 4; ++_q) { const int _rl = (_q >> 1) * HALF + sR[_q & 1]; _r[_q] = (_rl < (u).nvalid) ? (u).rows[_rl] : 0; } \
        _Pragma("unroll") for (int _q = 0; _q < 4; ++_q) _o[_q] = (unsigned)(_r[_q] * lda + sC[_q & 1]) * 2u; } *(LAS u32x4*)(gl + (T)) = _o; } while (0)
#define PG8_STAGE_A(bufoff, base, h, kbytes, G4) do { if constexpr (GATHER) { const u32x2 _g = {(G4)[2 * (h)], (G4)[2 * (h) + 1]}; PG8_STAGE(bufoff, (base) + (kbytes), _g); } else { PG8_STAGE(bufoff, (base) + (size_t)(h) * hstepA + (kbytes), voffA); } } while (0)
    Unit cur, nxt; int ui = 0;
    if (!S.next(0, cur)) return;
    f32x4 acc[2][2][4][2];
#pragma unroll
    for (int a = 0; a < 2; ++a)
#pragma unroll
        for (int b = 0; b < 2; ++b)
#pragma unroll
            for (int m = 0; m < 4; ++m)
#pragma unroll
                for (int n = 0; n < 2; ++n) acc[a][b][m][n] = (f32x4){0.f, 0.f, 0.f, 0.f};
    bf16x8 At[4][2], B0[2][2], B1[2][2];
    const char* cA = cur.a; const char* cB = cur.b;
    u32x4 gcur = {0u, 0u, 0u, 0u};
    if constexpr (GATHER) { PG8_GATH(gA0, cur); gcur = *(const LAS u32x4*)(gl + gA0); }
    PG8_STAGE(PG8_SB(0, 0), cB, voffB); PG8_STAGE(PG8_SB(0, 1), cB + hstepB, voffB); PG8_STAGE_A(PG8_SA(0, 0), cA, 0, 0, gcur); PG8_STAGE_A(PG8_SA(0, 1), cA, 1, 0, gcur);
    if (wr == 1) PG8_BAR;
    PG8_WAIT_V(2); PG8_BAR;
    PG8_STAGE(PG8_SB(1, 0), cB + kstep, voffB); PG8_STAGE_A(PG8_SA(1, 0), cA, 0, kstep, gcur); PG8_STAGE(PG8_SB(1, 1), cB + hstepB + kstep, voffB);
    PG8_WAIT_V(6); PG8_BAR;
    for (;;) {
        const bool has_next = S.next(ui + 1, nxt);
        const char* nA = has_next ? nxt.a : cA; const char* nB = has_next ? nxt.b : cB;
        if constexpr (GATHER) { if (has_next) { PG8_GATH(gA1, nxt); } else { PG8_GATH(gA1, cur); } }
#pragma unroll 1
        for (int t = 0; t < nt; t += 2) {
            const bool last = (t == nt - 2);
            const size_t k1 = (size_t)(t + 1) * kstep;
            const char* a2 = last ? nA : cA; const char* b2 = last ? nB : cB + (size_t)(t + 2) * kstep;
            const size_t ka2 = last ? 0 : (size_t)(t + 2) * kstep;
            const char* b3 = b2 + kstep; const size_t ka3 = ka2 + kstep;
            u32x4 gq = gcur; if constexpr (GATHER) { if (last) gq = *(const LAS u32x4*)(gl + gA1); }
            PG8_LDB(B0, 0, 0); PG8_LDB(B1, 0, 1); PG8_SCHED; PG8_LDA(At, 0, 0); PG8_STAGE_A(PG8_SA(1, 1), cA, 1, k1, gcur);
            PG8_WAIT_V(8); PG8_WAIT_L(0); PG8_BAR; PG8_MMA(0, 0, At, B0); PG8_MMA(0, 1, At, B1); PG8_BAR; PG8_SCHED;
            PG8_LDA(At, 0, 1); PG8_STAGE(PG8_SB(0, 0), b2, voffB); PG8_STAGE(PG8_SB(0, 1), b2 + hstepB, voffB);
            PG8_STAGE_A(PG8_SA(0, 0), a2, 0, ka2, gq);
            PG8_WAIT_V(8); PG8_WAIT_L(0); PG8_BAR; PG8_MMA(1, 0, At, B0); PG8_MMA(1, 1, At, B1); PG8_BAR; PG8_SCHED;
            PG8_LDB(B0, 1, 0); PG8_LDB(B1, 1, 1); PG8_SCHED; PG8_LDA(At, 1, 0);
            PG8_STAGE_A(PG8_SA(0, 1), a2, 1, ka2, gq);
            PG8_WAIT_V(8); PG8_WAIT_L(0); PG8_BAR; PG8_MMA(0, 0, At, B0); PG8_MMA(0, 1, At, B1); PG8_BAR; PG8_SCHED;
            PG8_LDA(At, 1, 1); PG8_STAGE(PG8_SB(1, 0), b3, voffB); PG8_STAGE(PG8_SB(1, 1), b3 + hstepB, voffB);
            PG8_STAGE_A(PG8_SA(1, 0), a2, 0, ka3, gq);
            PG8_WAIT_V(8); PG8_WAIT_L(0); PG8_BAR; PG8_MMA(1, 0, At, B0); PG8_MMA(1, 1, At, B1); PG8_BAR; PG8_SCHED;
        }
        if (wr == 0) PG8_BAR;
        E(acc, cur, wr, wc, fr, fq, xl);
        if (!has_next) break;
#pragma unroll
        for (int a = 0; a < 2; ++a)
#pragma unroll
            for (int b = 0; b < 2; ++b)
#pragma unroll
                for (int m = 0; m < 4; ++m)
#pragma unroll
                    for (int n = 0; n < 2; ++n) acc[a][b][m][n] = (f32x4){0.f, 0.f, 0.f, 0.f};
        cur = nxt; cA = nA; cB = nB; ++ui;
        if constexpr (GATHER) { gcur = *(const LAS u32x4*)(gl + gA1); const int _t = gA0; gA0 = gA1; gA1 = _t; }
        if (wr == 1) PG8_BAR;
    }
    PG8_WAIT_V(0);
    PG8_BAR;
#undef PG8_SA
#undef PG8_SB
#undef PG8_STAGE
#undef PG8_STAGE_A
#undef PG8_GATH
#undef PG8_LDA
#undef PG8_LDB
#undef PG8_MMA
#undef PG8_WAIT_V
#undef PG8_WAIT_L
#undef PG8_BAR
#undef PG8_SCHED
}
}
namespace fx {
using pg8::Unit; using pg8::cvt_pk_bf16;
constexpr int HALF = 128;
__device__ __forceinline__ u32x4 pack8(const f32x4 a, const f32x4 b) { u32x4 w; w.x = cvt_pk_bf16(a[0], a[1]); w.y = cvt_pk_bf16(a[2], a[3]); w.z = cvt_pk_bf16(b[0], b[1]); w.w = cvt_pk_bf16(b[2], b[3]); return w; }
__device__ __forceinline__ u32x2 pack4(const f32x4 a) { u32x2 w; w.x = cvt_pk_bf16(a[0], a[1]); w.y = cvt_pk_bf16(a[2], a[3]); return w; }
__device__ __forceinline__ float sq4(const f32x4 a) { return (a[0] * a[0] + a[1] * a[1]) + (a[2] * a[2] + a[3] * a[3]); }
__device__ __forceinline__ float quad_sum(float v) { v += __shfl_xor(v, 16); v += __shfl_xor(v, 32); return v; }
__device__ __forceinline__ float gamma_log2(int h) { return __log2f(1.f - exp2f(-5.f - (float)h)); }
__device__ __forceinline__ void rope4(f32x4& a, f32x4& b, const f32x4 cs0, const f32x4 cs1) {
    const f32x4 c = {cs0[0], cs0[2], cs1[0], cs1[2]}, s = {cs0[1], cs0[3], cs1[1], cs1[3]};
    const f32x4 ra = a * c - b * s, rb = b * c + a * s; a = ra; b = rb;
}

struct EpiInProj {
    static constexpr bool PERM = false;
    bf16_t *CQ, *CKV, *RQ, *RK, *RV, *RG; float *ssq_cq, *ssq_ckv, *ssq_kpe; const float* cs  ; const float* kg  ;
    __device__ __forceinline__ void operator()(f32x4 (&acc)[2][2][4][2], const Unit& u, int wr, int wc, int fr, int fq, LAS unsigned char*) const {
        asm volatile("" : "+v"(fr), "+v"(fq));
        const int row0 = u.pm * 256 + wr * 64 + fr, pn = u.pn;
        if (pn == 0) {
#pragma unroll
            for (int ai = 0; ai < 2; ++ai)
#pragma unroll
                for (int m = 0; m < 4; ++m) { const int row = row0 + ai * HALF + m * 16; float s = 0.f;
#pragma unroll
                    for (int bj = 0; bj < 2; ++bj) { s += sq4(acc[ai][bj][m][0]) + sq4(acc[ai][bj][m][1]);
                        *(u32x4*)(CQ + (size_t)row * 256 + bj * HALF + wc * 32 + 8 * fq) = pack8(acc[ai][bj][m][0], acc[ai][bj][m][1]); }
                    s = quad_sum(s); if (fq == 0) atomicAdd(ssq_cq + row, s); }
        } else if (pn == 1) {
            const int i0 = 16 * wc + 4 * fq;
            f32x4 g0 = {0.f, 0.f, 0.f, 0.f}, g1 = g0;
            if (wc < 2) { g0 = *(const f32x4*)(kg + 128 + i0); g1 = *(const f32x4*)(kg + 160 + i0); }
#pragma unroll
            for (int ai = 0; ai < 2; ++ai)
#pragma unroll
                for (int m = 0; m < 4; ++m) { const int row = row0 + ai * HALF + m * 16;
                    float s0 = sq4(acc[ai][0][m][0]) + sq4(acc[ai][0][m][1]), s1 = sq4(acc[ai][1][m][0]) + sq4(acc[ai][1][m][1]);
                    *(u32x4*)(CKV + (size_t)row * 256 + wc * 32 + 8 * fq) = pack8(acc[ai][0][m][0], acc[ai][0][m][1]);
                    s0 = quad_sum(s0); s1 = quad_sum(s1);
                    if (fq == 0) { atomicAdd(ssq_ckv + row, s0); if (wc < 2) atomicAdd(ssq_kpe + row, s1); }
                    if (wc < 2) {
                        f32x4 a = acc[ai][1][m][0] * g0, b = acc[ai][1][m][1] * g1;
                        const float* cp = cs + ((size_t)row * 64 + 2 * i0) * 2;
                        const f32x4 c0 = *(const f32x4*)(cp), c1 = *(const f32x4*)(cp + 4), c2 = *(const f32x4*)(cp + 8), c3 = *(const f32x4*)(cp + 12);
                        const f32x4 cc = {c0[0], c1[0], c2[0], c3[0]}, ss = {c0[1], c1[1], c2[1], c3[1]};
                        const f32x4 ra = a * cc - b * ss, rb = b * cc + a * ss;
                        *(u32x2*)(CKV + (size_t)row * 256 + 128 + i0) = pack4(ra); *(u32x2*)(CKV + (size_t)row * 256 + 160 + i0) = pack4(rb);
                    } else {
                        *(u32x4*)(CKV + (size_t)row * 256 + 192 + (wc - 2) * 32 + 8 * fq) = (u32x4){0u, 0u, 0u, 0u};
                    }
                    asm volatile("" ::: "memory"); __builtin_amdgcn_sched_barrier(0); }
        } else if (pn < 6) {
            bf16_t* O = (pn < 4) ? RQ : RK; const float sc = (pn < 4) ? 1.f : 0.08838834764831845f;
            const int i0 = 16 * wc + 4 * fq;
            const float sgn = (pn < 4) ? 1.f : -1.f; const float lgh[2] = {sgn * gamma_log2((pn & 1) * 2), sgn * gamma_log2((pn & 1) * 2 + 1)};
#pragma unroll
            for (int ai = 0; ai < 2; ++ai)
#pragma unroll
                for (int m = 0; m < 4; ++m) { const int row = row0 + ai * HALF + m * 16;
                    const float* cp = cs + ((size_t)row * 64 + i0) * 2;
                    const f32x4 c0 = *(const f32x4*)(cp), c1 = *(const f32x4*)(cp + 4);
#pragma unroll
                    for (int bj = 0; bj < 2; ++bj) { f32x4 a = acc[ai][bj][m][0], b = acc[ai][bj][m][1]; rope4(a, b, c0, c1); const float dc = sc * exp2f((float)(row & 127) * lgh[bj]); a = a * dc; b = b * dc;
                        bf16_t* o = O + (size_t)row * 512 + ((pn & 1) * 2 + bj) * 128 + i0;
                        *(u32x2*)(o) = pack4(a); *(u32x2*)(o + 64) = pack4(b); }
                    asm volatile("" ::: "memory"); __builtin_amdgcn_sched_barrier(0); }
        } else {
            bf16_t* O = (pn < 8) ? RV : RG;
#pragma unroll
            for (int ai = 0; ai < 2; ++ai)
#pragma unroll
                for (int m = 0; m < 4; ++m) { const int row = row0 + ai * HALF + m * 16;
#pragma unroll
                    for (int bj = 0; bj < 2; ++bj) *(u32x4*)(O + (size_t)row * 512 + (pn & 1) * 256 + bj * HALF + wc * 32 + 8 * fq) = pack8(acc[ai][bj][m][0], acc[ai][bj][m][1]); }
        }
    }
};
__device__ __forceinline__ int inproj_src(int n) {
    const int pn = n >> 8, p = n & 255;
    const int plain = (p & ~31) + pg8::perm32(p & 31);
    if (pn == 0) return plain;
    if (pn == 1) { if (p < 128) return 256 + plain; const int q = p - 128, wc = q >> 5; if (wc >= 2) return -1; return 384 + 32 * ((q >> 4) & 1) + 16 * wc + (q & 15); }
    if (pn < 6) { const int bj = p >> 7, q = p & 127, wc = q >> 5, nn = (q >> 4) & 1; const int d = 64 * nn + 16 * wc + (q & 15); return (pn < 4 ? 448 : 960) + ((pn & 1) * 2 + bj) * 128 + d; }
    return (pn < 8 ? 1472 : 1984) + (pn & 1) * 256 + plain;
}

struct EpiMlaQ {
    static constexpr bool PERM = false;
    bf16_t* QM; const float* ssq_cq; const float* qg; const float* cs;
    __device__ __forceinline__ void operator()(f32x4 (&acc)[2][2][4][2], const Unit& u, int wr, int wc, int fr, int fq, LAS unsigned char* xl) const {
        asm volatile("" : "+v"(fr), "+v"(fq));
        const int row0 = u.pm * 256 + wr * 64 + fr, h = u.pn;
        float s[2][4], rsr[2][4];
#pragma unroll
        for (int ai = 0; ai < 2; ++ai)
#pragma unroll
            for (int m = 0; m < 4; ++m) { const int row = row0 + ai * HALF + m * 16; rsr[ai][m] = rsqrtf(ssq_cq[row] * (1.f / 256.f) + EPS);
                s[ai][m] = (sq4(acc[ai][0][m][0]) + sq4(acc[ai][0][m][1]) + sq4(acc[ai][1][m][0]) + sq4(acc[ai][1][m][1])) * rsr[ai][m] * rsr[ai][m]; }
        pg8::row_allreduce_sum(s, wr, wc, fr, fq, xl);
        const int c0 = 32 * wc + 8 * fq, i0 = 16 * wc + 4 * fq;
        const f32x4 gA = *(const f32x4*)(qg + c0), gB = *(const f32x4*)(qg + c0 + 4);
        f32x4 g0 = {0.f, 0.f, 0.f, 0.f}, g1 = g0;
        if (wc < 2) { g0 = *(const f32x4*)(qg + 128 + i0); g1 = *(const f32x4*)(qg + 160 + i0); }
#pragma unroll
        for (int ai = 0; ai < 2; ++ai)
#pragma unroll
            for (int m = 0; m < 4; ++m) { const int row = row0 + ai * HALF + m * 16; const float rq = rsqrtf(s[ai][m] * (1.f / 192.f) + EPS) * rsr[ai][m];
                bf16_t* o = QM + (size_t)row * 768 + h * 192;
                *(u32x4*)(o + c0) = pack8(acc[ai][0][m][0] * rq * gA, acc[ai][0][m][1] * rq * gB);
                if (wc < 2) {
                    const f32x4 a = acc[ai][1][m][0] * rq * g0, b = acc[ai][1][m][1] * rq * g1;
                    const float* cp = cs + ((size_t)row * 64 + 2 * i0) * 2;
                    const f32x4 c0v = *(const f32x4*)(cp), c1v = *(const f32x4*)(cp + 4), c2v = *(const f32x4*)(cp + 8), c3v = *(const f32x4*)(cp + 12);
                    const f32x4 cc = {c0v[0], c1v[0], c2v[0], c3v[0]}, ss = {c0v[1], c1v[1], c2v[1], c3v[1]};
                    *(u32x2*)(o + 128 + i0) = pack4(a * cc - b * ss); *(u32x2*)(o + 160 + i0) = pack4(b * cc + a * ss);
                }
                asm volatile("" ::: "memory"); __builtin_amdgcn_sched_barrier(0); }
    }
};
__device__ __forceinline__ int mlaq_src(int n) {
    const int h = n >> 8, p = n & 255;
    if (p < 128) return h * 192 + (p & ~31) + pg8::perm32(p & 31);
    const int q = p - 128, wc = q >> 5; if (wc >= 2) return -1;
    return h * 192 + 128 + 32 * ((q >> 4) & 1) + 16 * wc + (q & 15);
}
struct EpiMlaKV {
    static constexpr bool PERM = false;
    bf16_t *KM, *VM; const bf16_t* CKV; const float *ssq_ckv, *ssq_kpe, *kg;
    __device__ __forceinline__ void operator()(f32x4 (&acc)[2][2][4][2], const Unit& u, int wr, int wc, int fr, int fq, LAS unsigned char* xl) const {
        asm volatile("" : "+v"(fr), "+v"(fq));
        const int row0 = u.pm * 256 + wr * 64 + fr, h = u.pn;
        float s[2][4], rsr[2][4];
#pragma unroll
        for (int ai = 0; ai < 2; ++ai)
#pragma unroll
            for (int m = 0; m < 4; ++m) { const int row = row0 + ai * HALF + m * 16; rsr[ai][m] = rsqrtf(ssq_ckv[row] * (1.f / 128.f) + EPS);
                s[ai][m] = (sq4(acc[ai][0][m][0]) + sq4(acc[ai][0][m][1])) * rsr[ai][m] * rsr[ai][m]; }
        pg8::row_allreduce_sum(s, wr, wc, fr, fq, xl);
        const int c0 = 32 * wc + 8 * fq, i0 = 16 * wc + 4 * fq;
        const f32x4 gA = *(const f32x4*)(kg + c0), gB = *(const f32x4*)(kg + c0 + 4);
#pragma unroll
        for (int ai = 0; ai < 2; ++ai)
#pragma unroll
            for (int m = 0; m < 4; ++m) { const int row = row0 + ai * HALF + m * 16; const float rk = rsqrtf((s[ai][m] + ssq_kpe[row]) * (1.f / 192.f) + EPS), rr = rsr[ai][m];
                bf16_t* ko = KM + (size_t)row * 768 + h * 192;
                *(u32x4*)(ko + c0) = pack8(acc[ai][0][m][0] * (rr * rk) * gA, acc[ai][0][m][1] * (rr * rk) * gB);
                *(u32x4*)(VM + (size_t)row * 512 + h * 128 + c0) = pack8(acc[ai][1][m][0] * rr, acc[ai][1][m][1] * rr);
                const u32x2 kp = *(const u32x2*)(CKV + (size_t)row * 256 + 128 + i0);
                const f32x4 kf = {__uint_as_float(kp.x << 16), __uint_as_float(kp.x & 0xffff0000u), __uint_as_float(kp.y << 16), __uint_as_float(kp.y & 0xffff0000u)};
                *(u32x2*)(ko + 128 + i0) = pack4(kf * rk); asm volatile("" ::: "memory"); __builtin_amdgcn_sched_barrier(0); }
    }
};
template <bool BASE_BF16, bool WRITE_F32>
struct EpiResid {
    static constexpr bool PERM = false;
    const float* base; float* out; bf16_t* xb; float* ssq;
    __device__ __forceinline__ void operator()(f32x4 (&acc)[2][2][4][2], const Unit& u, int wr, int wc, int fr, int fq, LAS unsigned char*) const {
        asm volatile("" : "+v"(fr), "+v"(fq));
        if (ssq == nullptr) { asm volatile("" :: "v"(acc[0][0][0][0]), "v"(acc[1][1][3][1])); return; }
        const int row0 = u.pm * 256 + wr * 64 + fr, col0 = u.pn * 256 + wc * 32 + 4 * fq;
#pragma unroll
        for (int ai = 0; ai < 2; ++ai)
#pragma unroll
            for (int m = 0; m < 4; ++m) { const int row = row0 + ai * HALF + m * 16; float s = 0.f;
#pragma unroll
                for (int bj = 0; bj < 2; ++bj)
#pragma unroll
                    for (int n = 0; n < 2; ++n) { const size_t off = (size_t)row * 1024 + col0 + bj * HALF + n * 16;
                        f32x4 bs;
                        if constexpr (BASE_BF16) { const u32x2 w = *(const u32x2*)(xb + off); bs = (f32x4){__uint_as_float(w.x << 16), __uint_as_float(w.x & 0xffff0000u), __uint_as_float(w.y << 16), __uint_as_float(w.y & 0xffff0000u)}; }
                        else bs = *(const f32x4*)(base + off);
                        const f32x4 o = bs + acc[ai][bj][m][n]; if constexpr (WRITE_F32) *(f32x4*)(out + off) = o; *(u32x2*)(xb + off) = pack4(o); s += sq4(o); }
                s = quad_sum(s); if (fq == 0) atomicAdd(ssq + row, s); }
    }
};
struct EpiHeadNorm {
    static constexpr bool PERM = false;
    bf16_t* O; const float* ssq_in  ; const float* g  ; float inv_n_in;
    __device__ __forceinline__ void operator()(f32x4 (&acc)[2][2][4][2], const Unit& u, int wr, int wc, int fr, int fq, LAS unsigned char* xl) const {
        asm volatile("" : "+v"(fr), "+v"(fq));
        const int row0 = u.pm * 256 + wr * 64 + fr, h = u.pn;
        float s[2][4], rsr[2][4];
#pragma unroll
        for (int ai = 0; ai < 2; ++ai)
#pragma unroll
            for (int m = 0; m < 4; ++m) { const int row = row0 + ai * HALF + m * 16; rsr[ai][m] = ssq_in ? rsqrtf(ssq_in[row] * inv_n_in + EPS) : 1.f;
                s[ai][m] = (sq4(acc[ai][0][m][0]) + sq4(acc[ai][0][m][1]) + sq4(acc[ai][1][m][0]) + sq4(acc[ai][1][m][1])) * rsr[ai][m] * rsr[ai][m]; }
        pg8::row_allreduce_sum(s, wr, wc, fr, fq, xl);
        const int c0 = 32 * wc + 8 * fq;
        f32x4 gv[2][2];
#pragma unroll
        for (int bj = 0; bj < 2; ++bj) { gv[bj][0] = *(const f32x4*)(g + bj * HALF + c0); gv[bj][1] = *(const f32x4*)(g + bj * HALF + c0 + 4); }
#pragma unroll
        for (int ai = 0; ai < 2; ++ai)
#pragma unroll
            for (int m = 0; m < 4; ++m) { const int row = row0 + ai * HALF + m * 16; const float rq = rsqrtf(s[ai][m] * (1.f / 256.f) + EPS) * rsr[ai][m];
#pragma unroll
                for (int bj = 0; bj < 2; ++bj) *(u32x4*)(O + (size_t)row * 1024 + h * 256 + bj * HALF + c0) = pack8(acc[ai][bj][m][0] * rq * gv[bj][0], acc[ai][bj][m][1] * rq * gv[bj][1]); }
    }
};
struct EpiStoreT {
    static constexpr bool PERM = true;
    bf16_t* O; int ldc; int tile_stride; float scale; int pad;
    __device__ __forceinline__ void operator()(f32x4 (&acc)[2][2][4][2], const Unit& u, int wr, int wc, int fr, int fq, LAS unsigned char*) const {
        asm volatile("" : "+v"(fr), "+v"(fq));
        const int row0 = u.pm * 256 + wr * 64 + fr;
#pragma unroll
        for (int ai = 0; ai < 2; ++ai)
#pragma unroll
            for (int m = 0; m < 4; ++m) { const int row = row0 + ai * HALF + m * 16;
#pragma unroll
                for (int bj = 0; bj < 2; ++bj) *(u32x4*)(O + (size_t)u.pn * tile_stride + (size_t)row * ldc + bj * HALF + wc * 32 + 8 * fq) = pack8(acc[ai][bj][m][0] * scale, acc[ai][bj][m][1] * scale); }
    }
};
struct EpiSoftmax {
    static constexpr bool PERM = true;
    bf16_t* PC;
    __device__ __forceinline__ void operator()(f32x4 (&acc)[2][2][4][2], const Unit& u, int wr, int wc, int fr, int fq, LAS unsigned char* xl) const {
        asm volatile("" : "+v"(fr), "+v"(fq));
        const int row0 = u.pm * 256 + wr * 64 + fr, h = u.pn;
        float mx[2][4], sm[2][4];
#pragma unroll
        for (int ai = 0; ai < 2; ++ai)
#pragma unroll
            for (int m = 0; m < 4; ++m) { float v = -3.0e38f;
#pragma unroll
                for (int bj = 0; bj < 2; ++bj)
#pragma unroll
                    for (int n = 0; n < 2; ++n) { const f32x4 a = acc[ai][bj][m][n]; v = fmaxf(v, fmaxf(fmaxf(a[0], a[1]), fmaxf(a[2], a[3]))); }
                mx[ai][m] = v; }
        pg8::row_allreduce_max(mx, wr, wc, fr, fq, xl);
        const float c2 = 0.0625f * 1.4426950408889634f;
#pragma unroll
        for (int ai = 0; ai < 2; ++ai)
#pragma unroll
            for (int m = 0; m < 4; ++m) { float t = 0.f; const float mm = mx[ai][m] * c2;
#pragma unroll
                for (int bj = 0; bj < 2; ++bj)
#pragma unroll
                    for (int n = 0; n < 2; ++n) { f32x4 a = acc[ai][bj][m][n] * c2 - mm;
                        a[0] = __builtin_amdgcn_exp2f(a[0]); a[1] = __builtin_amdgcn_exp2f(a[1]); a[2] = __builtin_amdgcn_exp2f(a[2]); a[3] = __builtin_amdgcn_exp2f(a[3]);
                        acc[ai][bj][m][n] = a; t += (a[0] + a[1]) + (a[2] + a[3]); }
                sm[ai][m] = t; }
        pg8::row_allreduce_sum(sm, wr, wc, fr, fq, xl);
#pragma unroll
        for (int ai = 0; ai < 2; ++ai)
#pragma unroll
            for (int m = 0; m < 4; ++m) { const int row = row0 + ai * HALF + m * 16; const float il = 1.f / sm[ai][m];
#pragma unroll
                for (int bj = 0; bj < 2; ++bj) *(u32x4*)(PC + (size_t)row * 1024 + h * 256 + bj * HALF + wc * 32 + 8 * fq) = pack8(acc[ai][bj][m][0] * il, acc[ai][bj][m][1] * il); }
    }
};
struct EpiStoreBf16 {
    static constexpr bool PERM = true;
    bf16_t* O; int ldc; int pad;
    __device__ __forceinline__ void operator()(f32x4 (&acc)[2][2][4][2], const Unit& u, int wr, int wc, int fr, int fq, LAS unsigned char*) const {
        asm volatile("" : "+v"(fr), "+v"(fq));
        const int row0 = u.pm * 256 + wr * 64 + fr;
#pragma unroll
        for (int ai = 0; ai < 2; ++ai)
#pragma unroll
            for (int m = 0; m < 4; ++m) { const int row = row0 + ai * HALF + m * 16;
#pragma unroll
                for (int bj = 0; bj < 2; ++bj) *(u32x4*)(O + (size_t)row * ldc + u.pn * 256 + bj * HALF + wc * 32 + 8 * fq) = pack8(acc[ai][bj][m][0], acc[ai][bj][m][1]); }
    }
};
struct HeadOrder {
    int G, c, nunits; const char* A; const char* B; size_t strideA, a_h, b_b, b_h;
    __device__ __forceinline__ bool next(int i, Unit& u) const {
        const long L = (long)i * G + c; if (L >= nunits) return false;
        u.pm = (int)(L >> 2); u.pn = (int)(L & 3); const int b = u.pm >> 4;
        u.a = A + (size_t)u.pm * strideA + (size_t)u.pn * a_h; u.b = B + (size_t)b * b_b + (size_t)u.pn * b_h; u.rows = nullptr; u.nvalid = 256; u.seg = 0; return true;
    }
};
constexpr int MOE_CAP = 32768;
struct MoeOrder {
    int G, c, seg_lo, seg_hi, ntn; const int* cnt; const int* lists; const char* A; const char* B; size_t a_tile  , b_exp  , b_tile  ;
    LAS int* tab;
    __device__ __forceinline__ void init(LAS unsigned char* xl) {
        tab = (LAS int*)(xl + 4096);
        if (threadIdx.x < 64) { const int n = __hip_atomic_load(cnt + threadIdx.x, __ATOMIC_RELAXED, __HIP_MEMORY_SCOPE_AGENT); int t = (n + 255) >> 8, incl = t;
#pragma unroll
            for (int o = 1; o < 64; o <<= 1) { const int v = __shfl_up(incl, o); if ((int)threadIdx.x >= o) incl += v; }
            tab[threadIdx.x + 1] = incl; tab[65 + threadIdx.x] = n; if (threadIdx.x == 0) tab[0] = 0; }
        asm volatile("s_waitcnt lgkmcnt(0)" ::: "memory"); __syncthreads();
    }
    __device__ __forceinline__ bool next(int i, Unit& u) const {
        const int gbase = tab[seg_lo], ntl = tab[seg_hi] - gbase;
        int rt, pn;
        if ((G & 7) == 0) { const int per = (ntl + 7) >> 3, xcd = c & 7, uu = (c >> 3) + (G >> 3) * i; const int rl_ = uu / ntn; if (rl_ >= per) return false; rt = xcd * per + rl_; pn = uu % ntn; }
        else { const long L = (long)i * G + c; rt = (int)(L / ntn); pn = (int)(L % ntn); }
        if (rt >= ntl) return false;
        const int rtg = gbase + rt;
        const int lane = threadIdx.x & 63;
        const int sgm = __builtin_popcountll(__ballot(rtg >= tab[lane + 1]));
        const int j = rtg - tab[sgm], n = tab[65 + sgm];
        u.pm = rtg; u.pn = pn; u.seg = sgm; u.nvalid = (n - j * 256) < 256 ? (n - j * 256) : 256; u.rows = lists + (size_t)sgm * MOE_CAP + j * 256;
        u.a = A + (size_t)u.pm * a_tile; u.b = B + (size_t)(sgm & 31) * b_exp + (size_t)pn * b_tile; return true;
    }
};
struct EpiGlu {
    static constexpr bool PERM = false;
    bf16_t* H; const float* ssq2; const float* roww; const int* lists0;
    __device__ __forceinline__ void operator()(f32x4 (&acc)[2][2][4][2], const Unit& u, int wr, int wc, int fr, int fq, LAS unsigned char*) const {
        asm volatile("" : "+v"(fr), "+v"(fq));
        if (H == nullptr) { asm volatile("" :: "v"(acc[0][0][0][0]), "v"(acc[1][1][3][1])); return; }
#pragma unroll
        for (int ai = 0; ai < 2; ++ai)
#pragma unroll
            for (int m = 0; m < 4; ++m) { const int rl = ai * HALF + wr * 64 + m * 16 + fr; const bool valid = rl < u.nvalid;
                const int tok = valid ? u.rows[rl] : 0;
                const float wgt = valid ? *(roww + ((u.rows + rl) - lists0)) : 0.f;
                const float rs = rsqrtf(ssq2[tok] * (1.f / 1024.f) + EPS);
                f32x4 hv[2];
#pragma unroll
                for (int n = 0; n < 2; ++n) { const f32x4 a = acc[ai][0][m][n] * rs, uu = acc[ai][1][m][n] * rs; f32x4 r;
#pragma unroll
                    for (int j = 0; j < 4; ++j) r[j] = a[j] / (1.f + __expf(-a[j])) * uu[j] * wgt;
                    hv[n] = r; }
                *(u32x4*)(H + ((size_t)u.pm * 256 + rl) * 256 + u.pn * 128 + wc * 32 + 8 * fq) = pack8(hv[0], hv[1]); }
    }
};
template <int SLOT>
struct EpiScatter {
    static constexpr bool PERM = false;
    float* out; bf16_t* y0;
    __device__ __forceinline__ void operator()(f32x4 (&acc)[2][2][4][2], const Unit& u, int wr, int wc, int fr, int fq, LAS unsigned char*) const {
        asm volatile("" : "+v"(fr), "+v"(fq));
        const int col0 = u.pn * 256 + wc * 32 + 4 * fq;
#pragma unroll
        for (int ai = 0; ai < 2; ++ai)
#pragma unroll
            for (int m = 0; m < 4; ++m) { const int rl = ai * HALF + wr * 64 + m * 16 + fr;
                if (rl < u.nvalid) { const int tok = u.rows[rl]; const size_t o = (size_t)tok * 1024 + col0;
#pragma unroll
                    for (int bj = 0; bj < 2; ++bj)
#pragma unroll
                        for (int n = 0; n < 2; ++n) { const size_t oo = o + bj * HALF + n * 16;
                            if constexpr (SLOT == 0) { *(u32x2*)(y0 + oo) = pack4(acc[ai][bj][m][n]); }
                            else { const u32x2 w = *(const u32x2*)(y0 + oo); const f32x4 yv = {__uint_as_float(w.x << 16), __uint_as_float(w.x & 0xffff0000u), __uint_as_float(w.y << 16), __uint_as_float(w.y & 0xffff0000u)};
                                   f32x4* q = (f32x4*)(out + oo); *q = (*q + yv) + acc[ai][bj][m][n]; } } } }
    }
};
struct MemKVOrder {
    int G, c; const char* MB; const char* W;
    __device__ __forceinline__ bool next(int i, Unit& u) const {
        const long L = (long)i * G + c; if (L >= 64) return false;
        const int r = (int)L & 31; u.rows = nullptr; u.nvalid = 256;
        if (L < 32) { u.seg = 0; u.pm = r >> 2; u.pn = r & 3; u.a = MB + (size_t)u.pm * 256 * 2048; u.b = W + (size_t)u.pn * 256 * 2048; }
        else { u.seg = 1; u.pm = r >> 3; u.pn = r & 7; u.a = W + (size_t)(1024 + u.pm * 256) * 2048; u.b = MB + (size_t)u.pn * 256 * 2048; }
        return true;
    }
};
struct EpiMemKV {
    static constexpr bool PERM = false;
    bf16_t* KC; bf16_t* VCT; const float* g;
    __device__ __forceinline__ void operator()(f32x4 (&acc)[2][2][4][2], const Unit& u, int wr, int wc, int fr, int fq, LAS unsigned char* xl) const {
        if (u.seg == 0) { EpiHeadNorm e{KC, nullptr, g, 0.f}; e(acc, u, wr, wc, fr, fq, xl); return; }
        asm volatile("" : "+v"(fr), "+v"(fq));
        const int row0 = u.pm * 256 + wr * 64 + fr;
#pragma unroll
        for (int ai = 0; ai < 2; ++ai)
#pragma unroll
            for (int m = 0; m < 4; ++m) { const int row = row0 + ai * HALF + m * 16;
#pragma unroll
                for (int bj = 0; bj < 2; ++bj)
#pragma unroll
                    for (int n = 0; n < 2; ++n) *(u32x2*)(VCT + (size_t)u.pn * 1024 * 256 + (size_t)row * 256 + bj * HALF + wc * 32 + n * 16 + 4 * fq) = pack4(acc[ai][bj][m][n]); }
    }
};
}
namespace at {
typedef float f32x16 __attribute__((ext_vector_type(16)));
typedef short s16x4 __attribute__((ext_vector_type(4)));
constexpr int NW = 8, QBLK = 32, KVBLK = 64, QB = 256;
constexpr int KROW = 400;
constexpr int SHM_V = KVBLK * 128 * 2, SHM_K = KVBLK * KROW;
constexpr int LDS_V = 0, LDS_K = 2 * SHM_V, LDS_WS = LDS_K + 2 * SHM_K, LDS_BYTES = LDS_WS + NW * 64 * 4;
constexpr float SCALE = 0.07216878364870322f;
constexpr float THR = 8.f;
#define SBAR() __builtin_amdgcn_sched_barrier(0)
__device__ __forceinline__ int v_st(int k, int c) { const int kk = (k & ~0xC) | ((k & 4) << 1) | ((k & 8) >> 1); return ((kk >> 3) * 4 + (c >> 5)) * 512 + ((kk & 7) * 32 + (c & 31)) * 2; }
__device__ __forceinline__ int v_rd_base(int lane) { return ((lane & 3) << 3) | (((lane >> 2) & 3) << 6) | (((lane >> 4) & 1) << 5) | (((lane >> 5) & 1) << 8); }
constexpr int v_rd_off(int d0, int ks, int half) { return d0 * 512 + ks * 4096 + half * 2048; }
__device__ __forceinline__ int crow(int r, int hi) { return (r & 3) + 8 * (r >> 2) + 4 * hi; }
__device__ __forceinline__ unsigned cvtpk(float lo, float hi) { unsigned r; asm volatile("v_cvt_pk_bf16_f32 %0, %1, %2" : "=v"(r) : "v"(lo), "v"(hi)); return r; }
__device__ __forceinline__ void mask_tile(f32x16& p0, f32x16& p1, int dq) {
    const float NEG = -__builtin_inff();
#pragma unroll
    for (int r = 0; r < 16; ++r) {
        const int c = (r & 3) + 8 * (r >> 2);
        if (dq - c < 0) p0[r] = NEG;
        if (dq - c - 32 < 0) p1[r] = NEG;
    }
}
__device__ __forceinline__ void partialSM(f32x16& p0, f32x16& p1, float& m_reg, float& mn, float& alpha) {
    float pmax = p0[0];
#pragma unroll
    for (int r = 1; r < 16; ++r) pmax = fmaxf(pmax, p0[r]);
#pragma unroll
    for (int r = 0; r < 16; ++r) pmax = fmaxf(pmax, p1[r]);
    { auto rr = __builtin_amdgcn_permlane32_swap(__float_as_uint(pmax), __float_as_uint(pmax), false, false);
      pmax = fmaxf(__uint_as_float(rr[0]), __uint_as_float(rr[1])); }
    constexpr float C2 = 1.4426950408889634f * SCALE;
    if (__builtin_expect(__all((pmax - m_reg) * SCALE <= THR), 1)) { mn = m_reg; alpha = 1.f; }
    else { mn = fmaxf(m_reg, pmax); alpha = __builtin_amdgcn_exp2f((m_reg - mn) * C2); m_reg = mn; }
    const float mnL = -mn * C2;
#pragma unroll
    for (int r = 0; r < 16; ++r) p0[r] = fmaf(p0[r], C2, mnL);
#pragma unroll
    for (int r = 0; r < 16; ++r) p1[r] = fmaf(p1[r], C2, mnL);
#pragma unroll
    for (int r = 0; r < 16; ++r) p0[r] = __builtin_amdgcn_exp2f(p0[r]);
}
__device__ __forceinline__ void finishSM(f32x16& p0, f32x16& p1, float alpha, float& l_reg, bf16x8& pa0, bf16x8& pa1, bf16x8& pa2, bf16x8& pa3) {
#pragma unroll
    for (int r = 0; r < 16; ++r) p1[r] = __builtin_amdgcn_exp2f(p1[r]);
    float ps = 0;
#pragma unroll
    for (int r = 0; r < 16; ++r) ps += p0[r];
#pragma unroll
    for (int r = 0; r < 16; ++r) ps += p1[r];
    { auto rr = __builtin_amdgcn_permlane32_swap(__float_as_uint(ps), __float_as_uint(ps), false, false);
      ps = __uint_as_float(rr[0]) + __uint_as_float(rr[1]); }
    l_reg = l_reg * alpha + ps;
#define PK4(P, B_, OUT) do { unsigned a0 = cvtpk(P[B_+0], P[B_+1]), a1 = cvtpk(P[B_+2], P[B_+3]);                          \
        unsigned b0 = cvtpk(P[B_+4], P[B_+5]), b1 = cvtpk(P[B_+6], P[B_+7]);                                             \
        auto r0 = __builtin_amdgcn_permlane32_swap(a0, b0, false, false); auto r1 = __builtin_amdgcn_permlane32_swap(a1, b1, false, false); \
        u32x4 w = {r0[0], r1[0], r0[1], r1[1]}; OUT = *reinterpret_cast<bf16x8*>(&w); } while (0)
    PK4(p0, 0, pa0); PK4(p0, 8, pa1); PK4(p1, 0, pa2); PK4(p1, 8, pa3);
#undef PK4
}
template <int KB>
__device__ __forceinline__ void qkt(f32x16& p0, f32x16& p1, const char* K_lds, int r32, int hi, const bf16x8* qr) {
    p0 = f32x16{}; p1 = f32x16{};
    const char* kb = K_lds + KB * SHM_K + r32 * KROW + hi * 16;
#pragma unroll
    for (int d0 = 0; d0 < 12; ++d0) {
        const bf16x8 b0 = *reinterpret_cast<const bf16x8*>(kb + d0 * 32);
        const bf16x8 b1 = *reinterpret_cast<const bf16x8*>(kb + 32 * KROW + d0 * 32);
        p0 = __builtin_amdgcn_mfma_f32_32x32x16_bf16(b0, qr[d0], p0, 0, 0, 0);
        p1 = __builtin_amdgcn_mfma_f32_32x32x16_bf16(b1, qr[d0], p1, 0, 0, 0);
    }
}
template <int VB>
__device__ __forceinline__ void pv_tile(f32x16* o, int vb0, bf16x8 pa0, bf16x8 pa1, bf16x8 pa2, bf16x8 pa3) {
#define TRRD(dst, off) asm volatile("ds_read_b64_tr_b16 %0, %1 offset:%2" : "=&v"(dst) : "v"(vb0), "i"(off) : "memory")
#define PV_D0(d0) do { s16x4 l0, l1, l2, l3, h0, h1, h2, h3; constexpr int b_ = VB * SHM_V + v_rd_off(d0, 0, 0);   \
        TRRD(l0, b_); TRRD(h0, b_ + 2048); TRRD(l1, b_ + 4096); TRRD(h1, b_ + 6144); TRRD(l2, b_ + 8192); TRRD(h2, b_ + 10240); TRRD(l3, b_ + 12288); TRRD(h3, b_ + 14336); \
        asm volatile("s_waitcnt lgkmcnt(0)" ::: "memory"); SBAR();   \
        o[d0] = __builtin_amdgcn_mfma_f32_32x32x16_bf16(pa0, (bf16x8){l0[0], l0[1], l0[2], l0[3], h0[0], h0[1], h0[2], h0[3]}, o[d0], 0, 0, 0);   \
        o[d0] = __builtin_amdgcn_mfma_f32_32x32x16_bf16(pa1, (bf16x8){l1[0], l1[1], l1[2], l1[3], h1[0], h1[1], h1[2], h1[3]}, o[d0], 0, 0, 0);   \
        o[d0] = __builtin_amdgcn_mfma_f32_32x32x16_bf16(pa2, (bf16x8){l2[0], l2[1], l2[2], l2[3], h2[0], h2[1], h2[2], h2[3]}, o[d0], 0, 0, 0);   \
        o[d0] = __builtin_amdgcn_mfma_f32_32x32x16_bf16(pa3, (bf16x8){l3[0], l3[1], l3[2], l3[3], h3[0], h3[1], h3[2], h3[3]}, o[d0], 0, 0, 0); } while (0)
    PV_D0(0); PV_D0(1); PV_D0(2); PV_D0(3);
#undef PV_D0
#undef TRRD
}

__device__ __forceinline__ void attn_block(const bf16_t* Q, const bf16_t* K, const bf16_t* V, bf16_t* O, size_t tb, int h, int P0, char* lds) {
    const int tid = threadIdx.x, wid = __builtin_amdgcn_readfirstlane(tid >> 6), lane = tid & 63, r32 = lane & 31, hi = lane >> 5;
    const int NT = (P0 + QB) / KVBLK;
    const int qlo = P0 + wid * QBLK, qm = qlo + r32 - 4 * hi;
    char* V_lds = lds + LDS_V; char* K_lds = lds + LDS_K;
    float* ws = (float*)(lds + LDS_WS) + wid * 64; float* li_l = ws, * al_l = ws + 32;
    float m_reg = -1e30f, l_reg = 0; f32x16 o[4] = {};
    const bf16_t* Kh = K + tb * 768 + h * 192; const bf16_t* Vh = V + tb * 512 + h * 128;
    const int sr = tid >> 4, sc = (tid & 15) * 8, vst0 = v_st(sr, sc), vst1 = v_st(32 + sr, sc);
    const int kgo = (tid >> 3) * 768 + (tid & 7) * 8, klo = (tid >> 3) * KROW + (tid & 7) * 16;
    const int vb0 = (int)(uintptr_t)V_lds + v_rd_base(lane);
    bf16x8 st_k0, st_k1, st_k2, st_v0, st_v1;
#define VMW() asm volatile("s_waitcnt vmcnt(0)" ::: "memory")
#define SLOAD(k0) do { const bf16_t* kp_ = Kh + (size_t)(k0) * 768 + kgo; st_k0 = *(const bf16x8*)(kp_); st_k1 = *(const bf16x8*)(kp_ + 64); st_k2 = *(const bf16x8*)(kp_ + 128); \
        st_v0 = *(const bf16x8*)(Vh + (size_t)((k0) + sr) * 512 + sc); st_v1 = *(const bf16x8*)(Vh + (size_t)((k0) + 32 + sr) * 512 + sc); } while (0)
#define SWRITE(bf) do { char* kw_ = K_lds + (bf) * SHM_K + klo; *(bf16x8*)(kw_) = st_k0; *(bf16x8*)(kw_ + 128) = st_k1; *(bf16x8*)(kw_ + 256) = st_k2; \
        *(bf16x8*)(V_lds + (bf) * SHM_V + vst0) = st_v0; *(bf16x8*)(V_lds + (bf) * SHM_V + vst1) = st_v1; } while (0)
#define RESC(a) do { if (__any((a) < 1.f)) { if (hi == 0) al_l[r32] = (a); asm volatile("s_waitcnt lgkmcnt(0)" ::: "memory");              \
                     for (int d_ = 0; d_ < 4; ++d_) for (int r = 0; r < 16; ++r) o[d_][r] *= al_l[crow(r, hi)]; } } while (0)
#define KBASE(t) ((t) * KVBLK)
#define MASKT(P0_, P1_, t) do { const int kb_ = KBASE(t); if (kb_ + KVBLK - 1 > qlo) mask_tile(P0_, P1_, qm - kb_); } while (0)
    bf16x8 qr[12];
    { const bf16_t* Qw = Q + (tb + qlo + r32) * 768 + h * 192 + hi * 8;
#pragma unroll
      for (int d0 = 0; d0 < 12; ++d0) qr[d0] = *(const bf16x8*)(Qw + d0 * 16); }
    SLOAD(0); VMW(); SWRITE(0);
    __syncthreads();
    f32x16 p0, p1; float mn, al; bf16x8 pa0, pa1, pa2, pa3;
#define TILE_STEP(t, BUF) do {                                                                   \
        if ((t) + 1 < NT) { SLOAD(KBASE((t) + 1)); }                                              \
        SBAR(); qkt<BUF>(p0, p1, K_lds, r32, hi, qr);                                             \
        MASKT(p0, p1, (t)); partialSM(p0, p1, m_reg, mn, al); RESC(al);                           \
        finishSM(p0, p1, al, l_reg, pa0, pa1, pa2, pa3); SBAR();                                  \
        pv_tile<BUF>(o, vb0, pa0, pa1, pa2, pa3);                                                 \
        if ((t) + 1 < NT) { VMW(); SWRITE(1 - BUF); }                                             \
        __syncthreads(); } while (0)
    for (int t = 0; t < NT; t += 2) { TILE_STEP(t, 0); TILE_STEP(t + 1, 1); }
    if (hi == 0) li_l[r32] = l_reg; asm volatile("s_waitcnt lgkmcnt(0)" ::: "memory");
    float rli[16];
#pragma unroll
    for (int r = 0; r < 16; ++r) rli[r] = __builtin_amdgcn_rcpf(li_l[crow(r, hi)]);
    bf16_t* Ow = O + (tb + qlo) * 1024 + h * 128;
#pragma unroll
    for (int r = 0; r < 16; ++r) { const int orow = crow(r, hi);
#pragma unroll
        for (int d0 = 0; d0 < 4; ++d0) { const float v = o[d0][r] * rli[r];
            const float vn = __shfl_xor(v, 1);
            if ((r32 & 1) == 0) *(unsigned*)(Ow + (size_t)orow * 1024 + d0 * 32 + r32) = cvtpk(v, vn); } }
#undef VMW
#undef SLOAD
#undef SWRITE
#undef RESC
#undef KBASE
#undef MASKT
#undef TILE_STEP
}
#undef SBAR

__device__ __forceinline__ void attn_phase(const bf16_t* Q, const bf16_t* K, const bf16_t* V, bf16_t* O, char* lds) {
    for (int L = blockIdx.x; L < 256; L += gridDim.x) {
        const int xcd = L & 7, k = L >> 3, bh = (k >> 3) * 8 + xcd, x = k & 7;
        const int b = bh >> 2, h = bh & 3; const size_t tb = (size_t)b * 4096;
        attn_block(Q, K, V, O, tb, h, (15 - x) * QB, lds);
        attn_block(Q, K, V, O, tb, h, x * QB, lds);
    }
}
}
namespace rt {
using at::f32x16; using at::s16x4; using at::v_st; using at::v_rd_base; using at::v_rd_off; using at::crow; using at::cvtpk;
constexpr int PITCH = 272;
constexpr int L_Q = 0, L_K = 128 * PITCH, L_V = 2 * 128 * PITCH, L_S = L_V + 32768, L_END = L_S + 128 * PITCH;
#define TRRD(dst, base, off) asm volatile("ds_read_b64_tr_b16 %0, %1 offset:%2" : "=&v"(dst) : "v"(base), "i"(off) : "memory")
#define FRAG(l, h) ((bf16x8){l[0], l[1], l[2], l[3], h[0], h[1], h[2], h[3]})
using fx::gamma_log2;

__device__ __forceinline__ void ret_kv_unit(const bf16_t* RK, const bf16_t* RV, bf16_t* KVS, int bh, int c, char* lds) {
    const int tid = threadIdx.x, wid = __builtin_amdgcn_readfirstlane(tid >> 6), lane = tid & 63, r32 = lane & 31, hi = lane >> 5;
    const int b = bh >> 2, h = bh & 3; const size_t t0 = (size_t)b * 4096 + (size_t)c * 128;
    char* Kl = lds; char* Vl = lds + 32768;
#pragma unroll
    for (int i = 0; i < 4; ++i) { const int q = tid + 512 * i, row = q >> 4, cc = (q & 15) * 8; const int lo = (row >> 6) * 16384 + v_st(row & 63, cc);
        *(bf16x8*)(Kl + lo) = *(const bf16x8*)(RK + (t0 + row) * 512 + h * 128 + cc);
        *(bf16x8*)(Vl + lo) = *(const bf16x8*)(RV + (t0 + row) * 512 + h * 128 + cc); }
    __syncthreads();
    const int dvb = wid >> 1, dkb = 2 * (wid & 1);
    const int vbase = (int)(uintptr_t)Vl + v_rd_base(lane) + dvb * 512, kbase = (int)(uintptr_t)Kl + v_rd_base(lane) + dkb * 512;
    f32x16 acc0 = {}, acc1 = {};
#define KVSTEP(sub, ks) do { s16x4 al, ah, b0l, b0h, b1l, b1h; constexpr int o_ = (sub) * 16384 + v_rd_off(0, ks, 0);   \
        TRRD(al, vbase, o_); TRRD(ah, vbase, o_ + 2048); TRRD(b0l, kbase, o_); TRRD(b0h, kbase, o_ + 2048); TRRD(b1l, kbase, o_ + 512); TRRD(b1h, kbase, o_ + 512 + 2048); \
        asm volatile("s_waitcnt lgkmcnt(0)" ::: "memory"); __builtin_amdgcn_sched_barrier(0);   \
        acc0 = __builtin_amdgcn_mfma_f32_32x32x16_bf16(FRAG(al, ah), FRAG(b0l, b0h), acc0, 0, 0, 0);   \
        acc1 = __builtin_amdgcn_mfma_f32_32x32x16_bf16(FRAG(al, ah), FRAG(b1l, b1h), acc1, 0, 0, 0); } while (0)
    KVSTEP(0, 0); KVSTEP(0, 1); KVSTEP(0, 2); KVSTEP(0, 3); KVSTEP(1, 0); KVSTEP(1, 1); KVSTEP(1, 2); KVSTEP(1, 3);
#undef KVSTEP
    const float sc = exp2f(127.f * gamma_log2(h));
    bf16_t* O = KVS + ((size_t)(bh * 32 + c) * 128 + dvb * 32) * 128 + dkb * 32;
#pragma unroll
    for (int r = 0; r < 16; ++r) { const int dv = crow(r, hi);
        const float v0 = acc0[r] * sc, v1 = acc1[r] * sc; const float n0 = __shfl_xor(v0, 1), n1 = __shfl_xor(v1, 1);
        if ((r32 & 1) == 0) { *(unsigned*)(O + (size_t)dv * 128 + r32) = cvtpk(v0, n0); *(unsigned*)(O + (size_t)dv * 128 + 32 + r32) = cvtpk(v1, n1); } }
    __syncthreads();
}
__device__ __forceinline__ void ret_kv_phase(const bf16_t* RK, const bf16_t* RV, bf16_t* KVS, char* lds) {
    for (int u = blockIdx.x; u < 1024; u += gridDim.x) ret_kv_unit(RK, RV, KVS, u >> 5, u & 31, lds);
}

__device__ __forceinline__ void ret_out_unit(const bf16_t* RQ, const bf16_t* RK, const bf16_t* RV, const bf16_t* RG, const bf16_t* KVS, const float* gn_g, bf16_t* AO, int bh, int c, char* lds) {
    const int tid = threadIdx.x, wid = __builtin_amdgcn_readfirstlane(tid >> 6), lane = tid & 63, r32 = lane & 31, hi = lane >> 5;
    const int b = bh >> 2, h = bh & 3; const size_t t0 = (size_t)b * 4096 + (size_t)c * 128;
    const float lg = gamma_log2(h);
#pragma unroll
    for (int i = 0; i < 4; ++i) { const int q = tid + 512 * i, row = q >> 4, cc = (q & 15) * 8;
        *(bf16x8*)(lds + L_Q + row * PITCH + cc * 2) = *(const bf16x8*)(RQ + (t0 + row) * 512 + h * 128 + cc);
        *(bf16x8*)(lds + L_K + row * PITCH + cc * 2) = *(const bf16x8*)(RK + (t0 + row) * 512 + h * 128 + cc);
        *(bf16x8*)(lds + L_V + (row >> 6) * 16384 + v_st(row & 63, cc)) = *(const bf16x8*)(RV + (t0 + row) * 512 + h * 128 + cc); }
    { f32x4 sa[4][2];
#pragma unroll
      for (int i = 0; i < 4; ++i) { sa[i][0] = (f32x4){0.f, 0.f, 0.f, 0.f}; sa[i][1] = sa[i][0]; }
      float w = 1.f; const float cd = exp2f(128.f * lg);
#define ST_ACC(V, W_) do { _Pragma("unroll") for (int i = 0; i < 4; ++i) { const u32x4 v = V[i]; \
              sa[i][0] += (W_) * (f32x4){__uint_as_float(v.x << 16), __uint_as_float(v.x & 0xffff0000u), __uint_as_float(v.y << 16), __uint_as_float(v.y & 0xffff0000u)}; \
              sa[i][1] += (W_) * (f32x4){__uint_as_float(v.z << 16), __uint_as_float(v.z & 0xffff0000u), __uint_as_float(v.w << 16), __uint_as_float(v.w & 0xffff0000u)}; } } while (0)
      const bf16_t* src0 = KVS + (size_t)(bh * 32) * 16384 + tid * 8;
      int j = c - 1;
      for (; j >= 3; j -= 4) {
          u32x4 va[4], vb[4], vc[4], vd[4];
#pragma unroll
          for (int i = 0; i < 4; ++i) { va[i] = *(const u32x4*)(src0 + (size_t)j * 16384 + 4096 * i); vb[i] = *(const u32x4*)(src0 + (size_t)(j - 1) * 16384 + 4096 * i);
                                        vc[i] = *(const u32x4*)(src0 + (size_t)(j - 2) * 16384 + 4096 * i); vd[i] = *(const u32x4*)(src0 + (size_t)(j - 3) * 16384 + 4096 * i); }
          const float w1 = w * cd, w2 = w1 * cd, w3 = w2 * cd;
          ST_ACC(va, w); ST_ACC(vb, w1); ST_ACC(vc, w2); ST_ACC(vd, w3); w = w3 * cd; }
      for (; j >= 0; --j) { u32x4 va[4];
#pragma unroll
          for (int i = 0; i < 4; ++i) va[i] = *(const u32x4*)(src0 + (size_t)j * 16384 + 4096 * i);
          ST_ACC(va, w); w *= cd; }
#undef ST_ACC
#pragma unroll
      for (int i = 0; i < 4; ++i) { const int e8 = tid + 512 * i, dv = e8 >> 4, dk0 = (e8 & 15) * 8; *(u32x4*)(lds + L_S + dv * PITCH + dk0 * 2) = fx::pack8(sa[i][0], sa[i][1]); } }
    __syncthreads();
    const int qg = wid & 3, dh = wid >> 2;
    bf16x8 qr[8];
#pragma unroll
    for (int d0 = 0; d0 < 8; ++d0) qr[d0] = *(const bf16x8*)(lds + L_Q + (32 * qg + r32) * PITCH + d0 * 32 + hi * 16);
    f32x16 o[2] = {};
#pragma unroll
    for (int dd = 0; dd < 2; ++dd) { const char* sb = lds + L_S + ((2 * dh + dd) * 32 + r32) * PITCH + hi * 16;
#pragma unroll
        for (int d0 = 0; d0 < 8; ++d0) o[dd] = __builtin_amdgcn_mfma_f32_32x32x16_bf16(qr[d0], *(const bf16x8*)(sb + d0 * 32), o[dd], 0, 0, 0); }
    { const float g1 = exp2f(lg);
#pragma unroll
      for (int dd = 0; dd < 2; ++dd)
#pragma unroll
          for (int r = 0; r < 16; ++r) o[dd][r] *= g1; }
    const int vb = (int)(uintptr_t)(lds + L_V) + v_rd_base(lane) + (2 * dh) * 512;
    const int qpos = 32 * qg + r32;
#define INTRA(kt) do { if (64 * (kt) <= 32 * qg + 31) { f32x16 p0 = {}, p1 = {}; const char* kb = lds + L_K + (64 * (kt) + r32) * PITCH + hi * 16;   \
        _Pragma("unroll") for (int d0 = 0; d0 < 8; ++d0) { p0 = __builtin_amdgcn_mfma_f32_32x32x16_bf16(*(const bf16x8*)(kb + d0 * 32), qr[d0], p0, 0, 0, 0);   \
                                                          p1 = __builtin_amdgcn_mfma_f32_32x32x16_bf16(*(const bf16x8*)(kb + 32 * PITCH + d0 * 32), qr[d0], p1, 0, 0, 0); }   \
        _Pragma("unroll") for (int r = 0; r < 16; ++r) { const int key = 64 * (kt) + crow(r, hi); if (key > qpos) p0[r] = 0.f; if (key + 32 > qpos) p1[r] = 0.f; }   \
        bf16x8 pa0, pa1, pa2, pa3;   \
        PK4(p0, 0, pa0); PK4(p0, 8, pa1); PK4(p1, 0, pa2); PK4(p1, 8, pa3);   \
        PVD(kt, 0); PVD(kt, 1); } } while (0)
#define PK4(P, B_, OUT) do { unsigned a0 = cvtpk(P[B_+0], P[B_+1]), a1 = cvtpk(P[B_+2], P[B_+3]); unsigned b0 = cvtpk(P[B_+4], P[B_+5]), b1 = cvtpk(P[B_+6], P[B_+7]);   \
        auto r0 = __builtin_amdgcn_permlane32_swap(a0, b0, false, false); auto r1 = __builtin_amdgcn_permlane32_swap(a1, b1, false, false);   \
        u32x4 w_ = {r0[0], r1[0], r0[1], r1[1]}; OUT = *reinterpret_cast<bf16x8*>(&w_); } while (0)
#define PVD(kt, dd) do { s16x4 l0, l1, l2, l3, h0, h1, h2, h3; constexpr int b_ = (kt) * 16384 + v_rd_off(dd, 0, 0);   \
        TRRD(l0, vb, b_); TRRD(h0, vb, b_ + 2048); TRRD(l1, vb, b_ + 4096); TRRD(h1, vb, b_ + 6144); TRRD(l2, vb, b_ + 8192); TRRD(h2, vb, b_ + 10240); TRRD(l3, vb, b_ + 12288); TRRD(h3, vb, b_ + 14336);   \
        asm volatile("s_waitcnt lgkmcnt(0)" ::: "memory"); __builtin_amdgcn_sched_barrier(0);   \
        o[dd] = __builtin_amdgcn_mfma_f32_32x32x16_bf16(pa0, FRAG(l0, h0), o[dd], 0, 0, 0); o[dd] = __builtin_amdgcn_mfma_f32_32x32x16_bf16(pa1, FRAG(l1, h1), o[dd], 0, 0, 0);   \
        o[dd] = __builtin_amdgcn_mfma_f32_32x32x16_bf16(pa2, FRAG(l2, h2), o[dd], 0, 0, 0); o[dd] = __builtin_amdgcn_mfma_f32_32x32x16_bf16(pa3, FRAG(l3, h3), o[dd], 0, 0, 0); } while (0)
    INTRA(0); INTRA(1);
#undef INTRA
#undef PK4
#undef PVD
    __syncthreads();
    float* Os = (float*)lds;
#pragma unroll
    for (int dd = 0; dd < 2; ++dd)
#pragma unroll
        for (int r = 0; r < 16; ++r) Os[(32 * qg + crow(r, hi)) * 132 + (2 * dh + dd) * 32 + r32] = o[dd][r];
    __syncthreads();
    { const int q = tid >> 2, seg = tid & 3; const float* orow = Os + q * 132 + seg * 32;
      f32x4 v[8]; float s1 = 0.f, s2 = 0.f;
#pragma unroll
      for (int i = 0; i < 8; ++i) { v[i] = *(const f32x4*)(orow + 4 * i); s1 += (v[i][0] + v[i][1]) + (v[i][2] + v[i][3]); s2 += fx::sq4(v[i]); }
      s1 += __shfl_xor(s1, 1); s1 += __shfl_xor(s1, 2); s2 += __shfl_xor(s2, 1); s2 += __shfl_xor(s2, 2);
      const float mean = s1 * (1.f / 128.f); const float var = fmaxf(s2 * (1.f / 128.f) - mean * mean, 0.f); const float rs = rsqrtf(var + EPS);
      const bf16_t* gp = RG + (t0 + q) * 512 + h * 128 + seg * 32; const float* gg = gn_g + h * 128 + seg * 32;
      bf16_t* op = AO + (t0 + q) * 1024 + 512 + h * 128 + seg * 32;
#pragma unroll
      for (int i = 0; i < 4; ++i) { const u32x4 gr = *(const u32x4*)(gp + 8 * i); const f32x4 g0 = *(const f32x4*)(gg + 8 * i), g1 = *(const f32x4*)(gg + 8 * i + 4);
          const f32x4 ga = {__uint_as_float(gr.x << 16), __uint_as_float(gr.x & 0xffff0000u), __uint_as_float(gr.y << 16), __uint_as_float(gr.y & 0xffff0000u)};
          const f32x4 gb = {__uint_as_float(gr.z << 16), __uint_as_float(gr.z & 0xffff0000u), __uint_as_float(gr.w << 16), __uint_as_float(gr.w & 0xffff0000u)};
          f32x4 ya = (v[2 * i] - mean) * rs * g0, yb = (v[2 * i + 1] - mean) * rs * g1;
#pragma unroll
          for (int k = 0; k < 4; ++k) { ya[k] *= ga[k] / (1.f + __expf(-ga[k])); yb[k] *= gb[k] / (1.f + __expf(-gb[k])); }
          *(u32x4*)(op + 8 * i) = fx::pack8(ya, yb); } }
    __syncthreads();
}
__device__ __forceinline__ void ret_out_phase(const bf16_t* RQ, const bf16_t* RK, const bf16_t* RV, const bf16_t* RG, const bf16_t* KVS, const float* gn_g, bf16_t* AO, char* lds) {
    for (int it = blockIdx.x; it < 512; it += gridDim.x) { const int bh = it >> 4, x = it & 15;
        ret_out_unit(RQ, RK, RV, RG, KVS, gn_g, AO, bh, 31 - x, lds);
        ret_out_unit(RQ, RK, RV, RG, KVS, gn_g, AO, bh, x, lds); }
}
#undef TRRD
#undef FRAG
}
namespace cg = cooperative_groups;
#ifndef DUP
#define DUP (-1)
#endif
__device__ __forceinline__ int opaque_reps(int n) { asm volatile("" : "+s"(n)); return n; }
#define REPS(code) for (int rep = 0; rep < ((DUP == (code)) ? 2 : 1); ++rep)
constexpr int NWAVES = 8;
constexpr int RING_BYTES = 131072, XL_OFF = RING_BYTES, XL_BYTES = 8192, XST_OFF = RING_BYTES + 8192 + 16384, LDS_BYTES = XST_OFF + 64;

struct Params {
    const float* in[28]; float* out; unsigned char* ws; int ph_lo, ph_hi; int coop; int pad;
};
typedef const Params __attribute__((address_space(4)))* KParams;
#define WSP(T_, off) ((T_*)(p->ws + (off)))

constexpr size_t WB_IN = WS_WB, WB_UQ = WB_IN + (size_t)2560 * 1024 * 2, WB_UKV = WB_UQ + (size_t)1024 * 256 * 2, WB_OUT = WB_UKV + (size_t)1024 * 256 * 2,
                 WB_CQ = WB_OUT + (size_t)1024 * 1024 * 2, WB_CKV = WB_CQ + (size_t)1024 * 1024 * 2, WB_CO = WB_CKV + (size_t)2048 * 1024 * 2,
                 WB_GU = WB_CO + (size_t)1024 * 1024 * 2, WB_D = WB_GU + (size_t)32 * 512 * 1024 * 2, WB_END = WB_D + (size_t)32 * 1024 * 256 * 2;
static_assert(WB_END <= WS_RQ, "weight copies overflow their region");

__device__ __forceinline__ float wave_sum64(float v) {
#pragma unroll
    for (int o = 1; o < 64; o <<= 1) v += __shfl_xor(v, o);
    return v;
}
__device__ __forceinline__ int plain_src(int n) { return (n & ~31) + pg8::perm32(n & 31); }

template <class SrcFn, class DstFn>
__device__ __forceinline__ void wprep_item(const float* __restrict__ W, int ldw, int Kreal, const float* __restrict__ gain, bf16_t* __restrict__ WT, int ldt,
                                           LAS float* scr, int kb, int nb, int lane, SrcFn src, DstFn dst) {
    const int k0 = 64 * kb, n0 = 64 * nb;
    u32x4* orow = (u32x4*)(WT + (size_t)dst(n0 + lane) * ldt + k0);
    if (k0 >= Kreal) {
#pragma unroll
        for (int c = 0; c < 8; ++c) orow[c] = (u32x4){0u, 0u, 0u, 0u};
        return; }
    const int krow = lane >> 4, n4 = lane & 15;
    int sc = src(n0 + 4 * n4); sc = sc < 0 ? 0 : sc;
    const float* wp = W + (size_t)(k0 + krow) * ldw + sc;
    f32x4 v[16];
#pragma unroll
    for (int i = 0; i < 16; ++i) v[i] = *(const f32x4*)(wp + (size_t)(4 * i) * ldw);
#pragma unroll
    for (int i = 0; i < 16; ++i) *(LAS f32x4*)(scr + (4 * i + krow) * 68 + 4 * n4) = v[i];
    asm volatile("s_waitcnt lgkmcnt(0)" ::: "memory");
    const bool zero = src(n0 + lane) < 0;
#pragma unroll
    for (int c = 0; c < 8; ++c) { float t[8];
#pragma unroll
        for (int j = 0; j < 8; ++j) { t[j] = scr[(8 * c + j) * 68 + lane]; if (gain) t[j] *= gain[k0 + 8 * c + j]; if (zero) t[j] = 0.f; }
        u32x4 o; o.x = pg8::cvt_pk_bf16(t[0], t[1]); o.y = pg8::cvt_pk_bf16(t[2], t[3]); o.z = pg8::cvt_pk_bf16(t[4], t[5]); o.w = pg8::cvt_pk_bf16(t[6], t[7]);
        orow[c] = o; }
    asm volatile("s_waitcnt lgkmcnt(0)" ::: "memory");
}
template <class SrcFn, class DstFn>
__device__ __forceinline__ void wprep_matrix(const float* W, int ldw, int Kreal, int Kpad, int Nitems64, const float* gain, bf16_t* WT, int ldt, LAS float* scr, int gw, int NGW, int lane, SrcFn src, DstFn dst) {
    const int nkb = Kpad / 64, total = nkb * Nitems64;
    for (int it = gw; it < total; it += NGW) wprep_item(W, ldw, Kreal, gain, WT, ldt, scr, it / Nitems64, it % Nitems64, lane, src, dst);
}
__device__ __forceinline__ void rms_row_to_bf16(const float* xrow, const float* g, bf16_t* orow, int lane) {
    const f32x4* xr = (const f32x4*)xrow + lane; const f32x4* gr = (const f32x4*)g + lane;
    f32x4 v[4]; float s = 0.f;
#pragma unroll
    for (int j = 0; j < 4; ++j) { v[j] = xr[64 * j]; s += fx::sq4(v[j]); }
    const float rs = rsqrtf(wave_sum64(s) * (1.f / 1024.f) + EPS);
    u32x2* o8 = (u32x2*)orow + lane;
#pragma unroll
    for (int j = 0; j < 4; ++j) { const f32x4 w = v[j] * rs * gr[64 * j]; o8[64 * j] = fx::pack4(w); }
}

__device__ __forceinline__ void p0_prologue(KParams p, LAS unsigned char* lds, int wave, int lane) {
    LAS float* scr = (LAS float*)(lds + wave * 17408);
    const int gw = blockIdx.x * NWAVES + wave, NGW = gridDim.x * NWAVES;
    auto ident = [](int n) { return n; };
    REPS(1004) {
    for (int it = gw; it < 2048; it += NGW) { int r = it;
        if (r < 640) { wprep_item(p->in[4], 2496, 1024, nullptr, WSP(bf16_t, WB_IN), 1024, scr, r / 40, r % 40, lane, [](int n) { return fx::inproj_src(n); }, ident); continue; } r -= 640;
        if (r < 256) { wprep_item(p->in[12], 1024, 1024, nullptr, WSP(bf16_t, WB_OUT), 1024, scr, r >> 4, r & 15, lane, ident, ident); continue; } r -= 256;
        if (r < 256) { wprep_item(p->in[19], 1024, 1024, nullptr, WSP(bf16_t, WB_CO), 1024, scr, r >> 4, r & 15, lane, ident, ident); continue; } r -= 256;
        if (r < 64) { wprep_item(p->in[6], 768, 256, p->in[5], WSP(bf16_t, WB_UQ), 256, scr, r >> 4, r & 15, lane, [](int n) { return fx::mlaq_src(n); }, ident); continue; } r -= 64;
        if (r < 64) { wprep_item(p->in[8], 1024, 128, p->in[7], WSP(bf16_t, WB_UKV), 256, scr, r >> 4, r & 15, lane, [](int n) { return plain_src(n); }, ident); continue; } r -= 64;
        if (r < 256) { wprep_item(p->in[15], 1024, 1024, p->in[13], WSP(bf16_t, WB_CQ), 1024, scr, r >> 4, r & 15, lane, [](int n) { return plain_src(n); }, ident); continue; } r -= 256;
        wprep_item(p->in[16], 2048, 1024, nullptr, WSP(bf16_t, WB_CKV), 1024, scr, r >> 5, r & 31, lane, [](int n) { return n < 1024 ? plain_src(n) : n; }, ident);
    }
    }
    REPS(1003) {
    for (int it = gw; it < 32 * 64; it += NGW) { const int e = it >> 6, r = it & 63, kb = r >> 2, nb = r & 3;
        auto srcf = [](int n) { return (n >> 7) * 128 + plain_src(n & 127); };
        wprep_item(p->in[25] + (size_t)e * 1024 * 256, 256, 1024, p->in[20], WSP(bf16_t, WB_GU) + (size_t)e * 512 * 1024, 1024, scr, kb, nb, lane, srcf, [](int n) { return (n >> 7) * 256 + (n & 127); });
        wprep_item(p->in[26] + (size_t)e * 1024 * 256, 256, 1024, p->in[20], WSP(bf16_t, WB_GU) + (size_t)e * 512 * 1024, 1024, scr, kb, nb, lane, srcf, [](int n) { return (n >> 7) * 256 + 128 + (n & 127); }); }
    for (int it = gw; it < 32 * 64; it += NGW) { const int e = it >> 6, r = it & 63, kb = r >> 4, nb = r & 15;
        wprep_item(p->in[27] + (size_t)e * 256 * 1024, 1024, 256, nullptr, WSP(bf16_t, WB_D) + (size_t)e * 1024 * 256, 256, scr, kb, nb, lane, ident, ident); }
    }
    REPS(1001) {
    for (int m = gw; m < T_TOK; m += 2 * NGW) {
        const f32x4* xr0 = (const f32x4*)(p->in[0] + (size_t)m * 1024) + lane; const f32x4* xr1 = (const f32x4*)(p->in[0] + (size_t)(m + NGW) * 1024) + lane; const f32x4* gr = (const f32x4*)p->in[3] + lane;
        f32x4 v0[4], v1[4]; float s0 = 0.f, s1 = 0.f;
#pragma unroll
        for (int j = 0; j < 4; ++j) { v0[j] = xr0[64 * j]; v1[j] = xr1[64 * j]; }
#pragma unroll
        for (int j = 0; j < 4; ++j) { s0 += fx::sq4(v0[j]); s1 += fx::sq4(v1[j]); }
        const float r0 = rsqrtf(wave_sum64(s0) * (1.f / 1024.f) + EPS), r1 = rsqrtf(wave_sum64(s1) * (1.f / 1024.f) + EPS);
        u32x2* o0 = (u32x2*)(WSP(bf16_t, WS_HB) + (size_t)m * 1024) + lane; u32x2* o1 = (u32x2*)(WSP(bf16_t, WS_HB) + (size_t)(m + NGW) * 1024) + lane;
#pragma unroll
        for (int j = 0; j < 4; ++j) { const f32x4 g = gr[64 * j]; o0[64 * j] = fx::pack4(v0[j] * r0 * g); o1[64 * j] = fx::pack4(v1[j] * r1 * g); } }
    for (int m = gw; m < 2048; m += NGW) rms_row_to_bf16(p->in[1] + (size_t)m * 1024, p->in[14], WSP(bf16_t, WS_MB) + (size_t)m * 1024, lane);
    }
    REPS(1002) {
    { const int* pos = (const int*)p->in[2]; float* cs = WSP(float, WS_CS);
      const int gt = blockIdx.x * (NWAVES * 64) + threadIdx.x, NT = gridDim.x * NWAVES * 64;
      { const int i = gt & 63; const float inv = powf(10000.f, -(float)i * (1.f / 64.f));
        for (int idx = gt; idx < T_TOK * 64; idx += NT) { const int t = idx >> 6; const float ang = (float)pos[t] * inv;
            const float n = rintf(ang * 0.15915494309189535f); float r = fmaf(-n, 6.2831854820251465f, ang); r = fmaf(-n, -1.7484555e-7f, r);
            *(f32x2*)(cs + (size_t)idx * 2) = (f32x2){__cosf(r), __sinf(r)}; } }
      float* z = WSP(float, WS_SSQ_CQ);
      for (int idx = gt; idx < 5 * 32768; idx += NT) z[idx] = 0.f;
      if (gt < 64) WSP(int, WS_CNT)[gt] = 0;
      bf16_t* wrh = WSP(bf16_t, WS_RW); bf16_t* wrl = wrh + 36 * 1032;
      for (int idx = gt; idx < 36 * 1032; idx += NT) { const int n = idx / 1032, k = idx % 1032; float v = 0.f;
          if (k < 1024) v = (n < 4) ? p->in[20][k] * p->in[21][k * 4 + n] : p->in[20][k] * p->in[23][k * 32 + n - 4];
          const bf16_t hh = f2bf(v); wrh[idx] = hh; wrl[idx] = f2bf(v - bf2f(hh)); } }
    }
}


#define GAS __attribute__((address_space(1)))
#define XB_TMO      128
#define XB_XCNT(j)  (256  + 64 * (j))
#define XB_XSUB(j)  (1280 + 64 * (j))
#define XB_XGEN(j)  (2304 + 64 * (j))
#define XB_TOP      3328
#define XB_TOPGEN   3392
#define XCD_BAR_WORDS 3456
#define XB_SPIN_CAP (1u << 18)
__device__ __forceinline__ unsigned xb_ld(unsigned* p)              { return __hip_atomic_load(p, __ATOMIC_RELAXED, __HIP_MEMORY_SCOPE_AGENT); }
__device__ __forceinline__ unsigned xb_add(unsigned* p, unsigned v) { return __hip_atomic_fetch_add(p, v, __ATOMIC_RELAXED, __HIP_MEMORY_SCOPE_AGENT); }
__device__ __forceinline__ unsigned xb_xcc_id() { return (unsigned)__builtin_amdgcn_s_getreg((3 << 11) | 20) & 0xFu; }
#define XB_SPIN(cond, bar) do { unsigned _sp = 0; while (cond) { __builtin_amdgcn_s_sleep(1); \
    if ((++_sp & 255u) == 0u) { if (xb_ld(&(bar)[XB_TMO])) break; if (_sp > XB_SPIN_CAP) { atomicAdd(&(bar)[XB_TMO], 1u); break; } } } } while (0)
struct XcdBarrier { unsigned* bar; unsigned x; volatile LAS unsigned* st; };
__device__ __forceinline__ XcdBarrier xcd_barrier_post(unsigned* bar, volatile LAS unsigned* st) {
    XcdBarrier b; b.bar = bar; b.x = xb_xcc_id(); b.st = st;
    if (threadIdx.x == 0) (void)xb_add(&bar[XB_XCNT(b.x)], 1u);
    return b;
}
__device__ __forceinline__ void xcd_barrier_complete(unsigned* bar, unsigned x, unsigned& nloc, unsigned& nx) {
    const unsigned G = gridDim.x * gridDim.y * gridDim.z;
    unsigned sum, cnt, mine, sp = 0u;
    for (;;) {
        sum = 0u; cnt = 0u; mine = 0u;
#pragma unroll
        for (unsigned j = 0; j < 16; ++j) { const unsigned c = xb_ld(&bar[XB_XCNT(j)]); sum += c; cnt += (c > 0u) ? 1u : 0u; mine = (j == x) ? c : mine; }
        if (sum == G) break;
        __builtin_amdgcn_s_sleep(1);
        if ((++sp & 255u) == 0u) { if (xb_ld(&bar[XB_TMO])) break; if (sp > XB_SPIN_CAP) { atomicAdd(&bar[XB_TMO], 1u); break; } }
    }
    nloc = mine > 0u ? mine : 1u; nx = cnt > 0u ? cnt : 1u;
}
__device__ __forceinline__ void xcd_barrier(const XcdBarrier& b) {
    asm volatile("s_waitcnt vmcnt(0)" ::: "memory");
    __syncthreads();
    if (threadIdx.x == 0) {
        unsigned* bar = b.bar;
        __builtin_amdgcn_s_waitcnt(0);
        unsigned nloc = b.st[0], nx = b.st[1];
        if (nloc == 0u) { xcd_barrier_complete(bar, b.x, nloc, nx); b.st[0] = nloc; b.st[1] = nx; }
        const unsigned old = xb_add(&bar[XB_XSUB(b.x)], 1u);
        const unsigned gen = old / nloc;
        if (old + 1u == (gen + 1u) * nloc) {
            __builtin_amdgcn_fence(__ATOMIC_RELEASE, "agent");
            asm volatile("s_waitcnt vmcnt(0)" ::: "memory");
            const unsigned og = xb_add(&bar[XB_TOP], 1u);
            const unsigned tg = og / nx;
            if (og + 1u == (tg + 1u) * nx) xb_add(&bar[XB_TOPGEN], 1u);
            else XB_SPIN(xb_ld(&bar[XB_TOPGEN]) == tg, bar);
            __builtin_amdgcn_fence(__ATOMIC_ACQUIRE, "agent");
            xb_add(&bar[XB_XGEN(b.x)], 1u);
            asm volatile("s_waitcnt vmcnt(0)" ::: "memory");
        } else {
            XB_SPIN(xb_ld(&bar[XB_XGEN(b.x)]) == gen, bar);
            __builtin_amdgcn_fence(__ATOMIC_ACQUIRE, "agent");
            asm volatile("s_waitcnt vmcnt(0)" ::: "memory");
        }
    }
    __syncthreads();
}

__device__ __forceinline__ void router_phase(KParams p, LAS unsigned char* lds, int wave, int lane, int* cnt, int* lists, float* roww) {
    const float* x2 = p->out;
    const float* bg = p->in[22]; const float* be = p->in[24];
    constexpr int RP = 2064;
    { const u32x4* src = WSP(u32x4, WS_RW); LAS u32x4* dst = (LAS u32x4*)lds;
      for (int i = threadIdx.x; i < 2 * 36 * RP / 16; i += NWAVES * 64) dst[i] = src[i]; }
    __syncthreads();
    const int tok = lane & 15, kq = lane >> 4;
    LAS unsigned char* wh = lds + tok * RP + kq * 16; LAS unsigned char* wl = wh + 36 * RP;
    const bool t2 = tok < 4;
    for (int item = blockIdx.x * NWAVES + wave; item < T_TOK / 16; item += gridDim.x * NWAVES) {
        const int t0 = item * 16;
        const float* xr = x2 + (size_t)(t0 + tok) * 1024 + 8 * kq;
        f32x4 c[3]; c[0] = (f32x4){0.f, 0.f, 0.f, 0.f}; c[1] = c[0]; c[2] = c[0]; float ss = 0.f;
#pragma unroll 8
        for (int ks = 0; ks < 32; ++ks) {
            const f32x4 xa = *(const f32x4*)(xr + 32 * ks), xb = *(const f32x4*)(xr + 32 * ks + 4);
            ss += fx::sq4(xa) + fx::sq4(xb);
            u32x4 hw = fx::pack8(xa, xb);
            const f32x4 ha = {__uint_as_float(hw.x << 16), __uint_as_float(hw.x & 0xffff0000u), __uint_as_float(hw.y << 16), __uint_as_float(hw.y & 0xffff0000u)};
            const f32x4 hb = {__uint_as_float(hw.z << 16), __uint_as_float(hw.z & 0xffff0000u), __uint_as_float(hw.w << 16), __uint_as_float(hw.w & 0xffff0000u)};
            u32x4 lw = fx::pack8(xa - ha, xb - hb);
            const bf16x8 xh = *reinterpret_cast<bf16x8*>(&hw), xl = *reinterpret_cast<bf16x8*>(&lw);
#pragma unroll
            for (int t = 0; t < 3; ++t) {
                bf16x8 ah, al;
                if (t < 2) { ah = *(const LAS bf16x8*)(wh + t * 16 * RP + ks * 64); al = *(const LAS bf16x8*)(wl + t * 16 * RP + ks * 64); }
                else { ah = *(const LAS bf16x8*)(wh + (t2 ? 32 * RP : 0) + ks * 64); al = *(const LAS bf16x8*)(wl + (t2 ? 32 * RP : 0) + ks * 64);
                       if (!t2) { ah = (bf16x8){0, 0, 0, 0, 0, 0, 0, 0}; al = ah; } }
                c[t] = __builtin_amdgcn_mfma_f32_16x16x32_bf16(ah, xh, c[t], 0, 0, 0);
                c[t] = __builtin_amdgcn_mfma_f32_16x16x32_bf16(ah, xl, c[t], 0, 0, 0);
                c[t] = __builtin_amdgcn_mfma_f32_16x16x32_bf16(al, xh, c[t], 0, 0, 0);
            }
        }
        ss = fx::quad_sum(ss);
        const float rs = rsqrtf(ss * (1.f / 1024.f) + EPS);
#pragma unroll
        for (int t = 0; t < 3; ++t) c[t] = c[t] * rs;
        float g[4];
#pragma unroll
        for (int r = 0; r < 4; ++r) g[r] = __shfl(c[0][r], tok);
        const float mx = fmaxf(fmaxf(g[0], g[1]), fmaxf(g[2], g[3]));
        float den = 0.f;
#pragma unroll
        for (int j = 0; j < 4; ++j) den += expf(g[j] - mx);
        int gs = 0; float best = g[0] + bg[0], lgs = g[0];
#pragma unroll
        for (int j = 1; j < 4; ++j) { const float v = g[j] + bg[j]; if (v > best) { best = v; gs = j; lgs = g[j]; } }
        const float gw = expf(lgs - mx) / den;
        const int qA = 1 + 2 * gs, qB = qA + 1;
        f32x4 sA = (qA >> 2) == 0 ? c[0] : ((qA >> 2) == 1 ? c[1] : c[2]);
        f32x4 sB = (qB >> 2) == 0 ? c[0] : ((qB >> 2) == 1 ? c[1] : c[2]);
        float el[8];
#pragma unroll
        for (int r = 0; r < 4; ++r) { el[r] = __shfl(sA[r], tok + 16 * (qA & 3)); el[4 + r] = __shfl(sB[r], tok + 16 * (qB & 3)); }
        float emx = el[0];
#pragma unroll
        for (int j = 1; j < 8; ++j) emx = fmaxf(emx, el[j]);
        float eden = 0.f;
#pragma unroll
        for (int j = 0; j < 8; ++j) eden += expf(el[j] - emx);
        float sc[8];
#pragma unroll
        for (int j = 0; j < 8; ++j) sc[j] = el[j] + be[gs * 8 + j];
        int i0 = 0; float b0 = sc[0], e0v = el[0];
#pragma unroll
        for (int j = 1; j < 8; ++j) if (sc[j] > b0) { b0 = sc[j]; i0 = j; e0v = el[j]; }
        int i1 = -1; float b1 = -3.0e38f, e1v = 0.f;
#pragma unroll
        for (int j = 0; j < 8; ++j) if (j != i0 && sc[j] > b1) { b1 = sc[j]; i1 = j; e1v = el[j]; }
        LAS int* hist = (LAS int*)(lds + 2 * 36 * RP + 128); LAS int* hbase = hist + 64;
        if (threadIdx.x < 64) hist[threadIdx.x] = 0;
        __syncthreads();
        const float p0 = expf(e0v - emx) / eden, p1 = expf(e1v - emx) / eden, sm = p0 + p1;
        const int sg0 = gs * 8 + i0, sg1 = 32 + gs * 8 + i1;
        int r0 = 0, r1 = 0;
        if (kq == 0) { r0 = __hip_atomic_fetch_add(hist + sg0, 1, __ATOMIC_RELAXED, __HIP_MEMORY_SCOPE_WORKGROUP); r1 = __hip_atomic_fetch_add(hist + sg1, 1, __ATOMIC_RELAXED, __HIP_MEMORY_SCOPE_WORKGROUP); }
        __syncthreads();
        if (threadIdx.x < 64) { const int n = hist[threadIdx.x]; hbase[threadIdx.x] = n > 0 ? atomicAdd(cnt + threadIdx.x, n) : 0; }
        __syncthreads();
        if (kq == 0) {
            const int t = t0 + tok; const int q0 = hbase[sg0] + r0, q1 = hbase[sg1] + r1;
            lists[(size_t)sg0 * fx::MOE_CAP + q0] = t; roww[(size_t)sg0 * fx::MOE_CAP + q0] = p0 / sm * gw;
            lists[(size_t)sg1 * fx::MOE_CAP + q1] = t; roww[(size_t)sg1 * fx::MOE_CAP + q1] = p1 / sm * gw;
        }
    }
    __syncthreads();
}

__global__ void __launch_bounds__(NWAVES * 64, 2) mk_fwd(Params p_arg) {
    KParams p = (KParams)__builtin_amdgcn_kernarg_segment_ptr();
    extern __shared__ __attribute__((aligned(16))) unsigned char lds_raw[];
    LAS unsigned char* lds = (LAS unsigned char*)lds_raw;
    LAS unsigned char* xl = lds + XL_OFF;
    const int tid = threadIdx.x, lane = tid & 63, wave = __builtin_amdgcn_readfirstlane(tid >> 6);
    const int lo = p->ph_lo, hi = p->ph_hi;
#ifndef PHMASK
#define PHMASK 0xffffffffu
#endif
#define IN(k) (((PHMASK >> (k)) & 1u) && lo <= (k) && (k) < hi)
#define SEAM(k) do { if (IN(k) && IN((k) + 1)) { xcd_barrier(xbar); if (DUP == 1000) xcd_barrier(xbar); } } while (0)
    volatile LAS unsigned* xst = (volatile LAS unsigned*)(lds + XST_OFF);
    if (tid == 0) { xst[0] = 0u; xst[1] = 0u; }
    __syncthreads();
    XcdBarrier xbar = xcd_barrier_post(WSP(unsigned, WS_BAR), xst);
    if (lo < 0) cg::this_grid().sync();
    float* const dummyf = WSP(float, 512 * 1024);
    REPS(0) if (IN(0)) { p0_prologue(p, lds, wave, lane); }
    SEAM(0);
    if (IN(1)) {
        REPS(1) {
        pg8::GridOrder S; S.init(WSP(bf16_t, WS_HB), 1024, WSP(bf16_t, WB_IN), 1024, T_TOK, 2560, gridDim.x, blockIdx.x);
        fx::EpiInProj E{WSP(bf16_t, WS_CQ), WSP(bf16_t, WS_CKV), WSP(bf16_t, WS_RQ), WSP(bf16_t, WS_RK), WSP(bf16_t, WS_RV), WSP(bf16_t, WS_RG),
                        rep ? dummyf : WSP(float, WS_SSQ_CQ), rep ? dummyf : WSP(float, WS_SSQ_CKV), rep ? dummyf : WSP(float, WS_SSQ_KPE), WSP(float, WS_CS), p->in[10]};
        pg8::gemm_phase<fx::EpiInProj, pg8::GridOrder>(lds, xl, 1024, 1024, 1024, S, E); }
        REPS(101) { fx::MemKVOrder S2{(int)gridDim.x, (int)blockIdx.x, (const char*)WSP(bf16_t, WS_MB), (const char*)WSP(bf16_t, WB_CKV)};
          fx::EpiMemKV E2{WSP(bf16_t, WS_KC), WSP(bf16_t, WS_VC), p->in[18]};
          pg8::gemm_phase<fx::EpiMemKV, fx::MemKVOrder>(lds, xl, 1024, 1024, 1024, S2, E2); }
    }
    SEAM(1);
    if (IN(2)) {
        REPS(2) {
        { pg8::GridOrder S; S.init(WSP(bf16_t, WS_CQ), 256, WSP(bf16_t, WB_UQ), 256, T_TOK, 1024, gridDim.x, blockIdx.x);
          fx::EpiMlaQ E{WSP(bf16_t, WS_QM), WSP(float, WS_SSQ_CQ), p->in[9], WSP(float, WS_CS)};
          pg8::gemm_phase<fx::EpiMlaQ, pg8::GridOrder>(lds, xl, 256, 256, 256, S, E); }
        { pg8::GridOrder S; S.init(WSP(bf16_t, WS_CKV), 256, WSP(bf16_t, WB_UKV), 256, T_TOK, 1024, gridDim.x, blockIdx.x);
          fx::EpiMlaKV E{WSP(bf16_t, WS_KM), WSP(bf16_t, WS_VM), WSP(bf16_t, WS_CKV), WSP(float, WS_SSQ_CKV), WSP(float, WS_SSQ_KPE), p->in[10]};
          pg8::gemm_phase<fx::EpiMlaKV, pg8::GridOrder>(lds, xl, 256, 256, 256, S, E); } }
        REPS(201) rt::ret_kv_phase(WSP(bf16_t, WS_RK), WSP(bf16_t, WS_RV), WSP(bf16_t, WS_KVS), (char*)lds_raw);
    }
    SEAM(2);
    if (IN(3)) { REPS(3) at::attn_phase(WSP(bf16_t, WS_QM), WSP(bf16_t, WS_KM), WSP(bf16_t, WS_VM), WSP(bf16_t, WS_AO), (char*)lds_raw);
                 REPS(301) rt::ret_out_phase(WSP(bf16_t, WS_RQ), WSP(bf16_t, WS_RK), WSP(bf16_t, WS_RV), WSP(bf16_t, WS_RG), WSP(bf16_t, WS_KVS), p->in[11], WSP(bf16_t, WS_AO), (char*)lds_raw); }
    SEAM(3);
    if (IN(4)) for (int rep = 0; rep < ((DUP == 4 || DUP == 1004 + 1000) ? 2 : 1); ++rep) {
        pg8::GridOrder S; S.init(WSP(bf16_t, WS_AO), 1024, WSP(bf16_t, WB_OUT), 1024, T_TOK, 1024, gridDim.x, blockIdx.x);
        fx::EpiResid<false, false> E{p->in[0], p->out, WSP(bf16_t, WS_XB), rep ? ((DUP == 4) ? dummyf : (float*)nullptr) : WSP(float, WS_SSQ1)};
        pg8::gemm_phase<fx::EpiResid<false, false>, pg8::GridOrder>(lds, xl, 1024, 1024, 1024, S, E);
    }
    SEAM(4);
    if (IN(5)) REPS(5) {
        pg8::GridOrder S; S.init(WSP(bf16_t, WS_XB), 1024, WSP(bf16_t, WB_CQ), 1024, T_TOK, 1024, gridDim.x, blockIdx.x);
        fx::EpiHeadNorm E{WSP(bf16_t, WS_QC), WSP(float, WS_SSQ1), p->in[17], 1.f / 1024.f};
        pg8::gemm_phase<fx::EpiHeadNorm, pg8::GridOrder>(lds, xl, 1024, 1024, 1024, S, E);
    }
    SEAM(5);
    if (IN(6)) REPS(6) {
        fx::HeadOrder S{(int)gridDim.x, (int)blockIdx.x, 512, (const char*)WSP(bf16_t, WS_QC), (const char*)WSP(bf16_t, WS_KC), (size_t)256 * 1024 * 2, (size_t)256 * 2, (size_t)256 * 1024 * 2, (size_t)256 * 2};
        fx::EpiSoftmax E{WSP(bf16_t, WS_PC)};
        pg8::gemm_phase<fx::EpiSoftmax, fx::HeadOrder>(lds, xl, 1024, 1024, 256, S, E);
    }
    SEAM(6);
    if (IN(7)) REPS(7) {
        fx::HeadOrder S{(int)gridDim.x, (int)blockIdx.x, 512, (const char*)WSP(bf16_t, WS_PC), (const char*)WSP(bf16_t, WS_VC), (size_t)256 * 1024 * 2, (size_t)256 * 2, (size_t)1024 * 256 * 2, (size_t)256 * 256 * 2};
        fx::EpiStoreBf16 E{WSP(bf16_t, WS_OC), 1024, 0};
        pg8::gemm_phase<fx::EpiStoreBf16, fx::HeadOrder>(lds, xl, 1024, 256, 256, S, E);
    }
    SEAM(7);
    if (IN(8)) {
        pg8::GridOrder S; S.init(WSP(bf16_t, WS_OC), 1024, WSP(bf16_t, WB_CO), 1024, T_TOK, 1024, gridDim.x, blockIdx.x);
        fx::EpiResid<true, true> E{nullptr, p->out, WSP(bf16_t, WS_XB), WSP(float, WS_SSQ2)};
        pg8::gemm_phase<fx::EpiResid<true, true>, pg8::GridOrder>(lds, xl, 1024, 1024, 1024, S, E);
    }
    SEAM(8);
    if (IN(9)) REPS(9) { router_phase(p, lds, wave, lane, rep ? WSP(int, 32 * 1024) : WSP(int, WS_CNT), rep ? WSP(int, WS_AO) : WSP(int, WS_LISTS), rep ? WSP(float, WS_AO + 8 * MiB) : WSP(float, WS_ROWW)); }
    SEAM(9);
    if (IN(10)) for (int rep = 0; rep < ((DUP == 10 || DUP == 2010 || DUP == 3010) ? 2 : 1); ++rep) {
        fx::MoeOrder S{(int)gridDim.x, (int)blockIdx.x, 0, 64, 2, WSP(int, WS_CNT), WSP(int, WS_LISTS), (const char*)WSP(bf16_t, WS_XB), (const char*)WSP(bf16_t, WB_GU), (DUP == 3010 && rep) ? (size_t)256 * 1024 * 2 : 0, (size_t)512 * 1024 * 2, (size_t)256 * 1024 * 2, nullptr}; S.init(xl);
        fx::EpiGlu E{(rep && DUP != 10) ? (bf16_t*)nullptr : WSP(bf16_t, WS_H), WSP(float, WS_SSQ2), WSP(float, WS_ROWW), WSP(int, WS_LISTS)};
        if (DUP == 3010 && rep) pg8::gemm_phase<fx::EpiGlu, fx::MoeOrder, false>(lds, xl, 1024, 1024, 1024, S, E);
        else pg8::gemm_phase<fx::EpiGlu, fx::MoeOrder, true>(lds, xl, 1024, 1024, 1024, S, E);
    }
    SEAM(10);
    if (IN(11)) {
        fx::MoeOrder S{(int)gridDim.x, (int)blockIdx.x, 0, 32, 4, WSP(int, WS_CNT), WSP(int, WS_LISTS), (const char*)WSP(bf16_t, WS_H), (const char*)WSP(bf16_t, WB_D), (size_t)256 * 256 * 2, (size_t)1024 * 256 * 2, (size_t)256 * 256 * 2, nullptr}; S.init(xl);
        fx::EpiScatter<0> E{p->out, WSP(bf16_t, WS_Y0)};
        pg8::gemm_phase<fx::EpiScatter<0>, fx::MoeOrder>(lds, xl, 256, 256, 256, S, E);
    }
    SEAM(11);
    if (IN(12)) {
        fx::MoeOrder S{(int)gridDim.x, (int)blockIdx.x, 32, 64, 4, WSP(int, WS_CNT), WSP(int, WS_LISTS), (const char*)WSP(bf16_t, WS_H), (const char*)WSP(bf16_t, WB_D), (size_t)256 * 256 * 2, (size_t)1024 * 256 * 2, (size_t)256 * 256 * 2, nullptr}; S.init(xl);
        fx::EpiScatter<1> E{p->out, WSP(bf16_t, WS_Y0)};
        pg8::gemm_phase<fx::EpiScatter<1>, fx::MoeOrder>(lds, xl, 256, 256, 256, S, E);
    }
#undef IN
#undef SEAM
}

extern "C" void kernel_launch(void* const* d_in, const int* in_sizes, int n_in, void* d_out, int out_size, void* d_ws, size_t ws_size, hipStream_t stream) {
    static int grid = 0;
    if (grid == 0) {
        if (n_in != 28 || out_size != T_TOK * 1024 || ws_size < WS_NEED) { fprintf(stderr, "kernel_launch: unexpected shapes n_in %d out %d ws %zu\n", n_in, out_size, ws_size); grid = -1; return; }
        int dev = 0, cus = 0, per_cu = 0;
        if (hipGetDevice(&dev) != hipSuccess || hipDeviceGetAttribute(&cus, hipDeviceAttributeMultiprocessorCount, dev) != hipSuccess) { grid = -1; return; }
        if (hipFuncSetAttribute((const void*)mk_fwd, hipFuncAttributeMaxDynamicSharedMemorySize, LDS_BYTES) != hipSuccess) { fprintf(stderr, "hipFuncSetAttribute failed\n"); grid = -1; return; }
        if (hipOccupancyMaxActiveBlocksPerMultiprocessor(&per_cu, (const void*)mk_fwd, NWAVES * 64, LDS_BYTES) != hipSuccess || per_cu < 1) { fprintf(stderr, "occupancy query failed (%d)\n", per_cu); grid = -1; return; }
        grid = cus;
        (void)hipGetLastError();
    }
    if (grid < 0) return;
    if (hipMemsetAsync(d_ws, 0, 65536, stream) != hipSuccess) { fprintf(stderr, "hipMemsetAsync failed\n"); return; }
    Params p; memset(&p, 0, sizeof(p));
    for (int i = 0; i < 28; ++i) p.in[i] = (const float*)d_in[i];
    p.out = (float*)d_out; p.ws = (unsigned char*)d_ws; p.ph_lo = 0; p.ph_hi = 13; p.coop = 1;
    void* args[] = {&p};
    hipError_t e = hipLaunchCooperativeKernel((const void*)mk_fwd, dim3(grid), dim3(NWAVES * 64), args, LDS_BYTES, stream);
    if (e != hipSuccess) fprintf(stderr, "cooperative launch failed: %s (grid %d)\n", hipGetErrorString(e), grid);
}
```

```cpp
#include <hip/hip_runtime.h>
#include <hip/hip_cooperative_groups.h>
#include <cstdint>
#include <cstdio>
#include <cmath>
#include <cstring>

typedef unsigned short bf16_t;
constexpr float EPS = 1e-6f;
constexpr int T_TOK = 32768;
__device__ __forceinline__ float bf2f(bf16_t h) { return __uint_as_float((unsigned)h << 16); }
__device__ __forceinline__ bf16_t f2bf(float f) { const unsigned u = __float_as_uint(f); return (bf16_t)((u + 0x7fffu + ((u >> 16) & 1u)) >> 16); }

constexpr size_t MiB = (size_t)1 << 20;
constexpr size_t WS_CTL = 0;
constexpr size_t WS_SSQ_CQ = 1 * MiB, WS_SSQ_CKV = WS_SSQ_CQ + 128 * 1024, WS_SSQ_KPE = WS_SSQ_CKV + 128 * 1024, WS_SSQ1 = WS_SSQ_KPE + 128 * 1024, WS_SSQ2 = WS_SSQ1 + 128 * 1024;
constexpr size_t WS_SEL = 2 * MiB, WS_WTS = WS_SEL + 256 * 1024;
constexpr size_t WS_RW = 4 * MiB;
constexpr size_t WS_CS = 5 * MiB;
constexpr size_t WS_MB = 21 * MiB, WS_KC = 25 * MiB, WS_VC = 29 * MiB;
constexpr size_t WS_WB = 33 * MiB;
constexpr size_t WS_RQ = 97 * MiB, WS_RK = 129 * MiB, WS_RV = 161 * MiB, WS_RG = 193 * MiB;
constexpr size_t WS_HB = 225 * MiB;
constexpr size_t WS_QM = 225 * MiB, WS_KM = 273 * MiB, WS_VM = 321 * MiB;
constexpr size_t WS_KVS = 353 * MiB;
constexpr size_t WS_AO = 385 * MiB;
constexpr size_t WS_STS = 449 * MiB;
constexpr size_t WS_CQ = 449 * MiB, WS_CKV = 465 * MiB;
constexpr size_t WS_PJ = 289 * MiB;
constexpr size_t WS_RAW = 353 * MiB;
constexpr size_t WS_XB = 97 * MiB;
constexpr size_t WS_QCR = 161 * MiB;
constexpr size_t WS_PC = 161 * MiB;
constexpr size_t WS_QC = 225 * MiB;
constexpr size_t WS_OC = 289 * MiB;
constexpr size_t WS_KVR = 353 * MiB;
constexpr size_t WS_BAR = 16 * 1024;
constexpr size_t WS_CNT = 64 * 1024;
constexpr size_t WS_LISTS = 353 * MiB, WS_ROWW = 361 * MiB;
constexpr size_t WS_Y0 = 225 * MiB;
constexpr size_t WS_H = 161 * MiB;
constexpr size_t WS_NEED = 481 * MiB;
#define LAS __attribute__((address_space(3)))
typedef short bf16x8 __attribute__((ext_vector_type(8)));
typedef float f32x4 __attribute__((ext_vector_type(4)));
typedef float f32x2 __attribute__((ext_vector_type(2)));
typedef unsigned u32x4 __attribute__((ext_vector_type(4)));
typedef unsigned u32x2 __attribute__((ext_vector_type(2)));

namespace pg8 {
constexpr int BM = 256, BK = 64, HALF = 128, HTB = HALF * BK * 2, STAGE_BYTES = 8 * HTB, NXCD = 8, WGM = 8;
__host__ __device__ __forceinline__ int lds_byte(int r, int c) { const int st = (r >> 4) * 2 + (c >> 5), rr = r & 15, cc = c & 31, ob = rr * 64 + cc * 2; return st * 1024 + (ob ^ (((ob >> 9) & 1) << 5)); }
__host__ __device__ __forceinline__ void stage_rc(int b, int& R, int& C) { const int st = b / 1024, sb = b % 1024, swz = sb ^ (((sb >> 9) & 1) << 5); R = (st >> 1) * 16 + swz / 64; C = (st & 1) * 32 + (swz % 64) / 2; }
__host__ __device__ __forceinline__ int perm32(int rho) { const int n = rho >> 4, i = rho & 15; return 8 * (i >> 2) + 4 * n + (i & 3); }
__device__ __forceinline__ unsigned cvt_pk_bf16(float lo, float hi) { unsigned r; asm volatile("v_cvt_pk_bf16_f32 %0, %1, %2" : "=v"(r) : "v"(lo), "v"(hi)); return r; }

struct Unit { int pm, pn; const char* a; const char* b; const int* rows; int nvalid, seg; };

struct GridOrder {
    int nM, nN, nwg, G, c; const char* A; const char* B; size_t strideA, strideB;
    __device__ __forceinline__ void init(const bf16_t* A_, int lda, const bf16_t* B_, int ldb, int M, int N, int G_, int c_) {
        nM = M / BM; nN = N / BM; nwg = nM * nN; G = G_; c = c_; A = (const char*)A_; B = (const char*)B_; strideA = (size_t)BM * lda * 2; strideB = (size_t)BM * ldb * 2; }
    __device__ __forceinline__ bool next(int i, Unit& u) const {
        const long L = (long)i * G + c; if (L >= nwg) return false;
        int wgid = (int)L; { const int q = nwg / NXCD, r = nwg % NXCD, xcd = wgid % NXCD, off = wgid / NXCD; wgid = (xcd < r ? xcd * (q + 1) : r * (q + 1) + (xcd - r) * q) + off; }
        const int nig = WGM * nN, gid = wgid / nig, fm = gid * WGM, gsz = (nM - fm) < WGM ? (nM - fm) : WGM;
        u.pm = fm + ((wgid % nig) % gsz); u.pn = (wgid % nig) / gsz; u.a = A + (size_t)u.pm * strideA; u.b = B + (size_t)u.pn * strideB; u.rows = nullptr; u.nvalid = 256; u.seg = 0; return true;
    }
};

#define XBAR() do { asm volatile("s_waitcnt lgkmcnt(0)" ::: "memory"); __builtin_amdgcn_s_barrier(); asm volatile("" ::: "memory"); } while (0)

__device__ __forceinline__ void row_allreduce_sum(float (&s)[2][4], int wr, int wc, int fr, int fq, LAS unsigned char* xl) {
    LAS float* P = (LAS float*)xl;
#pragma unroll
    for (int ai = 0; ai < 2; ++ai)
#pragma unroll
        for (int m = 0; m < 4; ++m) { float v = s[ai][m]; v += __shfl_xor(v, 16); v += __shfl_xor(v, 32); if (fq == 0) P[(ai * HALF + wr * 64 + m * 16 + fr) * 4 + wc] = v; }
    XBAR();
#pragma unroll
    for (int ai = 0; ai < 2; ++ai)
#pragma unroll
        for (int m = 0; m < 4; ++m) { const f32x4 p = *(const LAS f32x4*)(P + (ai * HALF + wr * 64 + m * 16 + fr) * 4); s[ai][m] = (p[0] + p[1]) + (p[2] + p[3]); }
    XBAR();
}
__device__ __forceinline__ void row_allreduce_max(float (&s)[2][4], int wr, int wc, int fr, int fq, LAS unsigned char* xl) {
    LAS float* P = (LAS float*)xl;
#pragma unroll
    for (int ai = 0; ai < 2; ++ai)
#pragma unroll
        for (int m = 0; m < 4; ++m) { float v = s[ai][m]; v = fmaxf(v, __shfl_xor(v, 16)); v = fmaxf(v, __shfl_xor(v, 32)); if (fq == 0) P[(ai * HALF + wr * 64 + m * 16 + fr) * 4 + wc] = v; }
    XBAR();
#pragma unroll
    for (int ai = 0; ai < 2; ++ai)
#pragma unroll
        for (int m = 0; m < 4; ++m) { const f32x4 p = *(const LAS f32x4*)(P + (ai * HALF + wr * 64 + m * 16 + fr) * 4); s[ai][m] = fmaxf(fmaxf(p[0], p[1]), fmaxf(p[2], p[3])); }
    XBAR();
}

template <class Epi, class Sched, bool GATHER = false>
__device__ __forceinline__ void gemm_phase(LAS unsigned char* lds, LAS unsigned char* xl, int lda, int ldb, int K, const Sched& S, const Epi& E) {
    const int tid = threadIdx.x, wid = __builtin_amdgcn_readfirstlane(tid >> 6), lane = tid & 63, wr = wid >> 2, wc = wid & 3, fr = lane & 15, fq = lane >> 4;
    asm volatile("" : "+s"(K));
    const int nt = K / BK;
    int sR[2], sC[2];
    unsigned voffA[2], voffB[2];
#pragma unroll
    for (int i = 0; i < 2; ++i) { int R, C; stage_rc(tid * 16 + i * 8192, R, C); const int Rb = Epi::PERM ? ((R & ~31) + perm32(R & 31)) : R; sR[i] = R; sC[i] = C;
        voffA[i] = (unsigned)(R * lda + C) * 2u; voffB[i] = (unsigned)(Rb * ldb + C) * 2u; }
    const size_t kstep = (size_t)(BK * 2);
    const size_t hstepA = (size_t)HALF * lda * 2, hstepB = (size_t)HALF * ldb * 2;
    const unsigned ldsw = (unsigned)wid * 1024u;
    const int aoff = lds_byte(wr * 64 + fr, fq * 8), boff = lds_byte(wc * 32 + fr, fq * 8);
#define PG8_SA(b, h) (((b) * 2 + (h)) * HTB)
#define PG8_SB(b, h) ((4 + (b) * 2 + (h)) * HTB)
#define PG8_STAGE(bufoff, gbase, voff) do { _Pragma("unroll") for (int _i = 0; _i < 2; ++_i) \
        __builtin_amdgcn_global_load_lds((const unsigned*)((const char*)(gbase) + (voff)[_i]), (LAS unsigned*)(lds + (bufoff) + ldsw + _i * 8192), 16, 0, 0); } while (0)
#define PG8_LDA(dst, b, h) do { _Pragma("unroll") for (int m = 0; m < 4; ++m) _Pragma("unroll") for (int k = 0; k < 2; ++k) dst[m][k] = *(const LAS bf16x8*)(lds + PG8_SA(b, h) + aoff + m * 2048 + k * 1024); } while (0)
#define PG8_LDB(dst, b, h) do { _Pragma("unroll") for (int n = 0; n < 2; ++n) _Pragma("unroll") for (int k = 0; k < 2; ++k) dst[n][k] = *(const LAS bf16x8*)(lds + PG8_SB(b, h) + boff + n * 2048 + k * 1024); } while (0)
#define PG8_MMA(ai, bj, At, Bt) do { __builtin_amdgcn_s_setprio(1); _Pragma("unroll") for (int m = 0; m < 4; ++m) _Pragma("unroll") for (int n = 0; n < 2; ++n) _Pragma("unroll") for (int k = 0; k < 2; ++k) \
        acc[ai][bj][m][n] = __builtin_amdgcn_mfma_f32_16x16x32_bf16(Bt[n][k], At[m][k], acc[ai][bj][m][n], 0, 0, 0); __builtin_amdgcn_s_setprio(0); } while (0)
#define PG8_WAIT_V(n) asm volatile("s_waitcnt vmcnt(" #n ")" ::: "memory")
#define PG8_WAIT_L(n) asm volatile("s_waitcnt lgkmcnt(" #n ")" ::: "memory")
#define PG8_BAR __builtin_amdgcn_s_barrier()
#define PG8_SCHED __builtin_amdgcn_sched_barrier(0)
    LAS unsigned char* gl = xl + 8192 + tid * 16;
    int gA0 = 0, gA1 = 8192;
#define PG8_GATH(T, u) do { u32x4 _o; { int _r[4]; _Pragma("unroll") for (int _q = 0; _q < 4; ++_q) { const int _rl = (_q >> 1) * HALF + sR[_q & 1]; _r[_q] = (_rl < (u).nvalid) ? (u).rows[_rl] : 0; } \
        _Pragma("unroll") for (int _q = 0; _q < 4; ++_q) _o[_q] = (unsigned)(_r[_q] * lda + sC[_q & 1]) * 2u; } *(LAS u32x4*)(gl + (T)) = _o; } while (0)
#define PG8_STAGE_A(bufoff, base, h, kbytes, G4) do { if constexpr (GATHER) { const u32x2 _g = {(G4)[2 * (h)], (G4)[2 * (h) + 1]}; PG8_STAGE(bufoff, (base) + (kbytes), _g); } else { PG8_STAGE(bufoff, (base) + (size_t)(h) * hstepA + (kbytes), voffA); } } while (0)
    Unit cur, nxt; int ui = 0;
    if (!S.next(0, cur)) return;
    f32x4 acc[2][2][4][2];
#pragma unroll
    for (int a = 0; a < 2; ++a)
#pragma unroll
        for (int b = 0; b < 2; ++b)
#pragma unroll
            for (int m = 0; m < 4; ++m)
#pragma unroll
                for (int n = 0; n < 2; ++n) acc[a][b][m][n] = (f32x4){0.f, 0.f, 0.f, 0.f};
    bf16x8 At[4][2], B0[2][2], B1[2][2];
    const char* cA = cur.a; const char* cB = cur.b;
    u32x4 gcur = {0u, 0u, 0u, 0u};
    if constexpr (GATHER) { PG8_GATH(gA0, cur); gcur = *(const LAS u32x4*)(gl + gA0); }
    PG8_STAGE(PG8_SB(0, 0), cB, voffB); PG8_STAGE(PG8_SB(0, 1), cB + hstepB, voffB); PG8_STAGE_A(PG8_SA(0, 0), cA, 0, 0, gcur); PG8_STAGE_A(PG8_SA(0, 1), cA, 1, 0, gcur);
    if (wr == 1) PG8_BAR;
    PG8_WAIT_V(2); PG8_BAR;
    PG8_STAGE(PG8_SB(1, 0), cB + kstep, voffB); PG8_STAGE_A(PG8_SA(1, 0), cA, 0, kstep, gcur); PG8_STAGE(PG8_SB(1, 1), cB + hstepB + kstep, voffB);
    PG8_WAIT_V(6); PG8_BAR;
    for (;;) {
        const bool has_next = S.next(ui + 1, nxt);
        const char* nA = has_next ? nxt.a : cA; const char* nB = has_next ? nxt.b : cB;
        if constexpr (GATHER) { if (has_next) { PG8_GATH(gA1, nxt); } else { PG8_GATH(gA1, cur); } }
#pragma unroll 1
        for (int t = 0; t < nt; t += 2) {
            const bool last = (t == nt - 2);
            const size_t k1 = (size_t)(t + 1) * kstep;
            const char* a2 = last ? nA : cA; const char* b2 = last ? nB : cB + (size_t)(t + 2) * kstep;
            const size_t ka2 = last ? 0 : (size_t)(t + 2) * kstep;
            const char* b3 = b2 + kstep; const size_t ka3 = ka2 + kstep;
            u32x4 gq = gcur; if constexpr (GATHER) { if (last) gq = *(const LAS u32x4*)(gl + gA1); }
            PG8_LDB(B0, 0, 0); PG8_LDB(B1, 0, 1); PG8_SCHED; PG8_LDA(At, 0, 0); PG8_STAGE_A(PG8_SA(1, 1), cA, 1, k1, gcur);
            PG8_WAIT_V(8); PG8_WAIT_L(0); PG8_BAR; PG8_MMA(0, 0, At, B0); PG8_MMA(0, 1, At, B1); PG8_BAR; PG8_SCHED;
            PG8_LDA(At, 0, 1); PG8_STAGE(PG8_SB(0, 0), b2, voffB); PG8_STAGE(PG8_SB(0, 1), b2 + hstepB, voffB);
            PG8_STAGE_A(PG8_SA(0, 0), a2, 0, ka2, gq);
            PG8_WAIT_V(8); PG8_WAIT_L(0); PG8_BAR; PG8_MMA(1, 0, At, B0); PG8_MMA(1, 1, At, B1); PG8_BAR; PG8_SCHED;
            PG8_LDB(B0, 1, 0); PG8_LDB(B1, 1, 1); PG8_SCHED; PG8_LDA(At, 1, 0);
            PG8_STAGE_A(PG8_SA(0, 1), a2, 1, ka2, gq);
            PG8_WAIT_V(8); PG8_WAIT_L(0); PG8_BAR; PG8_MMA(0, 0, At, B0); PG8_MMA(0, 1, At, B1); PG8_BAR; PG8_SCHED;
            PG8_LDA(At, 1, 1); PG8_STAGE(PG8_SB(1, 0), b3, voffB); PG8_STAGE(PG8_SB(1, 1), b3 + hstepB, voffB);
            PG8_STAGE_A(PG8_SA(1, 0), a2, 0, ka3, gq);
            PG8_WAIT_V(8); PG8_WAIT_L(0); PG8_BAR; PG8_MMA(1, 0, At, B0); PG8_MMA(1, 1, At, B1); PG8_BAR; PG8_SCHED;
        }
        if (wr == 0) PG8_BAR;
        E(acc, cur, wr, wc, fr, fq, xl);
        if (!has_next) break;
#pragma unroll
        for (int a = 0; a < 2; ++a)
#pragma unroll
            for (int b = 0; b < 2; ++b)
#pragma unroll
                for (int m = 0; m < 4; ++m)
#pragma unroll
                    for (int n = 0; n < 2; ++n) acc[a][b][m][n] = (f32x4){0.f, 0.f, 0.f, 0.f};
        cur = nxt; cA = nA; cB = nB; ++ui;
        if constexpr (GATHER) { gcur = *(const LAS u32x4*)(gl + gA1); const int _t = gA0; gA0 = gA1; gA1 = _t; }
        if (wr == 1) PG8_BAR;
    }
    PG8_WAIT_V(0);
    PG8_BAR;
#undef PG8_SA
#undef PG8_SB
#undef PG8_STAGE
#undef PG8_STAGE_A
#undef PG8_GATH
#undef PG8_LDA
#undef PG8_LDB
#undef PG8_MMA
#undef PG8_WAIT_V
#undef PG8_WAIT_L
#undef PG8_BAR
#undef PG8_SCHED
}
}
namespace fx {
using pg8::Unit; using pg8::cvt_pk_bf16;
constexpr int HALF = 128;
__device__ __forceinline__ u32x4 pack8(const f32x4 a, const f32x4 b) { u32x4 w; w.x = cvt_pk_bf16(a[0], a[1]); w.y = cvt_pk_bf16(a[2], a[3]); w.z = cvt_pk_bf16(b[0], b[1]); w.w = cvt_pk_bf16(b[2], b[3]); return w; }
__device__ __forceinline__ u32x2 pack4(const f32x4 a) { u32x2 w; w.x = cvt_pk_bf16(a[0], a[1]); w.y = cvt_pk_bf16(a[2], a[3]); return w; }
__device__ __forceinline__ float sq4(const f32x4 a) { return (a[0] * a[0] + a[1] * a[1]) + (a[2] * a[2] + a[3] * a[3]); }
__device__ __forceinline__ float quad_sum(float v) { v += __shfl_xor(v, 16); v += __shfl_xor(v, 32); return v; }
__device__ __forceinline__ float gamma_log2(int h) { return __log2f(1.f - exp2f(-5.f - (float)h)); }
__device__ __forceinline__ void rope4(f32x4& a, f32x4& b, const f32x4 cs0, const f32x4 cs1) {
    const f32x4 c = {cs0[0], cs0[2], cs1[0], cs1[2]}, s = {cs0[1], cs0[3], cs1[1], cs1[3]};
    const f32x4 ra = a * c - b * s, rb = b * c + a * s; a = ra; b = rb;
}

__device__ __forceinline__ void sincos4(float ps, const f32x4 inv, f32x4& c, f32x4& s) {
#pragma unroll
    for (int j = 0; j < 4; ++j) { const float ang = ps * inv[j]; const float n = rintf(ang * 0.15915494309189535f); float r = fmaf(-n, 6.2831854820251465f, ang); r = fmaf(-n, -1.7484555e-7f, r);
        c[j] = __cosf(r); s[j] = __sinf(r); }
}
__device__ __forceinline__ f32x4 inv_freq4(int i0, float inv_half) { f32x4 v;
#pragma unroll
    for (int j = 0; j < 4; ++j) v[j] = exp2f(-(float)(i0 + j) * inv_half * 13.287712379549449f);
    return v; }
struct EpiInProj {
    static constexpr bool PERM = false;
    bf16_t *CQ, *CKV, *RQ, *RK, *RV, *RG; float *ssq_cq, *ssq_ckv, *ssq_kpe; const int* pos  ; const float* kg  ;
    __device__ __forceinline__ void operator()(f32x4 (&acc)[2][2][4][2], const Unit& u, int wr, int wc, int fr, int fq, LAS unsigned char*) const {
        asm volatile("" : "+v"(fr), "+v"(fq));
        const int row0 = u.pm * 256 + wr * 64 + fr, pn = u.pn;
        if (pn == 0) {
#pragma unroll
            for (int ai = 0; ai < 2; ++ai)
#pragma unroll
                for (int m = 0; m < 4; ++m) { const int row = row0 + ai * HALF + m * 16; float s = 0.f;
#pragma unroll
                    for (int bj = 0; bj < 2; ++bj) { s += sq4(acc[ai][bj][m][0]) + sq4(acc[ai][bj][m][1]);
                        *(u32x4*)(CQ + (size_t)row * 256 + bj * HALF + wc * 32 + 8 * fq) = pack8(acc[ai][bj][m][0], acc[ai][bj][m][1]); }
                    s = quad_sum(s); if (fq == 0) atomicAdd(ssq_cq + row, s); }
        } else if (pn == 1) {
            const int i0 = 16 * wc + 4 * fq;
            f32x4 g0 = {0.f, 0.f, 0.f, 0.f}, g1 = g0;
            if (wc < 2) { g0 = *(const f32x4*)(kg + 128 + i0); g1 = *(const f32x4*)(kg + 160 + i0); }
#pragma unroll
            for (int ai = 0; ai < 2; ++ai)
#pragma unroll
                for (int m = 0; m < 4; ++m) { const int row = row0 + ai * HALF + m * 16;
                    float s0 = sq4(acc[ai][0][m][0]) + sq4(acc[ai][0][m][1]), s1 = sq4(acc[ai][1][m][0]) + sq4(acc[ai][1][m][1]);
                    *(u32x4*)(CKV + (size_t)row * 256 + wc * 32 + 8 * fq) = pack8(acc[ai][0][m][0], acc[ai][0][m][1]);
                    s0 = quad_sum(s0); s1 = quad_sum(s1);
                    if (fq == 0) { atomicAdd(ssq_ckv + row, s0); if (wc < 2) atomicAdd(ssq_kpe + row, s1); }
                    if (wc < 2) {
                        f32x4 a = acc[ai][1][m][0] * g0, b = acc[ai][1][m][1] * g1;
                        f32x4 cc, ss; sincos4((float)pos[row], inv_freq4(i0, 1.f / 32.f), cc, ss);
                        const f32x4 ra = a * cc - b * ss, rb = b * cc + a * ss;
                        *(u32x2*)(CKV + (size_t)row * 256 + 128 + i0) = pack4(ra); *(u32x2*)(CKV + (size_t)row * 256 + 160 + i0) = pack4(rb);
                    } else {
                        *(u32x4*)(CKV + (size_t)row * 256 + 192 + (wc - 2) * 32 + 8 * fq) = (u32x4){0u, 0u, 0u, 0u};
                    }
                    asm volatile("" ::: "memory"); __builtin_amdgcn_sched_barrier(0); }
        } else if (pn < 6) {
            bf16_t* O = (pn < 4) ? RQ : RK; const float sc = (pn < 4) ? 1.f : 0.08838834764831845f;
            const int i0 = 16 * wc + 4 * fq;
            const float sgn = (pn < 4) ? 1.f : -1.f; const float lgh[2] = {sgn * gamma_log2((pn & 1) * 2), sgn * gamma_log2((pn & 1) * 2 + 1)};
#pragma unroll
            for (int ai = 0; ai < 2; ++ai)
#pragma unroll
                for (int m = 0; m < 4; ++m) { const int row = row0 + ai * HALF + m * 16;
                    f32x4 cc, ss; sincos4((float)pos[row], inv_freq4(i0, 1.f / 64.f), cc, ss);
#pragma unroll
                    for (int bj = 0; bj < 2; ++bj) { f32x4 a = acc[ai][bj][m][0], b = acc[ai][bj][m][1]; { const f32x4 ra = a * cc - b * ss, rb = b * cc + a * ss; a = ra; b = rb; } const float dc = sc * exp2f((float)(row & 127) * lgh[bj]); a = a * dc; b = b * dc;
                        bf16_t* o = O + (size_t)row * 512 + ((pn & 1) * 2 + bj) * 128 + i0;
                        *(u32x2*)(o) = pack4(a); *(u32x2*)(o + 64) = pack4(b); }
                    asm volatile("" ::: "memory"); __builtin_amdgcn_sched_barrier(0); }
        } else {
            bf16_t* O = (pn < 8) ? RV : RG;
#pragma unroll
            for (int ai = 0; ai < 2; ++ai)
#pragma unroll
                for (int m = 0; m < 4; ++m) { const int row = row0 + ai * HALF + m * 16;
#pragma unroll
                    for (int bj = 0; bj < 2; ++bj) *(u32x4*)(O + (size_t)row * 512 + (pn & 1) * 256 + bj * HALF + wc * 32 + 8 * fq) = pack8(acc[ai][bj][m][0], acc[ai][bj][m][1]); }
        }
    }
};
__device__ __forceinline__ int inproj_src(int n) {
    const int pn = n >> 8, p = n & 255;
    const int plain = (p & ~31) + pg8::perm32(p & 31);
    if (pn == 0) return plain;
    if (pn == 1) { if (p < 128) return 256 + plain; const int q = p - 128, wc = q >> 5; if (wc >= 2) return -1; return 384 + 32 * ((q >> 4) & 1) + 16 * wc + (q & 15); }
    if (pn < 6) { const int bj = p >> 7, q = p & 127, wc = q >> 5, nn = (q >> 4) & 1; const int d = 64 * nn + 16 * wc + (q & 15); return (pn < 4 ? 448 : 960) + ((pn & 1) * 2 + bj) * 128 + d; }
    return (pn < 8 ? 1472 : 1984) + (pn & 1) * 256 + plain;
}

struct EpiMlaQ {
    static constexpr bool PERM = false;
    bf16_t* QM; const float* ssq_cq; const float* qg; const int* pos;
    __device__ __forceinline__ void operator()(f32x4 (&acc)[2][2][4][2], const Unit& u, int wr, int wc, int fr, int fq, LAS unsigned char* xl) const {
        asm volatile("" : "+v"(fr), "+v"(fq));
        const int row0 = u.pm * 256 + wr * 64 + fr, h = u.pn;
        float s[2][4], rsr[2][4];
#pragma unroll
        for (int ai = 0; ai < 2; ++ai)
#pragma unroll
            for (int m = 0; m < 4; ++m) { const int row = row0 + ai * HALF + m * 16; rsr[ai][m] = rsqrtf(ssq_cq[row] * (1.f / 256.f) + EPS);
                s[ai][m] = (sq4(acc[ai][0][m][0]) + sq4(acc[ai][0][m][1]) + sq4(acc[ai][1][m][0]) + sq4(acc[ai][1][m][1])) * rsr[ai][m] * rsr[ai][m]; }
        pg8::row_allreduce_sum(s, wr, wc, fr, fq, xl);
        const int c0 = 32 * wc + 8 * fq, i0 = 16 * wc + 4 * fq;
        const f32x4 gA = *(const f32x4*)(qg + c0), gB = *(const f32x4*)(qg + c0 + 4);
        f32x4 g0 = {0.f, 0.f, 0.f, 0.f}, g1 = g0;
        if (wc < 2) { g0 = *(const f32x4*)(qg + 128 + i0); g1 = *(const f32x4*)(qg + 160 + i0); }
#pragma unroll
        for (int ai = 0; ai < 2; ++ai)
#pragma unroll
            for (int m = 0; m < 4; ++m) { const int row = row0 + ai * HALF + m * 16; const float rq = rsqrtf(s[ai][m] * (1.f / 192.f) + EPS) * rsr[ai][m];
                bf16_t* o = QM + (size_t)row * 768 + h * 192;
                *(u32x4*)(o + c0) = pack8(acc[ai][0][m][0] * rq * gA, acc[ai][0][m][1] * rq * gB);
                if (wc < 2) {
                    const f32x4 a = acc[ai][1][m][0] * rq * g0, b = acc[ai][1][m][1] * rq * g1;
                    f32x4 cc, ss; sincos4((float)pos[row], inv_freq4(i0, 1.f / 32.f), cc, ss);
                    *(u32x2*)(o + 128 + i0) = pack4(a * cc - b * ss); *(u32x2*)(o + 160 + i0) = pack4(b * cc + a * ss);
                }
                asm volatile("" ::: "memory"); __builtin_amdgcn_sched_barrier(0); }
    }
};
__device__ __forceinline__ int mlaq_src(int n) {
    const int h = n >> 8, p = n & 255;
    if (p < 128) return h * 192 + (p & ~31) + pg8::perm32(p & 31);
    const int q = p - 128, wc = q >> 5; if (wc >= 2) return -1;
    return h * 192 + 128 + 32 * ((q >> 4) & 1) + 16 * wc + (q & 15);
}
struct EpiMlaKV {
    static constexpr bool PERM = false;
    bf16_t *KM, *VM; const bf16_t* CKV; const float *ssq_ckv, *ssq_kpe, *kg;
    __device__ __forceinline__ void operator()(f32x4 (&acc)[2][2][4][2], const Unit& u, int wr, int wc, int fr, int fq, LAS unsigned char* xl) const {
        asm volatile("" : "+v"(fr), "+v"(fq));
        const int row0 = u.pm * 256 + wr * 64 + fr, h = u.pn;
        float s[2][4], rsr[2][4];
#pragma unroll
        for (int ai = 0; ai < 2; ++ai)
#pragma unroll
            for (int m = 0; m < 4; ++m) { const int row = row0 + ai * HALF + m * 16; rsr[ai][m] = rsqrtf(ssq_ckv[row] * (1.f / 128.f) + EPS);
                s[ai][m] = (sq4(acc[ai][0][m][0]) + sq4(acc[ai][0][m][1])) * rsr[ai][m] * rsr[ai][m]; }
        pg8::row_allreduce_sum(s, wr, wc, fr, fq, xl);
        const int c0 = 32 * wc + 8 * fq, i0 = 16 * wc + 4 * fq;
        const f32x4 gA = *(const f32x4*)(kg + c0), gB = *(const f32x4*)(kg + c0 + 4);
#pragma unroll
        for (int ai = 0; ai < 2; ++ai)
#pragma unroll
            for (int m = 0; m < 4; ++m) { const int row = row0 + ai * HALF + m * 16; const float rk = rsqrtf((s[ai][m] + ssq_kpe[row]) * (1.f / 192.f) + EPS), rr = rsr[ai][m];
                bf16_t* ko = KM + (size_t)row * 768 + h * 192;
                *(u32x4*)(ko + c0) = pack8(acc[ai][0][m][0] * (rr * rk) * gA, acc[ai][0][m][1] * (rr * rk) * gB);
                *(u32x4*)(VM + (size_t)row * 512 + h * 128 + c0) = pack8(acc[ai][1][m][0] * rr, acc[ai][1][m][1] * rr);
                const u32x2 kp = *(const u32x2*)(CKV + (size_t)row * 256 + 128 + i0);
                const f32x4 kf = {__uint_as_float(kp.x << 16), __uint_as_float(kp.x & 0xffff0000u), __uint_as_float(kp.y << 16), __uint_as_float(kp.y & 0xffff0000u)};
                *(u32x2*)(ko + 128 + i0) = pack4(kf * rk); asm volatile("" ::: "memory"); __builtin_amdgcn_sched_barrier(0); }
    }
};
template <bool BASE_BF16, bool WRITE_F32>
struct EpiResid {
    static constexpr bool PERM = true;
    const float* base; float* out; bf16_t* xb; float* ssq;
    __device__ __forceinline__ void operator()(f32x4 (&acc)[2][2][4][2], const Unit& u, int wr, int wc, int fr, int fq, LAS unsigned char*) const {
        asm volatile("" : "+v"(fr), "+v"(fq));
        if (ssq == nullptr) { asm volatile("" :: "v"(acc[0][0][0][0]), "v"(acc[1][1][3][1])); return; }
        const int row0 = u.pm * 256 + wr * 64 + fr, col0 = u.pn * 256 + wc * 32 + 8 * fq;
#pragma unroll
        for (int ai = 0; ai < 2; ++ai)
#pragma unroll
            for (int m = 0; m < 4; ++m) { const int row = row0 + ai * HALF + m * 16; float s = 0.f;
#pragma unroll
                for (int bj = 0; bj < 2; ++bj) { const size_t off = (size_t)row * 1024 + col0 + bj * HALF;
                    f32x4 b0, b1;
                    if constexpr (BASE_BF16) { const u32x4 w = *(const u32x4*)(xb + off);
                        b0 = (f32x4){__uint_as_float(w.x << 16), __uint_as_float(w.x & 0xffff0000u), __uint_as_float(w.y << 16), __uint_as_float(w.y & 0xffff0000u)};
                        b1 = (f32x4){__uint_as_float(w.z << 16), __uint_as_float(w.z & 0xffff0000u), __uint_as_float(w.w << 16), __uint_as_float(w.w & 0xffff0000u)}; }
                    else { b0 = *(const f32x4*)(base + off); b1 = *(const f32x4*)(base + off + 4); }
                    const f32x4 o0 = b0 + acc[ai][bj][m][0], o1 = b1 + acc[ai][bj][m][1];
                    if constexpr (WRITE_F32) { *(f32x4*)(out + off) = o0; *(f32x4*)(out + off + 4) = o1; }
                    *(u32x4*)(xb + off) = pack8(o0, o1); s += sq4(o0) + sq4(o1); }
                s = quad_sum(s); if (fq == 0) atomicAdd(ssq + row, s); }
    }
};
struct EpiHeadNorm {
    static constexpr bool PERM = false;
    bf16_t* O; const float* ssq_in  ; const float* g  ; float inv_n_in;
    __device__ __forceinline__ void operator()(f32x4 (&acc)[2][2][4][2], const Unit& u, int wr, int wc, int fr, int fq, LAS unsigned char* xl) const {
        asm volatile("" : "+v"(fr), "+v"(fq));
        const int row0 = u.pm * 256 + wr * 64 + fr, h = u.pn;
        float s[2][4], rsr[2][4];
#pragma unroll
        for (int ai = 0; ai < 2; ++ai)
#pragma unroll
            for (int m = 0; m < 4; ++m) { const int row = row0 + ai * HALF + m * 16; rsr[ai][m] = ssq_in ? rsqrtf(ssq_in[row] * inv_n_in + EPS) : 1.f;
                s[ai][m] = (sq4(acc[ai][0][m][0]) + sq4(acc[ai][0][m][1]) + sq4(acc[ai][1][m][0]) + sq4(acc[ai][1][m][1])) * rsr[ai][m] * rsr[ai][m]; }
        pg8::row_allreduce_sum(s, wr, wc, fr, fq, xl);
        const int c0 = 32 * wc + 8 * fq;
        f32x4 gv[2][2];
#pragma unroll
        for (int bj = 0; bj < 2; ++bj) { gv[bj][0] = *(const f32x4*)(g + bj * HALF + c0); gv[bj][1] = *(const f32x4*)(g + bj * HALF + c0 + 4); }
#pragma unroll
        for (int ai = 0; ai < 2; ++ai)
#pragma unroll
            for (int m = 0; m < 4; ++m) { const int row = row0 + ai * HALF + m * 16; const float rq = rsqrtf(s[ai][m] * (1.f / 256.f) + EPS) * rsr[ai][m];
#pragma unroll
                for (int bj = 0; bj < 2; ++bj) *(u32x4*)(O + (size_t)row * 1024 + h * 256 + bj * HALF + c0) = pack8(acc[ai][bj][m][0] * rq * gv[bj][0], acc[ai][bj][m][1] * rq * gv[bj][1]); }
    }
};
struct EpiStoreT {
    static constexpr bool PERM = true;
    bf16_t* O; int ldc; int tile_stride; float scale; int pad;
    __device__ __forceinline__ void operator()(f32x4 (&acc)[2][2][4][2], const Unit& u, int wr, int wc, int fr, int fq, LAS unsigned char*) const {
        asm volatile("" : "+v"(fr), "+v"(fq));
        const int row0 = u.pm * 256 + wr * 64 + fr;
#pragma unroll
        for (int ai = 0; ai < 2; ++ai)
#pragma unroll
            for (int m = 0; m < 4; ++m) { const int row = row0 + ai * HALF + m * 16;
#pragma unroll
                for (int bj = 0; bj < 2; ++bj) *(u32x4*)(O + (size_t)u.pn * tile_stride + (size_t)row * ldc + bj * HALF + wc * 32 + 8 * fq) = pack8(acc[ai][bj][m][0] * scale, acc[ai][bj][m][1] * scale); }
    }
};
struct EpiSoftmax {
    static constexpr bool PERM = true;
    bf16_t* PC;
    __device__ __forceinline__ void operator()(f32x4 (&acc)[2][2][4][2], const Unit& u, int wr, int wc, int fr, int fq, LAS unsigned char* xl) const {
        asm volatile("" : "+v"(fr), "+v"(fq));
        const int row0 = u.pm * 256 + wr * 64 + fr, h = u.pn;
        float mx[2][4], sm[2][4];
#pragma unroll
        for (int ai = 0; ai < 2; ++ai)
#pragma unroll
            for (int m = 0; m < 4; ++m) { float v = -3.0e38f;
#pragma unroll
                for (int bj = 0; bj < 2; ++bj)
#pragma unroll
                    for (int n = 0; n < 2; ++n) { const f32x4 a = acc[ai][bj][m][n]; v = fmaxf(v, fmaxf(fmaxf(a[0], a[1]), fmaxf(a[2], a[3]))); }
                mx[ai][m] = v; }
        pg8::row_allreduce_max(mx, wr, wc, fr, fq, xl);
        const float c2 = 0.0625f * 1.4426950408889634f;
#pragma unroll
        for (int ai = 0; ai < 2; ++ai)
#pragma unroll
            for (int m = 0; m < 4; ++m) { float t = 0.f; const float mm = mx[ai][m] * c2;
#pragma unroll
                for (int bj = 0; bj < 2; ++bj)
#pragma unroll
                    for (int n = 0; n < 2; ++n) { f32x4 a = acc[ai][bj][m][n] * c2 - mm;
                        a[0] = __builtin_amdgcn_exp2f(a[0]); a[1] = __builtin_amdgcn_exp2f(a[1]); a[2] = __builtin_amdgcn_exp2f(a[2]); a[3] = __builtin_amdgcn_exp2f(a[3]);
                        acc[ai][bj][m][n] = a; t += (a[0] + a[1]) + (a[2] + a[3]); }
                sm[ai][m] = t; }
        pg8::row_allreduce_sum(sm, wr, wc, fr, fq, xl);
#pragma unroll
        for (int ai = 0; ai < 2; ++ai)
#pragma unroll
            for (int m = 0; m < 4; ++m) { const int row = row0 + ai * HALF + m * 16; const float il = 1.f / sm[ai][m];
#pragma unroll
                for (int bj = 0; bj < 2; ++bj) *(u32x4*)(PC + (size_t)row * 1024 + h * 256 + bj * HALF + wc * 32 + 8 * fq) = pack8(acc[ai][bj][m][0] * il, acc[ai][bj][m][1] * il); }
    }
};
struct EpiStoreBf16 {
    static constexpr bool PERM = true;
    bf16_t* O; int ldc; int pad;
    __device__ __forceinline__ void operator()(f32x4 (&acc)[2][2][4][2], const Unit& u, int wr, int wc, int fr, int fq, LAS unsigned char*) const {
        asm volatile("" : "+v"(fr), "+v"(fq));
        const int row0 = u.pm * 256 + wr * 64 + fr;
#pragma unroll
        for (int ai = 0; ai < 2; ++ai)
#pragma unroll
            for (int m = 0; m < 4; ++m) { const int row = row0 + ai * HALF + m * 16;
#pragma unroll
                for (int bj = 0; bj < 2; ++bj) *(u32x4*)(O + (size_t)row * ldc + u.pn * 256 + bj * HALF + wc * 32 + 8 * fq) = pack8(acc[ai][bj][m][0], acc[ai][bj][m][1]); }
    }
};
struct HeadOrder {
    int G, c, nunits; const char* A; const char* B; size_t strideA, a_h, b_b, b_h;
    __device__ __forceinline__ bool next(int i, Unit& u) const {
        int L;
        if (G == 256) { const int xcd = c & 7, uu = (c >> 3) + 32 * i; if (uu >= 64) return false; L = xcd * 64 + uu; }
        else { const long LL = (long)i * G + c; if (LL >= nunits) return false; L = (int)LL; }
        u.pm = L >> 2; u.pn = L & 3; const int b = u.pm >> 4;
        u.a = A + (size_t)u.pm * strideA + (size_t)u.pn * a_h; u.b = B + (size_t)b * b_b + (size_t)u.pn * b_h; u.rows = nullptr; u.nvalid = 256; u.seg = 0; return true;
    }
};
constexpr int MOE_CAP = 32768;
struct MoeOrder {
    int G, c, seg_lo, seg_hi, ntn; const int* cnt; const int* lists; const char* A; const char* B; size_t a_tile  , b_exp  , b_tile  ;
    LAS int* tab;
    __device__ __forceinline__ void init(LAS unsigned char* xl) {
        tab = (LAS int*)(xl + 4096);
        if (threadIdx.x < 64) { const int n = __hip_atomic_load(cnt + threadIdx.x, __ATOMIC_RELAXED, __HIP_MEMORY_SCOPE_AGENT); int t = (n + 255) >> 8, incl = t;
#pragma unroll
            for (int o = 1; o < 64; o <<= 1) { const int v = __shfl_up(incl, o); if ((int)threadIdx.x >= o) incl += v; }
            tab[threadIdx.x + 1] = incl; tab[65 + threadIdx.x] = n; if (threadIdx.x == 0) tab[0] = 0; }
        asm volatile("s_waitcnt lgkmcnt(0)" ::: "memory"); __syncthreads();
    }
    __device__ __forceinline__ bool next(int i, Unit& u) const {
        const int gbase = tab[seg_lo], ntl = tab[seg_hi] - gbase;
        int rt, pn;
        if ((G & 7) == 0) { const int per = (ntl + 7) >> 3, xcd = c & 7, uu = (c >> 3) + (G >> 3) * i; const int rl_ = uu / ntn; if (rl_ >= per) return false; rt = xcd * per + rl_; pn = uu % ntn; }
        else { const long L = (long)i * G + c; rt = (int)(L / ntn); pn = (int)(L % ntn); }
        if (rt >= ntl) return false;
        const int rtg = gbase + rt;
        const int lane = threadIdx.x & 63;
        const int sgm = __builtin_popcountll(__ballot(rtg >= tab[lane + 1]));
        const int j = rtg - tab[sgm], n = tab[65 + sgm];
        u.pm = rtg; u.pn = pn; u.seg = sgm; u.nvalid = (n - j * 256) < 256 ? (n - j * 256) : 256; u.rows = lists + (size_t)sgm * MOE_CAP + j * 256;
        u.a = A + (size_t)u.pm * a_tile; u.b = B + (size_t)(sgm & 31) * b_exp + (size_t)pn * b_tile; return true;
    }
};
struct EpiGlu {
    static constexpr bool PERM = false;
    bf16_t* H; const float* ssq2; const float* roww; const int* lists0;
    __device__ __forceinline__ void operator()(f32x4 (&acc)[2][2][4][2], const Unit& u, int wr, int wc, int fr, int fq, LAS unsigned char*) const {
        asm volatile("" : "+v"(fr), "+v"(fq));
        if (H == nullptr) { asm volatile("" :: "v"(acc[0][0][0][0]), "v"(acc[1][1][3][1])); return; }
#pragma unroll
        for (int ai = 0; ai < 2; ++ai)
#pragma unroll
            for (int m = 0; m < 4; ++m) { const int rl = ai * HALF + wr * 64 + m * 16 + fr; const bool valid = rl < u.nvalid;
                const int tok = valid ? u.rows[rl] : 0;
                const float wgt = valid ? *(roww + ((u.rows + rl) - lists0)) : 0.f;
                const float rs = rsqrtf(ssq2[tok] * (1.f / 1024.f) + EPS);
                f32x4 hv[2];
#pragma unroll
                for (int n = 0; n < 2; ++n) { const f32x4 a = acc[ai][0][m][n] * rs, uu = acc[ai][1][m][n] * rs; f32x4 r;
#pragma unroll
                    for (int j = 0; j < 4; ++j) r[j] = a[j] / (1.f + __expf(-a[j])) * uu[j] * wgt;
                    hv[n] = r; }
                *(u32x4*)(H + ((size_t)u.pm * 256 + rl) * 256 + u.pn * 128 + wc * 32 + 8 * fq) = pack8(hv[0], hv[1]); }
    }
};
template <int SLOT>
struct EpiScatter {
    static constexpr bool PERM = true;
    float* out; bf16_t* y0;
    __device__ __forceinline__ void operator()(f32x4 (&acc)[2][2][4][2], const Unit& u, int wr, int wc, int fr, int fq, LAS unsigned char*) const {
        asm volatile("" : "+v"(fr), "+v"(fq));
        const int col0 = u.pn * 256 + wc * 32 + 8 * fq;
#pragma unroll
        for (int ai = 0; ai < 2; ++ai)
#pragma unroll
            for (int m = 0; m < 4; ++m) { const int rl = ai * HALF + wr * 64 + m * 16 + fr;
                if (rl < u.nvalid) { const int tok = u.rows[rl]; const size_t o = (size_t)tok * 1024 + col0;
#pragma unroll
                    for (int bj = 0; bj < 2; ++bj) { const size_t oo = o + bj * HALF;
                        if constexpr (SLOT == 0) { *(u32x4*)(y0 + oo) = pack8(acc[ai][bj][m][0], acc[ai][bj][m][1]); }
                        else { const u32x4 w = *(const u32x4*)(y0 + oo);
                               const f32x4 y0v = {__uint_as_float(w.x << 16), __uint_as_float(w.x & 0xffff0000u), __uint_as_float(w.y << 16), __uint_as_float(w.y & 0xffff0000u)};
                               const f32x4 y1v = {__uint_as_float(w.z << 16), __uint_as_float(w.z & 0xffff0000u), __uint_as_float(w.w << 16), __uint_as_float(w.w & 0xffff0000u)};
                               f32x4* q = (f32x4*)(out + oo); q[0] = (q[0] + y0v) + acc[ai][bj][m][0]; q[1] = (q[1] + y1v) + acc[ai][bj][m][1]; } } } }
    }
};

struct MemKVOrder {
    int G, c; const char* MB; const char* W;
    __device__ __forceinline__ bool next(int i, Unit& u) const {
        const long L = (long)i * G + c; if (L >= 64) return false;
        const int r = (int)L & 31; u.rows = nullptr; u.nvalid = 256;
        if (L < 32) { u.seg = 0; u.pm = r >> 2; u.pn = r & 3; u.a = MB + (size_t)u.pm * 256 * 2048; u.b = W + (size_t)u.pn * 256 * 2048; }
        else { u.seg = 1; u.pm = r >> 3; u.pn = r & 7; u.a = W + (size_t)(1024 + u.pm * 256) * 2048; u.b = MB + (size_t)u.pn * 256 * 2048; }
        return true;
    }
};
struct EpiMemKV {
    static constexpr bool PERM = false;
    bf16_t* KC; bf16_t* VCT; const float* g;
    __device__ __forceinline__ void operator()(f32x4 (&acc)[2][2][4][2], const Unit& u, int wr, int wc, int fr, int fq, LAS unsigned char* xl) const {
        if (u.seg == 0) { EpiHeadNorm e{KC, nullptr, g, 0.f}; e(acc, u, wr, wc, fr, fq, xl); return; }
        asm volatile("" : "+v"(fr), "+v"(fq));
        const int row0 = u.pm * 256 + wr * 64 + fr;
#pragma unroll
        for (int ai = 0; ai < 2; ++ai)
#pragma unroll
            for (int m = 0; m < 4; ++m) { const int row = row0 + ai * HALF + m * 16;
#pragma unroll
                for (int bj = 0; bj < 2; ++bj)
#pragma unroll
                    for (int n = 0; n < 2; ++n) *(u32x2*)(VCT + (size_t)u.pn * 1024 * 256 + (size_t)row * 256 + bj * HALF + wc * 32 + n * 16 + 4 * fq) = pack4(acc[ai][bj][m][n]); }
    }
};
}
namespace at {
typedef float f32x16 __attribute__((ext_vector_type(16)));
typedef short s16x4 __attribute__((ext_vector_type(4)));
constexpr int NW = 8, QBLK = 32, KVBLK = 64, QB = 256;
constexpr int KROW = 400;
constexpr int SHM_V = KVBLK * 128 * 2, SHM_K = KVBLK * KROW;
constexpr int LDS_V = 0, LDS_K = 2 * SHM_V, LDS_WS = LDS_K + 2 * SHM_K, LDS_BYTES = LDS_WS + NW * 64 * 4;
constexpr float SCALE = 0.07216878364870322f;
constexpr float THR = 8.f;
#define SBAR() __builtin_amdgcn_sched_barrier(0)
__device__ __forceinline__ int v_st(int k, int c) { const int kk = (k & ~0xC) | ((k & 4) << 1) | ((k & 8) >> 1); return ((kk >> 3) * 4 + (c >> 5)) * 512 + ((kk & 7) * 32 + (c & 31)) * 2; }
__device__ __forceinline__ int v_rd_base(int lane) { return ((lane & 3) << 3) | (((lane >> 2) & 3) << 6) | (((lane >> 4) & 1) << 5) | (((lane >> 5) & 1) << 8); }
constexpr int v_rd_off(int d0, int ks, int half) { return d0 * 512 + ks * 4096 + half * 2048; }
__device__ __forceinline__ int crow(int r, int hi) { return (r & 3) + 8 * (r >> 2) + 4 * hi; }
__device__ __forceinline__ unsigned cvtpk(float lo, float hi) { unsigned r; asm volatile("v_cvt_pk_bf16_f32 %0, %1, %2" : "=v"(r) : "v"(lo), "v"(hi)); return r; }
__device__ __forceinline__ void mask_tile(f32x16& p0, f32x16& p1, int dq) {
    const float NEG = -__builtin_inff();
#pragma unroll
    for (int r = 0; r < 16; ++r) {
        const int c = (r & 3) + 8 * (r >> 2);
        if (dq - c < 0) p0[r] = NEG;
        if (dq - c - 32 < 0) p1[r] = NEG;
    }
}
__device__ __forceinline__ void partialSM(f32x16& p0, f32x16& p1, float& m_reg, float& mn, float& alpha) {
    float pmax = p0[0];
#pragma unroll
    for (int r = 1; r < 16; ++r) pmax = fmaxf(pmax, p0[r]);
#pragma unroll
    for (int r = 0; r < 16; ++r) pmax = fmaxf(pmax, p1[r]);
    { auto rr = __builtin_amdgcn_permlane32_swap(__float_as_uint(pmax), __float_as_uint(pmax), false, false);
      pmax = fmaxf(__uint_as_float(rr[0]), __uint_as_float(rr[1])); }
    constexpr float C2 = 1.4426950408889634f * SCALE;
    if (__builtin_expect(__all((pmax - m_reg) * SCALE <= THR), 1)) { mn = m_reg; alpha = 1.f; }
    else { mn = fmaxf(m_reg, pmax); alpha = __builtin_amdgcn_exp2f((m_reg - mn) * C2); m_reg = mn; }
    const float mnL = -mn * C2;
#pragma unroll
    for (int r = 0; r < 16; ++r) p0[r] = fmaf(p0[r], C2, mnL);
#pragma unroll
    for (int r = 0; r < 16; ++r) p1[r] = fmaf(p1[r], C2, mnL);
#pragma unroll
    for (int r = 0; r < 16; ++r) p0[r] = __builtin_amdgcn_exp2f(p0[r]);
}
__device__ __forceinline__ void finishSM(f32x16& p0, f32x16& p1, float alpha, float& l_reg, bf16x8& pa0, bf16x8& pa1, bf16x8& pa2, bf16x8& pa3) {
#pragma unroll
    for (int r = 0; r < 16; ++r) p1[r] = __builtin_amdgcn_exp2f(p1[r]);
    float ps = 0;
#pragma unroll
    for (int r = 0; r < 16; ++r) ps += p0[r];
#pragma unroll
    for (int r = 0; r < 16; ++r) ps += p1[r];
    { auto rr = __builtin_amdgcn_permlane32_swap(__float_as_uint(ps), __float_as_uint(ps), false, false);
      ps = __uint_as_float(rr[0]) + __uint_as_float(rr[1]); }
    l_reg = l_reg * alpha + ps;
#define PK4(P, B_, OUT) do { unsigned a0 = cvtpk(P[B_+0], P[B_+1]), a1 = cvtpk(P[B_+2], P[B_+3]);                          \
        unsigned b0 = cvtpk(P[B_+4], P[B_+5]), b1 = cvtpk(P[B_+6], P[B_+7]);                                             \
        auto r0 = __builtin_amdgcn_permlane32_swap(a0, b0, false, false); auto r1 = __builtin_amdgcn_permlane32_swap(a1, b1, false, false); \
        u32x4 w = {r0[0], r1[0], r0[1], r1[1]}; OUT = *reinterpret_cast<bf16x8*>(&w); } while (0)
    PK4(p0, 0, pa0); PK4(p0, 8, pa1); PK4(p1, 0, pa2); PK4(p1, 8, pa3);
#undef PK4
}
template <int KB>
__device__ __forceinline__ void qkt(f32x16& p0, f32x16& p1, const char* K_lds, int r32, int hi, const bf16x8* qr) {
    p0 = f32x16{}; p1 = f32x16{};
    const char* kb = K_lds + KB * SHM_K + r32 * KROW + hi * 16;
#pragma unroll
    for (int d0 = 0; d0 < 12; ++d0) {
        const bf16x8 b0 = *reinterpret_cast<const bf16x8*>(kb + d0 * 32);
        const bf16x8 b1 = *reinterpret_cast<const bf16x8*>(kb + 32 * KROW + d0 * 32);
        p0 = __builtin_amdgcn_mfma_f32_32x32x16_bf16(b0, qr[d0], p0, 0, 0, 0);
        p1 = __builtin_amdgcn_mfma_f32_32x32x16_bf16(b1, qr[d0], p1, 0, 0, 0);
    }
}
template <int VB>
__device__ __forceinline__ void pv_tile(f32x16* o, int vb0, bf16x8 pa0, bf16x8 pa1, bf16x8 pa2, bf16x8 pa3) {
#define TRRD(dst, off) asm volatile("ds_read_b64_tr_b16 %0, %1 offset:%2" : "=&v"(dst) : "v"(vb0), "i"(off) : "memory")
#define PV_D0(d0) do { s16x4 l0, l1, l2, l3, h0, h1, h2, h3; constexpr int b_ = VB * SHM_V + v_rd_off(d0, 0, 0);   \
        TRRD(l0, b_); TRRD(h0, b_ + 2048); TRRD(l1, b_ + 4096); TRRD(h1, b_ + 6144); TRRD(l2, b_ + 8192); TRRD(h2, b_ + 10240); TRRD(l3, b_ + 12288); TRRD(h3, b_ + 14336); \
        asm volatile("s_waitcnt lgkmcnt(0)" ::: "memory"); SBAR();   \
        o[d0] = __builtin_amdgcn_mfma_f32_32x32x16_bf16(pa0, (bf16x8){l0[0], l0[1], l0[2], l0[3], h0[0], h0[1], h0[2], h0[3]}, o[d0], 0, 0, 0);   \
        o[d0] = __builtin_amdgcn_mfma_f32_32x32x16_bf16(pa1, (bf16x8){l1[0], l1[1], l1[2], l1[3], h1[0], h1[1], h1[2], h1[3]}, o[d0], 0, 0, 0);   \
        o[d0] = __builtin_amdgcn_mfma_f32_32x32x16_bf16(pa2, (bf16x8){l2[0], l2[1], l2[2], l2[3], h2[0], h2[1], h2[2], h2[3]}, o[d0], 0, 0, 0);   \
        o[d0] = __builtin_amdgcn_mfma_f32_32x32x16_bf16(pa3, (bf16x8){l3[0], l3[1], l3[2], l3[3], h3[0], h3[1], h3[2], h3[3]}, o[d0], 0, 0, 0); } while (0)
    PV_D0(0); PV_D0(1); PV_D0(2); PV_D0(3);
#undef PV_D0
#undef TRRD
}

__device__ __forceinline__ void attn_block(const bf16_t* Q, const bf16_t* K, const bf16_t* V, bf16_t* O, size_t tb, int h, int P0, char* lds) {
    const int tid = threadIdx.x, wid = __builtin_amdgcn_readfirstlane(tid >> 6), lane = tid & 63, r32 = lane & 31, hi = lane >> 5;
    const int NT = (P0 + QB) / KVBLK;
    const int qlo = P0 + wid * QBLK, qm = qlo + r32 - 4 * hi;
    char* V_lds = lds + LDS_V; char* K_lds = lds + LDS_K;
    float* ws = (float*)(lds + LDS_WS) + wid * 64; float* li_l = ws, * al_l = ws + 32;
    float m_reg = -1e30f, l_reg = 0; f32x16 o[4] = {};
    const bf16_t* Kh = K + tb * 768 + h * 192; const bf16_t* Vh = V + tb * 512 + h * 128;
    const int sr = tid >> 4, sc = (tid & 15) * 8, vst0 = v_st(sr, sc), vst1 = v_st(32 + sr, sc);
    const int kgo = (tid >> 3) * 768 + (tid & 7) * 8, klo = (tid >> 3) * KROW + (tid & 7) * 16;
    const int vb0 = (int)(uintptr_t)V_lds + v_rd_base(lane);
    bf16x8 st_k0, st_k1, st_k2, st_v0, st_v1;
#define VMW() asm volatile("s_waitcnt vmcnt(0)" ::: "memory")
#define SLOAD(k0) do { const bf16_t* kp_ = Kh + (size_t)(k0) * 768 + kgo; st_k0 = *(const bf16x8*)(kp_); st_k1 = *(const bf16x8*)(kp_ + 64); st_k2 = *(const bf16x8*)(kp_ + 128); \
        st_v0 = *(const bf16x8*)(Vh + (size_t)((k0) + sr) * 512 + sc); st_v1 = *(const bf16x8*)(Vh + (size_t)((k0) + 32 + sr) * 512 + sc); } while (0)
#define SWRITE(bf) do { char* kw_ = K_lds + (bf) * SHM_K + klo; *(bf16x8*)(kw_) = st_k0; *(bf16x8*)(kw_ + 128) = st_k1; *(bf16x8*)(kw_ + 256) = st_k2; \
        *(bf16x8*)(V_lds + (bf) * SHM_V + vst0) = st_v0; *(bf16x8*)(V_lds + (bf) * SHM_V + vst1) = st_v1; } while (0)
#define RESC(a) do { if (__any((a) < 1.f)) { if (hi == 0) al_l[r32] = (a); asm volatile("s_waitcnt lgkmcnt(0)" ::: "memory");              \
                     for (int d_ = 0; d_ < 4; ++d_) for (int r = 0; r < 16; ++r) o[d_][r] *= al_l[crow(r, hi)]; } } while (0)
#define KBASE(t) ((t) * KVBLK)
#define MASKT(P0_, P1_, t) do { const int kb_ = KBASE(t); if (kb_ + KVBLK - 1 > qlo) mask_tile(P0_, P1_, qm - kb_); } while (0)
    bf16x8 qr[12];
    { const bf16_t* Qw = Q + (tb + qlo + r32) * 768 + h * 192 + hi * 8;
#pragma unroll
      for (int d0 = 0; d0 < 12; ++d0) qr[d0] = *(const bf16x8*)(Qw + d0 * 16); }
    SLOAD(0); VMW(); SWRITE(0);
    __syncthreads();
    f32x16 p0, p1; float mn, al; bf16x8 pa0, pa1, pa2, pa3;
#define TILE_STEP(t, BUF) do {                                                                   \
        if ((t) + 1 < NT) { SLOAD(KBASE((t) + 1)); }                                              \
        SBAR(); qkt<BUF>(p0, p1, K_lds, r32, hi, qr);                                             \
        MASKT(p0, p1, (t)); partialSM(p0, p1, m_reg, mn, al); RESC(al);                           \
        finishSM(p0, p1, al, l_reg, pa0, pa1, pa2, pa3); SBAR();                                  \
        pv_tile<BUF>(o, vb0, pa0, pa1, pa2, pa3);                                                 \
        if ((t) + 1 < NT) { VMW(); SWRITE(1 - BUF); }                                             \
        __syncthreads(); } while (0)
    for (int t = 0; t < NT; t += 2) { TILE_STEP(t, 0); TILE_STEP(t + 1, 1); }
    if (hi == 0) li_l[r32] = l_reg; asm volatile("s_waitcnt lgkmcnt(0)" ::: "memory");
    float rli[16];
#pragma unroll
    for (int r = 0; r < 16; ++r) rli[r] = __builtin_amdgcn_rcpf(li_l[crow(r, hi)]);
    bf16_t* Ow = O + (tb + qlo) * 1024 + h * 128;
#pragma unroll
    for (int r = 0; r < 16; ++r) { const int orow = crow(r, hi);
#pragma unroll
        for (int d0 = 0; d0 < 4; ++d0) { const float v = o[d0][r] * rli[r];
            const float vn = __shfl_xor(v, 1);
            if ((r32 & 1) == 0) *(unsigned*)(Ow + (size_t)orow * 1024 + d0 * 32 + r32) = cvtpk(v, vn); } }
#undef VMW
#undef SLOAD
#undef SWRITE
#undef RESC
#undef KBASE
#undef MASKT
#undef TILE_STEP
}

#undef SBAR

__device__ __forceinline__ void attn_phase(const bf16_t* Q, const bf16_t* K, const bf16_t* V, bf16_t* O, char* lds) {
    for (int L = blockIdx.x; L < 256; L += gridDim.x) {
        const int xcd = L & 7, k = L >> 3, bh = (k >> 3) * 8 + xcd, x = k & 7;
        const int b = bh >> 2, h = bh & 3; const size_t tb = (size_t)b * 4096;
        attn_block(Q, K, V, O, tb, h, (15 - x) * QB, lds);
        attn_block(Q, K, V, O, tb, h, x * QB, lds);
    }
}
}
namespace rt {
using at::f32x16; using at::s16x4; using at::v_st; using at::v_rd_base; using at::v_rd_off; using at::crow; using at::cvtpk;
constexpr int PITCH = 272;
constexpr int L_Q = 0, L_K = 128 * PITCH, L_V = 2 * 128 * PITCH, L_S = L_V + 32768, L_END = L_S + 128 * PITCH;
#define TRRD(dst, base, off) asm volatile("ds_read_b64_tr_b16 %0, %1 offset:%2" : "=&v"(dst) : "v"(base), "i"(off) : "memory")
#define FRAG(l, h) ((bf16x8){l[0], l[1], l[2], l[3], h[0], h[1], h[2], h[3]})
using fx::gamma_log2;

__device__ __forceinline__ void ret_kv_unit(const bf16_t* RK, const bf16_t* RV, bf16_t* KVS, int bh, int c, char* lds) {
    const int tid = threadIdx.x, wid = __builtin_amdgcn_readfirstlane(tid >> 6), lane = tid & 63, r32 = lane & 31, hi = lane >> 5;
    const int b = bh >> 2, h = bh & 3; const size_t t0 = (size_t)b * 4096 + (size_t)c * 128;
    char* Kl = lds; char* Vl = lds + 32768;
#pragma unroll
    for (int i = 0; i < 4; ++i) { const int q = tid + 512 * i, row = q >> 4, cc = (q & 15) * 8; const int lo = (row >> 6) * 16384 + v_st(row & 63, cc);
        *(bf16x8*)(Kl + lo) = *(const bf16x8*)(RK + (t0 + row) * 512 + h * 128 + cc);
        *(bf16x8*)(Vl + lo) = *(const bf16x8*)(RV + (t0 + row) * 512 + h * 128 + cc); }
    __syncthreads();
    const int dvb = wid >> 1, dkb = 2 * (wid & 1);
    const int vbase = (int)(uintptr_t)Vl + v_rd_base(lane) + dvb * 512, kbase = (int)(uintptr_t)Kl + v_rd_base(lane) + dkb * 512;
    f32x16 acc0 = {}, acc1 = {};
#define KVSTEP(sub, ks) do { s16x4 al, ah, b0l, b0h, b1l, b1h; constexpr int o_ = (sub) * 16384 + v_rd_off(0, ks, 0);   \
        TRRD(al, vbase, o_); TRRD(ah, vbase, o_ + 2048); TRRD(b0l, kbase, o_); TRRD(b0h, kbase, o_ + 2048); TRRD(b1l, kbase, o_ + 512); TRRD(b1h, kbase, o_ + 512 + 2048); \
        asm volatile("s_waitcnt lgkmcnt(0)" ::: "memory"); __builtin_amdgcn_sched_barrier(0);   \
        acc0 = __builtin_amdgcn_mfma_f32_32x32x16_bf16(FRAG(al, ah), FRAG(b0l, b0h), acc0, 0, 0, 0);   \
        acc1 = __builtin_amdgcn_mfma_f32_32x32x16_bf16(FRAG(al, ah), FRAG(b1l, b1h), acc1, 0, 0, 0); } while (0)
    KVSTEP(0, 0); KVSTEP(0, 1); KVSTEP(0, 2); KVSTEP(0, 3); KVSTEP(1, 0); KVSTEP(1, 1); KVSTEP(1, 2); KVSTEP(1, 3);
#undef KVSTEP
    const float sc = exp2f(127.f * gamma_log2(h));
    bf16_t* O = KVS + ((size_t)(bh * 32 + c) * 128 + dvb * 32) * 128 + dkb * 32;
#pragma unroll
    for (int r = 0; r < 16; ++r) { const int dv = crow(r, hi);
        const float v0 = acc0[r] * sc, v1 = acc1[r] * sc; const float n0 = __shfl_xor(v0, 1), n1 = __shfl_xor(v1, 1);
        if ((r32 & 1) == 0) { *(unsigned*)(O + (size_t)dv * 128 + r32) = cvtpk(v0, n0); *(unsigned*)(O + (size_t)dv * 128 + 32 + r32) = cvtpk(v1, n1); } }
    __syncthreads();
}
__device__ __forceinline__ void ret_kv_phase(const bf16_t* RK, const bf16_t* RV, bf16_t* KVS, char* lds) {
    for (int u = blockIdx.x; u < 1024; u += gridDim.x) ret_kv_unit(RK, RV, KVS, u >> 5, u & 31, lds);
}

__device__ __forceinline__ void ret_out_unit(const bf16_t* RQ, const bf16_t* RK, const bf16_t* RV, const bf16_t* RG, const bf16_t* STS, const float* gn_g, bf16_t* AO, int bh, int c, char* lds) {
    const int tid = threadIdx.x, wid = __builtin_amdgcn_readfirstlane(tid >> 6), lane = tid & 63, r32 = lane & 31, hi = lane >> 5;
    const int b = bh >> 2, h = bh & 3; const size_t t0 = (size_t)b * 4096 + (size_t)c * 128;
    const float lg = gamma_log2(h);
#pragma unroll
    for (int i = 0; i < 4; ++i) { const int q = tid + 512 * i, row = q >> 4, cc = (q & 15) * 8;
        *(bf16x8*)(lds + L_Q + row * PITCH + cc * 2) = *(const bf16x8*)(RQ + (t0 + row) * 512 + h * 128 + cc);
        *(bf16x8*)(lds + L_K + row * PITCH + cc * 2) = *(const bf16x8*)(RK + (t0 + row) * 512 + h * 128 + cc);
        *(bf16x8*)(lds + L_V + (row >> 6) * 16384 + v_st(row & 63, cc)) = *(const bf16x8*)(RV + (t0 + row) * 512 + h * 128 + cc); }
    { const bf16_t* src = STS + (size_t)(bh * 32 + c) * 16384 + tid * 8;
#pragma unroll
      for (int i = 0; i < 4; ++i) { const int e8 = tid + 512 * i, dv = e8 >> 4, dk0 = (e8 & 15) * 8; *(u32x4*)(lds + L_S + dv * PITCH + dk0 * 2) = *(const u32x4*)(src + 4096 * i); } }
    __syncthreads();
    const int qg = wid & 3, dh = wid >> 2;
    bf16x8 qr[8];
#pragma unroll
    for (int d0 = 0; d0 < 8; ++d0) qr[d0] = *(const bf16x8*)(lds + L_Q + (32 * qg + r32) * PITCH + d0 * 32 + hi * 16);
    f32x16 o[2] = {};
#pragma unroll
    for (int dd = 0; dd < 2; ++dd) { const char* sb = lds + L_S + ((2 * dh + dd) * 32 + r32) * PITCH + hi * 16;
#pragma unroll
        for (int d0 = 0; d0 < 8; ++d0) o[dd] = __builtin_amdgcn_mfma_f32_32x32x16_bf16(qr[d0], *(const bf16x8*)(sb + d0 * 32), o[dd], 0, 0, 0); }
    { const float g1 = exp2f(lg);
#pragma unroll
      for (int dd = 0; dd < 2; ++dd)
#pragma unroll
          for (int r = 0; r < 16; ++r) o[dd][r] *= g1; }
    const int vb = (int)(uintptr_t)(lds + L_V) + v_rd_base(lane) + (2 * dh) * 512;
    const int qpos = 32 * qg + r32;
#define INTRA(kt) do { if (64 * (kt) <= 32 * qg + 31) { f32x16 p0 = {}, p1 = {}; const char* kb = lds + L_K + (64 * (kt) + r32) * PITCH + hi * 16;   \
        _Pragma("unroll") for (int d0 = 0; d0 < 8; ++d0) { p0 = __builtin_amdgcn_mfma_f32_32x32x16_bf16(*(const bf16x8*)(kb + d0 * 32), qr[d0], p0, 0, 0, 0);   \
                                                          p1 = __builtin_amdgcn_mfma_f32_32x32x16_bf16(*(const bf16x8*)(kb + 32 * PITCH + d0 * 32), qr[d0], p1, 0, 0, 0); }   \
        _Pragma("unroll") for (int r = 0; r < 16; ++r) { const int key = 64 * (kt) + crow(r, hi); if (key > qpos) p0[r] = 0.f; if (key + 32 > qpos) p1[r] = 0.f; }   \
        bf16x8 pa0, pa1, pa2, pa3;   \
        PK4(p0, 0, pa0); PK4(p0, 8, pa1); PK4(p1, 0, pa2); PK4(p1, 8, pa3);   \
        PVD(kt, 0); PVD(kt, 1); } } while (0)
#define PK4(P, B_, OUT) do { unsigned a0 = cvtpk(P[B_+0], P[B_+1]), a1 = cvtpk(P[B_+2], P[B_+3]); unsigned b0 = cvtpk(P[B_+4], P[B_+5]), b1 = cvtpk(P[B_+6], P[B_+7]);   \
        auto r0 = __builtin_amdgcn_permlane32_swap(a0, b0, false, false); auto r1 = __builtin_amdgcn_permlane32_swap(a1, b1, false, false);   \
        u32x4 w_ = {r0[0], r1[0], r0[1], r1[1]}; OUT = *reinterpret_cast<bf16x8*>(&w_); } while (0)
#define PVD(kt, dd) do { s16x4 l0, l1, l2, l3, h0, h1, h2, h3; constexpr int b_ = (kt) * 16384 + v_rd_off(dd, 0, 0);   \
        TRRD(l0, vb, b_); TRRD(h0, vb, b_ + 2048); TRRD(l1, vb, b_ + 4096); TRRD(h1, vb, b_ + 6144); TRRD(l2, vb, b_ + 8192); TRRD(h2, vb, b_ + 10240); TRRD(l3, vb, b_ + 12288); TRRD(h3, vb, b_ + 14336);   \
        asm volatile("s_waitcnt lgkmcnt(0)" ::: "memory"); __builtin_amdgcn_sched_barrier(0);   \
        o[dd] = __builtin_amdgcn_mfma_f32_32x32x16_bf16(pa0, FRAG(l0, h0), o[dd], 0, 0, 0); o[dd] = __builtin_amdgcn_mfma_f32_32x32x16_bf16(pa1, FRAG(l1, h1), o[dd], 0, 0, 0);   \
        o[dd] = __builtin_amdgcn_mfma_f32_32x32x16_bf16(pa2, FRAG(l2, h2), o[dd], 0, 0, 0); o[dd] = __builtin_amdgcn_mfma_f32_32x32x16_bf16(pa3, FRAG(l3, h3), o[dd], 0, 0, 0); } while (0)
    INTRA(0); INTRA(1);
#undef INTRA
#undef PK4
#undef PVD
    __syncthreads();
    float* Os = (float*)lds;
#pragma unroll
    for (int dd = 0; dd < 2; ++dd)
#pragma unroll
        for (int r = 0; r < 16; ++r) Os[(32 * qg + crow(r, hi)) * 132 + (2 * dh + dd) * 32 + r32] = o[dd][r];
    __syncthreads();
    { const int q = tid >> 2, seg = tid & 3; const float* orow = Os + q * 132 + seg * 32;
      f32x4 v[8]; float s1 = 0.f, s2 = 0.f;
#pragma unroll
      for (int i = 0; i < 8; ++i) { v[i] = *(const f32x4*)(orow + 4 * i); s1 += (v[i][0] + v[i][1]) + (v[i][2] + v[i][3]); s2 += fx::sq4(v[i]); }
      s1 += __shfl_xor(s1, 1); s1 += __shfl_xor(s1, 2); s2 += __shfl_xor(s2, 1); s2 += __shfl_xor(s2, 2);
      const float mean = s1 * (1.f / 128.f); const float var = fmaxf(s2 * (1.f / 128.f) - mean * mean, 0.f); const float rs = rsqrtf(var + EPS);
      const bf16_t* gp = RG + (t0 + q) * 512 + h * 128 + seg * 32; const float* gg = gn_g + h * 128 + seg * 32;
      bf16_t* op = AO + (t0 + q) * 1024 + 512 + h * 128 + seg * 32;
#pragma unroll
      for (int i = 0; i < 4; ++i) { const u32x4 gr = *(const u32x4*)(gp + 8 * i); const f32x4 g0 = *(const f32x4*)(gg + 8 * i), g1 = *(const f32x4*)(gg + 8 * i + 4);
          const f32x4 ga = {__uint_as_float(gr.x << 16), __uint_as_float(gr.x & 0xffff0000u), __uint_as_float(gr.y << 16), __uint_as_float(gr.y & 0xffff0000u)};
          const f32x4 gb = {__uint_as_float(gr.z << 16), __uint_as_float(gr.z & 0xffff0000u), __uint_as_float(gr.w << 16), __uint_as_float(gr.w & 0xffff0000u)};
          f32x4 ya = (v[2 * i] - mean) * rs * g0, yb = (v[2 * i + 1] - mean) * rs * g1;
#pragma unroll
          for (int k = 0; k < 4; ++k) { ya[k] *= ga[k] / (1.f + __expf(-ga[k])); yb[k] *= gb[k] / (1.f + __expf(-gb[k])); }
          *(u32x4*)(op + 8 * i) = fx::pack8(ya, yb); } }
    __syncthreads();
}
__device__ __forceinline__ void ret_out_phase(const bf16_t* RQ, const bf16_t* RK, const bf16_t* RV, const bf16_t* RG, const bf16_t* STS, const float* gn_g, bf16_t* AO, char* lds) {
    for (int it = blockIdx.x; it < 512; it += gridDim.x) { const int bh = it >> 4, x = it & 15;
        ret_out_unit(RQ, RK, RV, RG, STS, gn_g, AO, bh, 31 - x, lds);
        ret_out_unit(RQ, RK, RV, RG, STS, gn_g, AO, bh, x, lds); }
}

__device__ __forceinline__ void ret_scan_phase(const bf16_t* KVS, bf16_t* STS) {
    const int gt = blockIdx.x * 512 + threadIdx.x, NT = gridDim.x * 512;
    for (int it = gt; it < 32 * 2048; it += NT) { const int bh = it >> 11, e8 = it & 2047;
        const float cd = exp2f(128.f * gamma_log2(bh & 3));
        const bf16_t* src = KVS + (size_t)bh * 32 * 16384 + e8 * 8; bf16_t* dst = STS + (size_t)bh * 32 * 16384 + e8 * 8;
        f32x4 s0 = {0.f, 0.f, 0.f, 0.f}, s1 = s0;
#pragma unroll 8
        for (int c = 0; c < 32; ++c) { const u32x4 v = *(const u32x4*)(src + (size_t)c * 16384);
            *(u32x4*)(dst + (size_t)c * 16384) = fx::pack8(s0, s1);
            s0 = s0 * cd + (f32x4){__uint_as_float(v.x << 16), __uint_as_float(v.x & 0xffff0000u), __uint_as_float(v.y << 16), __uint_as_float(v.y & 0xffff0000u)};
            s1 = s1 * cd + (f32x4){__uint_as_float(v.z << 16), __uint_as_float(v.z & 0xffff0000u), __uint_as_float(v.w << 16), __uint_as_float(v.w & 0xffff0000u)}; } }
}
#undef TRRD
#undef FRAG
}
namespace cg = cooperative_groups;
#ifndef DUP
#define DUP (-1)
#endif
__device__ __forceinline__ int opaque_reps(int n) { asm volatile("" : "+s"(n)); return n; }
#define REPS(code) for (int rep = 0; rep < ((DUP == (code)) ? 2 : 1); ++rep)
constexpr int NWAVES = 8;
constexpr int RING_BYTES = 131072, XL_OFF = RING_BYTES, XL_BYTES = 8192, XST_OFF = RING_BYTES + 8192 + 16384, LDS_BYTES = XST_OFF + 64;

struct Params {
    const float* in[28]; float* out; unsigned char* ws; int ph_lo, ph_hi; int coop; int pad;
};
typedef const Params __attribute__((address_space(4)))* KParams;
#define WSP(T_, off) ((T_*)(p->ws + (off)))

constexpr size_t WB_IN = WS_WB, WB_UQ = WB_IN + (size_t)2560 * 1024 * 2, WB_UKV = WB_UQ + (size_t)1024 * 256 * 2, WB_OUT = WB_UKV + (size_t)1024 * 256 * 2,
                 WB_CQ = WB_OUT + (size_t)1024 * 1024 * 2, WB_CKV = WB_CQ + (size_t)1024 * 1024 * 2, WB_CO = WB_CKV + (size_t)2048 * 1024 * 2,
                 WB_GU = WB_CO + (size_t)1024 * 1024 * 2, WB_D = WB_GU + (size_t)32 * 512 * 1024 * 2, WB_END = WB_D + (size_t)32 * 1024 * 256 * 2;
static_assert(WB_END <= WS_RQ, "weight copies overflow their region");

__device__ __forceinline__ float wave_sum64(float v) {
#pragma unroll
    for (int o = 1; o < 64; o <<= 1) v += __shfl_xor(v, o);
    return v;
}
__device__ __forceinline__ int plain_src(int n) { return (n & ~31) + pg8::perm32(n & 31); }

template <class SrcFn, class DstFn>
__device__ __forceinline__ void wprep_item(const float* __restrict__ W, int ldw, int Kreal, const float* __restrict__ gain, bf16_t* __restrict__ WT, int ldt,
                                           LAS float* scr, int kb, int nb, int lane, SrcFn src, DstFn dst) {
    const int k0 = 64 * kb, n0 = 64 * nb;
    u32x4* orow = (u32x4*)(WT + (size_t)dst(n0 + lane) * ldt + k0);
    if (k0 >= Kreal) {
#pragma unroll
        for (int c = 0; c < 8; ++c) orow[c] = (u32x4){0u, 0u, 0u, 0u};
        return; }
    const int krow = lane >> 4, n4 = lane & 15;
    int sc = src(n0 + 4 * n4); sc = sc < 0 ? 0 : sc;
    const float* wp = W + (size_t)(k0 + krow) * ldw + sc;
    f32x4 v[16];
#pragma unroll
    for (int i = 0; i < 16; ++i) v[i] = *(const f32x4*)(wp + (size_t)(4 * i) * ldw);
#pragma unroll
    for (int i = 0; i < 16; ++i) *(LAS f32x4*)(scr + (4 * i + krow) * 68 + 4 * n4) = v[i];
    asm volatile("s_waitcnt lgkmcnt(0)" ::: "memory");
    const bool zero = src(n0 + lane) < 0;
#pragma unroll
    for (int c = 0; c < 8; ++c) { float t[8];
#pragma unroll
        for (int j = 0; j < 8; ++j) { t[j] = scr[(8 * c + j) * 68 + lane]; if (gain) t[j] *= gain[k0 + 8 * c + j]; if (zero) t[j] = 0.f; }
        u32x4 o; o.x = pg8::cvt_pk_bf16(t[0], t[1]); o.y = pg8::cvt_pk_bf16(t[2], t[3]); o.z = pg8::cvt_pk_bf16(t[4], t[5]); o.w = pg8::cvt_pk_bf16(t[6], t[7]);
        orow[c] = o; }
    asm volatile("s_waitcnt lgkmcnt(0)" ::: "memory");
}
template <class SrcFn, class DstFn>
__device__ __forceinline__ void wprep_matrix(const float* W, int ldw, int Kreal, int Kpad, int Nitems64, const float* gain, bf16_t* WT, int ldt, LAS float* scr, int gw, int NGW, int lane, SrcFn src, DstFn dst) {
    const int nkb = Kpad / 64, total = nkb * Nitems64;
    for (int it = gw; it < total; it += NGW) wprep_item(W, ldw, Kreal, gain, WT, ldt, scr, it / Nitems64, it % Nitems64, lane, src, dst);
}
__device__ __forceinline__ void rms_row_to_bf16(const float* xrow, const float* g, bf16_t* orow, int lane) {
    const f32x4* xr = (const f32x4*)xrow + lane; const f32x4* gr = (const f32x4*)g + lane;
    f32x4 v[4]; float s = 0.f;
#pragma unroll
    for (int j = 0; j < 4; ++j) { v[j] = xr[64 * j]; s += fx::sq4(v[j]); }
    const float rs = rsqrtf(wave_sum64(s) * (1.f / 1024.f) + EPS);
    u32x2* o8 = (u32x2*)orow + lane;
#pragma unroll
    for (int j = 0; j < 4; ++j) { const f32x4 w = v[j] * rs * gr[64 * j]; o8[64 * j] = fx::pack4(w); }
}

__device__ __forceinline__ void expert_prep(KParams p, LAS unsigned char* lds, int wave, int lane) {
    LAS float* scr = (LAS float*)(lds + wave * 17408);
    const int gw = blockIdx.x * NWAVES + wave, NGW = gridDim.x * NWAVES;
    auto ident = [](int n) { return n; };
    for (int it = gw; it < 32 * 64; it += NGW) { const int e = it >> 6, r = it & 63, kb = r >> 2, nb = r & 3;
        auto srcf = [](int n) { return (n >> 7) * 128 + plain_src(n & 127); };
        wprep_item(p->in[25] + (size_t)e * 1024 * 256, 256, 1024, p->in[20], WSP(bf16_t, WB_GU) + (size_t)e * 512 * 1024, 1024, scr, kb, nb, lane, srcf, [](int n) { return (n >> 7) * 256 + (n & 127); });
        wprep_item(p->in[26] + (size_t)e * 1024 * 256, 256, 1024, p->in[20], WSP(bf16_t, WB_GU) + (size_t)e * 512 * 1024, 1024, scr, kb, nb, lane, srcf, [](int n) { return (n >> 7) * 256 + 128 + (n & 127); }); }
    for (int it = gw; it < 32 * 64; it += NGW) { const int e = it >> 6, r = it & 63, kb = r >> 4, nb = r & 15;
        wprep_item(p->in[27] + (size_t)e * 256 * 1024, 1024, 256, nullptr, WSP(bf16_t, WB_D) + (size_t)e * 1024 * 256, 256, scr, kb, nb, lane, ident, ident); }
    __syncthreads();
}

__device__ __forceinline__ void p0_prologue(KParams p, LAS unsigned char* lds, int wave, int lane) {
    LAS float* scr = (LAS float*)(lds + wave * 17408);
    const int gw = blockIdx.x * NWAVES + wave, NGW = gridDim.x * NWAVES;
    auto ident = [](int n) { return n; };
    REPS(1004) {
    for (int it = gw; it < 2048; it += NGW) { int r = it;
        if (r < 640) { wprep_item(p->in[4], 2496, 1024, nullptr, WSP(bf16_t, WB_IN), 1024, scr, r / 40, r % 40, lane, [](int n) { return fx::inproj_src(n); }, ident); continue; } r -= 640;
        if (r < 256) { wprep_item(p->in[12], 1024, 1024, nullptr, WSP(bf16_t, WB_OUT), 1024, scr, r >> 4, r & 15, lane, ident, ident); continue; } r -= 256;
        if (r < 256) { wprep_item(p->in[19], 1024, 1024, nullptr, WSP(bf16_t, WB_CO), 1024, scr, r >> 4, r & 15, lane, ident, ident); continue; } r -= 256;
        if (r < 64) { wprep_item(p->in[6], 768, 256, p->in[5], WSP(bf16_t, WB_UQ), 256, scr, r >> 4, r & 15, lane, [](int n) { return fx::mlaq_src(n); }, ident); continue; } r -= 64;
        if (r < 64) { wprep_item(p->in[8], 1024, 128, p->in[7], WSP(bf16_t, WB_UKV), 256, scr, r >> 4, r & 15, lane, [](int n) { return plain_src(n); }, ident); continue; } r -= 64;
        if (r < 256) { wprep_item(p->in[15], 1024, 1024, p->in[13], WSP(bf16_t, WB_CQ), 1024, scr, r >> 4, r & 15, lane, [](int n) { return plain_src(n); }, ident); continue; } r -= 256;
        wprep_item(p->in[16], 2048, 1024, nullptr, WSP(bf16_t, WB_CKV), 1024, scr, r >> 5, r & 31, lane, [](int n) { return n < 1024 ? plain_src(n) : n; }, ident);
    }
    }
    REPS(1001) {
    for (int m = gw; m < T_TOK; m += 2 * NGW) {
        const f32x4* xr0 = (const f32x4*)(p->in[0] + (size_t)m * 1024) + lane; const f32x4* xr1 = (const f32x4*)(p->in[0] + (size_t)(m + NGW) * 1024) + lane; const f32x4* gr = (const f32x4*)p->in[3] + lane;
        f32x4 v0[4], v1[4]; float s0 = 0.f, s1 = 0.f;
#pragma unroll
        for (int j = 0; j < 4; ++j) { v0[j] = xr0[64 * j]; v1[j] = xr1[64 * j]; }
#pragma unroll
        for (int j = 0; j < 4; ++j) { s0 += fx::sq4(v0[j]); s1 += fx::sq4(v1[j]); }
        const float r0 = rsqrtf(wave_sum64(s0) * (1.f / 1024.f) + EPS), r1 = rsqrtf(wave_sum64(s1) * (1.f / 1024.f) + EPS);
        u32x2* o0 = (u32x2*)(WSP(bf16_t, WS_HB) + (size_t)m * 1024) + lane; u32x2* o1 = (u32x2*)(WSP(bf16_t, WS_HB) + (size_t)(m + NGW) * 1024) + lane;
#pragma unroll
        for (int j = 0; j < 4; ++j) { const f32x4 g = gr[64 * j]; o0[64 * j] = fx::pack4(v0[j] * r0 * g); o1[64 * j] = fx::pack4(v1[j] * r1 * g); } }
    for (int m = gw; m < 2048; m += NGW) rms_row_to_bf16(p->in[1] + (size_t)m * 1024, p->in[14], WSP(bf16_t, WS_MB) + (size_t)m * 1024, lane);
    }
    REPS(1002) {
    { const int gt = blockIdx.x * (NWAVES * 64) + threadIdx.x, NT = gridDim.x * NWAVES * 64;
      float* z = WSP(float, WS_SSQ_CQ);
      for (int idx = gt; idx < 5 * 32768; idx += NT) z[idx] = 0.f;
      if (gt < 64) WSP(int, WS_CNT)[gt] = 0;
      bf16_t* wrh = WSP(bf16_t, WS_RW); bf16_t* wrl = wrh + 36 * 1032;
      for (int idx = gt; idx < 36 * 1032; idx += NT) { const int n = idx / 1032, k = idx % 1032; float v = 0.f;
          if (k < 1024) v = (n < 4) ? p->in[20][k] * p->in[21][k * 4 + n] : p->in[20][k] * p->in[23][k * 32 + n - 4];
          const bf16_t hh = f2bf(v); wrh[idx] = hh; wrl[idx] = f2bf(v - bf2f(hh)); } }
    }
}


#define GAS __attribute__((address_space(1)))
#define XB_TMO      128
#define XB_XCNT(j)  (256  + 64 * (j))
#define XB_XSUB(j)  (1280 + 64 * (j))
#define XB_XGEN(j)  (2304 + 64 * (j))
#define XB_TOP      3328
#define XB_TOPGEN   3392
#define XCD_BAR_WORDS 3456
#define XB_SPIN_CAP (1u << 18)
__device__ __forceinline__ unsigned xb_ld(unsigned* p)              { return __hip_atomic_load(p, __ATOMIC_RELAXED, __HIP_MEMORY_SCOPE_AGENT); }
__device__ __forceinline__ unsigned xb_add(unsigned* p, unsigned v) { return __hip_atomic_fetch_add(p, v, __ATOMIC_RELAXED, __HIP_MEMORY_SCOPE_AGENT); }
__device__ __forceinline__ unsigned xb_xcc_id() { return (unsigned)__builtin_amdgcn_s_getreg((3 << 11) | 20) & 0xFu; }
#define XB_SPIN(cond, bar) do { unsigned _sp = 0; while (cond) { __builtin_amdgcn_s_sleep(1); \
    if ((++_sp & 255u) == 0u) { if (xb_ld(&(bar)[XB_TMO])) break; if (_sp > XB_SPIN_CAP) { atomicAdd(&(bar)[XB_TMO], 1u); break; } } } } while (0)
struct XcdBarrier { unsigned* bar; unsigned x; volatile LAS unsigned* st; };
__device__ __forceinline__ XcdBarrier xcd_barrier_post(unsigned* bar, volatile LAS unsigned* st) {
    XcdBarrier b; b.bar = bar; b.x = xb_xcc_id(); b.st = st;
    if (threadIdx.x == 0) (void)xb_add(&bar[XB_XCNT(b.x)], 1u);
    return b;
}
__device__ __forceinline__ void xcd_barrier_complete(unsigned* bar, unsigned x, unsigned& nloc, unsigned& nx) {
    const unsigned G = gridDim.x * gridDim.y * gridDim.z;
    unsigned sum, cnt, mine, sp = 0u;
    for (;;) {
        sum = 0u; cnt = 0u; mine = 0u;
#pragma unroll
        for (unsigned j = 0; j < 16; ++j) { const unsigned c = xb_ld(&bar[XB_XCNT(j)]); sum += c; cnt += (c > 0u) ? 1u : 0u; mine = (j == x) ? c : mine; }
        if (sum == G) break;
        __builtin_amdgcn_s_sleep(1);
        if ((++sp & 255u) == 0u) { if (xb_ld(&bar[XB_TMO])) break; if (sp > XB_SPIN_CAP) { atomicAdd(&bar[XB_TMO], 1u); break; } }
    }
    nloc = mine > 0u ? mine : 1u; nx = cnt > 0u ? cnt : 1u;
}
__device__ __forceinline__ void xcd_barrier(const XcdBarrier& b) {
    asm volatile("s_waitcnt vmcnt(0)" ::: "memory");
    __syncthreads();
    if (threadIdx.x == 0) {
        unsigned* bar = b.bar;
        __builtin_amdgcn_s_waitcnt(0);
        unsigned nloc = b.st[0], nx = b.st[1];
        if (nloc == 0u) { xcd_barrier_complete(bar, b.x, nloc, nx); b.st[0] = nloc; b.st[1] = nx; }
        const unsigned old = xb_add(&bar[XB_XSUB(b.x)], 1u);
        const unsigned gen = old / nloc;
        if (old + 1u == (gen + 1u) * nloc) {
            __builtin_amdgcn_fence(__ATOMIC_RELEASE, "agent");
            asm volatile("s_waitcnt vmcnt(0)" ::: "memory");
            const unsigned og = xb_add(&bar[XB_TOP], 1u);
            const unsigned tg = og / nx;
            if (og + 1u == (tg + 1u) * nx) xb_add(&bar[XB_TOPGEN], 1u);
            else XB_SPIN(xb_ld(&bar[XB_TOPGEN]) == tg, bar);
            __builtin_amdgcn_fence(__ATOMIC_ACQUIRE, "agent");
            xb_add(&bar[XB_XGEN(b.x)], 1u);
            asm volatile("s_waitcnt vmcnt(0)" ::: "memory");
        } else {
            XB_SPIN(xb_ld(&bar[XB_XGEN(b.x)]) == gen, bar);
            __builtin_amdgcn_fence(__ATOMIC_ACQUIRE, "agent");
            asm volatile("s_waitcnt vmcnt(0)" ::: "memory");
        }
    }
    __syncthreads();
}

__device__ __forceinline__ void router_phase(KParams p, LAS unsigned char* lds, int wave, int lane, int* cnt, int* lists, float* roww) {
    const float* x2 = p->out;
    const float* bg = p->in[22]; const float* be = p->in[24];
    constexpr int RP = 2064;
    { const u32x4* src = WSP(u32x4, WS_RW); LAS u32x4* dst = (LAS u32x4*)lds;
      for (int i = threadIdx.x; i < 2 * 36 * RP / 16; i += NWAVES * 64) dst[i] = src[i]; }
    __syncthreads();
    const int tok = lane & 15, kq = lane >> 4;
    LAS unsigned char* wh = lds + tok * RP + kq * 16; LAS unsigned char* wl = wh + 36 * RP;
    const bool t2 = tok < 4;
    for (int item = blockIdx.x * NWAVES + wave; item < T_TOK / 16; item += gridDim.x * NWAVES) {
        const int t0 = item * 16;
        const float* xr = x2 + (size_t)(t0 + tok) * 1024 + 8 * kq;
        f32x4 c[3]; c[0] = (f32x4){0.f, 0.f, 0.f, 0.f}; c[1] = c[0]; c[2] = c[0]; float ss = 0.f;
#pragma unroll 8
        for (int ks = 0; ks < 32; ++ks) {
            const f32x4 xa = *(const f32x4*)(xr + 32 * ks), xb = *(const f32x4*)(xr + 32 * ks + 4);
            ss += fx::sq4(xa) + fx::sq4(xb);
            u32x4 hw = fx::pack8(xa, xb);
            const f32x4 ha = {__uint_as_float(hw.x << 16), __uint_as_float(hw.x & 0xffff0000u), __uint_as_float(hw.y << 16), __uint_as_float(hw.y & 0xffff0000u)};
            const f32x4 hb = {__uint_as_float(hw.z << 16), __uint_as_float(hw.z & 0xffff0000u), __uint_as_float(hw.w << 16), __uint_as_float(hw.w & 0xffff0000u)};
            u32x4 lw = fx::pack8(xa - ha, xb - hb);
            const bf16x8 xh = *reinterpret_cast<bf16x8*>(&hw), xl = *reinterpret_cast<bf16x8*>(&lw);
#pragma unroll
            for (int t = 0; t < 3; ++t) {
                bf16x8 ah, al;
                if (t < 2) { ah = *(const LAS bf16x8*)(wh + t * 16 * RP + ks * 64); al = *(const LAS bf16x8*)(wl + t * 16 * RP + ks * 64); }
                else { ah = *(const LAS bf16x8*)(wh + (t2 ? 32 * RP : 0) + ks * 64); al = *(const LAS bf16x8*)(wl + (t2 ? 32 * RP : 0) + ks * 64);
                       if (!t2) { ah = (bf16x8){0, 0, 0, 0, 0, 0, 0, 0}; al = ah; } }
                c[t] = __builtin_amdgcn_mfma_f32_16x16x32_bf16(ah, xh, c[t], 0, 0, 0);
                c[t] = __builtin_amdgcn_mfma_f32_16x16x32_bf16(ah, xl, c[t], 0, 0, 0);
                c[t] = __builtin_amdgcn_mfma_f32_16x16x32_bf16(al, xh, c[t], 0, 0, 0);
            }
        }
        ss = fx::quad_sum(ss);
        const float rs = rsqrtf(ss * (1.f / 1024.f) + EPS);
#pragma unroll
        for (int t = 0; t < 3; ++t) c[t] = c[t] * rs;
        float g[4];
#pragma unroll
        for (int r = 0; r < 4; ++r) g[r] = __shfl(c[0][r], tok);
        const float mx = fmaxf(fmaxf(g[0], g[1]), fmaxf(g[2], g[3]));
        float den = 0.f;
#pragma unroll
        for (int j = 0; j < 4; ++j) den += expf(g[j] - mx);
        int gs = 0; float best = g[0] + bg[0], lgs = g[0];
#pragma unroll
        for (int j = 1; j < 4; ++j) { const float v = g[j] + bg[j]; if (v > best) { best = v; gs = j; lgs = g[j]; } }
        const float gw = expf(lgs - mx) / den;
        const int qA = 1 + 2 * gs, qB = qA + 1;
        f32x4 sA = (qA >> 2) == 0 ? c[0] : ((qA >> 2) == 1 ? c[1] : c[2]);
        f32x4 sB = (qB >> 2) == 0 ? c[0] : ((qB >> 2) == 1 ? c[1] : c[2]);
        float el[8];
#pragma unroll
        for (int r = 0; r < 4; ++r) { el[r] = __shfl(sA[r], tok + 16 * (qA & 3)); el[4 + r] = __shfl(sB[r], tok + 16 * (qB & 3)); }
        float emx = el[0];
#pragma unroll
        for (int j = 1; j < 8; ++j) emx = fmaxf(emx, el[j]);
        float eden = 0.f;
#pragma unroll
        for (int j = 0; j < 8; ++j) eden += expf(el[j] - emx);
        float sc[8];
#pragma unroll
        for (int j = 0; j < 8; ++j) sc[j] = el[j] + be[gs * 8 + j];
        int i0 = 0; float b0 = sc[0], e0v = el[0];
#pragma unroll
        for (int j = 1; j < 8; ++j) if (sc[j] > b0) { b0 = sc[j]; i0 = j; e0v = el[j]; }
        int i1 = -1; float b1 = -3.0e38f, e1v = 0.f;
#pragma unroll
        for (int j = 0; j < 8; ++j) if (j != i0 && sc[j] > b1) { b1 = sc[j]; i1 = j; e1v = el[j]; }
        LAS int* hist = (LAS int*)(lds + 2 * 36 * RP + 128); LAS int* hbase = hist + 64;
        if (threadIdx.x < 64) hist[threadIdx.x] = 0;
        __syncthreads();
        const float p0 = expf(e0v - emx) / eden, p1 = expf(e1v - emx) / eden, sm = p0 + p1;
        const int sg0 = gs * 8 + i0, sg1 = 32 + gs * 8 + i1;
        int r0 = 0, r1 = 0;
        if (kq == 0) { r0 = __hip_atomic_fetch_add(hist + sg0, 1, __ATOMIC_RELAXED, __HIP_MEMORY_SCOPE_WORKGROUP); r1 = __hip_atomic_fetch_add(hist + sg1, 1, __ATOMIC_RELAXED, __HIP_MEMORY_SCOPE_WORKGROUP); }
        __syncthreads();
        if (threadIdx.x < 64) { const int n = hist[threadIdx.x]; hbase[threadIdx.x] = n > 0 ? atomicAdd(cnt + threadIdx.x, n) : 0; }
        __syncthreads();
        if (kq == 0) {
            const int t = t0 + tok; const int q0 = hbase[sg0] + r0, q1 = hbase[sg1] + r1;
            lists[(size_t)sg0 * fx::MOE_CAP + q0] = t; roww[(size_t)sg0 * fx::MOE_CAP + q0] = p0 / sm * gw;
            lists[(size_t)sg1 * fx::MOE_CAP + q1] = t; roww[(size_t)sg1 * fx::MOE_CAP + q1] = p1 / sm * gw;
        }
    }
    __syncthreads();
}

__global__ void __launch_bounds__(NWAVES * 64, 2) mk_fwd(Params p_arg) {
    KParams p = (KParams)__builtin_amdgcn_kernarg_segment_ptr();
    extern __shared__ __attribute__((aligned(16))) unsigned char lds_raw[];
    LAS unsigned char* lds = (LAS unsigned char*)lds_raw;
    LAS unsigned char* xl = lds + XL_OFF;
    const int tid = threadIdx.x, lane = tid & 63, wave = __builtin_amdgcn_readfirstlane(tid >> 6);
    const int lo = p->ph_lo, hi = p->ph_hi;
#ifndef PHMASK
#define PHMASK 0xffffffffu
#endif
#define IN(k) (((PHMASK >> (k)) & 1u) && lo <= (k) && (k) < hi)
#define SEAM(k) do { if (IN(k) && IN((k) + 1)) { xcd_barrier(xbar); if (DUP == 1000) xcd_barrier(xbar); } } while (0)
    volatile LAS unsigned* xst = (volatile LAS unsigned*)(lds + XST_OFF);
    if (tid == 0) { xst[0] = 0u; xst[1] = 0u; }
    __syncthreads();
    XcdBarrier xbar = xcd_barrier_post(WSP(unsigned, WS_BAR), xst);
    if (lo < 0) cg::this_grid().sync();
    float* const dummyf = WSP(float, 512 * 1024);
    REPS(0) if (IN(0)) { p0_prologue(p, lds, wave, lane); }
    SEAM(0);
    if (IN(1)) {
        REPS(1) {
        pg8::GridOrder S; S.init(WSP(bf16_t, WS_HB), 1024, WSP(bf16_t, WB_IN), 1024, T_TOK, 2560, gridDim.x, blockIdx.x);
        fx::EpiInProj E{WSP(bf16_t, WS_CQ), WSP(bf16_t, WS_CKV), WSP(bf16_t, WS_RQ), WSP(bf16_t, WS_RK), WSP(bf16_t, WS_RV), WSP(bf16_t, WS_RG),
                        rep ? dummyf : WSP(float, WS_SSQ_CQ), rep ? dummyf : WSP(float, WS_SSQ_CKV), rep ? dummyf : WSP(float, WS_SSQ_KPE), (const int*)p->in[2], p->in[10]};
        pg8::gemm_phase<fx::EpiInProj, pg8::GridOrder>(lds, xl, 1024, 1024, 1024, S, E); }
        REPS(101) { fx::MemKVOrder S2{(int)gridDim.x, (int)blockIdx.x, (const char*)WSP(bf16_t, WS_MB), (const char*)WSP(bf16_t, WB_CKV)};
          fx::EpiMemKV E2{WSP(bf16_t, WS_KC), WSP(bf16_t, WS_VC), p->in[18]};
          pg8::gemm_phase<fx::EpiMemKV, fx::MemKVOrder>(lds, xl, 1024, 1024, 1024, S2, E2); }
    }
    SEAM(1);
    if (IN(2)) {
        REPS(2) {
        { pg8::GridOrder S; S.init(WSP(bf16_t, WS_CQ), 256, WSP(bf16_t, WB_UQ), 256, T_TOK, 1024, gridDim.x, blockIdx.x);
          fx::EpiMlaQ E{WSP(bf16_t, WS_QM), WSP(float, WS_SSQ_CQ), p->in[9], (const int*)p->in[2]};
          pg8::gemm_phase<fx::EpiMlaQ, pg8::GridOrder>(lds, xl, 256, 256, 256, S, E); }
        { pg8::GridOrder S; S.init(WSP(bf16_t, WS_CKV), 256, WSP(bf16_t, WB_UKV), 256, T_TOK, 1024, gridDim.x, blockIdx.x);
          fx::EpiMlaKV E{WSP(bf16_t, WS_KM), WSP(bf16_t, WS_VM), WSP(bf16_t, WS_CKV), WSP(float, WS_SSQ_CKV), WSP(float, WS_SSQ_KPE), p->in[10]};
          pg8::gemm_phase<fx::EpiMlaKV, pg8::GridOrder>(lds, xl, 256, 256, 256, S, E); } }
        REPS(201) rt::ret_kv_phase(WSP(bf16_t, WS_RK), WSP(bf16_t, WS_RV), WSP(bf16_t, WS_KVS), (char*)lds_raw);
    }
    SEAM(2);
    if (IN(3)) { REPS(302) rt::ret_scan_phase(WSP(bf16_t, WS_KVS), WSP(bf16_t, WS_STS));
                 _Pragma("nounroll") for (int pos = 0; pos < 2; ++pos) {
                     if ((int)((blockIdx.x >> 3) & 1) == pos) expert_prep(p, lds, wave, lane);
                     if (pos == 0) at::attn_phase(WSP(bf16_t, WS_QM), WSP(bf16_t, WS_KM), WSP(bf16_t, WS_VM), WSP(bf16_t, WS_AO), (char*)lds_raw); }
                 xcd_barrier(xbar);
                 REPS(301) rt::ret_out_phase(WSP(bf16_t, WS_RQ), WSP(bf16_t, WS_RK), WSP(bf16_t, WS_RV), WSP(bf16_t, WS_RG), WSP(bf16_t, WS_STS), p->in[11], WSP(bf16_t, WS_AO), (char*)lds_raw); }
    SEAM(3);
    if (IN(4)) for (int rep = 0; rep < ((DUP == 4 || DUP == 1004 + 1000) ? 2 : 1); ++rep) {
        pg8::GridOrder S; S.init(WSP(bf16_t, WS_AO), 1024, WSP(bf16_t, WB_OUT), 1024, T_TOK, 1024, gridDim.x, blockIdx.x);
        fx::EpiResid<false, false> E{p->in[0], p->out, WSP(bf16_t, WS_XB), rep ? ((DUP == 4) ? dummyf : (float*)nullptr) : WSP(float, WS_SSQ1)};
        pg8::gemm_phase<fx::EpiResid<false, false>, pg8::GridOrder>(lds, xl, 1024, 1024, 1024, S, E);
    }
    SEAM(4);
#define LOCAL_SEAM() do { asm volatile("s_waitcnt vmcnt(0)" ::: "memory"); __syncthreads(); if (tid == 0) { __builtin_amdgcn_fence(__ATOMIC_ACQUIRE, "agent"); asm volatile("s_waitcnt vmcnt(0)" ::: "memory"); } __syncthreads(); } while (0)
    if (IN(5)) REPS(5) {
        fx::HeadOrder S{(int)gridDim.x, (int)blockIdx.x, 512, (const char*)WSP(bf16_t, WS_XB), (const char*)WSP(bf16_t, WB_CQ), (size_t)256 * 1024 * 2, 0, 0, (size_t)256 * 1024 * 2};
        fx::EpiHeadNorm E{WSP(bf16_t, WS_QC), WSP(float, WS_SSQ1), p->in[17], 1.f / 1024.f};
        pg8::gemm_phase<fx::EpiHeadNorm, fx::HeadOrder>(lds, xl, 1024, 1024, 1024, S, E);
    }
    if (IN(5) && IN(6) && gridDim.x == 256) LOCAL_SEAM(); else SEAM(5);
    if (IN(6)) REPS(6) {
        fx::HeadOrder S{(int)gridDim.x, (int)blockIdx.x, 512, (const char*)WSP(bf16_t, WS_QC), (const char*)WSP(bf16_t, WS_KC), (size_t)256 * 1024 * 2, (size_t)256 * 2, (size_t)256 * 1024 * 2, (size_t)256 * 2};
        fx::EpiSoftmax E{WSP(bf16_t, WS_PC)};
        pg8::gemm_phase<fx::EpiSoftmax, fx::HeadOrder>(lds, xl, 1024, 1024, 256, S, E);
    }
    if (IN(6) && IN(7) && gridDim.x == 256) LOCAL_SEAM(); else SEAM(6);
    if (IN(7)) REPS(7) {
        fx::HeadOrder S{(int)gridDim.x, (int)blockIdx.x, 512, (const char*)WSP(bf16_t, WS_PC), (const char*)WSP(bf16_t, WS_VC), (size_t)256 * 1024 * 2, (size_t)256 * 2, (size_t)1024 * 256 * 2, (size_t)256 * 256 * 2};
        fx::EpiStoreBf16 E{WSP(bf16_t, WS_OC), 1024, 0};
        pg8::gemm_phase<fx::EpiStoreBf16, fx::HeadOrder>(lds, xl, 1024, 256, 256, S, E);
    }
#undef LOCAL_SEAM
    SEAM(7);
    if (IN(8)) {
        pg8::GridOrder S; S.init(WSP(bf16_t, WS_OC), 1024, WSP(bf16_t, WB_CO), 1024, T_TOK, 1024, gridDim.x, blockIdx.x);
        fx::EpiResid<true, true> E{nullptr, p->out, WSP(bf16_t, WS_XB), WSP(float, WS_SSQ2)};
        pg8::gemm_phase<fx::EpiResid<true, true>, pg8::GridOrder>(lds, xl, 1024, 1024, 1024, S, E);
    }
    SEAM(8);
    if (IN(9)) REPS(9) { router_phase(p, lds, wave, lane, rep ? WSP(int, 32 * 1024) : WSP(int, WS_CNT), rep ? WSP(int, WS_AO) : WSP(int, WS_LISTS), rep ? WSP(float, WS_AO + 8 * MiB) : WSP(float, WS_ROWW)); }
    SEAM(9);
    if (IN(10)) for (int rep = 0; rep < ((DUP == 10 || DUP == 2010 || DUP == 3010) ? 2 : 1); ++rep) {
        fx::MoeOrder S{(int)gridDim.x, (int)blockIdx.x, 0, 64, 2, WSP(int, WS_CNT), WSP(int, WS_LISTS), (const char*)WSP(bf16_t, WS_XB), (const char*)WSP(bf16_t, WB_GU), (DUP == 3010 && rep) ? (size_t)256 * 1024 * 2 : 0, (size_t)512 * 1024 * 2, (size_t)256 * 1024 * 2, nullptr}; S.init(xl);
        fx::EpiGlu E{(rep && DUP != 10) ? (bf16_t*)nullptr : WSP(bf16_t, WS_H), WSP(float, WS_SSQ2), WSP(float, WS_ROWW), WSP(int, WS_LISTS)};
        if (DUP == 3010 && rep) pg8::gemm_phase<fx::EpiGlu, fx::MoeOrder, false>(lds, xl, 1024, 1024, 1024, S, E);
        else pg8::gemm_phase<fx::EpiGlu, fx::MoeOrder, true>(lds, xl, 1024, 1024, 1024, S, E);
    }
    SEAM(10);
    if (IN(11)) {
        fx::MoeOrder S{(int)gridDim.x, (int)blockIdx.x, 0, 32, 4, WSP(int, WS_CNT), WSP(int, WS_LISTS), (const char*)WSP(bf16_t, WS_H), (const char*)WSP(bf16_t, WB_D), (size_t)256 * 256 * 2, (size_t)1024 * 256 * 2, (size_t)256 * 256 * 2, nullptr}; S.init(xl);
        fx::EpiScatter<0> E{p->out, WSP(bf16_t, WS_Y0)};
        pg8::gemm_phase<fx::EpiScatter<0>, fx::MoeOrder>(lds, xl, 256, 256, 256, S, E);
    }
    SEAM(11);
    if (IN(12)) {
        fx::MoeOrder S{(int)gridDim.x, (int)blockIdx.x, 32, 64, 4, WSP(int, WS_CNT), WSP(int, WS_LISTS), (const char*)WSP(bf16_t, WS_H), (const char*)WSP(bf16_t, WB_D), (size_t)256 * 256 * 2, (size_t)1024 * 256 * 2, (size_t)256 * 256 * 2, nullptr}; S.init(xl);
        fx::EpiScatter<1> E{p->out, WSP(bf16_t, WS_Y0)};
        pg8::gemm_phase<fx::EpiScatter<1>, fx::MoeOrder>(lds, xl, 256, 256, 256, S, E);
    }
#undef IN
#undef SEAM
}

extern "C" void kernel_launch(void* const* d_in, const int* in_sizes, int n_in, void* d_out, int out_size, void* d_ws, size_t ws_size, hipStream_t stream) {
    static int grid = 0;
    if (grid == 0) {
        if (n_in != 28 || out_size != T_TOK * 1024 || ws_size < WS_NEED) { fprintf(stderr, "kernel_launch: unexpected shapes n_in %d out %d ws %zu\n", n_in, out_size, ws_size); grid = -1; return; }
        int dev = 0, cus = 0, per_cu = 0;
        if (hipGetDevice(&dev) != hipSuccess || hipDeviceGetAttribute(&cus, hipDeviceAttributeMultiprocessorCount, dev) != hipSuccess) { grid = -1; return; }
        if (hipFuncSetAttribute((const void*)mk_fwd, hipFuncAttributeMaxDynamicSharedMemorySize, LDS_BYTES) != hipSuccess) { fprintf(stderr, "hipFuncSetAttribute failed\n"); grid = -1; return; }
        if (hipOccupancyMaxActiveBlocksPerMultiprocessor(&per_cu, (const void*)mk_fwd, NWAVES * 64, LDS_BYTES) != hipSuccess || per_cu < 1) { fprintf(stderr, "occupancy query failed (%d)\n", per_cu); grid = -1; return; }
        grid = cus;
        (void)hipGetLastError();
    }
    if (grid < 0) return;
    if (hipMemsetAsync(d_ws, 0, 65536, stream) != hipSuccess) { fprintf(stderr, "hipMemsetAsync failed\n"); return; }
    Params p; memset(&p, 0, sizeof(p));
    for (int i = 0; i < 28; ++i) p.in[i] = (const float*)d_in[i];
    p.out = (float*)d_out; p.ws = (unsigned char*)d_ws; p.ph_lo = 0; p.ph_hi = 13; p.coop = 1;
#if defined(DUP) && DUP == 1
    p.pad = 1;
#endif
    void* args[] = {&p};
    hipError_t e = hipLaunchCooperativeKernel((const void*)mk_fwd, dim3(grid), dim3(NWAVES * 64), args, LDS_BYTES, stream);
    if (e != hipSuccess) fprintf(stderr, "cooperative launch failed: %s (grid %d)\n", hipGetErrorString(e), grid);
}
```

```cpp
#include <hip/hip_runtime.h>
#include <hip/hip_cooperative_groups.h>
#include <cstdint>
#include <cstdio>
#include <cmath>
#include <cstring>

typedef unsigned short bf16_t;
constexpr float EPS = 1e-6f;
constexpr int T_TOK = 32768;
__device__ __forceinline__ int opaque_tid() { int t = threadIdx.x; asm volatile("" : "+v"(t)); return t; }
__device__ __forceinline__ float bf2f(bf16_t h) { return __uint_as_float((unsigned)h << 16); }
__device__ __forceinline__ bf16_t f2bf(float f) { const unsigned u = __float_as_uint(f); return (bf16_t)((u + 0x7fffu + ((u >> 16) & 1u)) >> 16); }

constexpr size_t MiB = (size_t)1 << 20;
constexpr size_t WS_CTL = 0;
constexpr size_t WS_SSQ_CQ = 1 * MiB, WS_SSQ_CKV = WS_SSQ_CQ + 128 * 1024, WS_SSQ_KPE = WS_SSQ_CKV + 128 * 1024, WS_SSQ1 = WS_SSQ_KPE + 128 * 1024, WS_SSQ2 = WS_SSQ1 + 128 * 1024;
constexpr size_t WS_SEL = 2 * MiB, WS_WTS = WS_SEL + 256 * 1024;
constexpr size_t WS_RW = 4 * MiB;
constexpr size_t WS_VWT = 5 * MiB;
constexpr size_t WS_MB = 21 * MiB, WS_KC = 25 * MiB, WS_VC = 29 * MiB;
constexpr size_t WS_WB = 33 * MiB;
constexpr size_t WS_RQ = 97 * MiB, WS_RK = 129 * MiB, WS_RV = 161 * MiB, WS_RG = 193 * MiB;
constexpr size_t WS_HB = 225 * MiB;
constexpr size_t WS_QM = 225 * MiB, WS_KM = 273 * MiB, WS_VM = 321 * MiB;
constexpr size_t WS_KVS = 353 * MiB;
constexpr size_t WS_AO = 385 * MiB;
constexpr size_t WS_STS = 449 * MiB;
constexpr size_t WS_CQ = 449 * MiB, WS_CKV = 465 * MiB;
constexpr size_t WS_PJ = 289 * MiB;
constexpr size_t WS_RAW = 353 * MiB;
constexpr size_t WS_XB = 97 * MiB;
constexpr size_t WS_QCR = 161 * MiB;
constexpr size_t WS_PC = 161 * MiB;
constexpr size_t WS_QC = 225 * MiB;
constexpr size_t WS_OC = 289 * MiB;
constexpr size_t WS_KVR = 353 * MiB;
constexpr size_t WS_BAR = 16 * 1024;
constexpr size_t WS_CNT = 64 * 1024;
constexpr size_t WS_LISTS = 353 * MiB, WS_ROWW = 361 * MiB;
constexpr size_t WS_XLO = 385 * MiB;
constexpr size_t WS_Y0 = 225 * MiB;
constexpr size_t WS_H = 161 * MiB;
constexpr size_t WS_NEED = 481 * MiB;
#define LAS __attribute__((address_space(3)))
typedef short bf16x8 __attribute__((ext_vector_type(8)));
typedef float f32x4 __attribute__((ext_vector_type(4)));
typedef float f32x2 __attribute__((ext_vector_type(2)));
typedef unsigned u32x4 __attribute__((ext_vector_type(4)));
typedef unsigned u32x2 __attribute__((ext_vector_type(2)));

namespace pg8 {
constexpr int BM = 256, BK = 64, HALF = 128, HTB = HALF * BK * 2, STAGE_BYTES = 8 * HTB, NXCD = 8, WGM = 8;
__host__ __device__ __forceinline__ int lds_byte(int r, int c) { const int st = (r >> 4) * 2 + (c >> 5), rr = r & 15, cc = c & 31, ob = rr * 64 + cc * 2; return st * 1024 + (ob ^ (((ob >> 9) & 1) << 5)); }
__host__ __device__ __forceinline__ void stage_rc(int b, int& R, int& C) { const int st = b / 1024, sb = b % 1024, swz = sb ^ (((sb >> 9) & 1) << 5); R = (st >> 1) * 16 + swz / 64; C = (st & 1) * 32 + (swz % 64) / 2; }
__host__ __device__ __forceinline__ int perm32(int rho) { const int n = rho >> 4, i = rho & 15; return 8 * (i >> 2) + 4 * n + (i & 3); }
__device__ __forceinline__ unsigned cvt_pk_bf16(float lo, float hi) { unsigned r; asm volatile("v_cvt_pk_bf16_f32 %0, %1, %2" : "=v"(r) : "v"(lo), "v"(hi)); return r; }

struct Unit { int pm, pn; const char* a; const char* b; const int* rows; int nvalid, seg, half; };

struct GridOrder {
    int nM, nN, nwg, G, c; const char* A; const char* B; size_t strideA, strideB;
    __device__ __forceinline__ void init(const bf16_t* A_, int lda, const bf16_t* B_, int ldb, int M, int N, int G_, int c_) {
        nM = M / BM; nN = N / BM; nwg = nM * nN; G = G_; c = c_; A = (const char*)A_; B = (const char*)B_; strideA = (size_t)BM * lda * 2; strideB = (size_t)BM * ldb * 2; }
    __device__ __forceinline__ bool next(int i, Unit& u) const { return at((long)i * G + c, u); }
    __device__ __forceinline__ bool at(long L, Unit& u) const {
        if (L >= nwg) return false;
        int wgid = (int)L; { const int q = nwg / NXCD, r = nwg % NXCD, xcd = wgid % NXCD, off = wgid / NXCD; wgid = (xcd < r ? xcd * (q + 1) : r * (q + 1) + (xcd - r) * q) + off; }
        const int nig = WGM * nN, gid = wgid / nig, fm = gid * WGM, gsz = (nM - fm) < WGM ? (nM - fm) : WGM;
        u.pm = fm + ((wgid % nig) % gsz); u.pn = (wgid % nig) / gsz; u.a = A + (size_t)u.pm * strideA; u.b = B + (size_t)u.pn * strideB; u.rows = nullptr; u.nvalid = 256; u.seg = 0; return true;
    }
};

#define XBAR() do { asm volatile("s_waitcnt lgkmcnt(0)" ::: "memory"); __builtin_amdgcn_s_barrier(); asm volatile("" ::: "memory"); } while (0)

__device__ __forceinline__ void row_allreduce_sum(float (&s)[2][4], int wr, int wc, int fr, int fq, LAS unsigned char* xl) {
    LAS float* P = (LAS float*)xl;
#pragma unroll
    for (int ai = 0; ai < 2; ++ai)
#pragma unroll
        for (int m = 0; m < 4; ++m) { float v = s[ai][m]; v += __shfl_xor(v, 16); v += __shfl_xor(v, 32); if (fq == 0) P[(ai * HALF + wr * 64 + m * 16 + fr) * 4 + wc] = v; }
    XBAR();
#pragma unroll
    for (int ai = 0; ai < 2; ++ai)
#pragma unroll
        for (int m = 0; m < 4; ++m) { const f32x4 p = *(const LAS f32x4*)(P + (ai * HALF + wr * 64 + m * 16 + fr) * 4); s[ai][m] = (p[0] + p[1]) + (p[2] + p[3]); }
    XBAR();
}
__device__ __forceinline__ void row_allreduce_sum2(float (&s)[2][4], float (&t)[2][4], int wr, int wc, int fr, int fq, LAS unsigned char* xl) {
    LAS f32x2* P = (LAS f32x2*)xl;
#pragma unroll
    for (int ai = 0; ai < 2; ++ai)
#pragma unroll
        for (int m = 0; m < 4; ++m) { float v = s[ai][m], w = t[ai][m]; v += __shfl_xor(v, 16); v += __shfl_xor(v, 32); w += __shfl_xor(w, 16); w += __shfl_xor(w, 32);
            if (fq == 0) P[(ai * HALF + wr * 64 + m * 16 + fr) * 4 + wc] = (f32x2){v, w}; }
    XBAR();
#pragma unroll
    for (int ai = 0; ai < 2; ++ai)
#pragma unroll
        for (int m = 0; m < 4; ++m) { const LAS f32x4* q = (const LAS f32x4*)(P + (ai * HALF + wr * 64 + m * 16 + fr) * 4); const f32x4 a = q[0], b = q[1];
            s[ai][m] = (a[0] + a[2]) + (b[0] + b[2]); t[ai][m] = (a[1] + a[3]) + (b[1] + b[3]); }
    XBAR();
}
__device__ __forceinline__ void row_allreduce_max(float (&s)[2][4], int wr, int wc, int fr, int fq, LAS unsigned char* xl) {
    LAS float* P = (LAS float*)xl;
#pragma unroll
    for (int ai = 0; ai < 2; ++ai)
#pragma unroll
        for (int m = 0; m < 4; ++m) { float v = s[ai][m]; v = fmaxf(v, __shfl_xor(v, 16)); v = fmaxf(v, __shfl_xor(v, 32)); if (fq == 0) P[(ai * HALF + wr * 64 + m * 16 + fr) * 4 + wc] = v; }
    XBAR();
#pragma unroll
    for (int ai = 0; ai < 2; ++ai)
#pragma unroll
        for (int m = 0; m < 4; ++m) { const f32x4 p = *(const LAS f32x4*)(P + (ai * HALF + wr * 64 + m * 16 + fr) * 4); s[ai][m] = fmaxf(fmaxf(p[0], p[1]), fmaxf(p[2], p[3])); }
    XBAR();
}

template <class Epi, class Sched, bool GATHER = false>
__device__ __forceinline__ void gemm_phase(LAS unsigned char* lds, LAS unsigned char* xl, int lda, int ldb, int K, const Sched& S, const Epi& E) {
    const int tid = opaque_tid(), wid = __builtin_amdgcn_readfirstlane(tid >> 6), lane = tid & 63, wr = wid >> 2, wc = wid & 3, fr = lane & 15, fq = lane >> 4;
    asm volatile("" : "+s"(K));
    const int nt = K / BK;
    int sR[2], sC[2];
    unsigned voffA[2], voffB[2];
#pragma unroll
    for (int i = 0; i < 2; ++i) { int R, C; stage_rc(tid * 16 + i * 8192, R, C); const int Rb = Epi::PERM ? ((R & ~31) + perm32(R & 31)) : R; sR[i] = R; sC[i] = C;
        voffA[i] = (unsigned)(R * lda + C) * 2u; voffB[i] = (unsigned)(Rb * ldb + C) * 2u; }
    const size_t kstep = (size_t)(BK * 2);
    const size_t hstepA = (size_t)HALF * lda * 2, hstepB = (size_t)HALF * ldb * 2;
    const unsigned ldsw = (unsigned)wid * 1024u;
    const int aoff = lds_byte(wr * 64 + fr, fq * 8), boff = lds_byte(wc * 32 + fr, fq * 8);
#define PG8_SA(b, h) (((b) * 2 + (h)) * HTB)
#define PG8_SB(b, h) ((4 + (b) * 2 + (h)) * HTB)
#define PG8_STAGE(bufoff, gbase, voff) do { _Pragma("unroll") for (int _i = 0; _i < 2; ++_i) \
        __builtin_amdgcn_global_load_lds((const unsigned*)((const char*)(gbase) + (voff)[_i]), (LAS unsigned*)(lds + (bufoff) + ldsw + _i * 8192), 16, 0, 0); } while (0)
#define PG8_LDA(dst, b, h) do { _Pragma("unroll") for (int m = 0; m < 4; ++m) _Pragma("unroll") for (int k = 0; k < 2; ++k) dst[m][k] = *(const LAS bf16x8*)(lds + PG8_SA(b, h) + aoff + m * 2048 + k * 1024); } while (0)
#define PG8_LDB(dst, b, h) do { _Pragma("unroll") for (int n = 0; n < 2; ++n) _Pragma("unroll") for (int k = 0; k < 2; ++k) dst[n][k] = *(const LAS bf16x8*)(lds + PG8_SB(b, h) + boff + n * 2048 + k * 1024); } while (0)
#define PG8_MMA(ai, bj, At, Bt) do { __builtin_amdgcn_s_setprio(1); _Pragma("unroll") for (int m = 0; m < 4; ++m) _Pragma("unroll") for (int n = 0; n < 2; ++n) _Pragma("unroll") for (int k = 0; k < 2; ++k) \
        acc[ai][bj][m][n] = __builtin_amdgcn_mfma_f32_16x16x32_bf16(Bt[n][k], At[m][k], acc[ai][bj][m][n], 0, 0, 0); __builtin_amdgcn_s_setprio(0); } while (0)
#define PG8_WAIT_V(n) asm volatile("s_waitcnt vmcnt(" #n ")" ::: "memory")
#define PG8_WAIT_L(n) asm volatile("s_waitcnt lgkmcnt(" #n ")" ::: "memory")
#define PG8_BAR __builtin_amdgcn_s_barrier()
#define PG8_SCHED __builtin_amdgcn_sched_barrier(0)
    LAS unsigned char* gl = xl + 8192 + tid * 16;
    int gA0 = 0, gA1 = 8192;
#define PG8_GATH(T, u) do { u32x4 _o; { int _r[4]; _Pragma("unroll") for (int _q = 0; _q < 4; ++_q) { const int _rl = (_q >> 1) * HALF + sR[_q & 1]; _r[_q] = (_rl < (u).nvalid) ? (u).rows[_rl] : 0; } \
        _Pragma("unroll") for (int _q = 0; _q < 4; ++_q) _o[_q] = (unsigned)(_r[_q] * lda + sC[_q & 1]) * 2u; } *(LAS u32x4*)(gl + (T)) = _o; } while (0)
#define PG8_STAGE_A(bufoff, base, h, kbytes, G4) do { if constexpr (GATHER) { const u32x2 _g = {(G4)[2 * (h)], (G4)[2 * (h) + 1]}; PG8_STAGE(bufoff, (base) + (kbytes), _g); } else { PG8_STAGE(bufoff, (base) + (size_t)(h) * hstepA + (kbytes), voffA); } } while (0)
    Unit cur, nxt; int ui = 0;
    cur.half = -1; nxt.half = -1;
    if (!S.next(0, cur)) return;
    f32x4 acc[2][2][4][2];
#pragma unroll
    for (int a = 0; a < 2; ++a)
#pragma unroll
        for (int b = 0; b < 2; ++b)
#pragma unroll
            for (int m = 0; m < 4; ++m)
#pragma unroll
                for (int n = 0; n < 2; ++n) acc[a][b][m][n] = (f32x4){0.f, 0.f, 0.f, 0.f};
    bf16x8 At[4][2], B0[2][2], B1[2][2];
    const char* cA = cur.a; const char* cB = cur.b;
    u32x4 gcur = {0u, 0u, 0u, 0u};
    if constexpr (GATHER) { PG8_GATH(gA0, cur); gcur = *(const LAS u32x4*)(gl + gA0); }
    PG8_STAGE(PG8_SB(0, 0), cB, voffB); PG8_STAGE(PG8_SB(0, 1), cB + hstepB, voffB); PG8_STAGE_A(PG8_SA(0, 0), cA, 0, 0, gcur); PG8_STAGE_A(PG8_SA(0, 1), cA, 1, 0, gcur);
    if (wr == 1) PG8_BAR;
    PG8_WAIT_V(2); PG8_BAR;
    PG8_STAGE(PG8_SB(1, 0), cB + kstep, voffB); PG8_STAGE_A(PG8_SA(1, 0), cA, 0, kstep, gcur); PG8_STAGE(PG8_SB(1, 1), cB + hstepB + kstep, voffB);
    PG8_WAIT_V(6); PG8_BAR;
    for (;;) {
        nxt.half = -1;
        const bool has_next = S.next(ui + 1, nxt);
        const int hm = __builtin_amdgcn_readfirstlane(cur.half);
        const char* nA = has_next ? nxt.a : cA; const char* nB = has_next ? nxt.b : cB;
        if constexpr (GATHER) { if (has_next) { PG8_GATH(gA1, nxt); } else { PG8_GATH(gA1, cur); } }
#pragma unroll 1
        for (int t = 0; t < nt; t += 2) {
            const bool last = (t == nt - 2);
            const size_t k1 = (size_t)(t + 1) * kstep;
            const char* a2 = last ? nA : cA; const char* b2 = last ? nB : cB + (size_t)(t + 2) * kstep;
            const size_t ka2 = last ? 0 : (size_t)(t + 2) * kstep;
            const char* b3 = b2 + kstep; const size_t ka3 = ka2 + kstep;
            u32x4 gq = gcur; if constexpr (GATHER) { if (last) gq = *(const LAS u32x4*)(gl + gA1); }
            PG8_LDB(B0, 0, 0); PG8_LDB(B1, 0, 1); PG8_SCHED; PG8_LDA(At, 0, 0); PG8_STAGE_A(PG8_SA(1, 1), cA, 1, k1, gcur);
            PG8_WAIT_V(8); PG8_WAIT_L(0); PG8_BAR; if (hm != 1) { PG8_MMA(0, 0, At, B0); PG8_MMA(0, 1, At, B1); } PG8_BAR; PG8_SCHED;
            PG8_LDA(At, 0, 1); PG8_STAGE(PG8_SB(0, 0), b2, voffB); PG8_STAGE(PG8_SB(0, 1), b2 + hstepB, voffB);
            PG8_STAGE_A(PG8_SA(0, 0), a2, 0, ka2, gq);
            PG8_WAIT_V(8); PG8_WAIT_L(0); PG8_BAR; if (hm != 0) { PG8_MMA(1, 0, At, B0); PG8_MMA(1, 1, At, B1); } PG8_BAR; PG8_SCHED;
            PG8_LDB(B0, 1, 0); PG8_LDB(B1, 1, 1); PG8_SCHED; PG8_LDA(At, 1, 0);
            PG8_STAGE_A(PG8_SA(0, 1), a2, 1, ka2, gq);
            PG8_WAIT_V(8); PG8_WAIT_L(0); PG8_BAR; if (hm != 1) { PG8_MMA(0, 0, At, B0); PG8_MMA(0, 1, At, B1); } PG8_BAR; PG8_SCHED;
            PG8_LDA(At, 1, 1); PG8_STAGE(PG8_SB(1, 0), b3, voffB); PG8_STAGE(PG8_SB(1, 1), b3 + hstepB, voffB);
            PG8_STAGE_A(PG8_SA(1, 0), a2, 0, ka3, gq);
            PG8_WAIT_V(8); PG8_WAIT_L(0); PG8_BAR; if (hm != 0) { PG8_MMA(1, 0, At, B0); PG8_MMA(1, 1, At, B1); } PG8_BAR; PG8_SCHED;
        }
        if (wr == 0) PG8_BAR;
        E(acc, cur, wr, wc, fr, fq, xl);
        if (!has_next) break;
#pragma unroll
        for (int a = 0; a < 2; ++a)
#pragma unroll
            for (int b = 0; b < 2; ++b)
#pragma unroll
                for (int m = 0; m < 4; ++m)
#pragma unroll
                    for (int n = 0; n < 2; ++n) acc[a][b][m][n] = (f32x4){0.f, 0.f, 0.f, 0.f};
        cur = nxt; cA = nA; cB = nB; ++ui;
        if constexpr (GATHER) { gcur = *(const LAS u32x4*)(gl + gA1); const int _t = gA0; gA0 = gA1; gA1 = _t; }
        if (wr == 1) PG8_BAR;
    }
    PG8_WAIT_V(0);
    PG8_BAR;
#undef PG8_SA
#undef PG8_SB
#undef PG8_STAGE
#undef PG8_STAGE_A
#undef PG8_GATH
#undef PG8_LDA
#undef PG8_LDB
#undef PG8_MMA
#undef PG8_WAIT_V
#undef PG8_WAIT_L
#undef PG8_BAR
#undef PG8_SCHED
}
}
namespace fx {
using pg8::Unit; using pg8::cvt_pk_bf16;
constexpr int HALF = 128;
__device__ __forceinline__ u32x4 pack8(const f32x4 a, const f32x4 b) { u32x4 w; w.x = cvt_pk_bf16(a[0], a[1]); w.y = cvt_pk_bf16(a[2], a[3]); w.z = cvt_pk_bf16(b[0], b[1]); w.w = cvt_pk_bf16(b[2], b[3]); return w; }
__device__ __forceinline__ u32x2 pack4(const f32x4 a) { u32x2 w; w.x = cvt_pk_bf16(a[0], a[1]); w.y = cvt_pk_bf16(a[2], a[3]); return w; }
__device__ __forceinline__ float sq4(const f32x4 a) { return (a[0] * a[0] + a[1] * a[1]) + (a[2] * a[2] + a[3] * a[3]); }
__device__ __forceinline__ float quad_sum(float v) { v += __shfl_xor(v, 16); v += __shfl_xor(v, 32); return v; }
__device__ __forceinline__ float gamma_log2(int h) { return __log2f(1.f - exp2f(-5.f - (float)h)); }
__device__ __forceinline__ void rope4(f32x4& a, f32x4& b, const f32x4 cs0, const f32x4 cs1) {
    const f32x4 c = {cs0[0], cs0[2], cs1[0], cs1[2]}, s = {cs0[1], cs0[3], cs1[1], cs1[3]};
    const f32x4 ra = a * c - b * s, rb = b * c + a * s; a = ra; b = rb;
}

__device__ __forceinline__ void sincos4(float ps, const f32x4 inv, f32x4& c, f32x4& s) {
#pragma unroll
    for (int j = 0; j < 4; ++j) { const float ang = ps * inv[j]; const float n = rintf(ang * 0.15915494309189535f); float r = fmaf(-n, 6.2831854820251465f, ang); r = fmaf(-n, -1.7484555e-7f, r);
        c[j] = __cosf(r); s[j] = __sinf(r); }
}
__device__ __forceinline__ f32x4 inv_freq4(int i0, float inv_half) { f32x4 v;
#pragma unroll
    for (int j = 0; j < 4; ++j) v[j] = exp2f(-(float)(i0 + j) * inv_half * 13.287712379549449f);
    return v; }
struct EpiInProj {
    static constexpr bool PERM = false;
    bf16_t *CQ, *CKV, *RQ, *RK, *RV, *RG; float *ssq_cq, *ssq_ckv, *ssq_kpe; const int* pos  ; const float* kg  ;
    __device__ __forceinline__ void operator()(f32x4 (&acc)[2][2][4][2], const Unit& u, int wr, int wc, int fr, int fq, LAS unsigned char*) const {
        asm volatile("" : "+v"(fr), "+v"(fq));
        const int row0 = u.pm * 256 + wr * 64 + fr, pn = u.pn;
        if (pn == 0) {
#pragma unroll
            for (int ai = 0; ai < 2; ++ai)
#pragma unroll
                for (int m = 0; m < 4; ++m) { const int row = row0 + ai * HALF + m * 16; float s = 0.f;
#pragma unroll
                    for (int bj = 0; bj < 2; ++bj) { s += sq4(acc[ai][bj][m][0]) + sq4(acc[ai][bj][m][1]);
                        *(u32x4*)(CQ + (size_t)row * 256 + bj * HALF + wc * 32 + 8 * fq) = pack8(acc[ai][bj][m][0], acc[ai][bj][m][1]); }
                    s = quad_sum(s); if (fq == 0) atomicAdd(ssq_cq + row, s); }
        } else if (pn == 1) {
            const int i0 = 16 * wc + 4 * fq;
            f32x4 g0 = {0.f, 0.f, 0.f, 0.f}, g1 = g0;
            if (wc < 2) { g0 = *(const f32x4*)(kg + 128 + i0); g1 = *(const f32x4*)(kg + 160 + i0); }
#pragma unroll
            for (int ai = 0; ai < 2; ++ai)
#pragma unroll
                for (int m = 0; m < 4; ++m) { const int row = row0 + ai * HALF + m * 16;
                    float s0 = sq4(acc[ai][0][m][0]) + sq4(acc[ai][0][m][1]), s1 = sq4(acc[ai][1][m][0]) + sq4(acc[ai][1][m][1]);
                    *(u32x4*)(CKV + (size_t)row * 256 + wc * 32 + 8 * fq) = pack8(acc[ai][0][m][0], acc[ai][0][m][1]);
                    s0 = quad_sum(s0); s1 = quad_sum(s1);
                    if (fq == 0) { atomicAdd(ssq_ckv + row, s0); if (wc < 2) atomicAdd(ssq_kpe + row, s1); }
                    if (wc < 2) {
                        f32x4 a = acc[ai][1][m][0] * g0, b = acc[ai][1][m][1] * g1;
                        f32x4 cc, ss; sincos4((float)pos[row], inv_freq4(i0, 1.f / 32.f), cc, ss);
                        const f32x4 ra = a * cc - b * ss, rb = b * cc + a * ss;
                        *(u32x2*)(CKV + (size_t)row * 256 + 128 + i0) = pack4(ra); *(u32x2*)(CKV + (size_t)row * 256 + 160 + i0) = pack4(rb);
                    } else {
                        *(u32x4*)(CKV + (size_t)row * 256 + 192 + (wc - 2) * 32 + 8 * fq) = (u32x4){0u, 0u, 0u, 0u};
                    }
                    asm volatile("" ::: "memory"); __builtin_amdgcn_sched_barrier(0); }
        } else if (pn < 6) {
            bf16_t* O = (pn < 4) ? RQ : RK; const float sc = (pn < 4) ? 1.f : 0.08838834764831845f;
            const int head = (pn & 1) * 2 + (wc >> 1), i0 = 8 * ((wc & 1) * 4 + fq);
            const float lgh = ((pn < 4) ? 1.f : -1.f) * gamma_log2(head);
            const f32x4 inv0 = inv_freq4(i0, 1.f / 64.f), inv1 = inv_freq4(i0 + 4, 1.f / 64.f);
#pragma unroll
            for (int ai = 0; ai < 2; ++ai)
#pragma unroll
                for (int m = 0; m < 4; ++m) { const int row = row0 + ai * HALF + m * 16; const float ps = (float)pos[row];
                    f32x4 c0, s0, c1, s1; sincos4(ps, inv0, c0, s0); sincos4(ps, inv1, c1, s1);
                    const float dc = sc * exp2f((float)(row & 127) * lgh);
                    const f32x4 a0 = acc[ai][0][m][0], a1 = acc[ai][0][m][1], b0 = acc[ai][1][m][0], b1 = acc[ai][1][m][1];
                    bf16_t* o = O + (size_t)row * 512 + head * 128 + i0;
                    *(u32x4*)(o) = pack8((a0 * c0 - b0 * s0) * dc, (a1 * c1 - b1 * s1) * dc);
                    *(u32x4*)(o + 64) = pack8((b0 * c0 + a0 * s0) * dc, (b1 * c1 + a1 * s1) * dc);
                    asm volatile("" ::: "memory"); __builtin_amdgcn_sched_barrier(0); }
        } else {
            bf16_t* O = (pn < 8) ? RV : RG;
#pragma unroll
            for (int ai = 0; ai < 2; ++ai)
#pragma unroll
                for (int m = 0; m < 4; ++m) { const int row = row0 + ai * HALF + m * 16;
#pragma unroll
                    for (int bj = 0; bj < 2; ++bj) *(u32x4*)(O + (size_t)row * 512 + (pn & 1) * 256 + bj * HALF + wc * 32 + 8 * fq) = pack8(acc[ai][bj][m][0], acc[ai][bj][m][1]); }
        }
    }
};
__device__ __forceinline__ int inproj_src(int n) {
    const int pn = n >> 8, p = n & 255;
    const int plain = (p & ~31) + pg8::perm32(p & 31);
    if (pn == 0) return plain;
    if (pn == 1) { if (p < 128) return 256 + plain; const int q = p - 128, wc = q >> 5; if (wc >= 2) return -1; return 384 + 32 * ((q >> 4) & 1) + 16 * wc + (q & 15); }
    if (pn < 6) { const int bj = p >> 7, q = p & 127, wc = q >> 5, nn = (q >> 4) & 1, fq = (q >> 2) & 3, j = q & 3; const int d = 64 * bj + 8 * ((wc & 1) * 4 + fq) + 4 * nn + j; return (pn < 4 ? 448 : 960) + ((pn & 1) * 2 + (wc >> 1)) * 128 + d; }
    return (pn < 8 ? 1472 : 1984) + (pn & 1) * 256 + plain;
}

struct EpiMlaQ {
    static constexpr bool PERM = false;
    bf16_t* QM; const float* ssq_cq; const float* qg; const int* pos;
    __device__ __forceinline__ void operator()(f32x4 (&acc)[2][2][4][2], const Unit& u, int wr, int wc, int fr, int fq, LAS unsigned char* xl) const {
        asm volatile("" : "+v"(fr), "+v"(fq));
        const int row0 = u.pm * 256 + wr * 64 + fr, h = u.pn;
        float s[2][4], rsr[2][4];
#pragma unroll
        for (int ai = 0; ai < 2; ++ai)
#pragma unroll
            for (int m = 0; m < 4; ++m) { const int row = row0 + ai * HALF + m * 16; rsr[ai][m] = rsqrtf(ssq_cq[row] * (1.f / 256.f) + EPS);
                s[ai][m] = (sq4(acc[ai][0][m][0]) + sq4(acc[ai][0][m][1]) + sq4(acc[ai][1][m][0]) + sq4(acc[ai][1][m][1])) * rsr[ai][m] * rsr[ai][m]; }
        pg8::row_allreduce_sum(s, wr, wc, fr, fq, xl);
        const int c0 = 32 * wc + 8 * fq, i0 = 16 * wc + 4 * fq;
        const f32x4 gA = *(const f32x4*)(qg + c0), gB = *(const f32x4*)(qg + c0 + 4);
        f32x4 g0 = {0.f, 0.f, 0.f, 0.f}, g1 = g0;
        if (wc < 2) { g0 = *(const f32x4*)(qg + 128 + i0); g1 = *(const f32x4*)(qg + 160 + i0); }
#pragma unroll
        for (int ai = 0; ai < 2; ++ai)
#pragma unroll
            for (int m = 0; m < 4; ++m) { const int row = row0 + ai * HALF + m * 16; const float rq = rsqrtf(s[ai][m] * (1.f / 192.f) + EPS) * rsr[ai][m];
                bf16_t* o = QM + (size_t)row * 768 + h * 192;
                *(u32x4*)(o + c0) = pack8(acc[ai][0][m][0] * rq * gA, acc[ai][0][m][1] * rq * gB);
                if (wc < 2) {
                    const f32x4 a = acc[ai][1][m][0] * rq * g0, b = acc[ai][1][m][1] * rq * g1;
                    f32x4 cc, ss; sincos4((float)pos[row], inv_freq4(i0, 1.f / 32.f), cc, ss);
                    *(u32x2*)(o + 128 + i0) = pack4(a * cc - b * ss); *(u32x2*)(o + 160 + i0) = pack4(b * cc + a * ss);
                }
                asm volatile("" ::: "memory"); __builtin_amdgcn_sched_barrier(0); }
    }
};
__device__ __forceinline__ int mlaq_src(int n) {
    const int h = n >> 8, p = n & 255;
    if (p < 128) return h * 192 + (p & ~31) + pg8::perm32(p & 31);
    const int q = p - 128, wc = q >> 5; if (wc >= 2) return -1;
    return h * 192 + 128 + 32 * ((q >> 4) & 1) + 16 * wc + (q & 15);
}
struct EpiMlaKV {
    static constexpr bool PERM = false;
    bf16_t *KM, *VLAT; const bf16_t* CKV; const float *ssq_ckv, *ssq_kpe, *kg, *gkv  ;
    __device__ __forceinline__ void operator()(f32x4 (&acc)[2][2][4][2], const Unit& u, int wr, int wc, int fr, int fq, LAS unsigned char* xl) const {
        asm volatile("" : "+v"(fr), "+v"(fq));
        const int row0 = u.pm * 256 + wr * 64 + fr;
        float s0[2][4], s1[2][4], rsr[2][4];
#pragma unroll
        for (int ai = 0; ai < 2; ++ai)
#pragma unroll
            for (int m = 0; m < 4; ++m) { const int row = row0 + ai * HALF + m * 16; rsr[ai][m] = rsqrtf(ssq_ckv[row] * (1.f / 128.f) + EPS);
                s0[ai][m] = (sq4(acc[ai][0][m][0]) + sq4(acc[ai][0][m][1])) * rsr[ai][m] * rsr[ai][m];
                s1[ai][m] = (sq4(acc[ai][1][m][0]) + sq4(acc[ai][1][m][1])) * rsr[ai][m] * rsr[ai][m]; }
        pg8::row_allreduce_sum2(s0, s1, wr, wc, fr, fq, xl);
        const int c0 = 32 * wc + 8 * fq, i0 = 16 * wc + 4 * fq;
#pragma unroll
        for (int ai = 0; ai < 2; ++ai)
#pragma unroll
            for (int m = 0; m < 4; ++m) { const int row = row0 + ai * HALF + m * 16; const float rr = rsr[ai][m], kpe2 = ssq_kpe[row];
                const f32x4 gA = *(const f32x4*)(kg + c0), gB = *(const f32x4*)(kg + c0 + 4);
                const u32x2 kp = *(const u32x2*)(CKV + (size_t)row * 256 + 128 + i0);
                const f32x4 kf = {__uint_as_float(kp.x << 16), __uint_as_float(kp.x & 0xffff0000u), __uint_as_float(kp.y << 16), __uint_as_float(kp.y & 0xffff0000u)};
#pragma unroll
                for (int bj = 0; bj < 2; ++bj) { const float rk = rsqrtf(((bj ? s1[ai][m] : s0[ai][m]) + kpe2) * (1.f / 192.f) + EPS);
                    bf16_t* ko = KM + (size_t)row * 768 + (2 * u.pn + bj) * 192;
                    *(u32x4*)(ko + c0) = pack8(acc[ai][bj][m][0] * (rr * rk) * gA, acc[ai][bj][m][1] * (rr * rk) * gB);
                    *(u32x2*)(ko + 128 + i0) = pack4(kf * rk); }
                if (u.pn == 0) {
                    const u32x4 cw = *(const u32x4*)(CKV + (size_t)row * 256 + c0);
                    const f32x4 ca = {__uint_as_float(cw.x << 16), __uint_as_float(cw.x & 0xffff0000u), __uint_as_float(cw.y << 16), __uint_as_float(cw.y & 0xffff0000u)};
                    const f32x4 cb = {__uint_as_float(cw.z << 16), __uint_as_float(cw.z & 0xffff0000u), __uint_as_float(cw.w << 16), __uint_as_float(cw.w & 0xffff0000u)};
                    const f32x4 vA = *(const f32x4*)(gkv + c0), vB = *(const f32x4*)(gkv + c0 + 4);
                    *(u32x4*)(VLAT + (size_t)row * 128 + c0) = pack8(ca * rr * vA, cb * rr * vB); }
                asm volatile("" ::: "memory"); __builtin_amdgcn_sched_barrier(0); }
    }
};
template <bool BASE_BF16, bool WRITE_LO>
struct EpiResid {
    static constexpr bool PERM = true;
    const float* base; bf16_t* xlo; bf16_t* xb; float* ssq;
    __device__ __forceinline__ void operator()(f32x4 (&acc)[2][2][4][2], const Unit& u, int wr, int wc, int fr, int fq, LAS unsigned char*) const {
        asm volatile("" : "+v"(fr), "+v"(fq));
        if (ssq == nullptr) { asm volatile("" :: "v"(acc[0][0][0][0]), "v"(acc[1][1][3][1])); return; }
        const int row0 = u.pm * 256 + wr * 64 + fr, col0 = u.pn * 256 + wc * 32 + 8 * fq;
#pragma unroll
        for (int ai = 0; ai < 2; ++ai)
#pragma unroll
            for (int m = 0; m < 4; ++m) { const int row = row0 + ai * HALF + m * 16; float s = 0.f;
#pragma unroll
                for (int bj = 0; bj < 2; ++bj) { const size_t off = (size_t)row * 1024 + col0 + bj * HALF;
                    f32x4 b0, b1;
                    if constexpr (BASE_BF16) { const u32x4 w = *(const u32x4*)(xb + off);
                        b0 = (f32x4){__uint_as_float(w.x << 16), __uint_as_float(w.x & 0xffff0000u), __uint_as_float(w.y << 16), __uint_as_float(w.y & 0xffff0000u)};
                        b1 = (f32x4){__uint_as_float(w.z << 16), __uint_as_float(w.z & 0xffff0000u), __uint_as_float(w.w << 16), __uint_as_float(w.w & 0xffff0000u)}; }
                    else { b0 = __builtin_nontemporal_load((const f32x4*)(base + off)); b1 = __builtin_nontemporal_load((const f32x4*)(base + off + 4)); }
                    const f32x4 o0 = b0 + acc[ai][bj][m][0], o1 = b1 + acc[ai][bj][m][1];
                    const u32x4 hw = pack8(o0, o1); *(u32x4*)(xb + off) = hw; s += sq4(o0) + sq4(o1);
                    if constexpr (WRITE_LO) {
                        const f32x4 h0 = {__uint_as_float(hw.x << 16), __uint_as_float(hw.x & 0xffff0000u), __uint_as_float(hw.y << 16), __uint_as_float(hw.y & 0xffff0000u)};
                        const f32x4 h1 = {__uint_as_float(hw.z << 16), __uint_as_float(hw.z & 0xffff0000u), __uint_as_float(hw.w << 16), __uint_as_float(hw.w & 0xffff0000u)};
                        *(u32x4*)(xlo + off) = pack8(o0 - h0, o1 - h1); } }
                s = quad_sum(s); if (fq == 0) atomicAdd(ssq + row, s); }
    }
};
struct EpiHeadNorm {
    static constexpr bool PERM = false;
    bf16_t* O; const float* ssq_in  ; const float* g  ; float inv_n_in;
    __device__ __forceinline__ void operator()(f32x4 (&acc)[2][2][4][2], const Unit& u, int wr, int wc, int fr, int fq, LAS unsigned char* xl) const {
        asm volatile("" : "+v"(fr), "+v"(fq));
        const int row0 = u.pm * 256 + wr * 64 + fr, h = u.pn;
        float s[2][4], rsr[2][4];
#pragma unroll
        for (int ai = 0; ai < 2; ++ai)
#pragma unroll
            for (int m = 0; m < 4; ++m) { const int row = row0 + ai * HALF + m * 16; rsr[ai][m] = ssq_in ? rsqrtf(ssq_in[row] * inv_n_in + EPS) : 1.f;
                s[ai][m] = (sq4(acc[ai][0][m][0]) + sq4(acc[ai][0][m][1]) + sq4(acc[ai][1][m][0]) + sq4(acc[ai][1][m][1])) * rsr[ai][m] * rsr[ai][m]; }
        pg8::row_allreduce_sum(s, wr, wc, fr, fq, xl);
        const int c0 = 32 * wc + 8 * fq;
        f32x4 gv[2][2];
#pragma unroll
        for (int bj = 0; bj < 2; ++bj) { gv[bj][0] = *(const f32x4*)(g + bj * HALF + c0); gv[bj][1] = *(const f32x4*)(g + bj * HALF + c0 + 4); }
#pragma unroll
        for (int ai = 0; ai < 2; ++ai)
#pragma unroll
            for (int m = 0; m < 4; ++m) { if (u.half >= 0 && u.half != ai) continue;
                const int row = row0 + ai * HALF + m * 16; const float rq = rsqrtf(s[ai][m] * (1.f / 256.f) + EPS) * rsr[ai][m];
#pragma unroll
                for (int bj = 0; bj < 2; ++bj) *(u32x4*)(O + (size_t)row * 1024 + h * 256 + bj * HALF + c0) = pack8(acc[ai][bj][m][0] * rq * gv[bj][0], acc[ai][bj][m][1] * rq * gv[bj][1]); }
    }
};
struct EpiStoreT {
    static constexpr bool PERM = true;
    bf16_t* O; int ldc; int tile_stride; float scale; int pad;
    __device__ __forceinline__ void operator()(f32x4 (&acc)[2][2][4][2], const Unit& u, int wr, int wc, int fr, int fq, LAS unsigned char*) const {
        asm volatile("" : "+v"(fr), "+v"(fq));
        const int row0 = u.pm * 256 + wr * 64 + fr;
#pragma unroll
        for (int ai = 0; ai < 2; ++ai)
#pragma unroll
            for (int m = 0; m < 4; ++m) { if (u.half >= 0 && u.half != ai) continue;
                const int row = row0 + ai * HALF + m * 16;
#pragma unroll
                for (int bj = 0; bj < 2; ++bj) *(u32x4*)(O + (size_t)u.pn * tile_stride + (size_t)row * ldc + u.seg * 256 + bj * HALF + wc * 32 + 8 * fq) = pack8(acc[ai][bj][m][0] * scale, acc[ai][bj][m][1] * scale); }
    }
};
struct EpiSoftmax {
    static constexpr bool PERM = true;
    bf16_t* PC;
    __device__ __forceinline__ void operator()(f32x4 (&acc)[2][2][4][2], const Unit& u, int wr, int wc, int fr, int fq, LAS unsigned char* xl) const {
        asm volatile("" : "+v"(fr), "+v"(fq));
        const int row0 = u.pm * 256 + wr * 64 + fr, h = u.pn;
        float mx[2][4], sm[2][4];
#pragma unroll
        for (int ai = 0; ai < 2; ++ai)
#pragma unroll
            for (int m = 0; m < 4; ++m) { float v = -3.0e38f;
#pragma unroll
                for (int bj = 0; bj < 2; ++bj)
#pragma unroll
                    for (int n = 0; n < 2; ++n) { const f32x4 a = acc[ai][bj][m][n]; v = fmaxf(v, fmaxf(fmaxf(a[0], a[1]), fmaxf(a[2], a[3]))); }
                mx[ai][m] = v; }
        pg8::row_allreduce_max(mx, wr, wc, fr, fq, xl);
        const float c2 = 0.0625f * 1.4426950408889634f;
#pragma unroll
        for (int ai = 0; ai < 2; ++ai)
#pragma unroll
            for (int m = 0; m < 4; ++m) { float t = 0.f; const float mm = mx[ai][m] * c2;
#pragma unroll
                for (int bj = 0; bj < 2; ++bj)
#pragma unroll
                    for (int n = 0; n < 2; ++n) { f32x4 a = acc[ai][bj][m][n] * c2 - mm;
                        a[0] = __builtin_amdgcn_exp2f(a[0]); a[1] = __builtin_amdgcn_exp2f(a[1]); a[2] = __builtin_amdgcn_exp2f(a[2]); a[3] = __builtin_amdgcn_exp2f(a[3]);
                        acc[ai][bj][m][n] = a; t += (a[0] + a[1]) + (a[2] + a[3]); }
                sm[ai][m] = t; }
        pg8::row_allreduce_sum(sm, wr, wc, fr, fq, xl);
#pragma unroll
        for (int ai = 0; ai < 2; ++ai)
#pragma unroll
            for (int m = 0; m < 4; ++m) { const int row = row0 + ai * HALF + m * 16; const float il = 1.f / sm[ai][m];
#pragma unroll
                for (int bj = 0; bj < 2; ++bj) *(u32x4*)(PC + (size_t)row * 1024 + h * 256 + bj * HALF + wc * 32 + 8 * fq) = pack8(acc[ai][bj][m][0] * il, acc[ai][bj][m][1] * il); }
    }
};
struct EpiStoreBf16 {
    static constexpr bool PERM = true;
    bf16_t* O; int ldc; int pad;
    __device__ __forceinline__ void operator()(f32x4 (&acc)[2][2][4][2], const Unit& u, int wr, int wc, int fr, int fq, LAS unsigned char*) const {
        asm volatile("" : "+v"(fr), "+v"(fq));
        const int row0 = u.pm * 256 + wr * 64 + fr;
#pragma unroll
        for (int ai = 0; ai < 2; ++ai)
#pragma unroll
            for (int m = 0; m < 4; ++m) { const int row = row0 + ai * HALF + m * 16;
#pragma unroll
                for (int bj = 0; bj < 2; ++bj) *(u32x4*)(O + (size_t)row * ldc + u.pn * 256 + bj * HALF + wc * 32 + 8 * fq) = pack8(acc[ai][bj][m][0], acc[ai][bj][m][1]); }
    }
};
struct HeadOrder {
    int G, c, nunits; const char* A; const char* B; size_t strideA, a_h, b_b, b_h;
    __device__ __forceinline__ bool next(int i, Unit& u) const {
        int L;
        if (G == 256) { const int xcd = c & 7, uu = (c >> 3) + 32 * i; if (uu >= 64) return false; L = xcd * 64 + uu; }
        else { const long LL = (long)i * G + c; if (LL >= nunits) return false; L = (int)LL; }
        u.pm = L >> 2; u.pn = L & 3; const int b = u.pm >> 4;
        u.a = A + (size_t)u.pm * strideA + (size_t)u.pn * a_h; u.b = B + (size_t)b * b_b + (size_t)u.pn * b_h; u.rows = nullptr; u.nvalid = 256; u.seg = 0; return true;
    }
};
constexpr int MOE_CAP = 32768;
struct MoeOrder {
    int G, c, seg_lo, seg_hi, ntn; const int* cnt; const int* lists; const char* A; const char* B; size_t a_tile  , b_exp  , b_tile  ;
    LAS int* tab;
    __device__ __forceinline__ void init(LAS unsigned char* xl) {
        tab = (LAS int*)(xl + 4096);
        if (threadIdx.x < 64) { const int n = __hip_atomic_load(cnt + threadIdx.x, __ATOMIC_RELAXED, __HIP_MEMORY_SCOPE_AGENT); int t = (n + 255) >> 8, incl = t;
#pragma unroll
            for (int o = 1; o < 64; o <<= 1) { const int v = __shfl_up(incl, o); if ((int)threadIdx.x >= o) incl += v; }
            tab[threadIdx.x + 1] = incl; tab[65 + threadIdx.x] = n; if (threadIdx.x == 0) tab[0] = 0; }
        asm volatile("s_waitcnt lgkmcnt(0)" ::: "memory"); __syncthreads();
    }
    __device__ __forceinline__ bool next(int i, Unit& u) const {
        const int gbase = tab[seg_lo], ntl = tab[seg_hi] - gbase;
        int rt, pn, half = -1;
        if ((G & 7) == 0) { const int per = (ntl + 7) >> 3, xcd = c & 7, cux = G >> 3, k = c >> 3;
            int mine = ntl - xcd * per; mine = mine < 0 ? 0 : (mine > per ? per : mine);
            const int nu = mine * ntn, full = nu / cux, rem = nu - full * cux;
            int uu;
            if (i < full) uu = k + cux * i;
            else if (i == full && rem > 0) { if (2 * rem <= cux) { if (k >= 2 * rem) return false; uu = full * cux + (k >> 1); half = k & 1; }
                                             else { if (k >= rem) return false; uu = full * cux + k; } }
            else return false;
            rt = xcd * per + uu / ntn; pn = uu % ntn; }
        else { const long L = (long)i * G + c; rt = (int)(L / ntn); pn = (int)(L % ntn); }
        if (rt >= ntl) return false;
        const int rtg = gbase + rt;
        const int lane = threadIdx.x & 63;
        const int sgm = __builtin_popcountll(__ballot(rtg >= tab[lane + 1]));
        const int j = rtg - tab[sgm], n = tab[65 + sgm];
        u.pm = rtg; u.pn = pn; u.seg = sgm; u.half = half; u.nvalid = (n - j * 256) < 256 ? (n - j * 256) : 256; u.rows = lists + (size_t)sgm * MOE_CAP + j * 256;
        u.a = A + (size_t)u.pm * a_tile; u.b = B + (size_t)(sgm & 31) * b_exp + (size_t)pn * b_tile; return true;
    }
};
struct EpiGlu {
    static constexpr bool PERM = false;
    bf16_t* H; const float* rsr  ; const float* roww  ; const int* lists0;
    __device__ __forceinline__ void operator()(f32x4 (&acc)[2][2][4][2], const Unit& u, int wr, int wc, int fr, int fq, LAS unsigned char*) const {
        asm volatile("" : "+v"(fr), "+v"(fq));
        if (H == nullptr) { asm volatile("" :: "v"(acc[0][0][0][0]), "v"(acc[1][1][3][1])); return; }
#pragma unroll
        for (int ai = 0; ai < 2; ++ai)
#pragma unroll
            for (int m = 0; m < 4; ++m) { if (u.half >= 0 && u.half != ai) continue;
                const int rl = ai * HALF + wr * 64 + m * 16 + fr; const bool valid = rl < u.nvalid;
                const long slot = (u.rows + rl) - lists0;
                const float wgt = valid ? roww[slot] : 0.f;
                const float rs = valid ? rsr[slot] : 0.f;
                f32x4 hv[2];
#pragma unroll
                for (int n = 0; n < 2; ++n) { const f32x4 a = acc[ai][0][m][n] * rs, uu = acc[ai][1][m][n] * rs; f32x4 r;
#pragma unroll
                    for (int j = 0; j < 4; ++j) r[j] = a[j] * __builtin_amdgcn_rcpf(1.f + __expf(-a[j])) * uu[j] * wgt;
                    hv[n] = r; }
                *(u32x4*)(H + ((size_t)u.pm * 256 + rl) * 256 + u.pn * 128 + wc * 32 + 8 * fq) = pack8(hv[0], hv[1]); }
    }
};
template <int SLOT>
struct EpiScatter {
    static constexpr bool PERM = true;
    float* out; bf16_t* xb;
    __device__ __forceinline__ void operator()(f32x4 (&acc)[2][2][4][2], const Unit& u, int wr, int wc, int fr, int fq, LAS unsigned char*) const {
        asm volatile("" : "+v"(fr), "+v"(fq));
        const int col0 = u.pn * 256 + wc * 32 + 8 * fq;
#pragma unroll
        for (int ai = 0; ai < 2; ++ai)
#pragma unroll
            for (int m = 0; m < 4; ++m) { const int rl = ai * HALF + wr * 64 + m * 16 + fr;
                if (rl < u.nvalid && (u.half < 0 || u.half == ai)) { const int tok = u.rows[rl]; const size_t o = (size_t)tok * 1024 + col0;
#pragma unroll
                    for (int bj = 0; bj < 2; ++bj) { const size_t oo = o + bj * HALF;
                        const u32x4 w = *(const u32x4*)(xb + oo);
                        const f32x4 o0 = (f32x4){__uint_as_float(w.x << 16), __uint_as_float(w.x & 0xffff0000u), __uint_as_float(w.y << 16), __uint_as_float(w.y & 0xffff0000u)} + acc[ai][bj][m][0];
                        const f32x4 o1 = (f32x4){__uint_as_float(w.z << 16), __uint_as_float(w.z & 0xffff0000u), __uint_as_float(w.w << 16), __uint_as_float(w.w & 0xffff0000u)} + acc[ai][bj][m][1];
                        if constexpr (SLOT == 0) { *(u32x4*)(xb + oo) = pack8(o0, o1); }
                        else { f32x4* q = (f32x4*)(out + oo); q[0] = o0; q[1] = o1; } } } }
    }
};

struct MemKVOrder {
    int G, c; const char* MB; const char* W;
    __device__ __forceinline__ bool next(int i, Unit& u) const {
        long L = (long)i * G + c;
        if (G >= 128) { if (L >= 128) return false; u.half = (int)(L & 1); L >>= 1; }
        else if (L >= 64) return false;
        const int r = (int)L & 31; u.rows = nullptr; u.nvalid = 256;
        if (L < 32) { u.seg = 0; u.pm = r >> 2; u.pn = r & 3; u.a = MB + (size_t)u.pm * 256 * 2048; u.b = W + (size_t)u.pn * 256 * 2048; }
        else { u.seg = 1; u.pm = r >> 2; u.pn = r & 3; u.a = MB + (size_t)u.pm * 256 * 2048; u.b = W + (size_t)(1024 + u.pn * 256) * 2048; }
        return true;
    }
};
struct EpiMemKV {
    static constexpr bool PERM = false;
    bf16_t* KC; bf16_t* VC; const float* g;
    __device__ __forceinline__ void operator()(f32x4 (&acc)[2][2][4][2], const Unit& u, int wr, int wc, int fr, int fq, LAS unsigned char* xl) const {
        if (u.seg == 0) { EpiHeadNorm e{KC, nullptr, g, 0.f}; e(acc, u, wr, wc, fr, fq, xl); return; }
        asm volatile("" : "+v"(fr), "+v"(fq));
        const int row0 = u.pm * 256 + wr * 64 + fr;
#pragma unroll
        for (int ai = 0; ai < 2; ++ai)
#pragma unroll
            for (int m = 0; m < 4; ++m) { if (u.half >= 0 && u.half != ai) continue;
                const int row = row0 + ai * HALF + m * 16;
#pragma unroll
                for (int bj = 0; bj < 2; ++bj)
#pragma unroll
                    for (int n = 0; n < 2; ++n) *(u32x2*)(VC + (size_t)row * 1024 + u.pn * 256 + bj * HALF + wc * 32 + n * 16 + 4 * fq) = pack4(acc[ai][bj][m][n]); }
    }
};
struct VwOrder {
    int G, c; const char* WO; const char* VC;
    __device__ __forceinline__ bool next(int i, Unit& u) const {
        long L = (long)i * G + c;
        if (G >= 256) { if (L >= 256) return false; u.half = (int)(L & 1); L >>= 1; } else if (L >= 128) return false;
        u.seg = (int)L & 3; u.pn = ((int)L >> 2) & 7; u.pm = (int)L >> 5; u.rows = nullptr; u.nvalid = 256;
        u.a = WO + (size_t)u.pm * 256 * 2048 + (size_t)u.seg * 512; u.b = VC + (size_t)u.pn * 256 * 2048 + (size_t)u.seg * 512; return true;
    }
};
struct QupOrder {
    pg8::GridOrder g;
    __device__ __forceinline__ bool next(int i, Unit& u) const {
        if (g.G != 256) return g.next(i, u);
        if (g.c < 128) return i < 3 ? g.at(128 + g.c * 3 + i, u) : false;
        return i < 1 ? g.at(g.c - 128, u) : false;
    }
};
struct CrossOOrder {
    pg8::GridOrder g; const char* VWT;
    __device__ __forceinline__ bool next(int i, Unit& u) const {
        if (!g.next(i, u)) return false;
        u.b = VWT + (size_t)(u.pm >> 4) * ((size_t)1024 * 2048) + (size_t)u.pn * 256 * 2048; return true;
    }
};
}
namespace at {
typedef float f32x16 __attribute__((ext_vector_type(16)));
typedef short s16x4 __attribute__((ext_vector_type(4)));
constexpr int NW = 8, QBLK = 32, KVBLK = 64, QB = 256;
constexpr int KROW = 400;
constexpr int SHM_V = KVBLK * 128 * 2, SHM_K = KVBLK * KROW;
constexpr int LDS_V = 0, LDS_K = 2 * SHM_V, LDS_WS = LDS_K + 2 * SHM_K, LDS_BYTES = LDS_WS + NW * 64 * 4;
constexpr float SCALE = 0.07216878364870322f;
constexpr float THR = 8.f;
#define SBAR() __builtin_amdgcn_sched_barrier(0)
__device__ __forceinline__ int v_st(int k, int c) { const int kk = (k & ~0xC) | ((k & 4) << 1) | ((k & 8) >> 1); return ((kk >> 3) * 4 + (c >> 5)) * 512 + ((kk & 7) * 32 + (c & 31)) * 2; }
__device__ __forceinline__ int v_rd_base(int lane) { return ((lane & 3) << 3) | (((lane >> 2) & 3) << 6) | (((lane >> 4) & 1) << 5) | (((lane >> 5) & 1) << 8); }
constexpr int v_rd_off(int d0, int ks, int half) { return d0 * 512 + ks * 4096 + half * 2048; }
__device__ __forceinline__ int crow(int r, int hi) { return (r & 3) + 8 * (r >> 2) + 4 * hi; }
__device__ __forceinline__ unsigned cvtpk(float lo, float hi) { unsigned r; asm volatile("v_cvt_pk_bf16_f32 %0, %1, %2" : "=v"(r) : "v"(lo), "v"(hi)); return r; }
__device__ __forceinline__ void mask_tile(f32x16& p0, f32x16& p1, int dq) {
    const float NEG = -__builtin_inff();
#pragma unroll
    for (int r = 0; r < 16; ++r) {
        const int c = (r & 3) + 8 * (r >> 2);
        if (dq - c < 0) p0[r] = NEG;
        if (dq - c - 32 < 0) p1[r] = NEG;
    }
}
__device__ __forceinline__ void partialSM(f32x16& p0, f32x16& p1, float& m_reg, float& mn, float& alpha) {
    float pmax = p0[0];
#pragma unroll
    for (int r = 1; r < 16; ++r) pmax = fmaxf(pmax, p0[r]);
#pragma unroll
    for (int r = 0; r < 16; ++r) pmax = fmaxf(pmax, p1[r]);
    { auto rr = __builtin_amdgcn_permlane32_swap(__float_as_uint(pmax), __float_as_uint(pmax), false, false);
      pmax = fmaxf(__uint_as_float(rr[0]), __uint_as_float(rr[1])); }
    constexpr float C2 = 1.4426950408889634f * SCALE;
    if (__builtin_expect(__all((pmax - m_reg) * SCALE <= THR), 1)) { mn = m_reg; alpha = 1.f; }
    else { mn = fmaxf(m_reg, pmax); alpha = __builtin_amdgcn_exp2f((m_reg - mn) * C2); m_reg = mn; }
    const float mnL = -mn * C2;
#pragma unroll
    for (int r = 0; r < 16; ++r) p0[r] = fmaf(p0[r], C2, mnL);
#pragma unroll
    for (int r = 0; r < 16; ++r) p1[r] = fmaf(p1[r], C2, mnL);
#pragma unroll
    for (int r = 0; r < 16; ++r) p0[r] = __builtin_amdgcn_exp2f(p0[r]);
}
__device__ __forceinline__ void finishSM(f32x16& p0, f32x16& p1, float alpha, float& l_reg, bf16x8& pa0, bf16x8& pa1, bf16x8& pa2, bf16x8& pa3) {
#pragma unroll
    for (int r = 0; r < 16; ++r) p1[r] = __builtin_amdgcn_exp2f(p1[r]);
    float ps = 0;
#pragma unroll
    for (int r = 0; r < 16; ++r) ps += p0[r];
#pragma unroll
    for (int r = 0; r < 16; ++r) ps += p1[r];
    { auto rr = __builtin_amdgcn_permlane32_swap(__float_as_uint(ps), __float_as_uint(ps), false, false);
      ps = __uint_as_float(rr[0]) + __uint_as_float(rr[1]); }
    l_reg = l_reg * alpha + ps;
#define PK4(P, B_, OUT) do { unsigned a0 = cvtpk(P[B_+0], P[B_+1]), a1 = cvtpk(P[B_+2], P[B_+3]);                          \
        unsigned b0 = cvtpk(P[B_+4], P[B_+5]), b1 = cvtpk(P[B_+6], P[B_+7]);                                             \
        auto r0 = __builtin_amdgcn_permlane32_swap(a0, b0, false, false); auto r1 = __builtin_amdgcn_permlane32_swap(a1, b1, false, false); \
        u32x4 w = {r0[0], r1[0], r0[1], r1[1]}; OUT = *reinterpret_cast<bf16x8*>(&w); } while (0)
    PK4(p0, 0, pa0); PK4(p0, 8, pa1); PK4(p1, 0, pa2); PK4(p1, 8, pa3);
#undef PK4
}
template <int KB>
__device__ __forceinline__ void qkt(f32x16& p0, f32x16& p1, const char* K_lds, int r32, int hi, const bf16x8* qr) {
    p0 = f32x16{}; p1 = f32x16{};
    const char* kb = K_lds + KB * SHM_K + r32 * KROW + hi * 16;
#pragma unroll
    for (int d0 = 0; d0 < 12; ++d0) {
        const bf16x8 b0 = *reinterpret_cast<const bf16x8*>(kb + d0 * 32);
        const bf16x8 b1 = *reinterpret_cast<const bf16x8*>(kb + 32 * KROW + d0 * 32);
        p0 = __builtin_amdgcn_mfma_f32_32x32x16_bf16(b0, qr[d0], p0, 0, 0, 0);
        p1 = __builtin_amdgcn_mfma_f32_32x32x16_bf16(b1, qr[d0], p1, 0, 0, 0);
    }
}
template <int VB>
__device__ __forceinline__ void pv_tile(f32x16* o, int vb0, bf16x8 pa0, bf16x8 pa1, bf16x8 pa2, bf16x8 pa3) {
#define TRRD(dst, off) asm volatile("ds_read_b64_tr_b16 %0, %1 offset:%2" : "=&v"(dst) : "v"(vb0), "i"(off) : "memory")
#define PV_RD(S, d0) do { constexpr int b_ = VB * SHM_V + v_rd_off(d0, 0, 0);   \
        TRRD(S##l0, b_); TRRD(S##h0, b_ + 2048); TRRD(S##l1, b_ + 4096); TRRD(S##h1, b_ + 6144); TRRD(S##l2, b_ + 8192); TRRD(S##h2, b_ + 10240); TRRD(S##l3, b_ + 12288); TRRD(S##h3, b_ + 14336); } while (0)
#define PV_MM(S, d0) do {   \
        o[d0] = __builtin_amdgcn_mfma_f32_32x32x16_bf16(pa0, (bf16x8){S##l0[0], S##l0[1], S##l0[2], S##l0[3], S##h0[0], S##h0[1], S##h0[2], S##h0[3]}, o[d0], 0, 0, 0);   \
        o[d0] = __builtin_amdgcn_mfma_f32_32x32x16_bf16(pa1, (bf16x8){S##l1[0], S##l1[1], S##l1[2], S##l1[3], S##h1[0], S##h1[1], S##h1[2], S##h1[3]}, o[d0], 0, 0, 0);   \
        o[d0] = __builtin_amdgcn_mfma_f32_32x32x16_bf16(pa2, (bf16x8){S##l2[0], S##l2[1], S##l2[2], S##l2[3], S##h2[0], S##h2[1], S##h2[2], S##h2[3]}, o[d0], 0, 0, 0);   \
        o[d0] = __builtin_amdgcn_mfma_f32_32x32x16_bf16(pa3, (bf16x8){S##l3[0], S##l3[1], S##l3[2], S##l3[3], S##h3[0], S##h3[1], S##h3[2], S##h3[3]}, o[d0], 0, 0, 0); } while (0)
#define PV_W(n) do { asm volatile("s_waitcnt lgkmcnt(" #n ")" ::: "memory"); SBAR(); } while (0)
    s16x4 xl0, xl1, xl2, xl3, xh0, xh1, xh2, xh3, yl0, yl1, yl2, yl3, yh0, yh1, yh2, yh3;
    asm volatile("s_waitcnt lgkmcnt(0)" ::: "memory");
    PV_RD(x, 0); PV_RD(y, 1); PV_W(8); PV_MM(x, 0); SBAR();
    PV_RD(x, 2); PV_W(8); PV_MM(y, 1); SBAR();
    PV_RD(y, 3); PV_W(8); PV_MM(x, 2); SBAR();
    PV_W(0); PV_MM(y, 3);
#undef PV_RD
#undef PV_MM
#undef PV_W
#undef TRRD
}

__device__ __forceinline__ void attn_block(const bf16_t* Q, const bf16_t* K, const bf16_t* V, bf16_t* O, size_t tb, int h, int P0, char* lds) {
    const int tid = opaque_tid(), wid = __builtin_amdgcn_readfirstlane(tid >> 6), lane = tid & 63, r32 = lane & 31, hi = lane >> 5;
    const int NT = (P0 + QB) / KVBLK;
    const int qlo = P0 + wid * QBLK, qm = qlo + r32 - 4 * hi;
    char* V_lds = lds + LDS_V; char* K_lds = lds + LDS_K;
    float* ws = (float*)(lds + LDS_WS) + wid * 64; float* li_l = ws, * al_l = ws + 32;
    float m_reg = -1e30f, l_reg = 0; f32x16 o[4] = {};
    const bf16_t* Kh = K + tb * 768 + h * 192; const bf16_t* Vh = V + tb * 128;
    const int sr = tid >> 4, sc = (tid & 15) * 8, vst0 = v_st(sr, sc), vst1 = v_st(32 + sr, sc);
    const int kgo = (tid >> 3) * 768 + (tid & 7) * 8, klo = (tid >> 3) * KROW + (tid & 7) * 16;
    const int vb0 = (int)(uintptr_t)V_lds + v_rd_base(lane);
    bf16x8 st_k0, st_k1, st_k2, st_v0, st_v1;
#define VMW() asm volatile("s_waitcnt vmcnt(0)" ::: "memory")
#define SLOAD(k0) do { const bf16_t* kp_ = Kh + (size_t)(k0) * 768 + kgo; st_k0 = *(const bf16x8*)(kp_); st_k1 = *(const bf16x8*)(kp_ + 64); st_k2 = *(const bf16x8*)(kp_ + 128); \
        st_v0 = *(const bf16x8*)(Vh + (size_t)((k0) + sr) * 128 + sc); st_v1 = *(const bf16x8*)(Vh + (size_t)((k0) + 32 + sr) * 128 + sc); } while (0)
#define SWRITE(bf) do { char* kw_ = K_lds + (bf) * SHM_K + klo; *(bf16x8*)(kw_) = st_k0; *(bf16x8*)(kw_ + 128) = st_k1; *(bf16x8*)(kw_ + 256) = st_k2; \
        *(bf16x8*)(V_lds + (bf) * SHM_V + vst0) = st_v0; *(bf16x8*)(V_lds + (bf) * SHM_V + vst1) = st_v1; } while (0)
#define RESC(a) do { if (__any((a) < 1.f)) { if (hi == 0) al_l[r32] = (a); asm volatile("s_waitcnt lgkmcnt(0)" ::: "memory");              \
                     for (int d_ = 0; d_ < 4; ++d_) for (int r = 0; r < 16; ++r) o[d_][r] *= al_l[crow(r, hi)]; } } while (0)
#define KBASE(t) ((t) * KVBLK)
#define MASKT(P0_, P1_, t) do { const int kb_ = KBASE(t); if (kb_ + KVBLK - 1 > qlo) mask_tile(P0_, P1_, qm - kb_); } while (0)
    bf16x8 qr[12];
    { const bf16_t* Qw = Q + (tb + qlo + r32) * 768 + h * 192 + hi * 8;
#pragma unroll
      for (int d0 = 0; d0 < 12; ++d0) qr[d0] = *(const bf16x8*)(Qw + d0 * 16); }
    SLOAD(0); VMW(); SWRITE(0);
    __syncthreads();
    f32x16 p0, p1; float mn, al; bf16x8 pa0, pa1, pa2, pa3;
#define TILE_STEP(t, BUF) do {                                                                   \
        if ((t) + 1 < NT) { SLOAD(KBASE((t) + 1)); }                                              \
        SBAR(); qkt<BUF>(p0, p1, K_lds, r32, hi, qr);                                             \
        MASKT(p0, p1, (t)); partialSM(p0, p1, m_reg, mn, al); RESC(al);                           \
        finishSM(p0, p1, al, l_reg, pa0, pa1, pa2, pa3); SBAR();                                  \
        pv_tile<BUF>(o, vb0, pa0, pa1, pa2, pa3);                                                 \
        if ((t) + 1 < NT) { VMW(); SWRITE(1 - BUF); }                                             \
        __syncthreads(); } while (0)
    for (int t = 0; t < NT; t += 2) { TILE_STEP(t, 0); TILE_STEP(t + 1, 1); }
    if (hi == 0) li_l[r32] = l_reg; asm volatile("s_waitcnt lgkmcnt(0)" ::: "memory");
    float rli[16];
#pragma unroll
    for (int r = 0; r < 16; ++r) rli[r] = __builtin_amdgcn_rcpf(li_l[crow(r, hi)]);
    bf16_t* Ow = O + (tb + qlo) * 1024 + h * 128;
#pragma unroll
    for (int r = 0; r < 16; ++r) { const int orow = crow(r, hi);
#pragma unroll
        for (int d0 = 0; d0 < 4; ++d0) { const float v = o[d0][r] * rli[r];
            const float vn = __shfl_xor(v, 1);
            if ((r32 & 1) == 0) *(unsigned*)(Ow + (size_t)orow * 1024 + d0 * 32 + r32) = cvtpk(v, vn); } }
#undef VMW
#undef SLOAD
#undef SWRITE
#undef RESC
#undef KBASE
#undef MASKT
#undef TILE_STEP
}

#undef SBAR

__device__ __forceinline__ void attn_phase(const bf16_t* Q, const bf16_t* K, const bf16_t* V, bf16_t* O, char* lds) {
    for (int L = blockIdx.x; L < 256; L += gridDim.x) {
        const int xcd = L & 7, k = L >> 3, bh = (k >> 3) * 8 + xcd, x = k & 7;
        const int b = bh >> 2, h = bh & 3; const size_t tb = (size_t)b * 4096;
        attn_block(Q, K, V, O, tb, h, (15 - x) * QB, lds);
        attn_block(Q, K, V, O, tb, h, x * QB, lds);
    }
}
}
namespace rt {
using at::f32x16; using at::s16x4; using at::v_st; using at::v_rd_base; using at::v_rd_off; using at::crow; using at::cvtpk;
constexpr int PITCH = 272;
constexpr int L_Q = 0, L_K = 128 * PITCH, L_V = 2 * 128 * PITCH, L_S = L_V + 32768, L_END = L_S + 128 * PITCH;
#define TRRD(dst, base, off) asm volatile("ds_read_b64_tr_b16 %0, %1 offset:%2" : "=&v"(dst) : "v"(base), "i"(off) : "memory")
#define FRAG(l, h) ((bf16x8){l[0], l[1], l[2], l[3], h[0], h[1], h[2], h[3]})
using fx::gamma_log2;

__device__ __forceinline__ void ret_kv_unit(const bf16_t* RK, const bf16_t* RV, bf16_t* KVS, int bh, int c, char* lds) {
    const int tid = opaque_tid(), wid = __builtin_amdgcn_readfirstlane(tid >> 6), lane = tid & 63, r32 = lane & 31, hi = lane >> 5;
    const int b = bh >> 2, h = bh & 3; const size_t t0 = (size_t)b * 4096 + (size_t)c * 128;
    char* Kl = lds; char* Vl = lds + 32768;
#pragma unroll
    for (int i = 0; i < 4; ++i) { const int q = tid + 512 * i, row = q >> 4, cc = (q & 15) * 8; const int lo = (row >> 6) * 16384 + v_st(row & 63, cc);
        *(bf16x8*)(Kl + lo) = *(const bf16x8*)(RK + (t0 + row) * 512 + h * 128 + cc);
        *(bf16x8*)(Vl + lo) = *(const bf16x8*)(RV + (t0 + row) * 512 + h * 128 + cc); }
    __syncthreads();
    const int dvb = wid >> 1, dkb = 2 * (wid & 1);
    const int vbase = (int)(uintptr_t)Vl + v_rd_base(lane) + dvb * 512, kbase = (int)(uintptr_t)Kl + v_rd_base(lane) + dkb * 512;
    f32x16 acc0 = {}, acc1 = {};
#define KVSTEP(sub, ks) do { s16x4 al, ah, b0l, b0h, b1l, b1h; constexpr int o_ = (sub) * 16384 + v_rd_off(0, ks, 0);   \
        TRRD(al, vbase, o_); TRRD(ah, vbase, o_ + 2048); TRRD(b0l, kbase, o_); TRRD(b0h, kbase, o_ + 2048); TRRD(b1l, kbase, o_ + 512); TRRD(b1h, kbase, o_ + 512 + 2048); \
        asm volatile("s_waitcnt lgkmcnt(0)" ::: "memory"); __builtin_amdgcn_sched_barrier(0);   \
        acc0 = __builtin_amdgcn_mfma_f32_32x32x16_bf16(FRAG(al, ah), FRAG(b0l, b0h), acc0, 0, 0, 0);   \
        acc1 = __builtin_amdgcn_mfma_f32_32x32x16_bf16(FRAG(al, ah), FRAG(b1l, b1h), acc1, 0, 0, 0); } while (0)
    KVSTEP(0, 0); KVSTEP(0, 1); KVSTEP(0, 2); KVSTEP(0, 3); KVSTEP(1, 0); KVSTEP(1, 1); KVSTEP(1, 2); KVSTEP(1, 3);
#undef KVSTEP
    const float sc = exp2f(127.f * gamma_log2(h));
    bf16_t* O = KVS + ((size_t)(bh * 32 + c) * 128 + dvb * 32) * 128 + dkb * 32;
#pragma unroll
    for (int r = 0; r < 16; ++r) { const int dv = crow(r, hi);
        const float v0 = acc0[r] * sc, v1 = acc1[r] * sc; const float n0 = __shfl_xor(v0, 1), n1 = __shfl_xor(v1, 1);
        if ((r32 & 1) == 0) { *(unsigned*)(O + (size_t)dv * 128 + r32) = cvtpk(v0, n0); *(unsigned*)(O + (size_t)dv * 128 + 32 + r32) = cvtpk(v1, n1); } }
    __syncthreads();
}
__device__ __forceinline__ void ret_kv_phase(const bf16_t* RK, const bf16_t* RV, bf16_t* KVS, char* lds) {
    for (int u = blockIdx.x; u < 1024; u += gridDim.x) ret_kv_unit(RK, RV, KVS, u >> 5, u & 31, lds);
}

struct RetStage { u32x4 q[4], k[4], v[4], s[4]; };
__device__ __forceinline__ void ret_out_load(const bf16_t* RQ, const bf16_t* RK, const bf16_t* RV, const bf16_t* STS, int bh, int c, RetStage& st) {
    const int tid = threadIdx.x; const int b = bh >> 2, h = bh & 3; const size_t t0 = (size_t)b * 4096 + (size_t)c * 128;
    const bf16_t* src = STS + (size_t)(bh * 32 + c) * 16384 + tid * 8;
#pragma unroll
    for (int i = 0; i < 4; ++i) { const int q = tid + 512 * i, row = q >> 4, cc = (q & 15) * 8; const size_t g = (t0 + row) * 512 + h * 128 + cc;
        st.q[i] = *(const u32x4*)(RQ + g); st.k[i] = *(const u32x4*)(RK + g); st.v[i] = *(const u32x4*)(RV + g); st.s[i] = *(const u32x4*)(src + 4096 * i); }
}
__device__ __forceinline__ void ret_out_unit(const bf16_t* RQ, const bf16_t* RK, const bf16_t* RV, const bf16_t* RG, const bf16_t* STS, const float* gn_g, bf16_t* AO, int bh, int c, RetStage& st, bool has_next, int nbh, int nc, char* lds) {
    const int tid = opaque_tid(), wid = __builtin_amdgcn_readfirstlane(tid >> 6), lane = tid & 63, r32 = lane & 31, hi = lane >> 5;
    const int b = bh >> 2, h = bh & 3; const size_t t0 = (size_t)b * 4096 + (size_t)c * 128;
    const float lg = gamma_log2(h);
#pragma unroll
    for (int i = 0; i < 4; ++i) { const int q = tid + 512 * i, row = q >> 4, cc = (q & 15) * 8;
        *(u32x4*)(lds + L_Q + row * PITCH + cc * 2) = st.q[i];
        *(u32x4*)(lds + L_K + row * PITCH + cc * 2) = st.k[i];
        *(u32x4*)(lds + L_V + (row >> 6) * 16384 + v_st(row & 63, cc)) = st.v[i];
        *(u32x4*)(lds + L_S + row * PITCH + cc * 2) = st.s[i]; }
    __syncthreads();
    if (has_next) ret_out_load(RQ, RK, RV, STS, nbh, nc, st);
    const int qg = wid & 3, dh = wid >> 2;
    bf16x8 qr[8];
#pragma unroll
    for (int d0 = 0; d0 < 8; ++d0) qr[d0] = *(const bf16x8*)(lds + L_Q + (32 * qg + r32) * PITCH + d0 * 32 + hi * 16);
    f32x16 o[2] = {};
#pragma unroll
    for (int dd = 0; dd < 2; ++dd) { const char* sb = lds + L_S + ((2 * dh + dd) * 32 + r32) * PITCH + hi * 16;
#pragma unroll
        for (int d0 = 0; d0 < 8; ++d0) o[dd] = __builtin_amdgcn_mfma_f32_32x32x16_bf16(qr[d0], *(const bf16x8*)(sb + d0 * 32), o[dd], 0, 0, 0); }
    { const float g1 = exp2f(lg);
#pragma unroll
      for (int dd = 0; dd < 2; ++dd)
#pragma unroll
          for (int r = 0; r < 16; ++r) o[dd][r] *= g1; }
    const int vb = (int)(uintptr_t)(lds + L_V) + v_rd_base(lane) + (2 * dh) * 512;
    const int qpos = 32 * qg + r32;
#define INTRA(kt) do { if (64 * (kt) <= 32 * qg + 31) { f32x16 p0 = {}, p1 = {}; const char* kb = lds + L_K + (64 * (kt) + r32) * PITCH + hi * 16;   \
        _Pragma("unroll") for (int d0 = 0; d0 < 8; ++d0) { p0 = __builtin_amdgcn_mfma_f32_32x32x16_bf16(*(const bf16x8*)(kb + d0 * 32), qr[d0], p0, 0, 0, 0);   \
                                                          p1 = __builtin_amdgcn_mfma_f32_32x32x16_bf16(*(const bf16x8*)(kb + 32 * PITCH + d0 * 32), qr[d0], p1, 0, 0, 0); }   \
        _Pragma("unroll") for (int r = 0; r < 16; ++r) { const int key = 64 * (kt) + crow(r, hi); if (key > qpos) p0[r] = 0.f; if (key + 32 > qpos) p1[r] = 0.f; }   \
        bf16x8 pa0, pa1, pa2, pa3;   \
        PK4(p0, 0, pa0); PK4(p0, 8, pa1); PK4(p1, 0, pa2); PK4(p1, 8, pa3);   \
        PVD(kt, 0); PVD(kt, 1); } } while (0)
#define PK4(P, B_, OUT) do { unsigned a0 = cvtpk(P[B_+0], P[B_+1]), a1 = cvtpk(P[B_+2], P[B_+3]); unsigned b0 = cvtpk(P[B_+4], P[B_+5]), b1 = cvtpk(P[B_+6], P[B_+7]);   \
        auto r0 = __builtin_amdgcn_permlane32_swap(a0, b0, false, false); auto r1 = __builtin_amdgcn_permlane32_swap(a1, b1, false, false);   \
        u32x4 w_ = {r0[0], r1[0], r0[1], r1[1]}; OUT = *reinterpret_cast<bf16x8*>(&w_); } while (0)
#define PVD(kt, dd) do { s16x4 l0, l1, l2, l3, h0, h1, h2, h3; constexpr int b_ = (kt) * 16384 + v_rd_off(dd, 0, 0);   \
        TRRD(l0, vb, b_); TRRD(h0, vb, b_ + 2048); TRRD(l1, vb, b_ + 4096); TRRD(h1, vb, b_ + 6144); TRRD(l2, vb, b_ + 8192); TRRD(h2, vb, b_ + 10240); TRRD(l3, vb, b_ + 12288); TRRD(h3, vb, b_ + 14336);   \
        asm volatile("s_waitcnt lgkmcnt(0)" ::: "memory"); __builtin_amdgcn_sched_barrier(0);   \
        o[dd] = __builtin_amdgcn_mfma_f32_32x32x16_bf16(pa0, FRAG(l0, h0), o[dd], 0, 0, 0); o[dd] = __builtin_amdgcn_mfma_f32_32x32x16_bf16(pa1, FRAG(l1, h1), o[dd], 0, 0, 0);   \
        o[dd] = __builtin_amdgcn_mfma_f32_32x32x16_bf16(pa2, FRAG(l2, h2), o[dd], 0, 0, 0); o[dd] = __builtin_amdgcn_mfma_f32_32x32x16_bf16(pa3, FRAG(l3, h3), o[dd], 0, 0, 0); } while (0)
    INTRA(0); INTRA(1);
#undef INTRA
#undef PK4
#undef PVD
    __syncthreads();
    float* Os = (float*)lds;
#pragma unroll
    for (int dd = 0; dd < 2; ++dd)
#pragma unroll
        for (int r = 0; r < 16; ++r) Os[(32 * qg + crow(r, hi)) * 132 + (2 * dh + dd) * 32 + r32] = o[dd][r];
    __syncthreads();
    { const int q = tid >> 2, seg = tid & 3; const float* orow = Os + q * 132 + seg * 32;
      f32x4 v[8]; float s1 = 0.f, s2 = 0.f;
#pragma unroll
      for (int i = 0; i < 8; ++i) { v[i] = *(const f32x4*)(orow + 4 * i); s1 += (v[i][0] + v[i][1]) + (v[i][2] + v[i][3]); s2 += fx::sq4(v[i]); }
      s1 += __shfl_xor(s1, 1); s1 += __shfl_xor(s1, 2); s2 += __shfl_xor(s2, 1); s2 += __shfl_xor(s2, 2);
      const float mean = s1 * (1.f / 128.f); const float var = fmaxf(s2 * (1.f / 128.f) - mean * mean, 0.f); const float rs = rsqrtf(var + EPS);
      const bf16_t* gp = RG + (t0 + q) * 512 + h * 128 + seg * 32; const float* gg = gn_g + h * 128 + seg * 32;
      bf16_t* op = AO + (t0 + q) * 1024 + 512 + h * 128 + seg * 32;
#pragma unroll
      for (int i = 0; i < 4; ++i) { const u32x4 gr = *(const u32x4*)(gp + 8 * i); const f32x4 g0 = *(const f32x4*)(gg + 8 * i), g1 = *(const f32x4*)(gg + 8 * i + 4);
          const f32x4 ga = {__uint_as_float(gr.x << 16), __uint_as_float(gr.x & 0xffff0000u), __uint_as_float(gr.y << 16), __uint_as_float(gr.y & 0xffff0000u)};
          const f32x4 gb = {__uint_as_float(gr.z << 16), __uint_as_float(gr.z & 0xffff0000u), __uint_as_float(gr.w << 16), __uint_as_float(gr.w & 0xffff0000u)};
          f32x4 ya = (v[2 * i] - mean) * rs * g0, yb = (v[2 * i + 1] - mean) * rs * g1;
#pragma unroll
          for (int k = 0; k < 4; ++k) { ya[k] *= ga[k] / (1.f + __expf(-ga[k])); yb[k] *= gb[k] / (1.f + __expf(-gb[k])); }
          *(u32x4*)(op + 8 * i) = fx::pack8(ya, yb); } }
    __syncthreads();
}
__device__ __forceinline__ void ret_out_phase(const bf16_t* RQ, const bf16_t* RK, const bf16_t* RV, const bf16_t* RG, const bf16_t* STS, const float* gn_g, bf16_t* AO, char* lds) {
    RetStage st; int u = blockIdx.x;
    if (u < 1024) ret_out_load(RQ, RK, RV, STS, u >> 5, u & 31, st);
    for (; u < 1024; u += gridDim.x) { const int un = u + gridDim.x;
        ret_out_unit(RQ, RK, RV, RG, STS, gn_g, AO, u >> 5, u & 31, st, un < 1024, un >> 5, un & 31, lds); }
}

__device__ __forceinline__ void ret_scan_phase(const bf16_t* KVS, bf16_t* STS, int wg, int nwg) {
    const int gt = wg * 512 + threadIdx.x, NT = nwg * 512;
    for (int it = gt; it < 32 * 2048; it += NT) { const int bh = it >> 11, e8 = it & 2047;
        const float cd = exp2f(128.f * gamma_log2(bh & 3));
        const bf16_t* src = KVS + (size_t)bh * 32 * 16384 + e8 * 8; bf16_t* dst = STS + (size_t)bh * 32 * 16384 + e8 * 8;
        f32x4 s0 = {0.f, 0.f, 0.f, 0.f}, s1 = s0;
#pragma unroll 8
        for (int c = 0; c < 32; ++c) { const u32x4 v = *(const u32x4*)(src + (size_t)c * 16384);
            *(u32x4*)(dst + (size_t)c * 16384) = fx::pack8(s0, s1);
            s0 = s0 * cd + (f32x4){__uint_as_float(v.x << 16), __uint_as_float(v.x & 0xffff0000u), __uint_as_float(v.y << 16), __uint_as_float(v.y & 0xffff0000u)};
            s1 = s1 * cd + (f32x4){__uint_as_float(v.z << 16), __uint_as_float(v.z & 0xffff0000u), __uint_as_float(v.w << 16), __uint_as_float(v.w & 0xffff0000u)}; } }
}
#undef TRRD
#undef FRAG
}
namespace cg = cooperative_groups;
#ifndef STAG8
#define STAG8 1100
#endif
#ifndef DUP
#define DUP (-1)
#endif
__device__ __forceinline__ int opaque_reps(int n) { asm volatile("" : "+s"(n)); return n; }
#define REPS(code) for (int rep = 0; rep < ((DUP == (code)) ? 2 : 1); ++rep)
constexpr int NWAVES = 8;
constexpr int RING_BYTES = 131072, XL_OFF = RING_BYTES, XL_BYTES = 8192, XST_OFF = RING_BYTES + 8192 + 16384, LDS_BYTES = XST_OFF + 64;

struct Params {
    const float* in[28]; float* out; unsigned char* ws; int ph_lo, ph_hi; int coop; int pad;
};
typedef const Params __attribute__((address_space(4)))* KParams;
#define WSP(T_, off) ((T_*)(p->ws + (off)))

constexpr size_t WB_IN = WS_WB, WB_UQ = WB_IN + (size_t)2560 * 1024 * 2, WB_UKV = WB_UQ + (size_t)1024 * 256 * 2, WB_OUT = WB_UKV + (size_t)1024 * 256 * 2,
                 WB_CQ = WB_OUT + (size_t)1024 * 1024 * 2, WB_CKV = WB_CQ + (size_t)1024 * 1024 * 2, WB_CO = WB_CKV + (size_t)2048 * 1024 * 2,
                 WB_GU = WB_CO + (size_t)1024 * 1024 * 2, WB_D = WB_GU + (size_t)32 * 512 * 1024 * 2, WB_END = WB_D + (size_t)32 * 1024 * 256 * 2;
static_assert(WB_END <= WS_RQ, "weight copies overflow their region");

__device__ __forceinline__ float wave_sum64(float v) {
#pragma unroll
    for (int o = 1; o < 64; o <<= 1) v += __shfl_xor(v, o);
    return v;
}
__device__ __forceinline__ int plain_src(int n) { return (n & ~31) + pg8::perm32(n & 31); }

template <class SrcFn, class DstFn>
__device__ __forceinline__ void wprep_item(const float* __restrict__ W, int ldw, int Kreal, const float* __restrict__ gain, bf16_t* __restrict__ WT, int ldt,
                                           LAS float* scr, int kb, int nb, int lane, SrcFn src, DstFn dst) {
    const int k0 = 64 * kb, n0 = 64 * nb;
    u32x4* orow = (u32x4*)(WT + (size_t)dst(n0 + lane) * ldt + k0);
    if (k0 >= Kreal) {
#pragma unroll
        for (int c = 0; c < 8; ++c) orow[c] = (u32x4){0u, 0u, 0u, 0u};
        return; }
    const int krow = lane >> 4, n4 = lane & 15;
    int sc = src(n0 + 4 * n4); sc = sc < 0 ? 0 : sc;
    const float* wp = W + (size_t)(k0 + krow) * ldw + sc;
    f32x4 v[16];
#pragma unroll
    for (int i = 0; i < 16; ++i) v[i] = *(const f32x4*)(wp + (size_t)(4 * i) * ldw);
#pragma unroll
    for (int i = 0; i < 16; ++i) *(LAS f32x4*)(scr + (4 * i + krow) * 68 + 4 * n4) = v[i];
    asm volatile("s_waitcnt lgkmcnt(0)" ::: "memory");
    const bool zero = src(n0 + lane) < 0;
#pragma unroll
    for (int c = 0; c < 8; ++c) { float t[8];
#pragma unroll
        for (int j = 0; j < 8; ++j) { t[j] = scr[(8 * c + j) * 68 + lane]; if (gain) t[j] *= gain[k0 + 8 * c + j]; if (zero) t[j] = 0.f; }
        u32x4 o; o.x = pg8::cvt_pk_bf16(t[0], t[1]); o.y = pg8::cvt_pk_bf16(t[2], t[3]); o.z = pg8::cvt_pk_bf16(t[4], t[5]); o.w = pg8::cvt_pk_bf16(t[6], t[7]);
        orow[c] = o; }
    asm volatile("s_waitcnt lgkmcnt(0)" ::: "memory");
}
template <class SrcFn, class DstFn>
__device__ __forceinline__ void wprep_matrix(const float* W, int ldw, int Kreal, int Kpad, int Nitems64, const float* gain, bf16_t* WT, int ldt, LAS float* scr, int gw, int NGW, int lane, SrcFn src, DstFn dst) {
    const int nkb = Kpad / 64, total = nkb * Nitems64;
    for (int it = gw; it < total; it += NGW) wprep_item(W, ldw, Kreal, gain, WT, ldt, scr, it / Nitems64, it % Nitems64, lane, src, dst);
}
__device__ __forceinline__ void rms_row_to_bf16(const float* xrow, const float* g, bf16_t* orow, int lane) {
    const f32x4* xr = (const f32x4*)xrow + lane; const f32x4* gr = (const f32x4*)g + lane;
    f32x4 v[4]; float s = 0.f;
#pragma unroll
    for (int j = 0; j < 4; ++j) { v[j] = xr[64 * j]; s += fx::sq4(v[j]); }
    const float rs = rsqrtf(wave_sum64(s) * (1.f / 1024.f) + EPS);
    u32x2* o8 = (u32x2*)orow + lane;
#pragma unroll
    for (int j = 0; j < 4; ++j) { const f32x4 w = v[j] * rs * gr[64 * j]; o8[64 * j] = fx::pack4(w); }
}

__device__ __forceinline__ void expert_prep(KParams p, LAS unsigned char* lds, int wave, int lane) {
    LAS float* scr = (LAS float*)(lds + wave * 17408);
    const int gw = blockIdx.x * NWAVES + wave, NGW = gridDim.x * NWAVES;
    auto ident = [](int n) { return n; };
    for (int it = gw; it < 32 * 64; it += NGW) { const int e = it >> 6, r = it & 63, kb = r >> 2, nb = r & 3;
        auto srcf = [](int n) { return (n >> 7) * 128 + plain_src(n & 127); };
        wprep_item(p->in[25] + (size_t)e * 1024 * 256, 256, 1024, p->in[20], WSP(bf16_t, WB_GU) + (size_t)e * 512 * 1024, 1024, scr, kb, nb, lane, srcf, [](int n) { return (n >> 7) * 256 + (n & 127); });
        wprep_item(p->in[26] + (size_t)e * 1024 * 256, 256, 1024, p->in[20], WSP(bf16_t, WB_GU) + (size_t)e * 512 * 1024, 1024, scr, kb, nb, lane, srcf, [](int n) { return (n >> 7) * 256 + 128 + (n & 127); }); }
    for (int it = gw; it < 32 * 64; it += NGW) { const int e = it >> 6, r = it & 63, kb = r >> 4, nb = r & 15;
        wprep_item(p->in[27] + (size_t)e * 256 * 1024, 1024, 256, nullptr, WSP(bf16_t, WB_D) + (size_t)e * 1024 * 256, 256, scr, kb, nb, lane, ident, ident); }
    __syncthreads();
}

__device__ __forceinline__ void p0_prologue(KParams p, LAS unsigned char* lds, int wave, int lane) {
    LAS float* scr = (LAS float*)(lds + wave * 17408);
    const int gw = blockIdx.x * NWAVES + wave, NGW = gridDim.x * NWAVES;
    auto ident = [](int n) { return n; };
    REPS(1004) {
    for (int it = gw; it < 2048; it += NGW) { int r = it;
        if (r < 640) { wprep_item(p->in[4], 2496, 1024, nullptr, WSP(bf16_t, WB_IN), 1024, scr, r / 40, r % 40, lane, [](int n) { return fx::inproj_src(n); }, ident); continue; } r -= 640;
        if (r < 256) { if ((r >> 4) >= 8) wprep_item(p->in[12], 1024, 1024, nullptr, WSP(bf16_t, WB_OUT), 1024, scr, r >> 4, r & 15, lane, ident, ident); continue; } r -= 256;
        if (r < 256) { wprep_item(p->in[19], 1024, 1024, nullptr, WSP(bf16_t, WB_CO), 1024, scr, r >> 4, r & 15, lane, ident, ident); continue; } r -= 256;
        if (r < 64) { wprep_item(p->in[6], 768, 256, p->in[5], WSP(bf16_t, WB_UQ), 256, scr, r >> 4, r & 15, lane, [](int n) { return fx::mlaq_src(n); }, ident); continue; } r -= 64;
        if (r < 64) { if ((r & 15) < 8) wprep_item(p->in[8], 1024, 128, p->in[7], WSP(bf16_t, WB_UKV), 256, scr, r >> 4, r & 15, lane, [](int n) { return (n >> 7) * 256 + plain_src(n & 127); }, ident); continue; } r -= 64;
        if (r < 256) { wprep_item(p->in[15], 1024, 1024, p->in[13], WSP(bf16_t, WB_CQ), 1024, scr, r >> 4, r & 15, lane, [](int n) { return plain_src(n); }, ident); continue; } r -= 256;
        wprep_item(p->in[16], 2048, 1024, nullptr, WSP(bf16_t, WB_CKV), 1024, scr, r >> 5, r & 31, lane, [](int n) { return n < 1024 ? plain_src(n) : n; }, ident);
    }
    }
    REPS(1001) {
    for (int m = gw; m < T_TOK; m += 4 * NGW) {
        const f32x4* gr = (const f32x4*)p->in[3] + lane;
        f32x4 v[4][4]; float ss[4];
#pragma unroll
        for (int r = 0; r < 4; ++r) { const f32x4* xr = (const f32x4*)(p->in[0] + (size_t)(m + r * NGW) * 1024) + lane;
#pragma unroll
            for (int j = 0; j < 4; ++j) v[r][j] = __builtin_nontemporal_load(xr + 64 * j); }
#pragma unroll
        for (int r = 0; r < 4; ++r) { float s_ = 0.f;
#pragma unroll
            for (int j = 0; j < 4; ++j) s_ += fx::sq4(v[r][j]);
            ss[r] = rsqrtf(wave_sum64(s_) * (1.f / 1024.f) + EPS); }
#pragma unroll
        for (int r = 0; r < 4; ++r) { u32x2* o = (u32x2*)(WSP(bf16_t, WS_HB) + (size_t)(m + r * NGW) * 1024) + lane;
#pragma unroll
            for (int j = 0; j < 4; ++j) o[64 * j] = fx::pack4(v[r][j] * ss[r] * gr[64 * j]); } }
    for (int m = gw; m < 2048; m += NGW) rms_row_to_bf16(p->in[1] + (size_t)m * 1024, p->in[14], WSP(bf16_t, WS_MB) + (size_t)m * 1024, lane);
    }
    REPS(1002) {
    { const int gt = blockIdx.x * (NWAVES * 64) + threadIdx.x, NT = gridDim.x * NWAVES * 64;
      float* z = WSP(float, WS_SSQ_CQ);
      for (int idx = gt; idx < 5 * 32768; idx += NT) z[idx] = 0.f;
      if (gt < 64) WSP(int, WS_CNT)[gt] = 0;
      { const float* wukv = p->in[8]; const float* wout = p->in[12]; bf16_t* wo = WSP(bf16_t, WB_OUT);
        for (int it0 = gw; it0 < 2048; it0 += NGW) { const int it = __builtin_amdgcn_readfirstlane(it0), h = it >> 9, cb = (it >> 4) & 31, n = (it & 15) * 64 + lane;
            const float* a = wukv + (size_t)(cb * 4) * 1024 + h * 256 + 128; const float* bcol = wout + (size_t)(h * 128) * 1024 + n; f32x4 acc_ = {0.f, 0.f, 0.f, 0.f};
#pragma unroll 4
            for (int d = 0; d < 128; d += 4) { f32x4 av[4]; float bv[4];
#pragma unroll
                for (int j = 0; j < 4; ++j) { av[j] = *(const f32x4*)(a + (size_t)j * 1024 + d); bv[j] = bcol[(size_t)(d + j) * 1024]; }
#pragma unroll
                for (int j = 0; j < 4; ++j) { acc_[j] += av[j][0] * bv[0]; acc_[j] += av[j][1] * bv[1]; acc_[j] += av[j][2] * bv[2]; acc_[j] += av[j][3] * bv[3]; } }
            *(u32x2*)(wo + (size_t)n * 1024 + h * 128 + cb * 4) = fx::pack4(acc_); } }
      bf16_t* wrh = WSP(bf16_t, WS_RW); bf16_t* wrl = wrh + 36 * 1032;
      for (int idx = gt; idx < 36 * 1032; idx += NT) { const int n = idx / 1032, k = idx % 1032; float v = 0.f;
          if (k < 1024) v = (n < 4) ? p->in[20][k] * p->in[21][k * 4 + n] : p->in[20][k] * p->in[23][k * 32 + n - 4];
          const bf16_t hh = f2bf(v); wrh[idx] = hh; wrl[idx] = f2bf(v - bf2f(hh)); } }
    }
}


#define GAS __attribute__((address_space(1)))
#define XB_TMO      128
#define XB_XCNT(j)  (256  + 64 * (j))
#define XB_XSUB(j)  (1280 + 64 * (j))
#define XB_XGEN(j)  (2304 + 64 * (j))
#define XB_TOP      3328
#define XB_TOPGEN   3392
#define XCD_BAR_WORDS 3456
#define XB_SPIN_CAP (1u << 18)
__device__ __forceinline__ unsigned xb_ld(unsigned* p)              { return __hip_atomic_load(p, __ATOMIC_RELAXED, __HIP_MEMORY_SCOPE_AGENT); }
__device__ __forceinline__ unsigned xb_add(unsigned* p, unsigned v) { return __hip_atomic_fetch_add(p, v, __ATOMIC_RELAXED, __HIP_MEMORY_SCOPE_AGENT); }
__device__ __forceinline__ unsigned xb_xcc_id() { return (unsigned)__builtin_amdgcn_s_getreg((3 << 11) | 20) & 0xFu; }
#define XB_SPIN(cond, bar) do { unsigned _sp = 0; while (cond) { __builtin_amdgcn_s_sleep(1); \
    if ((++_sp & 255u) == 0u) { if (xb_ld(&(bar)[XB_TMO])) break; if (_sp > XB_SPIN_CAP) { atomicAdd(&(bar)[XB_TMO], 1u); break; } } } } while (0)
struct XcdBarrier { unsigned* bar; unsigned x; volatile LAS unsigned* st; };
__device__ __forceinline__ XcdBarrier xcd_barrier_post(unsigned* bar, volatile LAS unsigned* st) {
    XcdBarrier b; b.bar = bar; b.x = xb_xcc_id(); b.st = st;
    if (threadIdx.x == 0) (void)xb_add(&bar[XB_XCNT(b.x)], 1u);
    return b;
}
__device__ __forceinline__ void xcd_barrier_complete(unsigned* bar, unsigned x, unsigned& nloc, unsigned& nx) {
    const unsigned G = gridDim.x * gridDim.y * gridDim.z;
    unsigned sum, cnt, mine, sp = 0u;
    for (;;) {
        sum = 0u; cnt = 0u; mine = 0u;
#pragma unroll
        for (unsigned j = 0; j < 16; ++j) { const unsigned c = xb_ld(&bar[XB_XCNT(j)]); sum += c; cnt += (c > 0u) ? 1u : 0u; mine = (j == x) ? c : mine; }
        if (sum == G) break;
        __builtin_amdgcn_s_sleep(1);
        if ((++sp & 255u) == 0u) { if (xb_ld(&bar[XB_TMO])) break; if (sp > XB_SPIN_CAP) { atomicAdd(&bar[XB_TMO], 1u); break; } }
    }
    nloc = mine > 0u ? mine : 1u; nx = cnt > 0u ? cnt : 1u;
}
__device__ __forceinline__ void xcd_barrier(const XcdBarrier& b) {
    asm volatile("s_waitcnt vmcnt(0)" ::: "memory");
    __syncthreads();
    if (threadIdx.x == 0) {
        unsigned* bar = b.bar;
        __builtin_amdgcn_s_waitcnt(0);
        unsigned nloc = b.st[0], nx = b.st[1];
        if (nloc == 0u) { xcd_barrier_complete(bar, b.x, nloc, nx); b.st[0] = nloc; b.st[1] = nx; }
        const unsigned old = xb_add(&bar[XB_XSUB(b.x)], 1u);
        const unsigned gen = old / nloc;
        if (old + 1u == (gen + 1u) * nloc) {
            __builtin_amdgcn_fence(__ATOMIC_RELEASE, "agent");
            asm volatile("s_waitcnt vmcnt(0)" ::: "memory");
            const unsigned og = xb_add(&bar[XB_TOP], 1u);
            const unsigned tg = og / nx;
            if (og + 1u == (tg + 1u) * nx) xb_add(&bar[XB_TOPGEN], 1u);
            else XB_SPIN(xb_ld(&bar[XB_TOPGEN]) == tg, bar);
            __builtin_amdgcn_fence(__ATOMIC_ACQUIRE, "agent");
            xb_add(&bar[XB_XGEN(b.x)], 1u);
            asm volatile("s_waitcnt vmcnt(0)" ::: "memory");
        } else {
            XB_SPIN(xb_ld(&bar[XB_XGEN(b.x)]) == gen, bar);
            __builtin_amdgcn_fence(__ATOMIC_ACQUIRE, "agent");
            asm volatile("s_waitcnt vmcnt(0)" ::: "memory");
        }
    }
    __syncthreads();
}

__device__ __forceinline__ void stagger_start(int ticks) {
    if ((blockIdx.x >> 3) & 1) { const unsigned long long t0 = __builtin_amdgcn_s_memrealtime(); while (__builtin_amdgcn_s_memrealtime() - t0 < (unsigned long long)ticks) __builtin_amdgcn_s_sleep(8); }
}
__device__ __forceinline__ void router_phase(KParams p, LAS unsigned char* lds, int wave, int lane, int* cnt, int* lists, float* roww, float* rsr) {
    const float* bg = p->in[22]; const float* be = p->in[24];
    constexpr int RP = 2064;
    { const u32x4* src = WSP(u32x4, WS_RW); LAS u32x4* dst = (LAS u32x4*)lds;
      for (int i = threadIdx.x; i < 2 * 36 * RP / 16; i += NWAVES * 64) dst[i] = src[i]; }
    __syncthreads();
    const int tok = lane & 15, kq = lane >> 4;
    LAS unsigned char* wh = lds + tok * RP + kq * 16; LAS unsigned char* wl = wh + 36 * RP;
    const bool t2 = tok < 4;
    for (int item = blockIdx.x * NWAVES + wave; item < T_TOK / 16; item += gridDim.x * NWAVES) {
        const int t0 = item * 16;
        const bf16_t* xhr = WSP(bf16_t, WS_XB) + (size_t)(t0 + tok) * 1024 + 8 * kq;
        f32x4 c[3]; c[0] = (f32x4){0.f, 0.f, 0.f, 0.f}; c[1] = c[0]; c[2] = c[0];
#pragma unroll 8
        for (int ks = 0; ks < 32; ++ks) {
            const bf16x8 xh = *(const bf16x8*)(xhr + 32 * ks);
#pragma unroll
            for (int t = 0; t < 3; ++t) {
                bf16x8 ah, al;
                if (t < 2) { ah = *(const LAS bf16x8*)(wh + t * 16 * RP + ks * 64); al = *(const LAS bf16x8*)(wl + t * 16 * RP + ks * 64); }
                else { ah = *(const LAS bf16x8*)(wh + (t2 ? 32 * RP : 0) + ks * 64); al = *(const LAS bf16x8*)(wl + (t2 ? 32 * RP : 0) + ks * 64);
                       if (!t2) { ah = (bf16x8){0, 0, 0, 0, 0, 0, 0, 0}; al = ah; } }
                c[t] = __builtin_amdgcn_mfma_f32_16x16x32_bf16(ah, xh, c[t], 0, 0, 0);
                c[t] = __builtin_amdgcn_mfma_f32_16x16x32_bf16(al, xh, c[t], 0, 0, 0);
            }
        }
        const float rs = rsqrtf(WSP(float, WS_SSQ2)[t0 + tok] * (1.f / 1024.f) + EPS);
#pragma unroll
        for (int t = 0; t < 3; ++t) c[t] = c[t] * rs;
        float g[4];
#pragma unroll
        for (int r = 0; r < 4; ++r) g[r] = __shfl(c[0][r], tok);
        const float mx = fmaxf(fmaxf(g[0], g[1]), fmaxf(g[2], g[3]));
        float den = 0.f;
#pragma unroll
        for (int j = 0; j < 4; ++j) den += expf(g[j] - mx);
        int gs = 0; float best = g[0] + bg[0], lgs = g[0];
#pragma unroll
        for (int j = 1; j < 4; ++j) { const float v = g[j] + bg[j]; if (v > best) { best = v; gs = j; lgs = g[j]; } }
        const float gw = expf(lgs - mx) / den;
        const int qA = 1 + 2 * gs, qB = qA + 1;
        f32x4 sA = (qA >> 2) == 0 ? c[0] : ((qA >> 2) == 1 ? c[1] : c[2]);
        f32x4 sB = (qB >> 2) == 0 ? c[0] : ((qB >> 2) == 1 ? c[1] : c[2]);
        float el[8];
#pragma unroll
        for (int r = 0; r < 4; ++r) { el[r] = __shfl(sA[r], tok + 16 * (qA & 3)); el[4 + r] = __shfl(sB[r], tok + 16 * (qB & 3)); }
        float emx = el[0];
#pragma unroll
        for (int j = 1; j < 8; ++j) emx = fmaxf(emx, el[j]);
        float eden = 0.f;
#pragma unroll
        for (int j = 0; j < 8; ++j) eden += expf(el[j] - emx);
        float sc[8];
#pragma unroll
        for (int j = 0; j < 8; ++j) sc[j] = el[j] + be[gs * 8 + j];
        int i0 = 0; float b0 = sc[0], e0v = el[0];
#pragma unroll
        for (int j = 1; j < 8; ++j) if (sc[j] > b0) { b0 = sc[j]; i0 = j; e0v = el[j]; }
        int i1 = -1; float b1 = -3.0e38f, e1v = 0.f;
#pragma unroll
        for (int j = 0; j < 8; ++j) if (j != i0 && sc[j] > b1) { b1 = sc[j]; i1 = j; e1v = el[j]; }
        LAS int* hist = (LAS int*)(lds + 2 * 36 * RP + 128); LAS int* hbase = hist + 64;
        if (threadIdx.x < 64) hist[threadIdx.x] = 0;
        __syncthreads();
        const float p0 = expf(e0v - emx) / eden, p1 = expf(e1v - emx) / eden, sm = p0 + p1;
        const int sg0 = gs * 8 + i0, sg1 = 32 + gs * 8 + i1;
        int r0 = 0, r1 = 0;
        if (kq == 0) { r0 = __hip_atomic_fetch_add(hist + sg0, 1, __ATOMIC_RELAXED, __HIP_MEMORY_SCOPE_WORKGROUP); r1 = __hip_atomic_fetch_add(hist + sg1, 1, __ATOMIC_RELAXED, __HIP_MEMORY_SCOPE_WORKGROUP); }
        __syncthreads();
        if (threadIdx.x < 64) { const int n = hist[threadIdx.x]; hbase[threadIdx.x] = n > 0 ? atomicAdd(cnt + threadIdx.x, n) : 0; }
        __syncthreads();
        if (kq == 0) {
            const int t = t0 + tok; const int q0 = hbase[sg0] + r0, q1 = hbase[sg1] + r1;
            lists[(size_t)sg0 * fx::MOE_CAP + q0] = t; roww[(size_t)sg0 * fx::MOE_CAP + q0] = p0 / sm * gw; rsr[(size_t)sg0 * fx::MOE_CAP + q0] = rs;
            lists[(size_t)sg1 * fx::MOE_CAP + q1] = t; roww[(size_t)sg1 * fx::MOE_CAP + q1] = p1 / sm * gw; rsr[(size_t)sg1 * fx::MOE_CAP + q1] = rs;
        }
    }
    __syncthreads();
}

__global__ void __launch_bounds__(NWAVES * 64, 2) mk_fwd(Params p_arg) {
    KParams p = (KParams)__builtin_amdgcn_kernarg_segment_ptr();
    extern __shared__ __attribute__((aligned(16))) unsigned char lds_raw[];
    LAS unsigned char* lds = (LAS unsigned char*)lds_raw;
    LAS unsigned char* xl = lds + XL_OFF;
    const int tid = threadIdx.x, lane = tid & 63, wave = __builtin_amdgcn_readfirstlane(tid >> 6);
    const int lo = p->ph_lo, hi = p->ph_hi;
#ifndef PHMASK
#define PHMASK 0xffffffffu
#endif
#define IN(k) (((PHMASK >> (k)) & 1u) && lo <= (k) && (k) < hi)
#define SEAM(k) do { if (IN(k) && IN((k) + 1)) { xcd_barrier(xbar); if (DUP == 1000) xcd_barrier(xbar); } } while (0)
    volatile LAS unsigned* xst = (volatile LAS unsigned*)(lds + XST_OFF);
    if (tid == 0) { xst[0] = 0u; xst[1] = 0u; }
    __syncthreads();
    XcdBarrier xbar = xcd_barrier_post(WSP(unsigned, WS_BAR), xst);
    if (lo < 0) cg::this_grid().sync();
    float* const dummyf = WSP(float, 512 * 1024);
    REPS(0) if (IN(0)) { p0_prologue(p, lds, wave, lane); }
    SEAM(0);
    if (IN(1)) {
        REPS(1) {
        pg8::GridOrder S; S.init(WSP(bf16_t, WS_HB), 1024, WSP(bf16_t, WB_IN), 1024, T_TOK, 2560, gridDim.x, blockIdx.x);
        fx::EpiInProj E{WSP(bf16_t, WS_CQ), WSP(bf16_t, WS_CKV), WSP(bf16_t, WS_RQ), WSP(bf16_t, WS_RK), WSP(bf16_t, WS_RV), WSP(bf16_t, WS_RG),
                        rep ? dummyf : WSP(float, WS_SSQ_CQ), rep ? dummyf : WSP(float, WS_SSQ_CKV), rep ? dummyf : WSP(float, WS_SSQ_KPE), (const int*)p->in[2], p->in[10]};
        pg8::gemm_phase<fx::EpiInProj, pg8::GridOrder>(lds, xl, 1024, 1024, 1024, S, E); }
    }
    SEAM(1);
    if (IN(2)) {
        REPS(101) { const int G_ = (int)gridDim.x, c_ = (int)blockIdx.x; fx::MemKVOrder S2{G_, G_ >= 256 ? (c_ >= 128 ? c_ - 128 : 128) : c_, (const char*)WSP(bf16_t, WS_MB), (const char*)WSP(bf16_t, WB_CKV)};
          fx::EpiMemKV E2{WSP(bf16_t, WS_KC), WSP(bf16_t, WS_VC), p->in[18]};
          pg8::gemm_phase<fx::EpiMemKV, fx::MemKVOrder>(lds, xl, 1024, 1024, 1024, S2, E2); }
        REPS(2) {
        { fx::QupOrder S; S.g.init(WSP(bf16_t, WS_CQ), 256, WSP(bf16_t, WB_UQ), 256, T_TOK, 1024, gridDim.x, blockIdx.x);
          fx::EpiMlaQ E{WSP(bf16_t, WS_QM), WSP(float, WS_SSQ_CQ), p->in[9], (const int*)p->in[2]};
          pg8::gemm_phase<fx::EpiMlaQ, fx::QupOrder>(lds, xl, 256, 256, 256, S, E); }
        { pg8::GridOrder S; S.init(WSP(bf16_t, WS_CKV), 256, WSP(bf16_t, WB_UKV), 256, T_TOK, 512, gridDim.x, blockIdx.x);
          fx::EpiMlaKV E{WSP(bf16_t, WS_KM), WSP(bf16_t, WS_VM), WSP(bf16_t, WS_CKV), WSP(float, WS_SSQ_CKV), WSP(float, WS_SSQ_KPE), p->in[10], p->in[7]};
          pg8::gemm_phase<fx::EpiMlaKV, pg8::GridOrder>(lds, xl, 256, 256, 128, S, E); } }
        REPS(201) rt::ret_kv_phase(WSP(bf16_t, WS_RK), WSP(bf16_t, WS_RV), WSP(bf16_t, WS_KVS), (char*)lds_raw);
    }
    SEAM(2);
    if (IN(3)) { { fx::VwOrder S{(int)gridDim.x, (int)blockIdx.x, (const char*)WSP(bf16_t, WB_CO), (const char*)WSP(bf16_t, WS_VC)};
                   fx::EpiStoreT E{WSP(bf16_t, WS_VWT), 1024, 1024 * 1024, 1.f, 0};
                   pg8::gemm_phase<fx::EpiStoreT, fx::VwOrder>(lds, xl, 1024, 1024, 256, S, E); }
                 REPS(302) rt::ret_scan_phase(WSP(bf16_t, WS_KVS), WSP(bf16_t, WS_STS), (int)blockIdx.x, (int)gridDim.x);
                 unsigned* const scan_cnt = WSP(unsigned, 48 * 1024);
                 asm volatile("s_waitcnt vmcnt(0)" ::: "memory"); __syncthreads();
                 if (tid == 0) { __builtin_amdgcn_fence(__ATOMIC_RELEASE, "agent"); asm volatile("s_waitcnt vmcnt(0)" ::: "memory"); (void)xb_add(scan_cnt, 1u); }
                 _Pragma("nounroll") for (int pos = 0; pos < 2; ++pos) {
                     if ((int)((blockIdx.x >> 3) & 1) == pos) expert_prep(p, lds, wave, lane);
                     if (pos == 0) at::attn_phase(WSP(bf16_t, WS_QM), WSP(bf16_t, WS_KM), WSP(bf16_t, WS_VM), WSP(bf16_t, WS_AO), (char*)lds_raw); }
                 asm volatile("s_waitcnt vmcnt(0)" ::: "memory"); __syncthreads();
                 if (tid == 0) { XB_SPIN(xb_ld(scan_cnt) < gridDim.x, WSP(unsigned, WS_BAR)); __builtin_amdgcn_fence(__ATOMIC_ACQUIRE, "agent"); asm volatile("s_waitcnt vmcnt(0)" ::: "memory"); }
                 __syncthreads();
                 REPS(301) rt::ret_out_phase(WSP(bf16_t, WS_RQ), WSP(bf16_t, WS_RK), WSP(bf16_t, WS_RV), WSP(bf16_t, WS_RG), WSP(bf16_t, WS_STS), p->in[11], WSP(bf16_t, WS_AO), (char*)lds_raw); }
    SEAM(3);
    if (IN(4)) for (int rep = 0; rep < ((DUP == 4 || DUP == 1004 + 1000) ? 2 : 1); ++rep) {
        pg8::GridOrder S; S.init(WSP(bf16_t, WS_AO), 1024, WSP(bf16_t, WB_OUT), 1024, T_TOK, 1024, gridDim.x, blockIdx.x);
        fx::EpiResid<false, false> E{p->in[0], nullptr, WSP(bf16_t, WS_XB), rep ? ((DUP == 4) ? dummyf : (float*)nullptr) : WSP(float, WS_SSQ1)};
        pg8::gemm_phase<fx::EpiResid<false, false>, pg8::GridOrder>(lds, xl, 1024, 1024, 1024, S, E);
    }
    SEAM(4);
#define LOCAL_SEAM() do { asm volatile("s_waitcnt vmcnt(0)" ::: "memory"); __syncthreads(); if (tid == 0) { __builtin_amdgcn_fence(__ATOMIC_ACQUIRE, "agent"); asm volatile("s_waitcnt vmcnt(0)" ::: "memory"); } __syncthreads(); } while (0)
    if (IN(5)) REPS(5) {
        fx::HeadOrder S{(int)gridDim.x, (int)blockIdx.x, 512, (const char*)WSP(bf16_t, WS_XB), (const char*)WSP(bf16_t, WB_CQ), (size_t)256 * 1024 * 2, 0, 0, (size_t)256 * 1024 * 2};
        fx::EpiHeadNorm E{WSP(bf16_t, WS_QC), WSP(float, WS_SSQ1), p->in[17], 1.f / 1024.f};
        pg8::gemm_phase<fx::EpiHeadNorm, fx::HeadOrder>(lds, xl, 1024, 1024, 1024, S, E);
    }
    if (IN(5) && IN(6) && gridDim.x == 256) LOCAL_SEAM(); else SEAM(5);
    if (IN(6)) REPS(6) {
        fx::HeadOrder S{(int)gridDim.x, (int)blockIdx.x, 512, (const char*)WSP(bf16_t, WS_QC), (const char*)WSP(bf16_t, WS_KC), (size_t)256 * 1024 * 2, (size_t)256 * 2, (size_t)256 * 1024 * 2, (size_t)256 * 2};
        fx::EpiSoftmax E{WSP(bf16_t, WS_PC)};
        pg8::gemm_phase<fx::EpiSoftmax, fx::HeadOrder>(lds, xl, 1024, 1024, 256, S, E);
    }
    SEAM(6);
#undef LOCAL_SEAM
    if (IN(8)) {
        fx::CrossOOrder S; S.g.init(WSP(bf16_t, WS_PC), 1024, WSP(bf16_t, WS_VWT), 1024, T_TOK, 1024, gridDim.x, blockIdx.x); S.VWT = (const char*)WSP(bf16_t, WS_VWT);
        fx::EpiResid<true, false> E{nullptr, nullptr, WSP(bf16_t, WS_XB), WSP(float, WS_SSQ2)};
        pg8::gemm_phase<fx::EpiResid<true, false>, fx::CrossOOrder>(lds, xl, 1024, 1024, 1024, S, E);
    }
    SEAM(8);
    if (IN(9)) REPS(9) { router_phase(p, lds, wave, lane, rep ? WSP(int, 32 * 1024) : WSP(int, WS_CNT), rep ? WSP(int, WS_AO) : WSP(int, WS_LISTS), rep ? WSP(float, WS_AO + 8 * MiB) : WSP(float, WS_ROWW), WSP(float, WS_ROWW + 8 * MiB)); }
    SEAM(9);
    if (IN(10)) for (int rep = 0; rep < ((DUP == 10 || DUP == 2010 || DUP == 3010) ? 2 : 1); ++rep) {
        fx::MoeOrder S{(int)gridDim.x, (int)blockIdx.x, 0, 64, 2, WSP(int, WS_CNT), WSP(int, WS_LISTS), (const char*)WSP(bf16_t, WS_XB), (const char*)WSP(bf16_t, WB_GU), (DUP == 3010 && rep) ? (size_t)256 * 1024 * 2 : 0, (size_t)512 * 1024 * 2, (size_t)256 * 1024 * 2, nullptr}; S.init(xl);
        fx::EpiGlu E{(rep && DUP != 10) ? (bf16_t*)nullptr : WSP(bf16_t, WS_H), WSP(float, WS_ROWW + 8 * MiB), WSP(float, WS_ROWW), WSP(int, WS_LISTS)};
        if (DUP == 3010 && rep) pg8::gemm_phase<fx::EpiGlu, fx::MoeOrder, false>(lds, xl, 1024, 1024, 1024, S, E);
        else pg8::gemm_phase<fx::EpiGlu, fx::MoeOrder, true>(lds, xl, 1024, 1024, 1024, S, E);
    }
    SEAM(10);
    if (IN(11)) {
        fx::MoeOrder S{(int)gridDim.x, (int)blockIdx.x, 0, 32, 4, WSP(int, WS_CNT), WSP(int, WS_LISTS), (const char*)WSP(bf16_t, WS_H), (const char*)WSP(bf16_t, WB_D), (size_t)256 * 256 * 2, (size_t)1024 * 256 * 2, (size_t)256 * 256 * 2, nullptr}; S.init(xl);
        fx::EpiScatter<0> E{p->out, WSP(bf16_t, WS_XB)};
        pg8::gemm_phase<fx::EpiScatter<0>, fx::MoeOrder>(lds, xl, 256, 256, 256, S, E);
    }
    SEAM(11);
    if (IN(12)) {
        fx::MoeOrder S{(int)gridDim.x, (int)blockIdx.x, 32, 64, 4, WSP(int, WS_CNT), WSP(int, WS_LISTS), (const char*)WSP(bf16_t, WS_H), (const char*)WSP(bf16_t, WB_D), (size_t)256 * 256 * 2, (size_t)1024 * 256 * 2, (size_t)256 * 256 * 2, nullptr}; S.init(xl);
        fx::EpiScatter<1> E{p->out, WSP(bf16_t, WS_XB)};
        pg8::gemm_phase<fx::EpiScatter<1>, fx::MoeOrder>(lds, xl, 256, 256, 256, S, E);
    }
#undef IN
#undef SEAM
}

extern "C" void kernel_launch(void* const* d_in, const int* in_sizes, int n_in, void* d_out, int out_size, void* d_ws, size_t ws_size, hipStream_t stream) {
    static int grid = 0;
    if (grid == 0) {
        if (n_in != 28 || out_size != T_TOK * 1024 || ws_size < WS_NEED) { fprintf(stderr, "kernel_launch: unexpected shapes n_in %d out %d ws %zu\n", n_in, out_size, ws_size); grid = -1; return; }
        int dev = 0, cus = 0, per_cu = 0;
        if (hipGetDevice(&dev) != hipSuccess || hipDeviceGetAttribute(&cus, hipDeviceAttributeMultiprocessorCount, dev) != hipSuccess) { grid = -1; return; }
        if (hipFuncSetAttribute((const void*)mk_fwd, hipFuncAttributeMaxDynamicSharedMemorySize, LDS_BYTES) != hipSuccess) { fprintf(stderr, "hipFuncSetAttribute failed\n"); grid = -1; return; }
        if (hipOccupancyMaxActiveBlocksPerMultiprocessor(&per_cu, (const void*)mk_fwd, NWAVES * 64, LDS_BYTES) != hipSuccess || per_cu < 1) { fprintf(stderr, "occupancy query failed (%d)\n", per_cu); grid = -1; return; }
        grid = cus;
        (void)hipGetLastError();
    }
    if (grid < 0) return;
    if (hipMemsetAsync(d_ws, 0, 65536, stream) != hipSuccess) { fprintf(stderr, "hipMemsetAsync failed\n"); return; }
    Params p; memset(&p, 0, sizeof(p));
    for (int i = 0; i < 28; ++i) p.in[i] = (const float*)d_in[i];
    p.out = (float*)d_out; p.ws = (unsigned char*)d_ws; p.ph_lo = 0; p.ph_hi = 13; p.coop = 1;
#if defined(DUP) && DUP == 1
    p.pad = 1;
#endif
    void* args[] = {&p};
    hipError_t e = hipLaunchCooperativeKernel((const void*)mk_fwd, dim3(grid), dim3(NWAVES * 64), args, LDS_BYTES, stream);
    if (e != hipSuccess) fprintf(stderr, "cooperative launch failed: %s (grid %d)\n", hipGetErrorString(e), grid);
}
```

```cpp
#include <hip/hip_runtime.h>
#include <hip/hip_cooperative_groups.h>
#include <cstdint>
#include <cstdio>
#include <cmath>
#include <cstring>

typedef unsigned short bf16_t;
constexpr float EPS = 1e-6f;
constexpr int T_TOK = 32768;
__device__ __forceinline__ int opaque_tid() { int t = threadIdx.x; asm volatile("" : "+v"(t)); return t; }
__device__ __forceinline__ float bf2f(bf16_t h) { return __uint_as_float((unsigned)h << 16); }
__device__ __forceinline__ bf16_t f2bf(float f) { const unsigned u = __float_as_uint(f); return (bf16_t)((u + 0x7fffu + ((u >> 16) & 1u)) >> 16); }

constexpr size_t MiB = (size_t)1 << 20;
constexpr size_t WS_CTL = 0;
constexpr size_t WS_SSQ_CQ = 1 * MiB, WS_SSQ_CKV = WS_SSQ_CQ + 128 * 1024, WS_SSQ_KPE = WS_SSQ_CKV + 128 * 1024, WS_SSQ1 = WS_SSQ_KPE + 128 * 1024, WS_SSQ2 = WS_SSQ1 + 128 * 1024;
constexpr size_t WS_SEL = 2 * MiB, WS_WTS = WS_SEL + 256 * 1024;
constexpr size_t WS_RW = 4 * MiB;
constexpr size_t WS_VWT = 5 * MiB;
constexpr size_t WS_MB = 21 * MiB, WS_KC = 25 * MiB, WS_VC = 29 * MiB;
constexpr size_t WS_WB = 33 * MiB;
constexpr size_t WS_RQ = 97 * MiB, WS_RK = 129 * MiB, WS_RV = 161 * MiB, WS_RG = 193 * MiB;
constexpr size_t WS_HB = 225 * MiB;
constexpr size_t WS_QM = 225 * MiB, WS_KM = 273 * MiB, WS_VM = 321 * MiB;
constexpr size_t WS_KVS = 353 * MiB;
constexpr size_t WS_AO = 385 * MiB;
constexpr size_t WS_STS = 449 * MiB;
constexpr size_t WS_CQ = 449 * MiB, WS_CKV = 465 * MiB;
constexpr size_t WS_PJ = 289 * MiB;
constexpr size_t WS_RAW = 353 * MiB;
constexpr size_t WS_XB = 97 * MiB;
constexpr size_t WS_QCR = 161 * MiB;
constexpr size_t WS_PC = 161 * MiB;
constexpr size_t WS_QC = 225 * MiB;
constexpr size_t WS_OC = 289 * MiB;
constexpr size_t WS_KVR = 353 * MiB;
constexpr size_t WS_BAR = 16 * 1024;
constexpr size_t WS_CNT = 64 * 1024;
constexpr size_t WS_LISTS = 353 * MiB, WS_ROWW = 361 * MiB;
constexpr size_t WS_XLO = 385 * MiB;
constexpr size_t WS_Y0 = 225 * MiB;
constexpr size_t WS_H = 161 * MiB;
constexpr size_t WS_NEED = 481 * MiB;
#define LAS __attribute__((address_space(3)))
typedef short bf16x8 __attribute__((ext_vector_type(8)));
typedef float f32x4 __attribute__((ext_vector_type(4)));
typedef float f32x2 __attribute__((ext_vector_type(2)));
typedef unsigned u32x4 __attribute__((ext_vector_type(4)));
typedef unsigned u32x2 __attribute__((ext_vector_type(2)));

namespace pg8 {
constexpr int BM = 256, BK = 64, HALF = 128, HTB = HALF * BK * 2, STAGE_BYTES = 8 * HTB, NXCD = 8, WGM = 8;
__host__ __device__ __forceinline__ int lds_byte(int r, int c) { const int st = (r >> 4) * 2 + (c >> 5), rr = r & 15, cc = c & 31, ob = rr * 64 + cc * 2; return st * 1024 + (ob ^ (((ob >> 9) & 1) << 5)); }
__host__ __device__ __forceinline__ void stage_rc(int b, int& R, int& C) { const int st = b / 1024, sb = b % 1024, swz = sb ^ (((sb >> 9) & 1) << 5); R = (st >> 1) * 16 + swz / 64; C = (st & 1) * 32 + (swz % 64) / 2; }
__host__ __device__ __forceinline__ int perm32(int rho) { const int n = rho >> 4, i = rho & 15; return 8 * (i >> 2) + 4 * n + (i & 3); }
__device__ __forceinline__ unsigned cvt_pk_bf16(float lo, float hi) { unsigned r; asm volatile("v_cvt_pk_bf16_f32 %0, %1, %2" : "=v"(r) : "v"(lo), "v"(hi)); return r; }

struct Unit { int pm, pn; const char* a; const char* b; const int* rows; int nvalid, seg, half; };

struct GridOrder {
    int nM, nN, nwg, G, c; const char* A; const char* B; size_t strideA, strideB;
    __device__ __forceinline__ void init(const bf16_t* A_, int lda, const bf16_t* B_, int ldb, int M, int N, int G_, int c_) {
        nM = M / BM; nN = N / BM; nwg = nM * nN; G = G_; c = c_; A = (const char*)A_; B = (const char*)B_; strideA = (size_t)BM * lda * 2; strideB = (size_t)BM * ldb * 2; }
    __device__ __forceinline__ bool next(int i, Unit& u) const { return at((long)i * G + c, u); }
    __device__ __forceinline__ bool at(long L, Unit& u) const {
        if (L >= nwg) return false;
        int wgid = (int)L; { const int q = nwg / NXCD, r = nwg % NXCD, xcd = wgid % NXCD, off = wgid / NXCD; wgid = (xcd < r ? xcd * (q + 1) : r * (q + 1) + (xcd - r) * q) + off; }
        const int nig = WGM * nN, gid = wgid / nig, fm = gid * WGM, gsz = (nM - fm) < WGM ? (nM - fm) : WGM;
        u.pm = fm + ((wgid % nig) % gsz); u.pn = (wgid % nig) / gsz; u.a = A + (size_t)u.pm * strideA; u.b = B + (size_t)u.pn * strideB; u.rows = nullptr; u.nvalid = 256; u.seg = 0; return true;
    }
};

#define XBAR() do { asm volatile("s_waitcnt lgkmcnt(0)" ::: "memory"); __builtin_amdgcn_s_barrier(); asm volatile("" ::: "memory"); } while (0)

__device__ __forceinline__ void row_allreduce_sum(float (&s)[2][4], int wr, int wc, int fr, int fq, LAS unsigned char* xl) {
    LAS float* P = (LAS float*)xl;
#pragma unroll
    for (int ai = 0; ai < 2; ++ai)
#pragma unroll
        for (int m = 0; m < 4; ++m) { float v = s[ai][m]; v += __shfl_xor(v, 16); v += __shfl_xor(v, 32); if (fq == 0) P[(ai * HALF + wr * 64 + m * 16 + fr) * 4 + wc] = v; }
    XBAR();
#pragma unroll
    for (int ai = 0; ai < 2; ++ai)
#pragma unroll
        for (int m = 0; m < 4; ++m) { const f32x4 p = *(const LAS f32x4*)(P + (ai * HALF + wr * 64 + m * 16 + fr) * 4); s[ai][m] = (p[0] + p[1]) + (p[2] + p[3]); }
    XBAR();
}
__device__ __forceinline__ void row_allreduce_sum2(float (&s)[2][4], float (&t)[2][4], int wr, int wc, int fr, int fq, LAS unsigned char* xl) {
    LAS f32x2* P = (LAS f32x2*)xl;
#pragma unroll
    for (int ai = 0; ai < 2; ++ai)
#pragma unroll
        for (int m = 0; m < 4; ++m) { float v = s[ai][m], w = t[ai][m]; v += __shfl_xor(v, 16); v += __shfl_xor(v, 32); w += __shfl_xor(w, 16); w += __shfl_xor(w, 32);
            if (fq == 0) P[(ai * HALF + wr * 64 + m * 16 + fr) * 4 + wc] = (f32x2){v, w}; }
    XBAR();
#pragma unroll
    for (int ai = 0; ai < 2; ++ai)
#pragma unroll
        for (int m = 0; m < 4; ++m) { const LAS f32x4* q = (const LAS f32x4*)(P + (ai * HALF + wr * 64 + m * 16 + fr) * 4); const f32x4 a = q[0], b = q[1];
            s[ai][m] = (a[0] + a[2]) + (b[0] + b[2]); t[ai][m] = (a[1] + a[3]) + (b[1] + b[3]); }
    XBAR();
}
__device__ __forceinline__ void row_allreduce_max(float (&s)[2][4], int wr, int wc, int fr, int fq, LAS unsigned char* xl) {
    LAS float* P = (LAS float*)xl;
#pragma unroll
    for (int ai = 0; ai < 2; ++ai)
#pragma unroll
        for (int m = 0; m < 4; ++m) { float v = s[ai][m]; v = fmaxf(v, __shfl_xor(v, 16)); v = fmaxf(v, __shfl_xor(v, 32)); if (fq == 0) P[(ai * HALF + wr * 64 + m * 16 + fr) * 4 + wc] = v; }
    XBAR();
#pragma unroll
    for (int ai = 0; ai < 2; ++ai)
#pragma unroll
        for (int m = 0; m < 4; ++m) { const f32x4 p = *(const LAS f32x4*)(P + (ai * HALF + wr * 64 + m * 16 + fr) * 4); s[ai][m] = fmaxf(fmaxf(p[0], p[1]), fmaxf(p[2], p[3])); }
    XBAR();
}

template <class Epi, class Sched, bool GATHER = false>
__device__ __forceinline__ void gemm_phase(LAS unsigned char* lds, LAS unsigned char* xl, int lda, int ldb, int K, const Sched& S, const Epi& E) {
    const int tid = opaque_tid(), wid = __builtin_amdgcn_readfirstlane(tid >> 6), lane = tid & 63, wr = wid >> 2, wc = wid & 3, fr = lane & 15, fq = lane >> 4;
    asm volatile("" : "+s"(K));
    const int nt = K / BK;
    int sR[2], sC[2];
    unsigned voffA[2], voffB[2];
#pragma unroll
    for (int i = 0; i < 2; ++i) { int R, C; stage_rc(tid * 16 + i * 8192, R, C); const int Rb = Epi::PERM ? ((R & ~31) + perm32(R & 31)) : R; sR[i] = R; sC[i] = C;
        voffA[i] = (unsigned)(R * lda + C) * 2u; voffB[i] = (unsigned)(Rb * ldb + C) * 2u; }
    const size_t kstep = (size_t)(BK * 2);
    const size_t hstepA = (size_t)HALF * lda * 2, hstepB = (size_t)HALF * ldb * 2;
    const unsigned ldsw = (unsigned)wid * 1024u;
    const int aoff = lds_byte(wr * 64 + fr, fq * 8), boff = lds_byte(wc * 32 + fr, fq * 8);
#define PG8_SA(b, h) (((b) * 2 + (h)) * HTB)
#define PG8_SB(b, h) ((4 + (b) * 2 + (h)) * HTB)
#define PG8_STAGE(bufoff, gbase, voff) do { _Pragma("unroll") for (int _i = 0; _i < 2; ++_i) \
        __builtin_amdgcn_global_load_lds((const unsigned*)((const char*)(gbase) + (voff)[_i]), (LAS unsigned*)(lds + (bufoff) + ldsw + _i * 8192), 16, 0, 0); } while (0)
#define PG8_LDA(dst, b, h) do { _Pragma("unroll") for (int m = 0; m < 4; ++m) _Pragma("unroll") for (int k = 0; k < 2; ++k) dst[m][k] = *(const LAS bf16x8*)(lds + PG8_SA(b, h) + aoff + m * 2048 + k * 1024); } while (0)
#define PG8_LDB(dst, b, h) do { _Pragma("unroll") for (int n = 0; n < 2; ++n) _Pragma("unroll") for (int k = 0; k < 2; ++k) dst[n][k] = *(const LAS bf16x8*)(lds + PG8_SB(b, h) + boff + n * 2048 + k * 1024); } while (0)
#define PG8_MMA(ai, bj, At, Bt) do { __builtin_amdgcn_s_setprio(1); _Pragma("unroll") for (int m = 0; m < 4; ++m) _Pragma("unroll") for (int n = 0; n < 2; ++n) _Pragma("unroll") for (int k = 0; k < 2; ++k) \
        acc[ai][bj][m][n] = __builtin_amdgcn_mfma_f32_16x16x32_bf16(Bt[n][k], At[m][k], acc[ai][bj][m][n], 0, 0, 0); __builtin_amdgcn_s_setprio(0); } while (0)
#define PG8_WAIT_V(n) asm volatile("s_waitcnt vmcnt(" #n ")" ::: "memory")
#define PG8_WAIT_L(n) asm volatile("s_waitcnt lgkmcnt(" #n ")" ::: "memory")
#define PG8_BAR __builtin_amdgcn_s_barrier()
#define PG8_SCHED __builtin_amdgcn_sched_barrier(0)
    LAS unsigned char* gl = xl + 8192 + tid * 16;
    int gA0 = 0, gA1 = 8192;
#define PG8_GATH(T, u) do { u32x4 _o; { int _r[4]; _Pragma("unroll") for (int _q = 0; _q < 4; ++_q) { const int _rl = (_q >> 1) * HALF + sR[_q & 1]; _r[_q] = (_rl < (u).nvalid) ? (u).rows[_rl] : 0; } \
        _Pragma("unroll") for (int _q = 0; _q < 4; ++_q) _o[_q] = (unsigned)(_r[_q] * lda + sC[_q & 1]) * 2u; } *(LAS u32x4*)(gl + (T)) = _o; } while (0)
#define PG8_STAGE_A(bufoff, base, h, kbytes, G4) do { if constexpr (GATHER) { const u32x2 _g = {(G4)[2 * (h)], (G4)[2 * (h) + 1]}; PG8_STAGE(bufoff, (base) + (kbytes), _g); } else { PG8_STAGE(bufoff, (base) + (size_t)(h) * hstepA + (kbytes), voffA); } } while (0)
    Unit cur, nxt; int ui = 0;
    cur.half = -1; nxt.half = -1;
    if (!S.next(0, cur)) return;
    f32x4 acc[2][2][4][2];
#pragma unroll
    for (int a = 0; a < 2; ++a)
#pragma unroll
        for (int b = 0; b < 2; ++b)
#pragma unroll
            for (int m = 0; m < 4; ++m)
#pragma unroll
                for (int n = 0; n < 2; ++n) acc[a][b][m][n] = (f32x4){0.f, 0.f, 0.f, 0.f};
    bf16x8 At[4][2], B0[2][2], B1[2][2];
    const char* cA = cur.a; const char* cB = cur.b;
    u32x4 gcur = {0u, 0u, 0u, 0u};
    if constexpr (GATHER) { PG8_GATH(gA0, cur); gcur = *(const LAS u32x4*)(gl + gA0); }
    PG8_STAGE(PG8_SB(0, 0), cB, voffB); PG8_STAGE(PG8_SB(0, 1), cB + hstepB, voffB); PG8_STAGE_A(PG8_SA(0, 0), cA, 0, 0, gcur); PG8_STAGE_A(PG8_SA(0, 1), cA, 1, 0, gcur);
    if (wr == 1) PG8_BAR;
    PG8_WAIT_V(2); PG8_BAR;
    PG8_STAGE(PG8_SB(1, 0), cB + kstep, voffB); PG8_STAGE_A(PG8_SA(1, 0), cA, 0, kstep, gcur); PG8_STAGE(PG8_SB(1, 1), cB + hstepB + kstep, voffB);
    PG8_WAIT_V(6); PG8_BAR;
    for (;;) {
        nxt.half = -1;
        const bool has_next = S.next(ui + 1, nxt);
        const int hm = __builtin_amdgcn_readfirstlane(cur.half);
        const char* nA = has_next ? nxt.a : cA; const char* nB = has_next ? nxt.b : cB;
        if constexpr (GATHER) { if (has_next) { PG8_GATH(gA1, nxt); } else { PG8_GATH(gA1, cur); } }
#pragma unroll 1
        for (int t = 0; t < nt; t += 2) {
            const bool last = (t == nt - 2);
            const size_t k1 = (size_t)(t + 1) * kstep;
            const char* a2 = last ? nA : cA; const char* b2 = last ? nB : cB + (size_t)(t + 2) * kstep;
            const size_t ka2 = last ? 0 : (size_t)(t + 2) * kstep;
            const char* b3 = b2 + kstep; const size_t ka3 = ka2 + kstep;
            u32x4 gq = gcur; if constexpr (GATHER) { if (last) gq = *(const LAS u32x4*)(gl + gA1); }
            PG8_LDB(B0, 0, 0); PG8_LDB(B1, 0, 1); PG8_SCHED; PG8_LDA(At, 0, 0); PG8_STAGE_A(PG8_SA(1, 1), cA, 1, k1, gcur);
            PG8_WAIT_V(8); PG8_WAIT_L(0); PG8_BAR; if (hm != 1) { PG8_MMA(0, 0, At, B0); PG8_MMA(0, 1, At, B1); } PG8_BAR; PG8_SCHED;
            PG8_LDA(At, 0, 1); PG8_STAGE(PG8_SB(0, 0), b2, voffB); PG8_STAGE(PG8_SB(0, 1), b2 + hstepB, voffB);
            PG8_STAGE_A(PG8_SA(0, 0), a2, 0, ka2, gq);
            PG8_WAIT_V(8); PG8_WAIT_L(0); PG8_BAR; if (hm != 0) { PG8_MMA(1, 0, At, B0); PG8_MMA(1, 1, At, B1); } PG8_BAR; PG8_SCHED;
            PG8_LDB(B0, 1, 0); PG8_LDB(B1, 1, 1); PG8_SCHED; PG8_LDA(At, 1, 0);
            PG8_STAGE_A(PG8_SA(0, 1), a2, 1, ka2, gq);
            PG8_WAIT_V(8); PG8_WAIT_L(0); PG8_BAR; if (hm != 1) { PG8_MMA(0, 0, At, B0); PG8_MMA(0, 1, At, B1); } PG8_BAR; PG8_SCHED;
            PG8_LDA(At, 1, 1); PG8_STAGE(PG8_SB(1, 0), b3, voffB); PG8_STAGE(PG8_SB(1, 1), b3 + hstepB, voffB);
            PG8_STAGE_A(PG8_SA(1, 0), a2, 0, ka3, gq);
            PG8_WAIT_V(8); PG8_WAIT_L(0); PG8_BAR; if (hm != 0) { PG8_MMA(1, 0, At, B0); PG8_MMA(1, 1, At, B1); } PG8_BAR; PG8_SCHED;
        }
        if (wr == 0) PG8_BAR;
        E(acc, cur, wr, wc, fr, fq, xl);
        if (!has_next) break;
#pragma unroll
        for (int a = 0; a < 2; ++a)
#pragma unroll
            for (int b = 0; b < 2; ++b)
#pragma unroll
                for (int m = 0; m < 4; ++m)
#pragma unroll
                    for (int n = 0; n < 2; ++n) acc[a][b][m][n] = (f32x4){0.f, 0.f, 0.f, 0.f};
        cur = nxt; cA = nA; cB = nB; ++ui;
        if constexpr (GATHER) { gcur = *(const LAS u32x4*)(gl + gA1); const int _t = gA0; gA0 = gA1; gA1 = _t; }
        if (wr == 1) PG8_BAR;
    }
    PG8_WAIT_V(0);
    PG8_BAR;
#undef PG8_SA
#undef PG8_SB
#undef PG8_STAGE
#undef PG8_STAGE_A
#undef PG8_GATH
#undef PG8_LDA
#undef PG8_LDB
#undef PG8_MMA
#undef PG8_WAIT_V
#undef PG8_WAIT_L
#undef PG8_BAR
#undef PG8_SCHED
}
}
namespace fx {
using pg8::Unit; using pg8::cvt_pk_bf16;
constexpr int HALF = 128;
__device__ __forceinline__ u32x4 pack8(const f32x4 a, const f32x4 b) { u32x4 w; w.x = cvt_pk_bf16(a[0], a[1]); w.y = cvt_pk_bf16(a[2], a[3]); w.z = cvt_pk_bf16(b[0], b[1]); w.w = cvt_pk_bf16(b[2], b[3]); return w; }
__device__ __forceinline__ u32x2 pack4(const f32x4 a) { u32x2 w; w.x = cvt_pk_bf16(a[0], a[1]); w.y = cvt_pk_bf16(a[2], a[3]); return w; }
__device__ __forceinline__ float sq4(const f32x4 a) { return (a[0] * a[0] + a[1] * a[1]) + (a[2] * a[2] + a[3] * a[3]); }
__device__ __forceinline__ float quad_sum(float v) { v += __shfl_xor(v, 16); v += __shfl_xor(v, 32); return v; }
__device__ __forceinline__ float gamma_log2(int h) { return __log2f(1.f - exp2f(-5.f - (float)h)); }
__device__ __forceinline__ void rope4(f32x4& a, f32x4& b, const f32x4 cs0, const f32x4 cs1) {
    const f32x4 c = {cs0[0], cs0[2], cs1[0], cs1[2]}, s = {cs0[1], cs0[3], cs1[1], cs1[3]};
    const f32x4 ra = a * c - b * s, rb = b * c + a * s; a = ra; b = rb;
}

__device__ __forceinline__ void sincos4(float ps, const f32x4 inv, f32x4& c, f32x4& s) {
#pragma unroll
    for (int j = 0; j < 4; ++j) { const float ang = ps * inv[j]; const float n = rintf(ang * 0.15915494309189535f); float r = fmaf(-n, 6.2831854820251465f, ang); r = fmaf(-n, -1.7484555e-7f, r);
        c[j] = __cosf(r); s[j] = __sinf(r); }
}
__device__ __forceinline__ f32x4 inv_freq4(int i0, float inv_half) { f32x4 v;
#pragma unroll
    for (int j = 0; j < 4; ++j) v[j] = exp2f(-(float)(i0 + j) * inv_half * 13.287712379549449f);
    return v; }
struct EpiInProj {
    static constexpr bool PERM = false;
    bf16_t *CQ, *CKV, *RQ, *RK, *RV, *RG; float *ssq_cq, *ssq_ckv, *ssq_kpe; const int* pos  ; const float* kg  ;
    __device__ __forceinline__ void operator()(f32x4 (&acc)[2][2][4][2], const Unit& u, int wr, int wc, int fr, int fq, LAS unsigned char*) const {
        asm volatile("" : "+v"(fr), "+v"(fq));
        const int row0 = u.pm * 256 + wr * 64 + fr, pn = u.pn;
        if (pn == 0) {
#pragma unroll
            for (int ai = 0; ai < 2; ++ai)
#pragma unroll
                for (int m = 0; m < 4; ++m) { const int row = row0 + ai * HALF + m * 16; float s = 0.f;
#pragma unroll
                    for (int bj = 0; bj < 2; ++bj) { s += sq4(acc[ai][bj][m][0]) + sq4(acc[ai][bj][m][1]);
                        *(u32x4*)(CQ + (size_t)row * 256 + bj * HALF + wc * 32 + 8 * fq) = pack8(acc[ai][bj][m][0], acc[ai][bj][m][1]); }
                    s = quad_sum(s); if (fq == 0) atomicAdd(ssq_cq + row, s); }
        } else if (pn == 1) {
            const int i0 = 16 * wc + 4 * fq;
            f32x4 g0 = {0.f, 0.f, 0.f, 0.f}, g1 = g0;
            if (wc < 2) { g0 = *(const f32x4*)(kg + 128 + i0); g1 = *(const f32x4*)(kg + 160 + i0); }
#pragma unroll
            for (int ai = 0; ai < 2; ++ai)
#pragma unroll
                for (int m = 0; m < 4; ++m) { const int row = row0 + ai * HALF + m * 16;
                    float s0 = sq4(acc[ai][0][m][0]) + sq4(acc[ai][0][m][1]), s1 = sq4(acc[ai][1][m][0]) + sq4(acc[ai][1][m][1]);
                    *(u32x4*)(CKV + (size_t)row * 256 + wc * 32 + 8 * fq) = pack8(acc[ai][0][m][0], acc[ai][0][m][1]);
                    s0 = quad_sum(s0); s1 = quad_sum(s1);
                    if (fq == 0) { atomicAdd(ssq_ckv + row, s0); if (wc < 2) atomicAdd(ssq_kpe + row, s1); }
                    if (wc < 2) {
                        f32x4 a = acc[ai][1][m][0] * g0, b = acc[ai][1][m][1] * g1;
                        f32x4 cc, ss; sincos4((float)pos[row], inv_freq4(i0, 1.f / 32.f), cc, ss);
                        const f32x4 ra = a * cc - b * ss, rb = b * cc + a * ss;
                        *(u32x2*)(CKV + (size_t)row * 256 + 128 + i0) = pack4(ra); *(u32x2*)(CKV + (size_t)row * 256 + 160 + i0) = pack4(rb);
                    } else {
                        *(u32x4*)(CKV + (size_t)row * 256 + 192 + (wc - 2) * 32 + 8 * fq) = (u32x4){0u, 0u, 0u, 0u};
                    }
                    asm volatile("" ::: "memory"); __builtin_amdgcn_sched_barrier(0); }
        } else if (pn < 6) {
            bf16_t* O = (pn < 4) ? RQ : RK; const float sc = (pn < 4) ? 1.f : 0.08838834764831845f;
            const int head = (pn & 1) * 2 + (wc >> 1), i0 = 8 * ((wc & 1) * 4 + fq);
            const float lgh = ((pn < 4) ? 1.f : -1.f) * gamma_log2(head);
            const f32x4 inv0 = inv_freq4(i0, 1.f / 64.f), inv1 = inv_freq4(i0 + 4, 1.f / 64.f);
#pragma unroll
            for (int ai = 0; ai < 2; ++ai)
#pragma unroll
                for (int m = 0; m < 4; ++m) { const int row = row0 + ai * HALF + m * 16; const float ps = (float)pos[row];
                    f32x4 c0, s0, c1, s1; sincos4(ps, inv0, c0, s0); sincos4(ps, inv1, c1, s1);
                    const float dc = sc * exp2f((float)(row & 127) * lgh);
                    const f32x4 a0 = acc[ai][0][m][0], a1 = acc[ai][0][m][1], b0 = acc[ai][1][m][0], b1 = acc[ai][1][m][1];
                    bf16_t* o = O + (size_t)row * 512 + head * 128 + i0;
                    *(u32x4*)(o) = pack8((a0 * c0 - b0 * s0) * dc, (a1 * c1 - b1 * s1) * dc);
                    *(u32x4*)(o + 64) = pack8((b0 * c0 + a0 * s0) * dc, (b1 * c1 + a1 * s1) * dc);
                    asm volatile("" ::: "memory"); __builtin_amdgcn_sched_barrier(0); }
        } else {
            bf16_t* O = (pn < 8) ? RV : RG;
#pragma unroll
            for (int ai = 0; ai < 2; ++ai)
#pragma unroll
                for (int m = 0; m < 4; ++m) { const int row = row0 + ai * HALF + m * 16;
#pragma unroll
                    for (int bj = 0; bj < 2; ++bj) *(u32x4*)(O + (size_t)row * 512 + (pn & 1) * 256 + bj * HALF + wc * 32 + 8 * fq) = pack8(acc[ai][bj][m][0], acc[ai][bj][m][1]); }
        }
    }
};
__device__ __forceinline__ int inproj_src(int n) {
    const int pn = n >> 8, p = n & 255;
    const int plain = (p & ~31) + pg8::perm32(p & 31);
    if (pn == 0) return plain;
    if (pn == 1) { if (p < 128) return 256 + plain; const int q = p - 128, wc = q >> 5; if (wc >= 2) return -1; return 384 + 32 * ((q >> 4) & 1) + 16 * wc + (q & 15); }
    if (pn < 6) { const int bj = p >> 7, q = p & 127, wc = q >> 5, nn = (q >> 4) & 1, fq = (q >> 2) & 3, j = q & 3; const int d = 64 * bj + 8 * ((wc & 1) * 4 + fq) + 4 * nn + j; return (pn < 4 ? 448 : 960) + ((pn & 1) * 2 + (wc >> 1)) * 128 + d; }
    return (pn < 8 ? 1472 : 1984) + (pn & 1) * 256 + plain;
}

struct EpiMlaQ {
    static constexpr bool PERM = false;
    bf16_t* QM; const float* ssq_cq; const float* qg; const int* pos;
    __device__ __forceinline__ void operator()(f32x4 (&acc)[2][2][4][2], const Unit& u, int wr, int wc, int fr, int fq, LAS unsigned char* xl) const {
        asm volatile("" : "+v"(fr), "+v"(fq));
        const int row0 = u.pm * 256 + wr * 64 + fr, h = u.pn;
        float s[2][4], rsr[2][4];
#pragma unroll
        for (int ai = 0; ai < 2; ++ai)
#pragma unroll
            for (int m = 0; m < 4; ++m) { const int row = row0 + ai * HALF + m * 16; rsr[ai][m] = rsqrtf(ssq_cq[row] * (1.f / 256.f) + EPS);
                s[ai][m] = (sq4(acc[ai][0][m][0]) + sq4(acc[ai][0][m][1]) + sq4(acc[ai][1][m][0]) + sq4(acc[ai][1][m][1])) * rsr[ai][m] * rsr[ai][m]; }
        pg8::row_allreduce_sum(s, wr, wc, fr, fq, xl);
        const int c0 = 32 * wc + 8 * fq, i0 = 16 * wc + 4 * fq;
        const f32x4 gA = *(const f32x4*)(qg + c0), gB = *(const f32x4*)(qg + c0 + 4);
        f32x4 g0 = {0.f, 0.f, 0.f, 0.f}, g1 = g0;
        if (wc < 2) { g0 = *(const f32x4*)(qg + 128 + i0); g1 = *(const f32x4*)(qg + 160 + i0); }
#pragma unroll
        for (int ai = 0; ai < 2; ++ai)
#pragma unroll
            for (int m = 0; m < 4; ++m) { const int row = row0 + ai * HALF + m * 16; const float rq = rsqrtf(s[ai][m] * (1.f / 192.f) + EPS) * rsr[ai][m];
                bf16_t* o = QM + (size_t)row * 768 + h * 192;
                *(u32x4*)(o + c0) = pack8(acc[ai][0][m][0] * rq * gA, acc[ai][0][m][1] * rq * gB);
                if (wc < 2) {
                    const f32x4 a = acc[ai][1][m][0] * rq * g0, b = acc[ai][1][m][1] * rq * g1;
                    f32x4 cc, ss; sincos4((float)pos[row], inv_freq4(i0, 1.f / 32.f), cc, ss);
                    *(u32x2*)(o + 128 + i0) = pack4(a * cc - b * ss); *(u32x2*)(o + 160 + i0) = pack4(b * cc + a * ss);
                }
                asm volatile("" ::: "memory"); __builtin_amdgcn_sched_barrier(0); }
    }
};
__device__ __forceinline__ int mlaq_src(int n) {
    const int h = n >> 8, p = n & 255;
    if (p < 128) return h * 192 + (p & ~31) + pg8::perm32(p & 31);
    const int q = p - 128, wc = q >> 5; if (wc >= 2) return -1;
    return h * 192 + 128 + 32 * ((q >> 4) & 1) + 16 * wc + (q & 15);
}
struct EpiMlaKV {
    static constexpr bool PERM = false;
    bf16_t *KM, *VLAT; const bf16_t* CKV; const float *ssq_ckv, *ssq_kpe, *kg, *gkv  ;
    __device__ __forceinline__ void operator()(f32x4 (&acc)[2][2][4][2], const Unit& u, int wr, int wc, int fr, int fq, LAS unsigned char* xl) const {
        asm volatile("" : "+v"(fr), "+v"(fq));
        const int row0 = u.pm * 256 + wr * 64 + fr;
        float s0[2][4], s1[2][4], rsr[2][4];
#pragma unroll
        for (int ai = 0; ai < 2; ++ai)
#pragma unroll
            for (int m = 0; m < 4; ++m) { const int row = row0 + ai * HALF + m * 16; rsr[ai][m] = rsqrtf(ssq_ckv[row] * (1.f / 128.f) + EPS);
                s0[ai][m] = (sq4(acc[ai][0][m][0]) + sq4(acc[ai][0][m][1])) * rsr[ai][m] * rsr[ai][m];
                s1[ai][m] = (sq4(acc[ai][1][m][0]) + sq4(acc[ai][1][m][1])) * rsr[ai][m] * rsr[ai][m]; }
        pg8::row_allreduce_sum2(s0, s1, wr, wc, fr, fq, xl);
        const int c0 = 32 * wc + 8 * fq, i0 = 16 * wc + 4 * fq;
#pragma unroll
        for (int ai = 0; ai < 2; ++ai)
#pragma unroll
            for (int m = 0; m < 4; ++m) { const int row = row0 + ai * HALF + m * 16; const float rr = rsr[ai][m], kpe2 = ssq_kpe[row];
                const f32x4 gA = *(const f32x4*)(kg + c0), gB = *(const f32x4*)(kg + c0 + 4);
                const u32x2 kp = *(const u32x2*)(CKV + (size_t)row * 256 + 128 + i0);
                const f32x4 kf = {__uint_as_float(kp.x << 16), __uint_as_float(kp.x & 0xffff0000u), __uint_as_float(kp.y << 16), __uint_as_float(kp.y & 0xffff0000u)};
#pragma unroll
                for (int bj = 0; bj < 2; ++bj) { const float rk = rsqrtf(((bj ? s1[ai][m] : s0[ai][m]) + kpe2) * (1.f / 192.f) + EPS);
                    bf16_t* ko = KM + (size_t)row * 768 + (2 * u.pn + bj) * 192;
                    *(u32x4*)(ko + c0) = pack8(acc[ai][bj][m][0] * (rr * rk) * gA, acc[ai][bj][m][1] * (rr * rk) * gB);
                    *(u32x2*)(ko + 128 + i0) = pack4(kf * rk); }
                if (u.pn == 0) {
                    const u32x4 cw = *(const u32x4*)(CKV + (size_t)row * 256 + c0);
                    const f32x4 ca = {__uint_as_float(cw.x << 16), __uint_as_float(cw.x & 0xffff0000u), __uint_as_float(cw.y << 16), __uint_as_float(cw.y & 0xffff0000u)};
                    const f32x4 cb = {__uint_as_float(cw.z << 16), __uint_as_float(cw.z & 0xffff0000u), __uint_as_float(cw.w << 16), __uint_as_float(cw.w & 0xffff0000u)};
                    const f32x4 vA = *(const f32x4*)(gkv + c0), vB = *(const f32x4*)(gkv + c0 + 4);
                    *(u32x4*)(VLAT + (size_t)row * 128 + c0) = pack8(ca * rr * vA, cb * rr * vB); }
                asm volatile("" ::: "memory"); __builtin_amdgcn_sched_barrier(0); }
    }
};
template <bool BASE_BF16, bool WRITE_LO>
struct EpiResid {
    static constexpr bool PERM = true;
    const float* base; bf16_t* xlo; bf16_t* xb; float* ssq;
    __device__ __forceinline__ void operator()(f32x4 (&acc)[2][2][4][2], const Unit& u, int wr, int wc, int fr, int fq, LAS unsigned char*) const {
        asm volatile("" : "+v"(fr), "+v"(fq));
        if (ssq == nullptr) { asm volatile("" :: "v"(acc[0][0][0][0]), "v"(acc[1][1][3][1])); return; }
        const int row0 = u.pm * 256 + wr * 64 + fr, col0 = u.pn * 256 + wc * 32 + 8 * fq;
#pragma unroll
        for (int ai = 0; ai < 2; ++ai)
#pragma unroll
            for (int m = 0; m < 4; ++m) { const int row = row0 + ai * HALF + m * 16; float s = 0.f;
#pragma unroll
                for (int bj = 0; bj < 2; ++bj) { const size_t off = (size_t)row * 1024 + col0 + bj * HALF;
                    f32x4 b0, b1;
                    if constexpr (BASE_BF16) { const u32x4 w = *(const u32x4*)(xb + off);
                        b0 = (f32x4){__uint_as_float(w.x << 16), __uint_as_float(w.x & 0xffff0000u), __uint_as_float(w.y << 16), __uint_as_float(w.y & 0xffff0000u)};
                        b1 = (f32x4){__uint_as_float(w.z << 16), __uint_as_float(w.z & 0xffff0000u), __uint_as_float(w.w << 16), __uint_as_float(w.w & 0xffff0000u)}; }
                    else { b0 = __builtin_nontemporal_load((const f32x4*)(base + off)); b1 = __builtin_nontemporal_load((const f32x4*)(base + off + 4)); }
                    const f32x4 o0 = b0 + acc[ai][bj][m][0], o1 = b1 + acc[ai][bj][m][1];
                    const u32x4 hw = pack8(o0, o1); *(u32x4*)(xb + off) = hw; s += sq4(o0) + sq4(o1);
                    if constexpr (WRITE_LO) {
                        const f32x4 h0 = {__uint_as_float(hw.x << 16), __uint_as_float(hw.x & 0xffff0000u), __uint_as_float(hw.y << 16), __uint_as_float(hw.y & 0xffff0000u)};
                        const f32x4 h1 = {__uint_as_float(hw.z << 16), __uint_as_float(hw.z & 0xffff0000u), __uint_as_float(hw.w << 16), __uint_as_float(hw.w & 0xffff0000u)};
                        *(u32x4*)(xlo + off) = pack8(o0 - h0, o1 - h1); } }
                s = quad_sum(s); if (fq == 0) atomicAdd(ssq + row, s); }
    }
};
struct EpiHeadNorm {
    static constexpr bool PERM = false;
    bf16_t* O; const float* ssq_in  ; const float* g  ; float inv_n_in;
    __device__ __forceinline__ void operator()(f32x4 (&acc)[2][2][4][2], const Unit& u, int wr, int wc, int fr, int fq, LAS unsigned char* xl) const {
        asm volatile("" : "+v"(fr), "+v"(fq));
        const int row0 = u.pm * 256 + wr * 64 + fr, h = u.pn;
        float s[2][4], rsr[2][4];
#pragma unroll
        for (int ai = 0; ai < 2; ++ai)
#pragma unroll
            for (int m = 0; m < 4; ++m) { const int row = row0 + ai * HALF + m * 16; rsr[ai][m] = ssq_in ? rsqrtf(ssq_in[row] * inv_n_in + EPS) : 1.f;
                s[ai][m] = (sq4(acc[ai][0][m][0]) + sq4(acc[ai][0][m][1]) + sq4(acc[ai][1][m][0]) + sq4(acc[ai][1][m][1])) * rsr[ai][m] * rsr[ai][m]; }
        pg8::row_allreduce_sum(s, wr, wc, fr, fq, xl);
        const int c0 = 32 * wc + 8 * fq;
        f32x4 gv[2][2];
#pragma unroll
        for (int bj = 0; bj < 2; ++bj) { gv[bj][0] = *(const f32x4*)(g + bj * HALF + c0); gv[bj][1] = *(const f32x4*)(g + bj * HALF + c0 + 4); }
#pragma unroll
        for (int ai = 0; ai < 2; ++ai)
#pragma unroll
            for (int m = 0; m < 4; ++m) { if (u.half >= 0 && u.half != ai) continue;
                const int row = row0 + ai * HALF + m * 16; const float rq = rsqrtf(s[ai][m] * (1.f / 256.f) + EPS) * rsr[ai][m];
#pragma unroll
                for (int bj = 0; bj < 2; ++bj) *(u32x4*)(O + (size_t)row * 1024 + h * 256 + bj * HALF + c0) = pack8(acc[ai][bj][m][0] * rq * gv[bj][0], acc[ai][bj][m][1] * rq * gv[bj][1]); }
    }
};
struct EpiStoreT {
    static constexpr bool PERM = true;
    bf16_t* O; int ldc; int tile_stride; float scale; int pad;
    __device__ __forceinline__ void operator()(f32x4 (&acc)[2][2][4][2], const Unit& u, int wr, int wc, int fr, int fq, LAS unsigned char*) const {
        asm volatile("" : "+v"(fr), "+v"(fq));
        const int row0 = u.pm * 256 + wr * 64 + fr;
#pragma unroll
        for (int ai = 0; ai < 2; ++ai)
#pragma unroll
            for (int m = 0; m < 4; ++m) { if (u.half >= 0 && u.half != ai) continue;
                const int row = row0 + ai * HALF + m * 16;
#pragma unroll
                for (int bj = 0; bj < 2; ++bj) *(u32x4*)(O + (size_t)u.pn * tile_stride + (size_t)row * ldc + u.seg * 256 + bj * HALF + wc * 32 + 8 * fq) = pack8(acc[ai][bj][m][0] * scale, acc[ai][bj][m][1] * scale); }
    }
};
struct EpiSoftmax {
    static constexpr bool PERM = true;
    bf16_t* PC;
    __device__ __forceinline__ void operator()(f32x4 (&acc)[2][2][4][2], const Unit& u, int wr, int wc, int fr, int fq, LAS unsigned char* xl) const {
        asm volatile("" : "+v"(fr), "+v"(fq));
        const int row0 = u.pm * 256 + wr * 64 + fr, h = u.pn;
        float mx[2][4], sm[2][4];
#pragma unroll
        for (int ai = 0; ai < 2; ++ai)
#pragma unroll
            for (int m = 0; m < 4; ++m) { float v = -3.0e38f;
#pragma unroll
                for (int bj = 0; bj < 2; ++bj)
#pragma unroll
                    for (int n = 0; n < 2; ++n) { const f32x4 a = acc[ai][bj][m][n]; v = fmaxf(v, fmaxf(fmaxf(a[0], a[1]), fmaxf(a[2], a[3]))); }
                mx[ai][m] = v; }
        pg8::row_allreduce_max(mx, wr, wc, fr, fq, xl);
        const float c2 = 0.0625f * 1.4426950408889634f;
#pragma unroll
        for (int ai = 0; ai < 2; ++ai)
#pragma unroll
            for (int m = 0; m < 4; ++m) { float t = 0.f; const float mm = mx[ai][m] * c2;
#pragma unroll
                for (int bj = 0; bj < 2; ++bj)
#pragma unroll
                    for (int n = 0; n < 2; ++n) { f32x4 a = acc[ai][bj][m][n] * c2 - mm;
                        a[0] = __builtin_amdgcn_exp2f(a[0]); a[1] = __builtin_amdgcn_exp2f(a[1]); a[2] = __builtin_amdgcn_exp2f(a[2]); a[3] = __builtin_amdgcn_exp2f(a[3]);
                        acc[ai][bj][m][n] = a; t += (a[0] + a[1]) + (a[2] + a[3]); }
                sm[ai][m] = t; }
        pg8::row_allreduce_sum(sm, wr, wc, fr, fq, xl);
#pragma unroll
        for (int ai = 0; ai < 2; ++ai)
#pragma unroll
            for (int m = 0; m < 4; ++m) { const int row = row0 + ai * HALF + m * 16; const float il = 1.f / sm[ai][m];
#pragma unroll
                for (int bj = 0; bj < 2; ++bj) *(u32x4*)(PC + (size_t)row * 1024 + h * 256 + bj * HALF + wc * 32 + 8 * fq) = pack8(acc[ai][bj][m][0] * il, acc[ai][bj][m][1] * il); }
    }
};
struct EpiStoreBf16 {
    static constexpr bool PERM = true;
    bf16_t* O; int ldc; int pad;
    __device__ __forceinline__ void operator()(f32x4 (&acc)[2][2][4][2], const Unit& u, int wr, int wc, int fr, int fq, LAS unsigned char*) const {
        asm volatile("" : "+v"(fr), "+v"(fq));
        const int row0 = u.pm * 256 + wr * 64 + fr;
#pragma unroll
        for (int ai = 0; ai < 2; ++ai)
#pragma unroll
            for (int m = 0; m < 4; ++m) { const int row = row0 + ai * HALF + m * 16;
#pragma unroll
                for (int bj = 0; bj < 2; ++bj) *(u32x4*)(O + (size_t)row * ldc + u.pn * 256 + bj * HALF + wc * 32 + 8 * fq) = pack8(acc[ai][bj][m][0], acc[ai][bj][m][1]); }
    }
};
struct HeadOrder {
    int G, c, nunits; const char* A; const char* B; size_t strideA, a_h, b_b, b_h;
    __device__ __forceinline__ bool next(int i, Unit& u) const {
        int L;
        if (G == 256) { const int xcd = c & 7, uu = (c >> 3) + 32 * i; if (uu >= 64) return false; L = xcd * 64 + uu; }
        else { const long LL = (long)i * G + c; if (LL >= nunits) return false; L = (int)LL; }
        u.pm = L >> 2; u.pn = L & 3; const int b = u.pm >> 4;
        u.a = A + (size_t)u.pm * strideA + (size_t)u.pn * a_h; u.b = B + (size_t)b * b_b + (size_t)u.pn * b_h; u.rows = nullptr; u.nvalid = 256; u.seg = 0; return true;
    }
};
constexpr int MOE_CAP = 32768;
struct MoeOrder {
    int G, c, seg_lo, seg_hi, ntn; const int* cnt; const int* lists; const char* A; const char* B; size_t a_tile  , b_exp  , b_tile  ;
    LAS int* tab;
    __device__ __forceinline__ void init(LAS unsigned char* xl) {
        tab = (LAS int*)(xl + 4096);
        if (threadIdx.x < 64) { const int n = __hip_atomic_load(cnt + threadIdx.x, __ATOMIC_RELAXED, __HIP_MEMORY_SCOPE_AGENT); int t = (n + 255) >> 8, incl = t;
#pragma unroll
            for (int o = 1; o < 64; o <<= 1) { const int v = __shfl_up(incl, o); if ((int)threadIdx.x >= o) incl += v; }
            tab[threadIdx.x + 1] = incl; tab[65 + threadIdx.x] = n; if (threadIdx.x == 0) tab[0] = 0; }
        asm volatile("s_waitcnt lgkmcnt(0)" ::: "memory"); __syncthreads();
    }
    __device__ __forceinline__ bool next(int i, Unit& u) const {
        const int gbase = tab[seg_lo], ntl = tab[seg_hi] - gbase;
        int rt, pn, half = -1;
        if ((G & 7) == 0) { const int per = (ntl + 7) >> 3, xcd = c & 7, cux = G >> 3, k = c >> 3;
            int mine = ntl - xcd * per; mine = mine < 0 ? 0 : (mine > per ? per : mine);
            const int nu = mine * ntn, full = nu / cux, rem = nu - full * cux;
            int uu;
            if (i < full) uu = k + cux * i;
            else if (i == full && rem > 0) { if (2 * rem <= cux) { if (k >= 2 * rem) return false; uu = full * cux + (k >> 1); half = k & 1; }
                                             else { if (k >= rem) return false; uu = full * cux + k; } }
            else return false;
            rt = xcd * per + uu / ntn; pn = uu % ntn; }
        else { const long L = (long)i * G + c; rt = (int)(L / ntn); pn = (int)(L % ntn); }
        if (rt >= ntl) return false;
        const int rtg = gbase + rt;
        const int lane = threadIdx.x & 63;
        const int sgm = __builtin_popcountll(__ballot(rtg >= tab[lane + 1]));
        const int j = rtg - tab[sgm], n = tab[65 + sgm];
        u.pm = rtg; u.pn = pn; u.seg = sgm; u.half = half; u.nvalid = (n - j * 256) < 256 ? (n - j * 256) : 256; u.rows = lists + (size_t)sgm * MOE_CAP + j * 256;
        u.a = A + (size_t)u.pm * a_tile; u.b = B + (size_t)(sgm & 31) * b_exp + (size_t)pn * b_tile; return true;
    }
};
struct EpiGlu {
    static constexpr bool PERM = false;
    bf16_t* H; const float* rsr  ; const float* roww  ; const int* lists0;
    __device__ __forceinline__ void operator()(f32x4 (&acc)[2][2][4][2], const Unit& u, int wr, int wc, int fr, int fq, LAS unsigned char*) const {
        asm volatile("" : "+v"(fr), "+v"(fq));
        if (H == nullptr) { asm volatile("" :: "v"(acc[0][0][0][0]), "v"(acc[1][1][3][1])); return; }
#pragma unroll
        for (int ai = 0; ai < 2; ++ai)
#pragma unroll
            for (int m = 0; m < 4; ++m) { if (u.half >= 0 && u.half != ai) continue;
                const int rl = ai * HALF + wr * 64 + m * 16 + fr; const bool valid = rl < u.nvalid;
                const long slot = (u.rows + rl) - lists0;
                const float wgt = valid ? roww[slot] : 0.f;
                const float rs = valid ? rsr[slot] : 0.f;
                f32x4 hv[2];
#pragma unroll
                for (int n = 0; n < 2; ++n) { const f32x4 a = acc[ai][0][m][n] * rs, uu = acc[ai][1][m][n] * rs; f32x4 r;
#pragma unroll
                    for (int j = 0; j < 4; ++j) r[j] = a[j] * __builtin_amdgcn_rcpf(1.f + __expf(-a[j])) * uu[j] * wgt;
                    hv[n] = r; }
                *(u32x4*)(H + ((size_t)u.pm * 256 + rl) * 256 + u.pn * 128 + wc * 32 + 8 * fq) = pack8(hv[0], hv[1]); }
    }
};
template <int SLOT>
struct EpiScatter {
    static constexpr bool PERM = true;
    float* out; bf16_t* xb;
    __device__ __forceinline__ void operator()(f32x4 (&acc)[2][2][4][2], const Unit& u, int wr, int wc, int fr, int fq, LAS unsigned char*) const {
        asm volatile("" : "+v"(fr), "+v"(fq));
        const int col0 = u.pn * 256 + wc * 32 + 8 * fq;
#pragma unroll
        for (int ai = 0; ai < 2; ++ai)
#pragma unroll
            for (int m = 0; m < 4; ++m) { const int rl = ai * HALF + wr * 64 + m * 16 + fr;
                if (rl < u.nvalid && (u.half < 0 || u.half == ai)) { const int tok = u.rows[rl]; const size_t o = (size_t)tok * 1024 + col0;
#pragma unroll
                    for (int bj = 0; bj < 2; ++bj) { const size_t oo = o + bj * HALF;
                        const u32x4 w = *(const u32x4*)(xb + oo);
                        const f32x4 o0 = (f32x4){__uint_as_float(w.x << 16), __uint_as_float(w.x & 0xffff0000u), __uint_as_float(w.y << 16), __uint_as_float(w.y & 0xffff0000u)} + acc[ai][bj][m][0];
                        const f32x4 o1 = (f32x4){__uint_as_float(w.z << 16), __uint_as_float(w.z & 0xffff0000u), __uint_as_float(w.w << 16), __uint_as_float(w.w & 0xffff0000u)} + acc[ai][bj][m][1];
                        if constexpr (SLOT == 0) { *(u32x4*)(xb + oo) = pack8(o0, o1); }
                        else { f32x4* q = (f32x4*)(out + oo); q[0] = o0; q[1] = o1; } } } }
    }
};

struct MemKVOrder {
    int G, c; const char* MB; const char* W;
    __device__ __forceinline__ bool next(int i, Unit& u) const {
        long L = (long)i * G + c;
        if (G >= 128) { if (L >= 128) return false; u.half = (int)(L & 1); L >>= 1; }
        else if (L >= 64) return false;
        const int r = (int)L & 31; u.rows = nullptr; u.nvalid = 256;
        if (L < 32) { u.seg = 0; u.pm = r >> 2; u.pn = r & 3; u.a = MB + (size_t)u.pm * 256 * 2048; u.b = W + (size_t)u.pn * 256 * 2048; }
        else { u.seg = 1; u.pm = r >> 2; u.pn = r & 3; u.a = MB + (size_t)u.pm * 256 * 2048; u.b = W + (size_t)(1024 + u.pn * 256) * 2048; }
        return true;
    }
};
struct EpiMemKV {
    static constexpr bool PERM = false;
    bf16_t* KC; bf16_t* VC; const float* g;
    __device__ __forceinline__ void operator()(f32x4 (&acc)[2][2][4][2], const Unit& u, int wr, int wc, int fr, int fq, LAS unsigned char* xl) const {
        if (u.seg == 0) { EpiHeadNorm e{KC, nullptr, g, 0.f}; e(acc, u, wr, wc, fr, fq, xl); return; }
        asm volatile("" : "+v"(fr), "+v"(fq));
        const int row0 = u.pm * 256 + wr * 64 + fr;
#pragma unroll
        for (int ai = 0; ai < 2; ++ai)
#pragma unroll
            for (int m = 0; m < 4; ++m) { if (u.half >= 0 && u.half != ai) continue;
                const int row = row0 + ai * HALF + m * 16;
#pragma unroll
                for (int bj = 0; bj < 2; ++bj)
#pragma unroll
                    for (int n = 0; n < 2; ++n) *(u32x2*)(VC + (size_t)row * 1024 + u.pn * 256 + bj * HALF + wc * 32 + n * 16 + 4 * fq) = pack4(acc[ai][bj][m][n]); }
    }
};
struct VwOrder {
    int G, c; const char* WO; const char* VC;
    __device__ __forceinline__ bool next(int i, Unit& u) const {
        long L = (long)i * G + c;
        if (G >= 256) { if (L >= 256) return false; u.half = (int)(L & 1); L >>= 1; } else if (L >= 128) return false;
        u.seg = (int)L & 3; u.pn = ((int)L >> 2) & 7; u.pm = (int)L >> 5; u.rows = nullptr; u.nvalid = 256;
        u.a = WO + (size_t)u.pm * 256 * 2048 + (size_t)u.seg * 512; u.b = VC + (size_t)u.pn * 256 * 2048 + (size_t)u.seg * 512; return true;
    }
};
struct QupOrder {
    pg8::GridOrder g;
    __device__ __forceinline__ bool next(int i, Unit& u) const {
        if (g.G != 256) return g.next(i, u);
        if (g.c < 128) return i < 3 ? g.at(128 + g.c * 3 + i, u) : false;
        return i < 1 ? g.at(g.c - 128, u) : false;
    }
};
struct CrossOOrder {
    pg8::GridOrder g; const char* VWT;
    __device__ __forceinline__ bool next(int i, Unit& u) const {
        if (!g.next(i, u)) return false;
        u.b = VWT + (size_t)(u.pm >> 4) * ((size_t)1024 * 2048) + (size_t)u.pn * 256 * 2048; return true;
    }
};
}
namespace at {
typedef float f32x16 __attribute__((ext_vector_type(16)));
typedef short s16x4 __attribute__((ext_vector_type(4)));
constexpr int NW = 8, QBLK = 32, KVBLK = 64, QB = 256;
constexpr int KROW = 400;
constexpr int SHM_V = KVBLK * 128 * 2, SHM_K = KVBLK * KROW;
constexpr int LDS_V = 0, LDS_K = 2 * SHM_V, LDS_WS = LDS_K + 2 * SHM_K, LDS_BYTES = LDS_WS + NW * 64 * 4;
constexpr float SCALE = 0.07216878364870322f;
constexpr float THR = 8.f;
#define SBAR() __builtin_amdgcn_sched_barrier(0)
__device__ __forceinline__ int v_st(int k, int c) { const int kk = (k & ~0xC) | ((k & 4) << 1) | ((k & 8) >> 1); return ((kk >> 3) * 4 + (c >> 5)) * 512 + ((kk & 7) * 32 + (c & 31)) * 2; }
__device__ __forceinline__ int v_rd_base(int lane) { return ((lane & 3) << 3) | (((lane >> 2) & 3) << 6) | (((lane >> 4) & 1) << 5) | (((lane >> 5) & 1) << 8); }
constexpr int v_rd_off(int d0, int ks, int half) { return d0 * 512 + ks * 4096 + half * 2048; }
__device__ __forceinline__ int crow(int r, int hi) { return (r & 3) + 8 * (r >> 2) + 4 * hi; }
__device__ __forceinline__ unsigned cvtpk(float lo, float hi) { unsigned r; asm volatile("v_cvt_pk_bf16_f32 %0, %1, %2" : "=v"(r) : "v"(lo), "v"(hi)); return r; }
__device__ __forceinline__ void mask_tile(f32x16& p0, f32x16& p1, int dq) {
    const float NEG = -__builtin_inff();
#pragma unroll
    for (int r = 0; r < 16; ++r) {
        const int c = (r & 3) + 8 * (r >> 2);
        if (dq - c < 0) p0[r] = NEG;
        if (dq - c - 32 < 0) p1[r] = NEG;
    }
}
__device__ __forceinline__ void partialSM(f32x16& p0, f32x16& p1, float& m_reg, float& mn, float& alpha) {
    float pmax = p0[0];
#pragma unroll
    for (int r = 1; r < 16; ++r) pmax = fmaxf(pmax, p0[r]);
#pragma unroll
    for (int r = 0; r < 16; ++r) pmax = fmaxf(pmax, p1[r]);
    { auto rr = __builtin_amdgcn_permlane32_swap(__float_as_uint(pmax), __float_as_uint(pmax), false, false);
      pmax = fmaxf(__uint_as_float(rr[0]), __uint_as_float(rr[1])); }
    constexpr float C2 = 1.4426950408889634f * SCALE;
    if (__builtin_expect(__all((pmax - m_reg) * SCALE <= THR), 1)) { mn = m_reg; alpha = 1.f; }
    else { mn = fmaxf(m_reg, pmax); alpha = __builtin_amdgcn_exp2f((m_reg - mn) * C2); m_reg = mn; }
    const float mnL = -mn * C2;
#pragma unroll
    for (int r = 0; r < 16; ++r) p0[r] = fmaf(p0[r], C2, mnL);
#pragma unroll
    for (int r = 0; r < 16; ++r) p1[r] = fmaf(p1[r], C2, mnL);
#pragma unroll
    for (int r = 0; r < 16; ++r) p0[r] = __builtin_amdgcn_exp2f(p0[r]);
}
__device__ __forceinline__ void finishSM(f32x16& p0, f32x16& p1, float alpha, float& l_reg, bf16x8& pa0, bf16x8& pa1, bf16x8& pa2, bf16x8& pa3) {
#pragma unroll
    for (int r = 0; r < 16; ++r) p1[r] = __builtin_amdgcn_exp2f(p1[r]);
    float ps = 0;
#pragma unroll
    for (int r = 0; r < 16; ++r) ps += p0[r];
#pragma unroll
    for (int r = 0; r < 16; ++r) ps += p1[r];
    { auto rr = __builtin_amdgcn_permlane32_swap(__float_as_uint(ps), __float_as_uint(ps), false, false);
      ps = __uint_as_float(rr[0]) + __uint_as_float(rr[1]); }
    l_reg = l_reg * alpha + ps;
#define PK4(P, B_, OUT) do { unsigned a0 = cvtpk(P[B_+0], P[B_+1]), a1 = cvtpk(P[B_+2], P[B_+3]);                          \
        unsigned b0 = cvtpk(P[B_+4], P[B_+5]), b1 = cvtpk(P[B_+6], P[B_+7]);                                             \
        auto r0 = __builtin_amdgcn_permlane32_swap(a0, b0, false, false); auto r1 = __builtin_amdgcn_permlane32_swap(a1, b1, false, false); \
        u32x4 w = {r0[0], r1[0], r0[1], r1[1]}; OUT = *reinterpret_cast<bf16x8*>(&w); } while (0)
    PK4(p0, 0, pa0); PK4(p0, 8, pa1); PK4(p1, 0, pa2); PK4(p1, 8, pa3);
#undef PK4
}
template <int KB>
__device__ __forceinline__ void qkt(f32x16& p0, f32x16& p1, const char* K_lds, int r32, int hi, const bf16x8* qr) {
    p0 = f32x16{}; p1 = f32x16{};
    const char* kb = K_lds + KB * SHM_K + r32 * KROW + hi * 16;
#pragma unroll
    for (int d0 = 0; d0 < 12; ++d0) {
        const bf16x8 b0 = *reinterpret_cast<const bf16x8*>(kb + d0 * 32);
        const bf16x8 b1 = *reinterpret_cast<const bf16x8*>(kb + 32 * KROW + d0 * 32);
        p0 = __builtin_amdgcn_mfma_f32_32x32x16_bf16(b0, qr[d0], p0, 0, 0, 0);
        p1 = __builtin_amdgcn_mfma_f32_32x32x16_bf16(b1, qr[d0], p1, 0, 0, 0);
    }
}
template <int VB>
__device__ __forceinline__ void pv_tile(f32x16* o, int vb0, bf16x8 pa0, bf16x8 pa1, bf16x8 pa2, bf16x8 pa3) {
#define TRRD(dst, off) asm volatile("ds_read_b64_tr_b16 %0, %1 offset:%2" : "=&v"(dst) : "v"(vb0), "i"(off) : "memory")
#define PV_RD(S, d0) do { constexpr int b_ = VB * SHM_V + v_rd_off(d0, 0, 0);   \
        TRRD(S##l0, b_); TRRD(S##h0, b_ + 2048); TRRD(S##l1, b_ + 4096); TRRD(S##h1, b_ + 6144); TRRD(S##l2, b_ + 8192); TRRD(S##h2, b_ + 10240); TRRD(S##l3, b_ + 12288); TRRD(S##h3, b_ + 14336); } while (0)
#define PV_MM(S, d0) do {   \
        o[d0] = __builtin_amdgcn_mfma_f32_32x32x16_bf16(pa0, (bf16x8){S##l0[0], S##l0[1], S##l0[2], S##l0[3], S##h0[0], S##h0[1], S##h0[2], S##h0[3]}, o[d0], 0, 0, 0);   \
        o[d0] = __builtin_amdgcn_mfma_f32_32x32x16_bf16(pa1, (bf16x8){S##l1[0], S##l1[1], S##l1[2], S##l1[3], S##h1[0], S##h1[1], S##h1[2], S##h1[3]}, o[d0], 0, 0, 0);   \
        o[d0] = __builtin_amdgcn_mfma_f32_32x32x16_bf16(pa2, (bf16x8){S##l2[0], S##l2[1], S##l2[2], S##l2[3], S##h2[0], S##h2[1], S##h2[2], S##h2[3]}, o[d0], 0, 0, 0);   \
        o[d0] = __builtin_amdgcn_mfma_f32_32x32x16_bf16(pa3, (bf16x8){S##l3[0], S##l3[1], S##l3[2], S##l3[3], S##h3[0], S##h3[1], S##h3[2], S##h3[3]}, o[d0], 0, 0, 0); } while (0)
#define PV_W(n) do { asm volatile("s_waitcnt lgkmcnt(" #n ")" ::: "memory"); SBAR(); } while (0)
    s16x4 xl0, xl1, xl2, xl3, xh0, xh1, xh2, xh3, yl0, yl1, yl2, yl3, yh0, yh1, yh2, yh3;
    asm volatile("s_waitcnt lgkmcnt(0)" ::: "memory");
    PV_RD(x, 0); PV_RD(y, 1); PV_W(8); PV_MM(x, 0); SBAR();
    PV_RD(x, 2); PV_W(8); PV_MM(y, 1); SBAR();
    PV_RD(y, 3); PV_W(8); PV_MM(x, 2); SBAR();
    PV_W(0); PV_MM(y, 3);
#undef PV_RD
#undef PV_MM
#undef PV_W
#undef TRRD
}

__device__ __forceinline__ void attn_block(const bf16_t* Q, const bf16_t* K, const bf16_t* V, bf16_t* O, size_t tb, int h, int P0, char* lds) {
    const int tid = opaque_tid(), wid = __builtin_amdgcn_readfirstlane(tid >> 6), lane = tid & 63, r32 = lane & 31, hi = lane >> 5;
    const int NT = (P0 + QB) / KVBLK;
    const int qlo = P0 + wid * QBLK, qm = qlo + r32 - 4 * hi;
    char* V_lds = lds + LDS_V; char* K_lds = lds + LDS_K;
    float* ws = (float*)(lds + LDS_WS) + wid * 64; float* li_l = ws, * al_l = ws + 32;
    float m_reg = -1e30f, l_reg = 0; f32x16 o[4] = {};
    const bf16_t* Kh = K + tb * 768 + h * 192; const bf16_t* Vh = V + tb * 128;
    const int sr = tid >> 4, sc = (tid & 15) * 8, vst0 = v_st(sr, sc), vst1 = v_st(32 + sr, sc);
    const int kgo = (tid >> 3) * 768 + (tid & 7) * 8, klo = (tid >> 3) * KROW + (tid & 7) * 16;
    const int vb0 = (int)(uintptr_t)V_lds + v_rd_base(lane);
    bf16x8 st_k0, st_k1, st_k2, st_v0, st_v1;
#define VMW() asm volatile("s_waitcnt vmcnt(0)" ::: "memory")
#define SLOAD(k0) do { const bf16_t* kp_ = Kh + (size_t)(k0) * 768 + kgo; st_k0 = *(const bf16x8*)(kp_); st_k1 = *(const bf16x8*)(kp_ + 64); st_k2 = *(const bf16x8*)(kp_ + 128); \
        st_v0 = *(const bf16x8*)(Vh + (size_t)((k0) + sr) * 128 + sc); st_v1 = *(const bf16x8*)(Vh + (size_t)((k0) + 32 + sr) * 128 + sc); } while (0)
#define SWRITE(bf) do { char* kw_ = K_lds + (bf) * SHM_K + klo; *(bf16x8*)(kw_) = st_k0; *(bf16x8*)(kw_ + 128) = st_k1; *(bf16x8*)(kw_ + 256) = st_k2; \
        *(bf16x8*)(V_lds + (bf) * SHM_V + vst0) = st_v0; *(bf16x8*)(V_lds + (bf) * SHM_V + vst1) = st_v1; } while (0)
#define RESC(a) do { if (__any((a) < 1.f)) { if (hi == 0) al_l[r32] = (a); asm volatile("s_waitcnt lgkmcnt(0)" ::: "memory");              \
                     for (int d_ = 0; d_ < 4; ++d_) for (int r = 0; r < 16; ++r) o[d_][r] *= al_l[crow(r, hi)]; } } while (0)
#define KBASE(t) ((t) * KVBLK)
#define MASKT(P0_, P1_, t) do { const int kb_ = KBASE(t); if (kb_ + KVBLK - 1 > qlo) mask_tile(P0_, P1_, qm - kb_); } while (0)
    bf16x8 qr[12];
    { const bf16_t* Qw = Q + (tb + qlo + r32) * 768 + h * 192 + hi * 8;
#pragma unroll
      for (int d0 = 0; d0 < 12; ++d0) qr[d0] = *(const bf16x8*)(Qw + d0 * 16); }
    SLOAD(0); VMW(); SWRITE(0);
    __syncthreads();
    f32x16 p0, p1; float mn, al; bf16x8 pa0, pa1, pa2, pa3;
#define TILE_STEP(t, BUF) do {                                                                   \
        if ((t) + 1 < NT) { SLOAD(KBASE((t) + 1)); }                                              \
        SBAR(); qkt<BUF>(p0, p1, K_lds, r32, hi, qr);                                             \
        MASKT(p0, p1, (t)); partialSM(p0, p1, m_reg, mn, al); RESC(al);                           \
        finishSM(p0, p1, al, l_reg, pa0, pa1, pa2, pa3); SBAR();                                  \
        pv_tile<BUF>(o, vb0, pa0, pa1, pa2, pa3);                                                 \
        if ((t) + 1 < NT) { VMW(); SWRITE(1 - BUF); }                                             \
        __syncthreads(); } while (0)
    for (int t = 0; t < NT; t += 2) { TILE_STEP(t, 0); TILE_STEP(t + 1, 1); }
    if (hi == 0) li_l[r32] = l_reg; asm volatile("s_waitcnt lgkmcnt(0)" ::: "memory");
    float rli[16];
#pragma unroll
    for (int r = 0; r < 16; ++r) rli[r] = __builtin_amdgcn_rcpf(li_l[crow(r, hi)]);
    bf16_t* Ow = O + (tb + qlo) * 1024 + h * 128;
#pragma unroll
    for (int r = 0; r < 16; ++r) { const int orow = crow(r, hi);
#pragma unroll
        for (int d0 = 0; d0 < 4; ++d0) { const float v = o[d0][r] * rli[r];
            const float vn = __shfl_xor(v, 1);
            if ((r32 & 1) == 0) *(unsigned*)(Ow + (size_t)orow * 1024 + d0 * 32 + r32) = cvtpk(v, vn); } }
#undef VMW
#undef SLOAD
#undef SWRITE
#undef RESC
#undef KBASE
#undef MASKT
#undef TILE_STEP
}

#undef SBAR

__device__ __forceinline__ void attn_phase(const bf16_t* Q, const bf16_t* K, const bf16_t* V, bf16_t* O, char* lds) {
    for (int L = blockIdx.x; L < 256; L += gridDim.x) {
        const int xcd = L & 7, k = L >> 3, bh = (k >> 3) * 8 + xcd, x = k & 7;
        const int b = bh >> 2, h = bh & 3; const size_t tb = (size_t)b * 4096;
        attn_block(Q, K, V, O, tb, h, (15 - x) * QB, lds);
        attn_block(Q, K, V, O, tb, h, x * QB, lds);
    }
}
}
namespace rt {
using at::f32x16; using at::s16x4; using at::v_st; using at::v_rd_base; using at::v_rd_off; using at::crow; using at::cvtpk;
constexpr int PITCH = 272;
constexpr int L_Q = 0, L_K = 128 * PITCH, L_V = 2 * 128 * PITCH, L_S = L_V + 32768, L_END = L_S + 128 * PITCH;
#define TRRD(dst, base, off) asm volatile("ds_read_b64_tr_b16 %0, %1 offset:%2" : "=&v"(dst) : "v"(base), "i"(off) : "memory")
#define FRAG(l, h) ((bf16x8){l[0], l[1], l[2], l[3], h[0], h[1], h[2], h[3]})
using fx::gamma_log2;

__device__ __forceinline__ void ret_kv_unit(const bf16_t* RK, const bf16_t* RV, bf16_t* KVS, int bh, int c, char* lds) {
    const int tid = opaque_tid(), wid = __builtin_amdgcn_readfirstlane(tid >> 6), lane = tid & 63, r32 = lane & 31, hi = lane >> 5;
    const int b = bh >> 2, h = bh & 3; const size_t t0 = (size_t)b * 4096 + (size_t)c * 128;
    char* Kl = lds; char* Vl = lds + 32768;
#pragma unroll
    for (int i = 0; i < 4; ++i) { const int q = tid + 512 * i, row = q >> 4, cc = (q & 15) * 8; const int lo = (row >> 6) * 16384 + v_st(row & 63, cc);
        *(bf16x8*)(Kl + lo) = *(const bf16x8*)(RK + (t0 + row) * 512 + h * 128 + cc);
        *(bf16x8*)(Vl + lo) = *(const bf16x8*)(RV + (t0 + row) * 512 + h * 128 + cc); }
    __syncthreads();
    const int dvb = wid >> 1, dkb = 2 * (wid & 1);
    const int vbase = (int)(uintptr_t)Vl + v_rd_base(lane) + dvb * 512, kbase = (int)(uintptr_t)Kl + v_rd_base(lane) + dkb * 512;
    f32x16 acc0 = {}, acc1 = {};
#define KVSTEP(sub, ks) do { s16x4 al, ah, b0l, b0h, b1l, b1h; constexpr int o_ = (sub) * 16384 + v_rd_off(0, ks, 0);   \
        TRRD(al, vbase, o_); TRRD(ah, vbase, o_ + 2048); TRRD(b0l, kbase, o_); TRRD(b0h, kbase, o_ + 2048); TRRD(b1l, kbase, o_ + 512); TRRD(b1h, kbase, o_ + 512 + 2048); \
        asm volatile("s_waitcnt lgkmcnt(0)" ::: "memory"); __builtin_amdgcn_sched_barrier(0);   \
        acc0 = __builtin_amdgcn_mfma_f32_32x32x16_bf16(FRAG(al, ah), FRAG(b0l, b0h), acc0, 0, 0, 0);   \
        acc1 = __builtin_amdgcn_mfma_f32_32x32x16_bf16(FRAG(al, ah), FRAG(b1l, b1h), acc1, 0, 0, 0); } while (0)
    KVSTEP(0, 0); KVSTEP(0, 1); KVSTEP(0, 2); KVSTEP(0, 3); KVSTEP(1, 0); KVSTEP(1, 1); KVSTEP(1, 2); KVSTEP(1, 3);
#undef KVSTEP
    const float sc = exp2f(127.f * gamma_log2(h));
    bf16_t* O = KVS + ((size_t)(bh * 32 + c) * 128 + dvb * 32) * 128 + dkb * 32;
#pragma unroll
    for (int r = 0; r < 16; ++r) { const int dv = crow(r, hi);
        const float v0 = acc0[r] * sc, v1 = acc1[r] * sc; const float n0 = __shfl_xor(v0, 1), n1 = __shfl_xor(v1, 1);
        if ((r32 & 1) == 0) { *(unsigned*)(O + (size_t)dv * 128 + r32) = cvtpk(v0, n0); *(unsigned*)(O + (size_t)dv * 128 + 32 + r32) = cvtpk(v1, n1); } }
    __syncthreads();
}
__device__ __forceinline__ void ret_kv_phase(const bf16_t* RK, const bf16_t* RV, bf16_t* KVS, char* lds) {
    for (int u = blockIdx.x; u < 1024; u += gridDim.x) ret_kv_unit(RK, RV, KVS, u >> 5, u & 31, lds);
}

struct RetStage { u32x4 q[4], k[4], v[4], s[4]; };
__device__ __forceinline__ void ret_out_load(const bf16_t* RQ, const bf16_t* RK, const bf16_t* RV, const bf16_t* STS, int bh, int c, RetStage& st) {
    const int tid = threadIdx.x; const int b = bh >> 2, h = bh & 3; const size_t t0 = (size_t)b * 4096 + (size_t)c * 128;
    const bf16_t* src = STS + (size_t)(bh * 32 + c) * 16384 + tid * 8;
#pragma unroll
    for (int i = 0; i < 4; ++i) { const int q = tid + 512 * i, row = q >> 4, cc = (q & 15) * 8; const size_t g = (t0 + row) * 512 + h * 128 + cc;
        st.q[i] = *(const u32x4*)(RQ + g); st.k[i] = *(const u32x4*)(RK + g); st.v[i] = *(const u32x4*)(RV + g); st.s[i] = *(const u32x4*)(src + 4096 * i); }
}
__device__ __forceinline__ void ret_out_unit(const bf16_t* RQ, const bf16_t* RK, const bf16_t* RV, const bf16_t* RG, const bf16_t* STS, const float* gn_g, bf16_t* AO, int bh, int c, RetStage& st, bool has_next, int nbh, int nc, char* lds) {
    const int tid = opaque_tid(), wid = __builtin_amdgcn_readfirstlane(tid >> 6), lane = tid & 63, r32 = lane & 31, hi = lane >> 5;
    const int b = bh >> 2, h = bh & 3; const size_t t0 = (size_t)b * 4096 + (size_t)c * 128;
    const float lg = gamma_log2(h);
#pragma unroll
    for (int i = 0; i < 4; ++i) { const int q = tid + 512 * i, row = q >> 4, cc = (q & 15) * 8;
        *(u32x4*)(lds + L_Q + row * PITCH + cc * 2) = st.q[i];
        *(u32x4*)(lds + L_K + row * PITCH + cc * 2) = st.k[i];
        *(u32x4*)(lds + L_V + (row >> 6) * 16384 + v_st(row & 63, cc)) = st.v[i];
        *(u32x4*)(lds + L_S + row * PITCH + cc * 2) = st.s[i]; }
    __syncthreads();
    if (has_next) ret_out_load(RQ, RK, RV, STS, nbh, nc, st);
    const int qg = wid & 3, dh = wid >> 2;
    bf16x8 qr[8];
#pragma unroll
    for (int d0 = 0; d0 < 8; ++d0) qr[d0] = *(const bf16x8*)(lds + L_Q + (32 * qg + r32) * PITCH + d0 * 32 + hi * 16);
    f32x16 o[2] = {};
#pragma unroll
    for (int dd = 0; dd < 2; ++dd) { const char* sb = lds + L_S + ((2 * dh + dd) * 32 + r32) * PITCH + hi * 16;
#pragma unroll
        for (int d0 = 0; d0 < 8; ++d0) o[dd] = __builtin_amdgcn_mfma_f32_32x32x16_bf16(qr[d0], *(const bf16x8*)(sb + d0 * 32), o[dd], 0, 0, 0); }
    { const float g1 = exp2f(lg);
#pragma unroll
      for (int dd = 0; dd < 2; ++dd)
#pragma unroll
          for (int r = 0; r < 16; ++r) o[dd][r] *= g1; }
    const int vb = (int)(uintptr_t)(lds + L_V) + v_rd_base(lane) + (2 * dh) * 512;
    const int qpos = 32 * qg + r32;
#define INTRA(kt) do { if (64 * (kt) <= 32 * qg + 31) { f32x16 p0 = {}, p1 = {}; const char* kb = lds + L_K + (64 * (kt) + r32) * PITCH + hi * 16;   \
        _Pragma("unroll") for (int d0 = 0; d0 < 8; ++d0) { p0 = __builtin_amdgcn_mfma_f32_32x32x16_bf16(*(const bf16x8*)(kb + d0 * 32), qr[d0], p0, 0, 0, 0);   \
                                                          p1 = __builtin_amdgcn_mfma_f32_32x32x16_bf16(*(const bf16x8*)(kb + 32 * PITCH + d0 * 32), qr[d0], p1, 0, 0, 0); }   \
        _Pragma("unroll") for (int r = 0; r < 16; ++r) { const int key = 64 * (kt) + crow(r, hi); if (key > qpos) p0[r] = 0.f; if (key + 32 > qpos) p1[r] = 0.f; }   \
        bf16x8 pa0, pa1, pa2, pa3;   \
        PK4(p0, 0, pa0); PK4(p0, 8, pa1); PK4(p1, 0, pa2); PK4(p1, 8, pa3);   \
        PVD(kt, 0); PVD(kt, 1); } } while (0)
#define PK4(P, B_, OUT) do { unsigned a0 = cvtpk(P[B_+0], P[B_+1]), a1 = cvtpk(P[B_+2], P[B_+3]); unsigned b0 = cvtpk(P[B_+4], P[B_+5]), b1 = cvtpk(P[B_+6], P[B_+7]);   \
        auto r0 = __builtin_amdgcn_permlane32_swap(a0, b0, false, false); auto r1 = __builtin_amdgcn_permlane32_swap(a1, b1, false, false);   \
        u32x4 w_ = {r0[0], r1[0], r0[1], r1[1]}; OUT = *reinterpret_cast<bf16x8*>(&w_); } while (0)
#define PVD(kt, dd) do { s16x4 l0, l1, l2, l3, h0, h1, h2, h3; constexpr int b_ = (kt) * 16384 + v_rd_off(dd, 0, 0);   \
        TRRD(l0, vb, b_); TRRD(h0, vb, b_ + 2048); TRRD(l1, vb, b_ + 4096); TRRD(h1, vb, b_ + 6144); TRRD(l2, vb, b_ + 8192); TRRD(h2, vb, b_ + 10240); TRRD(l3, vb, b_ + 12288); TRRD(h3, vb, b_ + 14336);   \
        asm volatile("s_waitcnt lgkmcnt(0)" ::: "memory"); __builtin_amdgcn_sched_barrier(0);   \
        o[dd] = __builtin_amdgcn_mfma_f32_32x32x16_bf16(pa0, FRAG(l0, h0), o[dd], 0, 0, 0); o[dd] = __builtin_amdgcn_mfma_f32_32x32x16_bf16(pa1, FRAG(l1, h1), o[dd], 0, 0, 0);   \
        o[dd] = __builtin_amdgcn_mfma_f32_32x32x16_bf16(pa2, FRAG(l2, h2), o[dd], 0, 0, 0); o[dd] = __builtin_amdgcn_mfma_f32_32x32x16_bf16(pa3, FRAG(l3, h3), o[dd], 0, 0, 0); } while (0)
    INTRA(0); INTRA(1);
#undef INTRA
#undef PK4
#undef PVD
    __syncthreads();
    float* Os = (float*)lds;
#pragma unroll
    for (int dd = 0; dd < 2; ++dd)
#pragma unroll
        for (int r = 0; r < 16; ++r) Os[(32 * qg + crow(r, hi)) * 132 + (2 * dh + dd) * 32 + r32] = o[dd][r];
    __syncthreads();
    { const int q = tid >> 2, seg = tid & 3; const float* orow = Os + q * 132 + seg * 32;
      f32x4 v[8]; float s1 = 0.f, s2 = 0.f;
#pragma unroll
      for (int i = 0; i < 8; ++i) { v[i] = *(const f32x4*)(orow + 4 * i); s1 += (v[i][0] + v[i][1]) + (v[i][2] + v[i][3]); s2 += fx::sq4(v[i]); }
      s1 += __shfl_xor(s1, 1); s1 += __shfl_xor(s1, 2); s2 += __shfl_xor(s2, 1); s2 += __shfl_xor(s2, 2);
      const float mean = s1 * (1.f / 128.f); const float var = fmaxf(s2 * (1.f / 128.f) - mean * mean, 0.f); const float rs = rsqrtf(var + EPS);
      const bf16_t* gp = RG + (t0 + q) * 512 + h * 128 + seg * 32; const float* gg = gn_g + h * 128 + seg * 32;
      bf16_t* op = AO + (t0 + q) * 1024 + 512 + h * 128 + seg * 32;
#pragma unroll
      for (int i = 0; i < 4; ++i) { const u32x4 gr = *(const u32x4*)(gp + 8 * i); const f32x4 g0 = *(const f32x4*)(gg + 8 * i), g1 = *(const f32x4*)(gg + 8 * i + 4);
          const f32x4 ga = {__uint_as_float(gr.x << 16), __uint_as_float(gr.x & 0xffff0000u), __uint_as_float(gr.y << 16), __uint_as_float(gr.y & 0xffff0000u)};
          const f32x4 gb = {__uint_as_float(gr.z << 16), __uint_as_float(gr.z & 0xffff0000u), __uint_as_float(gr.w << 16), __uint_as_float(gr.w & 0xffff0000u)};
          f32x4 ya = (v[2 * i] - mean) * rs * g0, yb = (v[2 * i + 1] - mean) * rs * g1;
#pragma unroll
          for (int k = 0; k < 4; ++k) { ya[k] *= ga[k] / (1.f + __expf(-ga[k])); yb[k] *= gb[k] / (1.f + __expf(-gb[k])); }
          *(u32x4*)(op + 8 * i) = fx::pack8(ya, yb); } }
    __syncthreads();
}
__device__ __forceinline__ void ret_out_phase(const bf16_t* RQ, const bf16_t* RK, const bf16_t* RV, const bf16_t* RG, const bf16_t* STS, const float* gn_g, bf16_t* AO, char* lds) {
    RetStage st; int u = blockIdx.x;
    if (u < 1024) ret_out_load(RQ, RK, RV, STS, u >> 5, u & 31, st);
    for (; u < 1024; u += gridDim.x) { const int un = u + gridDim.x;
        ret_out_unit(RQ, RK, RV, RG, STS, gn_g, AO, u >> 5, u & 31, st, un < 1024, un >> 5, un & 31, lds); }
}

__device__ __forceinline__ void ret_scan_phase(const bf16_t* KVS, bf16_t* STS, int wg, int nwg) {
    const int gt = wg * 512 + threadIdx.x, NT = nwg * 512;
    for (int it = gt; it < 32 * 2048; it += NT) { const int bh = it >> 11, e8 = it & 2047;
        const float cd = exp2f(128.f * gamma_log2(bh & 3));
        const bf16_t* src = KVS + (size_t)bh * 32 * 16384 + e8 * 8; bf16_t* dst = STS + (size_t)bh * 32 * 16384 + e8 * 8;
        f32x4 s0 = {0.f, 0.f, 0.f, 0.f}, s1 = s0;
#pragma unroll 8
        for (int c = 0; c < 32; ++c) { const u32x4 v = *(const u32x4*)(src + (size_t)c * 16384);
            *(u32x4*)(dst + (size_t)c * 16384) = fx::pack8(s0, s1);
            s0 = s0 * cd + (f32x4){__uint_as_float(v.x << 16), __uint_as_float(v.x & 0xffff0000u), __uint_as_float(v.y << 16), __uint_as_float(v.y & 0xffff0000u)};
            s1 = s1 * cd + (f32x4){__uint_as_float(v.z << 16), __uint_as_float(v.z & 0xffff0000u), __uint_as_float(v.w << 16), __uint_as_float(v.w & 0xffff0000u)}; } }
}
#undef TRRD
#undef FRAG
}
namespace cg = cooperative_groups;
#ifndef STAG8
#define STAG8 1100
#endif
#ifndef DUP
#define DUP (-1)
#endif
__device__ __forceinline__ int opaque_reps(int n) { asm volatile("" : "+s"(n)); return n; }
#define REPS(code) for (int rep = 0; rep < ((DUP == (code)) ? 2 : 1); ++rep)
constexpr int NWAVES = 8;
constexpr int RING_BYTES = 131072, XL_OFF = RING_BYTES, XL_BYTES = 8192, XST_OFF = RING_BYTES + 8192 + 16384, LDS_BYTES = XST_OFF + 64;

struct Params {
    const float* in[28]; float* out; unsigned char* ws; int ph_lo, ph_hi; int coop; int pad;
};
typedef const Params __attribute__((address_space(4)))* KParams;
#define WSP(T_, off) ((T_*)(p->ws + (off)))

constexpr size_t WB_IN = WS_WB, WB_UQ = WB_IN + (size_t)2560 * 1024 * 2, WB_UKV = WB_UQ + (size_t)1024 * 256 * 2, WB_OUT = WB_UKV + (size_t)1024 * 256 * 2,
                 WB_CQ = WB_OUT + (size_t)1024 * 1024 * 2, WB_CKV = WB_CQ + (size_t)1024 * 1024 * 2, WB_CO = WB_CKV + (size_t)2048 * 1024 * 2,
                 WB_GU = WB_CO + (size_t)1024 * 1024 * 2, WB_D = WB_GU + (size_t)32 * 512 * 1024 * 2, WB_END = WB_D + (size_t)32 * 1024 * 256 * 2;
static_assert(WB_END <= WS_RQ, "weight copies overflow their region");

__device__ __forceinline__ float wave_sum64(float v) {
#pragma unroll
    for (int o = 1; o < 64; o <<= 1) v += __shfl_xor(v, o);
    return v;
}
__device__ __forceinline__ int plain_src(int n) { return (n & ~31) + pg8::perm32(n & 31); }

template <class SrcFn, class DstFn>
__device__ __forceinline__ void wprep_item(const float* __restrict__ W, int ldw, int Kreal, const float* __restrict__ gain, bf16_t* __restrict__ WT, int ldt,
                                           LAS float* scr, int kb, int nb, int lane, SrcFn src, DstFn dst) {
    const int k0 = 64 * kb, n0 = 64 * nb;
    u32x4* orow = (u32x4*)(WT + (size_t)dst(n0 + lane) * ldt + k0);
    if (k0 >= Kreal) {
#pragma unroll
        for (int c = 0; c < 8; ++c) orow[c] = (u32x4){0u, 0u, 0u, 0u};
        return; }
    const int krow = lane >> 4, n4 = lane & 15;
    int sc = src(n0 + 4 * n4); sc = sc < 0 ? 0 : sc;
    const float* wp = W + (size_t)(k0 + krow) * ldw + sc;
    f32x4 v[16];
#pragma unroll
    for (int i = 0; i < 16; ++i) v[i] = *(const f32x4*)(wp + (size_t)(4 * i) * ldw);
#pragma unroll
    for (int i = 0; i < 16; ++i) *(LAS f32x4*)(scr + (4 * i + krow) * 68 + 4 * n4) = v[i];
    asm volatile("s_waitcnt lgkmcnt(0)" ::: "memory");
    const bool zero = src(n0 + lane) < 0;
#pragma unroll
    for (int c = 0; c < 8; ++c) { float t[8];
#pragma unroll
        for (int j = 0; j < 8; ++j) { t[j] = scr[(8 * c + j) * 68 + lane]; if (gain) t[j] *= gain[k0 + 8 * c + j]; if (zero) t[j] = 0.f; }
        u32x4 o; o.x = pg8::cvt_pk_bf16(t[0], t[1]); o.y = pg8::cvt_pk_bf16(t[2], t[3]); o.z = pg8::cvt_pk_bf16(t[4], t[5]); o.w = pg8::cvt_pk_bf16(t[6], t[7]);
        orow[c] = o; }
    asm volatile("s_waitcnt lgkmcnt(0)" ::: "memory");
}
template <class SrcFn, class DstFn>
__device__ __forceinline__ void wprep_matrix(const float* W, int ldw, int Kreal, int Kpad, int Nitems64, const float* gain, bf16_t* WT, int ldt, LAS float* scr, int gw, int NGW, int lane, SrcFn src, DstFn dst) {
    const int nkb = Kpad / 64, total = nkb * Nitems64;
    for (int it = gw; it < total; it += NGW) wprep_item(W, ldw, Kreal, gain, WT, ldt, scr, it / Nitems64, it % Nitems64, lane, src, dst);
}
__device__ __forceinline__ void rms_row_to_bf16(const float* xrow, const float* g, bf16_t* orow, int lane) {
    const f32x4* xr = (const f32x4*)xrow + lane; const f32x4* gr = (const f32x4*)g + lane;
    f32x4 v[4]; float s = 0.f;
#pragma unroll
    for (int j = 0; j < 4; ++j) { v[j] = xr[64 * j]; s += fx::sq4(v[j]); }
    const float rs = rsqrtf(wave_sum64(s) * (1.f / 1024.f) + EPS);
    u32x2* o8 = (u32x2*)orow + lane;
#pragma unroll
    for (int j = 0; j < 4; ++j) { const f32x4 w = v[j] * rs * gr[64 * j]; o8[64 * j] = fx::pack4(w); }
}

__device__ __forceinline__ void expert_prep(KParams p, LAS unsigned char* lds, int wave, int lane) {
    LAS float* scr = (LAS float*)(lds + wave * 17408);
    const int gw = blockIdx.x * NWAVES + wave, NGW = gridDim.x * NWAVES;
    auto ident = [](int n) { return n; };
    for (int it = gw; it < 32 * 64; it += NGW) { const int e = it >> 6, r = it & 63, kb = r >> 2, nb = r & 3;
        auto srcf = [](int n) { return (n >> 7) * 128 + plain_src(n & 127); };
        wprep_item(p->in[25] + (size_t)e * 1024 * 256, 256, 1024, p->in[20], WSP(bf16_t, WB_GU) + (size_t)e * 512 * 1024, 1024, scr, kb, nb, lane, srcf, [](int n) { return (n >> 7) * 256 + (n & 127); });
        wprep_item(p->in[26] + (size_t)e * 1024 * 256, 256, 1024, p->in[20], WSP(bf16_t, WB_GU) + (size_t)e * 512 * 1024, 1024, scr, kb, nb, lane, srcf, [](int n) { return (n >> 7) * 256 + 128 + (n & 127); }); }
    for (int it = gw; it < 32 * 64; it += NGW) { const int e = it >> 6, r = it & 63, kb = r >> 4, nb = r & 15;
        wprep_item(p->in[27] + (size_t)e * 256 * 1024, 1024, 256, nullptr, WSP(bf16_t, WB_D) + (size_t)e * 1024 * 256, 256, scr, kb, nb, lane, ident, ident); }
    __syncthreads();
}

__device__ __forceinline__ void p0_prologue(KParams p, LAS unsigned char* lds, int wave, int lane) {
    LAS float* scr = (LAS float*)(lds + wave * 17408);
    const int gw = blockIdx.x * NWAVES + wave, NGW = gridDim.x * NWAVES;
    auto ident = [](int n) { return n; };
    REPS(1004) {
    for (int it = gw; it < 2048; it += NGW) { int r = it;
        if (r < 640) { wprep_item(p->in[4], 2496, 1024, nullptr, WSP(bf16_t, WB_IN), 1024, scr, r / 40, r % 40, lane, [](int n) { return fx::inproj_src(n); }, ident); continue; } r -= 640;
        if (r < 256) { if ((r >> 4) >= 8) wprep_item(p->in[12], 1024, 1024, nullptr, WSP(bf16_t, WB_OUT), 1024, scr, r >> 4, r & 15, lane, ident, ident); continue; } r -= 256;
        if (r < 256) { wprep_item(p->in[19], 1024, 1024, nullptr, WSP(bf16_t, WB_CO), 1024, scr, r >> 4, r & 15, lane, ident, ident); continue; } r -= 256;
        if (r < 64) { wprep_item(p->in[6], 768, 256, p->in[5], WSP(bf16_t, WB_UQ), 256, scr, r >> 4, r & 15, lane, [](int n) { return fx::mlaq_src(n); }, ident); continue; } r -= 64;
        if (r < 64) { if ((r & 15) < 8) wprep_item(p->in[8], 1024, 128, p->in[7], WSP(bf16_t, WB_UKV), 256, scr, r >> 4, r & 15, lane, [](int n) { return (n >> 7) * 256 + plain_src(n & 127); }, ident); continue; } r -= 64;
        if (r < 256) { wprep_item(p->in[15], 1024, 1024, p->in[13], WSP(bf16_t, WB_CQ), 1024, scr, r >> 4, r & 15, lane, [](int n) { return plain_src(n); }, ident); continue; } r -= 256;
        wprep_item(p->in[16], 2048, 1024, nullptr, WSP(bf16_t, WB_CKV), 1024, scr, r >> 5, r & 31, lane, [](int n) { return n < 1024 ? plain_src(n) : n; }, ident);
    }
    }
    REPS(1001) {
    for (int m = gw; m < T_TOK; m += 4 * NGW) {
        const f32x4* gr = (const f32x4*)p->in[3] + lane;
        f32x4 v[4][4]; float ss[4];
#pragma unroll
        for (int r = 0; r < 4; ++r) { const f32x4* xr = (const f32x4*)(p->in[0] + (size_t)(m + r * NGW) * 1024) + lane;
#pragma unroll
            for (int j = 0; j < 4; ++j) v[r][j] = __builtin_nontemporal_load(xr + 64 * j); }
#pragma unroll
        for (int r = 0; r < 4; ++r) { float s_ = 0.f;
#pragma unroll
            for (int j = 0; j < 4; ++j) s_ += fx::sq4(v[r][j]);
            ss[r] = rsqrtf(wave_sum64(s_) * (1.f / 1024.f) + EPS); }
#pragma unroll
        for (int r = 0; r < 4; ++r) { u32x2* o = (u32x2*)(WSP(bf16_t, WS_HB) + (size_t)(m + r * NGW) * 1024) + lane;
#pragma unroll
            for (int j = 0; j < 4; ++j) o[64 * j] = fx::pack4(v[r][j] * ss[r] * gr[64 * j]); } }
    for (int m = gw; m < 2048; m += NGW) rms_row_to_bf16(p->in[1] + (size_t)m * 1024, p->in[14], WSP(bf16_t, WS_MB) + (size_t)m * 1024, lane);
    }
    REPS(1002) {
    { const int gt = blockIdx.x * (NWAVES * 64) + threadIdx.x, NT = gridDim.x * NWAVES * 64;
      float* z = WSP(float, WS_SSQ_CQ);
      for (int idx = gt; idx < 5 * 32768; idx += NT) z[idx] = 0.f;
      if (gt < 64) WSP(int, WS_CNT)[gt] = 0;
      { const float* wukv = p->in[8]; const float* wout = p->in[12]; bf16_t* wo = WSP(bf16_t, WB_OUT);
        for (int it0 = gw; it0 < 2048; it0 += NGW) { const int it = __builtin_amdgcn_readfirstlane(it0), h = it >> 9, cb = (it >> 4) & 31, n = (it & 15) * 64 + lane;
            const float* a = wukv + (size_t)(cb * 4) * 1024 + h * 256 + 128; const float* bcol = wout + (size_t)(h * 128) * 1024 + n; f32x4 acc_ = {0.f, 0.f, 0.f, 0.f};
#pragma unroll 4
            for (int d = 0; d < 128; d += 4) { f32x4 av[4]; float bv[4];
#pragma unroll
                for (int j = 0; j < 4; ++j) { av[j] = *(const f32x4*)(a + (size_t)j * 1024 + d); bv[j] = bcol[(size_t)(d + j) * 1024]; }
#pragma unroll
                for (int j = 0; j < 4; ++j) { acc_[j] += av[j][0] * bv[0]; acc_[j] += av[j][1] * bv[1]; acc_[j] += av[j][2] * bv[2]; acc_[j] += av[j][3] * bv[3]; } }
            *(u32x2*)(wo + (size_t)n * 1024 + h * 128 + cb * 4) = fx::pack4(acc_); } }
      bf16_t* wrh = WSP(bf16_t, WS_RW); bf16_t* wrl = wrh + 36 * 1032;
      for (int idx = gt; idx < 36 * 1032; idx += NT) { const int n = idx / 1032, k = idx % 1032; float v = 0.f;
          if (k < 1024) v = (n < 4) ? p->in[20][k] * p->in[21][k * 4 + n] : p->in[20][k] * p->in[23][k * 32 + n - 4];
          const bf16_t hh = f2bf(v); wrh[idx] = hh; wrl[idx] = f2bf(v - bf2f(hh)); } }
    }
}


#define GAS __attribute__((address_space(1)))
#define XB_TMO      128
#define XB_XCNT(j)  (256  + 64 * (j))
#define XB_XSUB(j)  (1280 + 64 * (j))
#define XB_XGEN(j)  (2304 + 64 * (j))
#define XB_TOP      3328
#define XB_TOPGEN   3392
#define XCD_BAR_WORDS 3456
#define XB_SPIN_CAP (1u << 18)
__device__ __forceinline__ unsigned xb_ld(unsigned* p)              { return __hip_atomic_load(p, __ATOMIC_RELAXED, __HIP_MEMORY_SCOPE_AGENT); }
__device__ __forceinline__ unsigned xb_add(unsigned* p, unsigned v) { return __hip_atomic_fetch_add(p, v, __ATOMIC_RELAXED, __HIP_MEMORY_SCOPE_AGENT); }
__device__ __forceinline__ unsigned xb_xcc_id() { return (unsigned)__builtin_amdgcn_s_getreg((3 << 11) | 20) & 0xFu; }
#define XB_SPIN(cond, bar) do { unsigned _sp = 0; while (cond) { __builtin_amdgcn_s_sleep(1); \
    if ((++_sp & 255u) == 0u) { if (xb_ld(&(bar)[XB_TMO])) break; if (_sp > XB_SPIN_CAP) { atomicAdd(&(bar)[XB_TMO], 1u); break; } } } } while (0)
struct XcdBarrier { unsigned* bar; unsigned x; volatile LAS unsigned* st; };
__device__ __forceinline__ XcdBarrier xcd_barrier_post(unsigned* bar, volatile LAS unsigned* st) {
    XcdBarrier b; b.bar = bar; b.x = xb_xcc_id(); b.st = st;
    if (threadIdx.x == 0) (void)xb_add(&bar[XB_XCNT(b.x)], 1u);
    return b;
}
__device__ __forceinline__ void xcd_barrier_complete(unsigned* bar, unsigned x, unsigned& nloc, unsigned& nx) {
    const unsigned G = gridDim.x * gridDim.y * gridDim.z;
    unsigned sum, cnt, mine, sp = 0u;
    for (;;) {
        sum = 0u; cnt = 0u; mine = 0u;
#pragma unroll
        for (unsigned j = 0; j < 16; ++j) { const unsigned c = xb_ld(&bar[XB_XCNT(j)]); sum += c; cnt += (c > 0u) ? 1u : 0u; mine = (j == x) ? c : mine; }
        if (sum == G) break;
        __builtin_amdgcn_s_sleep(1);
        if ((++sp & 255u) == 0u) { if (xb_ld(&bar[XB_TMO])) break; if (sp > XB_SPIN_CAP) { atomicAdd(&bar[XB_TMO], 1u); break; } }
    }
    nloc = mine > 0u ? mine : 1u; nx = cnt > 0u ? cnt : 1u;
}
__device__ __forceinline__ void xcd_barrier(const XcdBarrier& b) {
    asm volatile("s_waitcnt vmcnt(0)" ::: "memory");
    __syncthreads();
    if (threadIdx.x == 0) {
        unsigned* bar = b.bar;
        __builtin_amdgcn_s_waitcnt(0);
        unsigned nloc = b.st[0], nx = b.st[1];
        if (nloc == 0u) { xcd_barrier_complete(bar, b.x, nloc, nx); b.st[0] = nloc; b.st[1] = nx; }
        asm volatile("buffer_inv sc1" ::: "memory");
        const unsigned old = xb_add(&bar[XB_XSUB(b.x)], 1u);
        const unsigned gen = old / nloc;
        if (old + 1u == (gen + 1u) * nloc) {
            __builtin_amdgcn_fence(__ATOMIC_RELEASE, "agent");
            asm volatile("s_waitcnt vmcnt(0)" ::: "memory");
            const unsigned og = xb_add(&bar[XB_TOP], 1u);
            const unsigned tg = og / nx;
            if (og + 1u == (tg + 1u) * nx) xb_add(&bar[XB_TOPGEN], 1u);
            else XB_SPIN(xb_ld(&bar[XB_TOPGEN]) == tg, bar);
            xb_add(&bar[XB_XGEN(b.x)], 1u);
            asm volatile("s_waitcnt vmcnt(0)" ::: "memory");
        } else {
            XB_SPIN(xb_ld(&bar[XB_XGEN(b.x)]) == gen, bar);
            asm volatile("s_waitcnt vmcnt(0)" ::: "memory");
        }
    }
    __syncthreads();
}

__device__ __forceinline__ void stagger_start(int ticks) {
    if ((blockIdx.x >> 3) & 1) { const unsigned long long t0 = __builtin_amdgcn_s_memrealtime(); while (__builtin_amdgcn_s_memrealtime() - t0 < (unsigned long long)ticks) __builtin_amdgcn_s_sleep(8); }
}
__device__ __forceinline__ void router_phase(KParams p, LAS unsigned char* lds, int wave, int lane, int* cnt, int* lists, float* roww, float* rsr) {
    const float* bg = p->in[22]; const float* be = p->in[24];
    constexpr int RP = 2064;
    { const u32x4* src = WSP(u32x4, WS_RW); LAS u32x4* dst = (LAS u32x4*)lds;
      for (int i = threadIdx.x; i < 2 * 36 * RP / 16; i += NWAVES * 64) dst[i] = src[i]; }
    __syncthreads();
    const int tok = lane & 15, kq = lane >> 4;
    LAS unsigned char* wh = lds + tok * RP + kq * 16; LAS unsigned char* wl = wh + 36 * RP;
    const bool t2 = tok < 4;
    for (int item = blockIdx.x * NWAVES + wave; item < T_TOK / 16; item += gridDim.x * NWAVES) {
        const int t0 = item * 16;
        const bf16_t* xhr = WSP(bf16_t, WS_XB) + (size_t)(t0 + tok) * 1024 + 8 * kq;
        f32x4 c[3]; c[0] = (f32x4){0.f, 0.f, 0.f, 0.f}; c[1] = c[0]; c[2] = c[0];
#pragma unroll 8
        for (int ks = 0; ks < 32; ++ks) {
            const bf16x8 xh = *(const bf16x8*)(xhr + 32 * ks);
#pragma unroll
            for (int t = 0; t < 3; ++t) {
                bf16x8 ah, al;
                if (t < 2) { ah = *(const LAS bf16x8*)(wh + t * 16 * RP + ks * 64); al = *(const LAS bf16x8*)(wl + t * 16 * RP + ks * 64); }
                else { ah = *(const LAS bf16x8*)(wh + (t2 ? 32 * RP : 0) + ks * 64); al = *(const LAS bf16x8*)(wl + (t2 ? 32 * RP : 0) + ks * 64);
                       if (!t2) { ah = (bf16x8){0, 0, 0, 0, 0, 0, 0, 0}; al = ah; } }
                c[t] = __builtin_amdgcn_mfma_f32_16x16x32_bf16(ah, xh, c[t], 0, 0, 0);
                c[t] = __builtin_amdgcn_mfma_f32_16x16x32_bf16(al, xh, c[t], 0, 0, 0);
            }
        }
        const float rs = rsqrtf(WSP(float, WS_SSQ2)[t0 + tok] * (1.f / 1024.f) + EPS);
#pragma unroll
        for (int t = 0; t < 3; ++t) c[t] = c[t] * rs;
        float g[4];
#pragma unroll
        for (int r = 0; r < 4; ++r) g[r] = __shfl(c[0][r], tok);
        const float mx = fmaxf(fmaxf(g[0], g[1]), fmaxf(g[2], g[3]));
        float den = 0.f;
#pragma unroll
        for (int j = 0; j < 4; ++j) den += expf(g[j] - mx);
        int gs = 0; float best = g[0] + bg[0], lgs = g[0];
#pragma unroll
        for (int j = 1; j < 4; ++j) { const float v = g[j] + bg[j]; if (v > best) { best = v; gs = j; lgs = g[j]; } }
        const float gw = expf(lgs - mx) / den;
        const int qA = 1 + 2 * gs, qB = qA + 1;
        f32x4 sA = (qA >> 2) == 0 ? c[0] : ((qA >> 2) == 1 ? c[1] : c[2]);
        f32x4 sB = (qB >> 2) == 0 ? c[0] : ((qB >> 2) == 1 ? c[1] : c[2]);
        float el[8];
#pragma unroll
        for (int r = 0; r < 4; ++r) { el[r] = __shfl(sA[r], tok + 16 * (qA & 3)); el[4 + r] = __shfl(sB[r], tok + 16 * (qB & 3)); }
        float emx = el[0];
#pragma unroll
        for (int j = 1; j < 8; ++j) emx = fmaxf(emx, el[j]);
        float eden = 0.f;
#pragma unroll
        for (int j = 0; j < 8; ++j) eden += expf(el[j] - emx);
        float sc[8];
#pragma unroll
        for (int j = 0; j < 8; ++j) sc[j] = el[j] + be[gs * 8 + j];
        int i0 = 0; float b0 = sc[0], e0v = el[0];
#pragma unroll
        for (int j = 1; j < 8; ++j) if (sc[j] > b0) { b0 = sc[j]; i0 = j; e0v = el[j]; }
        int i1 = -1; float b1 = -3.0e38f, e1v = 0.f;
#pragma unroll
        for (int j = 0; j < 8; ++j) if (j != i0 && sc[j] > b1) { b1 = sc[j]; i1 = j; e1v = el[j]; }
        LAS int* hist = (LAS int*)(lds + 2 * 36 * RP + 128); LAS int* hbase = hist + 64;
        if (threadIdx.x < 64) hist[threadIdx.x] = 0;
        __syncthreads();
        const float p0 = expf(e0v - emx) / eden, p1 = expf(e1v - emx) / eden, sm = p0 + p1;
        const int sg0 = gs * 8 + i0, sg1 = 32 + gs * 8 + i1;
        int r0 = 0, r1 = 0;
        if (kq == 0) { r0 = __hip_atomic_fetch_add(hist + sg0, 1, __ATOMIC_RELAXED, __HIP_MEMORY_SCOPE_WORKGROUP); r1 = __hip_atomic_fetch_add(hist + sg1, 1, __ATOMIC_RELAXED, __HIP_MEMORY_SCOPE_WORKGROUP); }
        __syncthreads();
        if (threadIdx.x < 64) { const int n = hist[threadIdx.x]; hbase[threadIdx.x] = n > 0 ? atomicAdd(cnt + threadIdx.x, n) : 0; }
        __syncthreads();
        if (kq == 0) {
            const int t = t0 + tok; const int q0 = hbase[sg0] + r0, q1 = hbase[sg1] + r1;
            lists[(size_t)sg0 * fx::MOE_CAP + q0] = t; roww[(size_t)sg0 * fx::MOE_CAP + q0] = p0 / sm * gw; rsr[(size_t)sg0 * fx::MOE_CAP + q0] = rs;
            lists[(size_t)sg1 * fx::MOE_CAP + q1] = t; roww[(size_t)sg1 * fx::MOE_CAP + q1] = p1 / sm * gw; rsr[(size_t)sg1 * fx::MOE_CAP + q1] = rs;
        }
    }
    __syncthreads();
}

__global__ void __launch_bounds__(NWAVES * 64, 2) mk_fwd(Params p_arg) {
    KParams p = (KParams)__builtin_amdgcn_kernarg_segment_ptr();
    extern __shared__ __attribute__((aligned(16))) unsigned char lds_raw[];
    LAS unsigned char* lds = (LAS unsigned char*)lds_raw;
    LAS unsigned char* xl = lds + XL_OFF;
    const int tid = threadIdx.x, lane = tid & 63, wave = __builtin_amdgcn_readfirstlane(tid >> 6);
    const int lo = p->ph_lo, hi = p->ph_hi;
#ifndef PHMASK
#define PHMASK 0xffffffffu
#endif
#define IN(k) (((PHMASK >> (k)) & 1u) && lo <= (k) && (k) < hi)
#define SEAM(k) do { if (IN(k) && IN((k) + 1)) { xcd_barrier(xbar); if (DUP == 1000) xcd_barrier(xbar); } } while (0)
    volatile LAS unsigned* xst = (volatile LAS unsigned*)(lds + XST_OFF);
    if (tid == 0) { xst[0] = 0u; xst[1] = 0u; }
    __syncthreads();
    XcdBarrier xbar = xcd_barrier_post(WSP(unsigned, WS_BAR), xst);
    if (lo < 0) cg::this_grid().sync();
    float* const dummyf = WSP(float, 512 * 1024);
    REPS(0) if (IN(0)) { p0_prologue(p, lds, wave, lane); }
    SEAM(0);
    if (IN(1)) {
        REPS(1) {
        pg8::GridOrder S; S.init(WSP(bf16_t, WS_HB), 1024, WSP(bf16_t, WB_IN), 1024, T_TOK, 2560, gridDim.x, blockIdx.x);
        fx::EpiInProj E{WSP(bf16_t, WS_CQ), WSP(bf16_t, WS_CKV), WSP(bf16_t, WS_RQ), WSP(bf16_t, WS_RK), WSP(bf16_t, WS_RV), WSP(bf16_t, WS_RG),
                        rep ? dummyf : WSP(float, WS_SSQ_CQ), rep ? dummyf : WSP(float, WS_SSQ_CKV), rep ? dummyf : WSP(float, WS_SSQ_KPE), (const int*)p->in[2], p->in[10]};
        pg8::gemm_phase<fx::EpiInProj, pg8::GridOrder>(lds, xl, 1024, 1024, 1024, S, E); }
    }
    SEAM(1);
    if (IN(2)) {
        REPS(101) { const int G_ = (int)gridDim.x, c_ = (int)blockIdx.x; fx::MemKVOrder S2{G_, G_ >= 256 ? (c_ >= 128 ? c_ - 128 : 128) : c_, (const char*)WSP(bf16_t, WS_MB), (const char*)WSP(bf16_t, WB_CKV)};
          fx::EpiMemKV E2{WSP(bf16_t, WS_KC), WSP(bf16_t, WS_VC), p->in[18]};
          pg8::gemm_phase<fx::EpiMemKV, fx::MemKVOrder>(lds, xl, 1024, 1024, 1024, S2, E2); }
        REPS(2) {
        { fx::QupOrder S; S.g.init(WSP(bf16_t, WS_CQ), 256, WSP(bf16_t, WB_UQ), 256, T_TOK, 1024, gridDim.x, blockIdx.x);
          fx::EpiMlaQ E{WSP(bf16_t, WS_QM), WSP(float, WS_SSQ_CQ), p->in[9], (const int*)p->in[2]};
          pg8::gemm_phase<fx::EpiMlaQ, fx::QupOrder>(lds, xl, 256, 256, 256, S, E); }
        { pg8::GridOrder S; S.init(WSP(bf16_t, WS_CKV), 256, WSP(bf16_t, WB_UKV), 256, T_TOK, 512, gridDim.x, blockIdx.x);
          fx::EpiMlaKV E{WSP(bf16_t, WS_KM), WSP(bf16_t, WS_VM), WSP(bf16_t, WS_CKV), WSP(float, WS_SSQ_CKV), WSP(float, WS_SSQ_KPE), p->in[10], p->in[7]};
          pg8::gemm_phase<fx::EpiMlaKV, pg8::GridOrder>(lds, xl, 256, 256, 128, S, E); } }
        REPS(201) rt::ret_kv_phase(WSP(bf16_t, WS_RK), WSP(bf16_t, WS_RV), WSP(bf16_t, WS_KVS), (char*)lds_raw);
    }
    SEAM(2);
    if (IN(3)) { { fx::VwOrder S{(int)gridDim.x, (int)blockIdx.x, (const char*)WSP(bf16_t, WB_CO), (const char*)WSP(bf16_t, WS_VC)};
                   fx::EpiStoreT E{WSP(bf16_t, WS_VWT), 1024, 1024 * 1024, 1.f, 0};
                   pg8::gemm_phase<fx::EpiStoreT, fx::VwOrder>(lds, xl, 1024, 1024, 256, S, E); }
                 REPS(302) rt::ret_scan_phase(WSP(bf16_t, WS_KVS), WSP(bf16_t, WS_STS), (int)blockIdx.x, (int)gridDim.x);
                 unsigned* const scan_cnt = WSP(unsigned, 48 * 1024);
                 asm volatile("s_waitcnt vmcnt(0)" ::: "memory"); __syncthreads();
                 if (tid == 0) { __builtin_amdgcn_fence(__ATOMIC_RELEASE, "agent"); asm volatile("s_waitcnt vmcnt(0)" ::: "memory"); (void)xb_add(scan_cnt, 1u); }
                 _Pragma("nounroll") for (int pos = 0; pos < 2; ++pos) {
                     if ((int)((blockIdx.x >> 3) & 1) == pos) expert_prep(p, lds, wave, lane);
                     if (pos == 0) at::attn_phase(WSP(bf16_t, WS_QM), WSP(bf16_t, WS_KM), WSP(bf16_t, WS_VM), WSP(bf16_t, WS_AO), (char*)lds_raw); }
                 asm volatile("s_waitcnt vmcnt(0)" ::: "memory"); __syncthreads();
                 if (tid == 0) { XB_SPIN(xb_ld(scan_cnt) < gridDim.x, WSP(unsigned, WS_BAR)); __builtin_amdgcn_fence(__ATOMIC_ACQUIRE, "agent"); asm volatile("s_waitcnt vmcnt(0)" ::: "memory"); }
                 __syncthreads();
                 REPS(301) rt::ret_out_phase(WSP(bf16_t, WS_RQ), WSP(bf16_t, WS_RK), WSP(bf16_t, WS_RV), WSP(bf16_t, WS_RG), WSP(bf16_t, WS_STS), p->in[11], WSP(bf16_t, WS_AO), (char*)lds_raw); }
    SEAM(3);
    if (IN(4)) for (int rep = 0; rep < ((DUP == 4 || DUP == 1004 + 1000) ? 2 : 1); ++rep) {
        pg8::GridOrder S; S.init(WSP(bf16_t, WS_AO), 1024, WSP(bf16_t, WB_OUT), 1024, T_TOK, 1024, gridDim.x, blockIdx.x);
        fx::EpiResid<false, false> E{p->in[0], nullptr, WSP(bf16_t, WS_XB), rep ? ((DUP == 4) ? dummyf : (float*)nullptr) : WSP(float, WS_SSQ1)};
        pg8::gemm_phase<fx::EpiResid<false, false>, pg8::GridOrder>(lds, xl, 1024, 1024, 1024, S, E);
    }
    SEAM(4);
#define LOCAL_SEAM() do { asm volatile("s_waitcnt vmcnt(0)" ::: "memory"); __syncthreads(); if (tid == 0) { __builtin_amdgcn_fence(__ATOMIC_ACQUIRE, "agent"); asm volatile("s_waitcnt vmcnt(0)" ::: "memory"); } __syncthreads(); } while (0)
    if (IN(5)) REPS(5) {
        fx::HeadOrder S{(int)gridDim.x, (int)blockIdx.x, 512, (const char*)WSP(bf16_t, WS_XB), (const char*)WSP(bf16_t, WB_CQ), (size_t)256 * 1024 * 2, 0, 0, (size_t)256 * 1024 * 2};
        fx::EpiHeadNorm E{WSP(bf16_t, WS_QC), WSP(float, WS_SSQ1), p->in[17], 1.f / 1024.f};
        pg8::gemm_phase<fx::EpiHeadNorm, fx::HeadOrder>(lds, xl, 1024, 1024, 1024, S, E);
    }
    if (IN(5) && IN(6) && gridDim.x == 256) LOCAL_SEAM(); else SEAM(5);
    if (IN(6)) REPS(6) {
        fx::HeadOrder S{(int)gridDim.x, (int)blockIdx.x, 512, (const char*)WSP(bf16_t, WS_QC), (const char*)WSP(bf16_t, WS_KC), (size_t)256 * 1024 * 2, (size_t)256 * 2, (size_t)256 * 1024 * 2, (size_t)256 * 2};
        fx::EpiSoftmax E{WSP(bf16_t, WS_PC)};
        pg8::gemm_phase<fx::EpiSoftmax, fx::HeadOrder>(lds, xl, 1024, 1024, 256, S, E);
    }
    SEAM(6);
#undef LOCAL_SEAM
    if (IN(8)) {
        fx::CrossOOrder S; S.g.init(WSP(bf16_t, WS_PC), 1024, WSP(bf16_t, WS_VWT), 1024, T_TOK, 1024, gridDim.x, blockIdx.x); S.VWT = (const char*)WSP(bf16_t, WS_VWT);
        fx::EpiResid<true, false> E{nullptr, nullptr, WSP(bf16_t, WS_XB), WSP(float, WS_SSQ2)};
        pg8::gemm_phase<fx::EpiResid<true, false>, fx::CrossOOrder>(lds, xl, 1024, 1024, 1024, S, E);
    }
    SEAM(8);
    if (IN(9)) REPS(9) { router_phase(p, lds, wave, lane, rep ? WSP(int, 32 * 1024) : WSP(int, WS_CNT), rep ? WSP(int, WS_AO) : WSP(int, WS_LISTS), rep ? WSP(float, WS_AO + 8 * MiB) : WSP(float, WS_ROWW), WSP(float, WS_ROWW + 8 * MiB)); }
    SEAM(9);
    if (IN(10)) for (int rep = 0; rep < ((DUP == 10 || DUP == 2010 || DUP == 3010) ? 2 : 1); ++rep) {
        fx::MoeOrder S{(int)gridDim.x, (int)blockIdx.x, 0, 64, 2, WSP(int, WS_CNT), WSP(int, WS_LISTS), (const char*)WSP(bf16_t, WS_XB), (const char*)WSP(bf16_t, WB_GU), (DUP == 3010 && rep) ? (size_t)256 * 1024 * 2 : 0, (size_t)512 * 1024 * 2, (size_t)256 * 1024 * 2, nullptr}; S.init(xl);
        fx::EpiGlu E{(rep && DUP != 10) ? (bf16_t*)nullptr : WSP(bf16_t, WS_H), WSP(float, WS_ROWW + 8 * MiB), WSP(float, WS_ROWW), WSP(int, WS_LISTS)};
        if (DUP == 3010 && rep) pg8::gemm_phase<fx::EpiGlu, fx::MoeOrder, false>(lds, xl, 1024, 1024, 1024, S, E);
        else pg8::gemm_phase<fx::EpiGlu, fx::MoeOrder, true>(lds, xl, 1024, 1024, 1024, S, E);
    }
    SEAM(10);
    if (IN(11)) {
        fx::MoeOrder S{(int)gridDim.x, (int)blockIdx.x, 0, 32, 4, WSP(int, WS_CNT), WSP(int, WS_LISTS), (const char*)WSP(bf16_t, WS_H), (const char*)WSP(bf16_t, WB_D), (size_t)256 * 256 * 2, (size_t)1024 * 256 * 2, (size_t)256 * 256 * 2, nullptr}; S.init(xl);
        fx::EpiScatter<0> E{p->out, WSP(bf16_t, WS_XB)};
        pg8::gemm_phase<fx::EpiScatter<0>, fx::MoeOrder>(lds, xl, 256, 256, 256, S, E);
    }
    SEAM(11);
    if (IN(12)) {
        fx::MoeOrder S{(int)gridDim.x, (int)blockIdx.x, 32, 64, 4, WSP(int, WS_CNT), WSP(int, WS_LISTS), (const char*)WSP(bf16_t, WS_H), (const char*)WSP(bf16_t, WB_D), (size_t)256 * 256 * 2, (size_t)1024 * 256 * 2, (size_t)256 * 256 * 2, nullptr}; S.init(xl);
        fx::EpiScatter<1> E{p->out, WSP(bf16_t, WS_XB)};
        pg8::gemm_phase<fx::EpiScatter<1>, fx::MoeOrder>(lds, xl, 256, 256, 256, S, E);
    }
#undef IN
#undef SEAM
}

extern "C" void kernel_launch(void* const* d_in, const int* in_sizes, int n_in, void* d_out, int out_size, void* d_ws, size_t ws_size, hipStream_t stream) {
    static int grid = 0;
    if (grid == 0) {
        if (n_in != 28 || out_size != T_TOK * 1024 || ws_size < WS_NEED) { fprintf(stderr, "kernel_launch: unexpected shapes n_in %d out %d ws %zu\n", n_in, out_size, ws_size); grid = -1; return; }
        int dev = 0, cus = 0, per_cu = 0;
        if (hipGetDevice(&dev) != hipSuccess || hipDeviceGetAttribute(&cus, hipDeviceAttributeMultiprocessorCount, dev) != hipSuccess) { grid = -1; return; }
        if (hipFuncSetAttribute((const void*)mk_fwd, hipFuncAttributeMaxDynamicSharedMemorySize, LDS_BYTES) != hipSuccess) { fprintf(stderr, "hipFuncSetAttribute failed\n"); grid = -1; return; }
        if (hipOccupancyMaxActiveBlocksPerMultiprocessor(&per_cu, (const void*)mk_fwd, NWAVES * 64, LDS_BYTES) != hipSuccess || per_cu < 1) { fprintf(stderr, "occupancy query failed (%d)\n", per_cu); grid = -1; return; }
        grid = cus;
        (void)hipGetLastError();
    }
    if (grid < 0) return;
    if (hipMemsetAsync(d_ws, 0, 65536, stream) != hipSuccess) { fprintf(stderr, "hipMemsetAsync failed\n"); return; }
    Params p; memset(&p, 0, sizeof(p));
    for (int i = 0; i < 28; ++i) p.in[i] = (const float*)d_in[i];
    p.out = (float*)d_out; p.ws = (unsigned char*)d_ws; p.ph_lo = 0; p.ph_hi = 13; p.coop = 1;
#if defined(DUP) && DUP == 1
    p.pad = 1;
#endif
    void* args[] = {&p};
    hipError_t e = hipLaunchCooperativeKernel((const void*)mk_fwd, dim3(grid), dim3(NWAVES * 64), args, LDS_BYTES, stream);
    if (e != hipSuccess) fprintf(stderr, "cooperative launch failed: %s (grid %d)\n", hipGetErrorString(e), grid);
}
```
